# Optimizing an MI355X kernel written in HIP

```python
import math
import jax, jax.numpy as jnp
from jax import lax
import numpy as np

D_MODEL = 2048
BATCH = 2
SEQ = 4096
DEPTH = 1

ATT_HEADS = 8
ATT_QK_DIM = 64
ATT_V_DIM = 2 * ATT_QK_DIM
ATT_WIDTH = ATT_HEADS * ATT_V_DIM
ROPE_DIM = ATT_QK_DIM // 4
ROPE_THETA = 500000.0
Q_BLOCK = 128
RWKV_HEAD = 64
RWKV_WIDTH = D_MODEL // 2
RWKV_HEADS = RWKV_WIDTH // RWKV_HEAD
DECAY_RANK = 64
ICLR_RANK = 64
GATE_RANK = 128
QK_COLS = ATT_HEADS * 2 * ATT_QK_DIM
ATT_COLS = 2 * QK_COLS + ATT_WIDTH
RWKV_COLS = 3 * RWKV_WIDTH + DECAY_RANK + ICLR_RANK + GATE_RANK
GATE_COLS = 2 * D_MODEL
IN_COLS = ATT_COLS + RWKV_COLS + GATE_COLS
N_GROUPS = 8
EXPERTS_PER_GROUP = 8
N_EXPERTS = N_GROUPS * EXPERTS_PER_GROUP
EXPERT_FF = D_MODEL // 2
TOP_K = 2
EXPERT_BLOCK = 128
NORM_EPS = 1e-6
SUBLN_EPS = 1e-5
LNX_EPS = 64e-5

kernel_name = "hybrid_diffattn_rwkv7_hmoe"


def rmsnorm(x, g, eps=NORM_EPS):
    xf = x.astype(jnp.float32)
    y = xf * lax.rsqrt(jnp.mean(xf * xf, axis=-1, keepdims=True) + eps)
    return (y * g).astype(x.dtype)


def rope_partial(t, positions):
    half = ROPE_DIM // 2
    inv = ROPE_THETA ** (-jnp.arange(half, dtype=jnp.float32) / half)
    ang = positions.astype(jnp.float32)[..., None] * inv
    cos = jnp.cos(ang)[:, :, None, None, :]
    sin = jnp.sin(ang)[:, :, None, None, :]
    t1 = t[..., :half].astype(jnp.float32)
    t2 = t[..., half:ROPE_DIM].astype(jnp.float32)
    rot = jnp.concatenate([t1 * cos - t2 * sin, t1 * sin + t2 * cos], axis=-1).astype(t.dtype)
    return jnp.concatenate([rot, t[..., ROPE_DIM:]], axis=-1)


def diff_attention(q, k, v, lam, lambda_init, subln_g):
    B, S, H = v.shape[:3]
    nqb = S // Q_BLOCK
    qb = (q * (ATT_QK_DIM ** -0.5)).reshape(B, nqb, Q_BLOCK, H, 2, ATT_QK_DIM).transpose(1, 0, 3, 4, 2, 5)
    kt = k.transpose(0, 2, 3, 1, 4)
    vt = v.transpose(0, 2, 1, 3)
    kpos = jnp.arange(S)

    def one_block(args):
        qblk, i = args
        s = jnp.einsum('bhcqd,bhckd->bhcqk', qblk, kt, preferred_element_type=jnp.float32)
        qpos = i * Q_BLOCK + jnp.arange(Q_BLOCK)
        s = jnp.where(kpos[None, :] <= qpos[:, None], s, -jnp.inf)
        p = jax.nn.softmax(s, axis=-1)
        a = p[:, :, 0] - lam * p[:, :, 1]
        return jnp.einsum('bhqk,bhkd->bhqd', a.astype(vt.dtype), vt)

    o = lax.map(one_block, (qb, jnp.arange(nqb)))
    o = o.transpose(1, 0, 3, 2, 4).reshape(B, S, H, ATT_V_DIM)
    o = rmsnorm(o, subln_g, SUBLN_EPS) * (1.0 - lambda_init)
    return o.reshape(B, S, ATT_WIDTH)


def rwkv7_timemix(p, mu, w0, w2, a0, a2, g2, k_k, k_a, r_k, lnx_g, lnx_b):
    B, S, _ = p.shape
    f32 = jnp.float32
    prev = jnp.pad(p[:, :-1], ((0, 0), (1, 0), (0, 0)))
    p = p + (prev - p) * mu
    splits = [RWKV_WIDTH, 2 * RWKV_WIDTH, 3 * RWKV_WIDTH, 3 * RWKV_WIDTH + DECAY_RANK,
              3 * RWKV_WIDTH + DECAY_RANK + ICLR_RANK]
    r, k, v, wl, al, gl = jnp.split(p, splits, axis=-1)
    w_log = -jax.nn.softplus(-(w0 + jnp.tanh(wl) @ w2)) - 0.5
    decay = jnp.exp(-jnp.exp(w_log.astype(f32)))
    a = jax.nn.sigmoid(a0 + al @ a2)
    g = jax.nn.sigmoid(gl) @ g2
    heads = lambda t: t.reshape(B, S, RWKV_HEADS, RWKV_HEAD)
    kk = heads(k * k_k).astype(f32)
    kk = kk * lax.rsqrt(jnp.maximum(jnp.sum(kk * kk, axis=-1, keepdims=True), 1e-24))
    k = k * (1.0 + (a - 1.0) * k_a)
    rh, dh, kh, vh, ah = (heads(t).astype(f32) for t in (r, decay, k, v, a))
    xs = tuple(t.transpose(1, 0, 2, 3) for t in (rh, dh, kh, vh, -kk, kk * ah))

    def step(state, inp):
        r_t, w_t, k_t, v_t, a_t, b_t = inp
        sa = jnp.einsum('bhvk,bhk->bhv', state, a_t)
        state = state * w_t[:, :, None, :] + sa[..., None] * b_t[:, :, None, :] + v_t[..., None] * k_t[:, :, None, :]
        return state, jnp.einsum('bhvk,bhk->bhv', state, r_t)

    s0 = jnp.zeros((B, RWKV_HEADS, RWKV_HEAD, RWKV_HEAD), f32)
    _, ys = lax.scan(step, s0, xs)
    y = ys.transpose(1, 0, 2, 3)
    mean = jnp.mean(y, axis=-1, keepdims=True)
    var = jnp.mean(jnp.square(y - mean), axis=-1, keepdims=True)
    y = ((y - mean) * lax.rsqrt(var + LNX_EPS)).reshape(B, S, RWKV_WIDTH) * lnx_g + lnx_b
    bonus = jnp.sum(rh * kh * r_k, axis=-1, keepdims=True) * vh
    y = (y + bonus.reshape(B, S, RWKV_WIDTH)) * g
    return y.astype(p.dtype)


def hier_moe(h, w_rg, b_rg, w_re, b_re, w_gate, w_up, w_down):
    B, S, D = h.shape
    N = B * S
    f32 = jnp.float32
    hf = h.reshape(N, D)
    gprob = jax.nn.softmax((hf @ w_rg).astype(f32) + b_rg, axis=-1)
    gp, gidx = lax.top_k(gprob, 1)
    elog = ((hf @ w_re).astype(f32) + b_re).reshape(N, N_GROUPS, EXPERTS_PER_GROUP)
    elog = jnp.take_along_axis(elog, gidx[:, :, None], axis=1)[:, 0]
    ep, eidx = lax.top_k(jax.nn.softmax(elog, axis=-1), TOP_K)
    ew = (gp * ep / jnp.sum(ep, axis=-1, keepdims=True)).reshape(-1)
    expert_id = (gidx * EXPERTS_PER_GROUP + eidx).reshape(-1).astype(jnp.int32)
    flat_tok = jnp.repeat(jnp.arange(N, dtype=jnp.int32), TOP_K)
    A = N * TOP_K
    nblk = -(-A // EXPERT_BLOCK) + N_EXPERTS
    order = jnp.argsort(expert_id)
    se, stok, sw = expert_id[order], flat_tok[order], ew[order]
    counts = jnp.bincount(expert_id, length=N_EXPERTS).astype(jnp.int32)
    padded = (counts + EXPERT_BLOCK - 1) // EXPERT_BLOCK * EXPERT_BLOCK
    pad_end = jnp.cumsum(padded)
    pad_start = pad_end - padded
    start = jnp.cumsum(counts) - counts
    dest = pad_start[se] + jnp.arange(A, dtype=jnp.int32) - start[se]
    buf_tok = jnp.full((nblk * EXPERT_BLOCK,), N, jnp.int32).at[dest].set(stok)
    buf_w = jnp.zeros((nblk * EXPERT_BLOCK,), f32).at[dest].set(sw)
    blk_expert = jnp.minimum(jnp.searchsorted(pad_end, jnp.arange(nblk, dtype=jnp.int32) * EXPERT_BLOCK, side='right'), N_EXPERTS - 1)
    h_pad = jnp.concatenate([hf, jnp.zeros((1, D), hf.dtype)], axis=0)

    def run_block(args):
        tok, e = args
        xb = h_pad[tok]
        u = jax.nn.silu(xb @ w_gate[e]) * (xb @ w_up[e])
        return u @ w_down[e]

    yb = lax.map(run_block, (buf_tok.reshape(nblk, EXPERT_BLOCK), blk_expert))
    yb = yb.reshape(-1, D).astype(f32) * buf_w[:, None]
    out = jnp.zeros((N + 1, D), f32).at[buf_tok].add(yb)[:N]
    return out.reshape(B, S, D).astype(h.dtype)


def setup_inputs(seed: int = 0) -> dict:
    key = jax.random.key(seed)
    ks = iter(jax.random.split(key, 48))
    L, D = DEPTH, D_MODEL
    nrm = lambda shape, scale: jax.random.normal(next(ks), shape, jnp.float32) * scale
    x = nrm((BATCH, SEQ, D), 1.0)
    c = nrm((BATCH, D), 1.0)
    positions = jax.random.randint(next(ks), (BATCH, 1), 0, 4096, dtype=jnp.int32) + jnp.arange(SEQ, dtype=jnp.int32)[None, :]
    return {
        'x': x, 'c': c, 'positions': positions,
        'ada_w': nrm((L, D, 6 * D), 0.5 * D ** -0.5),
        'ada_b': nrm((L, 6 * D), 0.02),
        'norm_mix_g': 1.0 + nrm((L, D), 0.02),
        'w_in': nrm((L, D, IN_COLS), D ** -0.5),
        'tshift_mu': jax.random.uniform(next(ks), (L, RWKV_COLS), jnp.float32, 0.0, 1.0),
        'lambda_q1': nrm((L, ATT_QK_DIM), 0.1),
        'lambda_k1': nrm((L, ATT_QK_DIM), 0.1),
        'lambda_q2': nrm((L, ATT_QK_DIM), 0.1),
        'lambda_k2': nrm((L, ATT_QK_DIM), 0.1),
        'subln_g': 1.0 + nrm((L, ATT_V_DIM), 0.02),
        'w0': jax.random.uniform(next(ks), (L, RWKV_WIDTH), jnp.float32, -4.0, 0.0),
        'w2': nrm((L, DECAY_RANK, RWKV_WIDTH), 0.1),
        'a0': nrm((L, RWKV_WIDTH), 0.1),
        'a2': nrm((L, ICLR_RANK, RWKV_WIDTH), 0.1),
        'g2': nrm((L, GATE_RANK, RWKV_WIDTH), GATE_RANK ** -0.5),
        'k_k': 0.85 + nrm((L, RWKV_WIDTH), 0.02),
        'k_a': 1.0 + nrm((L, RWKV_WIDTH), 0.02),
        'r_k': nrm((L, RWKV_HEADS, RWKV_HEAD), 0.1),
        'lnx_g': 1.0 + nrm((L, RWKV_WIDTH), 0.02),
        'lnx_b': nrm((L, RWKV_WIDTH), 0.02),
        'w_up_attn': nrm((L, ATT_WIDTH, D), ATT_WIDTH ** -0.5),
        'w_up_rwkv': nrm((L, RWKV_WIDTH, D), RWKV_WIDTH ** -0.5),
        'w_out': nrm((L, D, D), D ** -0.5),
        'norm_ffn_g': 1.0 + nrm((L, D), 0.02),
        'w_route_group': nrm((L, D, N_GROUPS), D ** -0.5),
        'b_route_group': nrm((L, N_GROUPS), 0.01),
        'w_route_expert': nrm((L, D, N_EXPERTS), D ** -0.5),
        'b_route_expert': nrm((L, N_EXPERTS), 0.01),
        'w_gate': nrm((L, N_EXPERTS, D, EXPERT_FF), D ** -0.5),
        'w_up': nrm((L, N_EXPERTS, D, EXPERT_FF), D ** -0.5),
        'w_down': nrm((L, N_EXPERTS, EXPERT_FF, D), EXPERT_FF ** -0.5),
        'final_g': 1.0 + nrm((D,), 0.02),
    }


def reference(x, c, positions, ada_w, ada_b, norm_mix_g, w_in, tshift_mu, lambda_q1, lambda_k1,
              lambda_q2, lambda_k2, subln_g, w0, w2, a0, a2, g2, k_k, k_a, r_k, lnx_g, lnx_b,
              w_up_attn, w_up_rwkv, w_out, norm_ffn_g, w_route_group, b_route_group,
              w_route_expert, b_route_expert, w_gate, w_up, w_down, final_g):
    B, S, D = x.shape
    f32 = jnp.float32
    h = x
    for l in range(DEPTH):
        ada = jax.nn.silu(c) @ ada_w[l] + ada_b[l]
        sh1, sc1, gt1, sh2, sc2, gt2 = [t[:, None, :] for t in jnp.split(ada, 6, axis=-1)]
        u = rmsnorm(h, norm_mix_g[l]) * (1.0 + sc1) + sh1
        proj = u @ w_in[l]
        p_att, p_rwkv, p_gate = jnp.split(proj, [ATT_COLS, ATT_COLS + RWKV_COLS], axis=-1)
        q, k, v = jnp.split(p_att, [QK_COLS, 2 * QK_COLS], axis=-1)
        q = rope_partial(q.reshape(B, S, ATT_HEADS, 2, ATT_QK_DIM), positions)
        k = rope_partial(k.reshape(B, S, ATT_HEADS, 2, ATT_QK_DIM), positions)
        v = v.reshape(B, S, ATT_HEADS, ATT_V_DIM)
        lambda_init = 0.8 - 0.6 * math.exp(-0.3 * l)
        lam = (jnp.exp(jnp.sum(lambda_q1[l] * lambda_k1[l]).astype(f32))
               - jnp.exp(jnp.sum(lambda_q2[l] * lambda_k2[l]).astype(f32)) + lambda_init)
        y_att = diff_attention(q, k, v, lam, lambda_init, subln_g[l])
        y_rwkv = rwkv7_timemix(p_rwkv, tshift_mu[l], w0[l], w2[l], a0[l], a2[l], g2[l],
                               k_k[l], k_a[l], r_k[l], lnx_g[l], lnx_b[l])
        g_att, g_rwkv = jnp.split(jax.nn.sigmoid(p_gate), 2, axis=-1)
        merged = g_att * (y_att @ w_up_attn[l]) + g_rwkv * (y_rwkv @ w_up_rwkv[l])
        h = h + gt1 * (merged @ w_out[l])
        u2 = rmsnorm(h, norm_ffn_g[l]) * (1.0 + sc2) + sh2
        h = h + gt2 * hier_moe(u2, w_route_group[l], b_route_group[l], w_route_expert[l],
                               b_route_expert[l], w_gate[l], w_up[l], w_down[l])
    return rmsnorm(h, final_g)
```

```cpp
#include <hip/hip_runtime.h>
#include <hip/hip_bf16.h>
#include <cstdio>
#include <cstdint>
#include <cmath>
namespace pg8 {
#define PG8_LAS __attribute__((address_space(3)))
typedef unsigned short bf16_t;
typedef short bf16x8 __attribute__((ext_vector_type(8)));
typedef float f32x4 __attribute__((ext_vector_type(4)));
typedef unsigned u32x4 __attribute__((ext_vector_type(4)));
constexpr int BM = 256, BK = 64, HALF = 128, HTB = HALF * BK * 2  , STAGE_BYTES = 8 * HTB, NXCD = 8, WGM = 8;

__host__ __device__ __forceinline__ int lds_byte(int r, int c) { const int st = (r >> 4) * 2 + (c >> 5), rr = r & 15, cc = c & 31, ob = rr * 64 + cc * 2; return st * 1024 + (ob ^ (((ob >> 9) & 1) << 5)); }
__host__ __device__ __forceinline__ void stage_rc(int b, int& R, int& C) { const int st = b / 1024, sb = b % 1024, swz = sb ^ (((sb >> 9) & 1) << 5); R = (st >> 1) * 16 + swz / 64; C = (st & 1) * 32 + (swz % 64) / 2; }
__host__ __device__ __forceinline__ int perm32(int rho) { const int n = rho >> 4, i = rho & 15; return 8 * (i >> 2) + 4 * n + (i & 3); }

struct Unit { int pm, pn; };
struct Gemm { const bf16_t* A; const bf16_t* Bt; int M, N, K; };

struct StaticOrder {
    int nM, nN, nwg, G, c;
    __host__ __device__ void init(int M, int N, int G_, int c_) { nM = M / BM; nN = N / BM; nwg = nM * nN; G = G_; c = c_; }
    __host__ __device__ bool next(int i, Unit& u) const {
        const long L = (long)i * G + c; if (L >= nwg) return false;
        int wgid = (int)L; { const int q = nwg / NXCD, r = nwg % NXCD, xcd = wgid % NXCD, off = wgid / NXCD; wgid = (xcd < r ? xcd * (q + 1) : r * (q + 1) + (xcd - r) * q) + off; }
        const int nig = WGM * nN, gid = wgid / nig, fm = gid * WGM, gsz = (nM - fm) < WGM ? (nM - fm) : WGM;
        u.pm = fm + ((wgid % nig) % gsz); u.pn = (wgid % nig) / gsz; return true;
    }
    __device__ __forceinline__ void a_ready(const Unit&) const {}
    __device__ __forceinline__ void done(const Unit&) const {}
};

__device__ __forceinline__ unsigned cvt_pk_bf16(float lo, float hi) { unsigned r; asm volatile("v_cvt_pk_bf16_f32 %0, %1, %2" : "=v"(r) : "v"(lo), "v"(hi)); return r; }
typedef float f32x2 __attribute__((ext_vector_type(2)));
__device__ __forceinline__ f32x2 gelu_pk(f32x2 v) {
    const f32x2 av = __builtin_elementwise_abs(v), d = av * 0.2316418882f + 1.0f;
    f32x2 t; t.x = __builtin_amdgcn_rcpf(d.x); t.y = __builtin_amdgcn_rcpf(d.y);
    f32x2 q = t * 0.5307027145f + (-0.7265760135f); q = q * t + 0.7107068705f; q = q * t + (-0.142248368f); q = q * t + 0.127414796f; q = q * t;
    const f32x2 s = (v * v) * (-0.72134752044f);
    f32x2 e; e.x = __builtin_amdgcn_exp2f(s.x); e.y = __builtin_amdgcn_exp2f(s.y);
    const f32x2 m = v * (q * e), r = v - m;
    f32x2 o; o.x = v.x < 0.f ? m.x : r.x; o.y = v.y < 0.f ? m.y : r.y; return o;
}


template <class Epi, class Sched, bool ALIGN_EPI = false, bool SP2 = false>
__device__ __forceinline__ void gemm_phase(PG8_LAS unsigned char* lds, const Gemm g, const Sched& S, const Epi& E) {
    const int tid = threadIdx.x, wid = __builtin_amdgcn_readfirstlane(tid >> 6), lane = tid & 63, wr = wid >> 2, wc = wid & 3, fr = lane & 15, fq = lane >> 4;
    const int K = g.K, nt = K / BK;
    unsigned voffA[2], voffB[2];
#pragma unroll
    for (int i = 0; i < 2; ++i) { int R, C; stage_rc(tid * 16 + i * 8192, R, C); const int Rb = Epi::PERM ? ((R & ~31) + perm32(R & 31)) : R;
        voffA[i] = (unsigned)(R * K + C) * 2u; voffB[i] = (unsigned)(Rb * K + C) * 2u; }
    const size_t kstep = (size_t)(BK * 2);
    const size_t hstep = (size_t)HALF * K * 2;
    const size_t tstep = 2 * hstep;
    const unsigned ldsw = (unsigned)wid * 1024u;
    const int aoff = lds_byte(wr * 64 + fr, fq * 8), boff = lds_byte(wc * 32 + fr, fq * 8);
#define PG8_SA(b, h) (((b) * 2 + (h)) * HTB)
#define PG8_SB(b, h) ((4 + (b) * 2 + (h)) * HTB)
#define PG8_STAGE(bufoff, gbase, voff) do { _Pragma("unroll") for (int _i = 0; _i < 2; ++_i) \
        __builtin_amdgcn_global_load_lds((const unsigned*)((const char*)(gbase) + (voff)[_i]), (PG8_LAS unsigned*)(lds + (bufoff) + ldsw + _i * 8192), 16, 0, 0); } while (0)
#define PG8_LDA(dst, b, h) do { _Pragma("unroll") for (int m = 0; m < 4; ++m) _Pragma("unroll") for (int k = 0; k < 2; ++k) dst[m][k] = *(const PG8_LAS bf16x8*)(lds + PG8_SA(b, h) + aoff + m * 2048 + k * 1024); } while (0)
#define PG8_LDB(dst, b, h) do { _Pragma("unroll") for (int n = 0; n < 2; ++n) _Pragma("unroll") for (int k = 0; k < 2; ++k) dst[n][k] = *(const PG8_LAS bf16x8*)(lds + PG8_SB(b, h) + boff + n * 2048 + k * 1024); } while (0)
#define PG8_MMA(ai, bj, At, Bt) do { __builtin_amdgcn_s_setprio(1); _Pragma("unroll") for (int m = 0; m < 4; ++m) _Pragma("unroll") for (int n = 0; n < 2; ++n) _Pragma("unroll") for (int k = 0; k < 2; ++k) \
        acc[ai][bj][m][n] = __builtin_amdgcn_mfma_f32_16x16x32_bf16(Bt[n][k], At[m][k], acc[ai][bj][m][n], 0, 0, 0); __builtin_amdgcn_s_setprio(0); } while (0)
#define PG8_WAIT_V(n) asm volatile("s_waitcnt vmcnt(" #n ")" ::: "memory")
#define PG8_WAIT_L(n) asm volatile("s_waitcnt lgkmcnt(" #n ")" ::: "memory")
#define PG8_BAR __builtin_amdgcn_s_barrier()
#define PG8_SCHED __builtin_amdgcn_sched_barrier(0)
    Unit cur, nxt; int ui = 0;
    if (!S.next(0, cur)) return;
    f32x4 acc[2][2][4][2];
#pragma unroll
    for (int a = 0; a < 2; ++a)
#pragma unroll
        for (int b = 0; b < 2; ++b)
#pragma unroll
            for (int m = 0; m < 4; ++m)
#pragma unroll
                for (int n = 0; n < 2; ++n) acc[a][b][m][n] = (f32x4){0.f, 0.f, 0.f, 0.f};
    bf16x8 At[4][2], B0[2][2], B1[2][2];
    const char* cA = (const char*)g.A + (size_t)cur.pm * tstep; const char* cB = (const char*)g.Bt + (size_t)cur.pn * tstep;
    S.a_ready(cur);
    if constexpr (SP2) {
        PG8_STAGE(PG8_SB(0, 0), cB, voffB); PG8_STAGE(PG8_SB(0, 1), cB + hstep, voffB); PG8_STAGE(PG8_SA(0, 0), cA, voffA); PG8_STAGE(PG8_SA(0, 1), cA + hstep, voffA);
        if (wr == 1) PG8_BAR;
        PG8_WAIT_V(2); PG8_BAR;
        PG8_STAGE(PG8_SB(1, 0), cB + kstep, voffB); PG8_STAGE(PG8_SA(1, 0), cA + kstep, voffA); PG8_STAGE(PG8_SB(1, 1), cB + hstep + kstep, voffB);
        PG8_WAIT_V(6); PG8_BAR;
    } else {
        PG8_STAGE(PG8_SB(0, 0), cB, voffB); PG8_STAGE(PG8_SA(0, 0), cA, voffA); PG8_STAGE(PG8_SB(0, 1), cB + hstep, voffB); PG8_STAGE(PG8_SA(0, 1), cA + hstep, voffA);
        if (wr == 1) PG8_BAR;
        PG8_WAIT_V(4); PG8_BAR;
        PG8_STAGE(PG8_SB(1, 0), cB + kstep, voffB); PG8_STAGE(PG8_SA(1, 0), cA + kstep, voffA); PG8_STAGE(PG8_SB(1, 1), cB + hstep + kstep, voffB);
        PG8_WAIT_V(6); PG8_BAR;
    }
    for (;;) {
        const bool has_next = S.next(ui + 1, nxt);
        const char* nA = has_next ? (const char*)g.A + (size_t)nxt.pm * tstep : cA; const char* nB = has_next ? (const char*)g.Bt + (size_t)nxt.pn * tstep : cB;
        for (int t = 0; t < nt; t += 2) {
            const bool last = (t == nt - 2);
            const char* a1 = cA + (size_t)(t + 1) * kstep;
            const char* a2 = last ? nA : cA + (size_t)(t + 2) * kstep; const char* b2 = last ? nB : cB + (size_t)(t + 2) * kstep;
            const char* a3 = a2 + kstep; const char* b3 = b2 + kstep;
            if (last && has_next) S.a_ready(nxt);
            if constexpr (SP2) {
            PG8_LDB(B0, 0, 0); PG8_LDB(B1, 0, 1); PG8_SCHED; PG8_LDA(At, 0, 0); PG8_STAGE(PG8_SA(1, 1), a1 + hstep, voffA);
            PG8_WAIT_V(8); PG8_WAIT_L(0); PG8_BAR; PG8_MMA(0, 0, At, B0); PG8_MMA(0, 1, At, B1); PG8_BAR; PG8_SCHED;
            PG8_LDA(At, 0, 1); PG8_STAGE(PG8_SB(0, 0), b2, voffB); PG8_STAGE(PG8_SB(0, 1), b2 + hstep, voffB); PG8_STAGE(PG8_SA(0, 0), a2, voffA);
            PG8_WAIT_V(8); PG8_WAIT_L(0); PG8_BAR; PG8_MMA(1, 0, At, B0); PG8_MMA(1, 1, At, B1); PG8_BAR; PG8_SCHED;
            PG8_LDB(B0, 1, 0); PG8_LDB(B1, 1, 1); PG8_SCHED; PG8_LDA(At, 1, 0); PG8_STAGE(PG8_SA(0, 1), a2 + hstep, voffA);
            PG8_WAIT_V(8); PG8_WAIT_L(0); PG8_BAR; PG8_MMA(0, 0, At, B0); PG8_MMA(0, 1, At, B1); PG8_BAR; PG8_SCHED;
            PG8_LDA(At, 1, 1); PG8_STAGE(PG8_SB(1, 0), b3, voffB); PG8_STAGE(PG8_SB(1, 1), b3 + hstep, voffB); PG8_STAGE(PG8_SA(1, 0), a3, voffA);
            PG8_WAIT_V(8); PG8_WAIT_L(0); PG8_BAR; PG8_MMA(1, 0, At, B0); PG8_MMA(1, 1, At, B1); PG8_BAR; PG8_SCHED;
            } else {
            PG8_LDB(B0, 0, 0); PG8_SCHED; PG8_LDA(At, 0, 0); PG8_STAGE(PG8_SA(1, 1), a1 + hstep, voffA);
            PG8_WAIT_L(8); PG8_BAR; PG8_WAIT_L(0); PG8_MMA(0, 0, At, B0); PG8_BAR; PG8_SCHED;
            PG8_LDB(B1, 0, 1); PG8_STAGE(PG8_SB(0, 0), b2, voffB);
            PG8_BAR; PG8_WAIT_L(0); PG8_MMA(0, 1, At, B1); PG8_BAR;
            PG8_LDA(At, 0, 1); PG8_STAGE(PG8_SA(0, 0), a2, voffA);
            PG8_BAR; PG8_WAIT_L(0); PG8_MMA(1, 0, At, B0); PG8_BAR; PG8_SCHED;
            PG8_STAGE(PG8_SB(0, 1), b2 + hstep, voffB);
            PG8_WAIT_V(6); PG8_BAR; PG8_MMA(1, 1, At, B1); PG8_BAR;
            PG8_LDB(B0, 1, 0); PG8_SCHED; PG8_LDA(At, 1, 0); PG8_STAGE(PG8_SA(0, 1), a2 + hstep, voffA);
            PG8_WAIT_L(8); PG8_BAR; PG8_WAIT_L(0); PG8_MMA(0, 0, At, B0); PG8_BAR; PG8_SCHED;
            PG8_LDB(B1, 1, 1); PG8_STAGE(PG8_SB(1, 0), b3, voffB);
            PG8_BAR; PG8_WAIT_L(0); PG8_MMA(0, 1, At, B1); PG8_BAR;
            PG8_LDA(At, 1, 1); PG8_STAGE(PG8_SA(1, 0), a3, voffA);
            PG8_BAR; PG8_WAIT_L(0); PG8_MMA(1, 0, At, B0); PG8_BAR; PG8_SCHED;
            PG8_STAGE(PG8_SB(1, 1), b3 + hstep, voffB);
            PG8_WAIT_V(6); PG8_BAR; PG8_MMA(1, 1, At, B1); PG8_BAR;
            }
        }
        if constexpr (ALIGN_EPI) { if (wr == 0) PG8_BAR; }
        if constexpr (!Epi::AFTER_DRAIN) { E(acc, cur, wr, wc, fr, fq); S.done(cur); }
        if (!has_next) break;
#pragma unroll
        for (int a = 0; a < 2; ++a)
#pragma unroll
            for (int b = 0; b < 2; ++b)
#pragma unroll
                for (int m = 0; m < 4; ++m)
#pragma unroll
                    for (int n = 0; n < 2; ++n) acc[a][b][m][n] = (f32x4){0.f, 0.f, 0.f, 0.f};
        cur = nxt; cA = nA; cB = nB; ++ui;
        if constexpr (ALIGN_EPI) { if (wr == 1) PG8_BAR; }
    }
    PG8_WAIT_V(0);
    if constexpr (!ALIGN_EPI) { if (wr == 0) PG8_BAR; }
    PG8_BAR;
    if constexpr (Epi::AFTER_DRAIN) { E.fused(acc, cur, wr, wc, fr, fq, lds, wid, lane); S.done(cur); }
#undef PG8_SA
#undef PG8_SB
#undef PG8_STAGE
#undef PG8_LDA
#undef PG8_LDB
#undef PG8_MMA
#undef PG8_WAIT_V
#undef PG8_WAIT_L
#undef PG8_BAR
#undef PG8_SCHED
}
}

#ifndef PG8_SP2
#define PG8_SP2 true
#endif
#ifndef PG8_ALIGN
#define PG8_ALIGN true
#endif

namespace attn_body {
using bf16=__hip_bfloat16;
using bf16x8=__attribute__((ext_vector_type(8)))short;
using s16x4=__attribute__((ext_vector_type(4)))short;
using f32x16=__attribute__((ext_vector_type(16)))float;
using u32x4=__attribute__((ext_vector_type(4)))unsigned;
constexpr int BATCH=2,NHEAD=16,SEQ=4096,D=64,DM=NHEAD*D;
constexpr int NW=8,QBLK=32,QB=QBLK*NW,KVBLK=64,NQB=SEQ/QB;
constexpr int ATTN_PITCH=DM, ATTN_UNIT_ROWS=QB;
__device__ __forceinline__ int crow(int r,int hi){return (r&3)+8*(r>>2)+4*hi;}
#define SBAR() __builtin_amdgcn_sched_barrier(0)
__device__ __forceinline__ void cmask(f32x16&p0,f32x16&p1,int jb,int qrel,int hi){
  const float NEG=-INFINITY; int kb=64*jb+4*hi;
  #pragma unroll
  for(int r=0;r<16;++r){int kv=kb+(r&3)+8*(r>>2); if(kv>qrel)p0[r]=NEG; if(kv+32>qrel)p1[r]=NEG;}
}

constexpr int NSLOT=3, SLOTB=8192;
constexpr int LDS_K=0, LDS_V=NSLOT*SLOTB, LDS_WS=2*NSLOT*SLOTB, LDS_OST=LDS_WS+NW*64*4, LDS_BYTES=LDS_OST+NW*4096;
constexpr float C2=0.125f*1.4426950408889634f;
__device__ __forceinline__ void glds16(const void*gsrc,unsigned lds_dst){unsigned keep;
  asm volatile("s_mov_b32 %0, m0\n\ts_mov_b32 m0, %2\n\ts_nop 0\n\tglobal_load_lds_dwordx4 %1, off\n\ts_mov_b32 m0, %0":"=&s"(keep):"v"(gsrc),"s"(lds_dst):"memory");}
__device__ __forceinline__ float max3f(float a,float b,float c){float r;asm("v_max3_f32 %0, %1, %2, %3":"=v"(r):"v"(a),"v"(b),"v"(c));return r;}
__device__ __forceinline__ float max2f(float a,float b){float r;asm("v_max_f32_e32 %0, %1, %2":"=v"(r):"v"(a),"v"(b));return r;}
__device__ __forceinline__ float fadd_s(float a,float b){float r;asm("v_add_f32_e32 %0, %1, %2":"=v"(r):"v"(a),"v"(b));return r;}
__device__ __forceinline__ float fsub_s(float a,float b){float r;asm("v_sub_f32_e32 %0, %1, %2":"=v"(r):"v"(a),"v"(b));return r;}
typedef float f32x2_t __attribute__((ext_vector_type(2))); typedef __bf16 bf16x2_t __attribute__((ext_vector_type(2)));
__device__ __forceinline__ unsigned cvtpk_s(float lo,float hi){f32x2_t v={lo,hi};bf16x2_t b=__builtin_convertvector(v,bf16x2_t);return __builtin_bit_cast(unsigned,b);}
#define WAIT_BAR(N) asm volatile("s_waitcnt vmcnt(" #N ") lgkmcnt(0)\n\ts_barrier":::"memory")

__device__ __forceinline__ void qkt(f32x16&p0,f32x16&p1,const char*Kslot,const bf16x8*qr,const f32x16&negm,int r32,int hi){
  const char*kb=Kslot+hi*1024+r32*16;
  #pragma unroll
  for(int d0=0;d0<4;++d0){
    const bf16x8 b0=*reinterpret_cast<const bf16x8*>(kb+d0*2048);
    const bf16x8 b1=*reinterpret_cast<const bf16x8*>(kb+d0*2048+512);
    if(d0==0){p0=__builtin_amdgcn_mfma_f32_32x32x16_bf16(b0,qr[0],negm,0,0,0);p1=__builtin_amdgcn_mfma_f32_32x32x16_bf16(b1,qr[0],negm,0,0,0);}
    else{p0=__builtin_amdgcn_mfma_f32_32x32x16_bf16(b0,qr[d0],p0,0,0,0);p1=__builtin_amdgcn_mfma_f32_32x32x16_bf16(b1,qr[d0],p1,0,0,0);}}
}
typedef __attribute__((address_space(3))) const char* lds_cptr;
typedef short v4i16_t __attribute__((ext_vector_type(4)));
__device__ __forceinline__ void kload8(bf16x8*kf,lds_cptr kp){
  kf[0]=*(const __attribute__((address_space(3))) bf16x8*)(kp);      kf[1]=*(const __attribute__((address_space(3))) bf16x8*)(kp+512);
  kf[2]=*(const __attribute__((address_space(3))) bf16x8*)(kp+2048); kf[3]=*(const __attribute__((address_space(3))) bf16x8*)(kp+2560);
  kf[4]=*(const __attribute__((address_space(3))) bf16x8*)(kp+4096); kf[5]=*(const __attribute__((address_space(3))) bf16x8*)(kp+4608);
  kf[6]=*(const __attribute__((address_space(3))) bf16x8*)(kp+6144); kf[7]=*(const __attribute__((address_space(3))) bf16x8*)(kp+6656);
}
__device__ __forceinline__ void kload2(bf16x8*kf,lds_cptr kp,int j){ kf[2*j]=*(const __attribute__((address_space(3))) bf16x8*)(kp+j*2048); kf[2*j+1]=*(const __attribute__((address_space(3))) bf16x8*)(kp+j*2048+512); }
__device__ __forceinline__ s16x4 vtr(lds_cptr p){ return __builtin_bit_cast(s16x4,__builtin_amdgcn_ds_read_tr16_b64_v4i16((__attribute__((address_space(3))) v4i16_t*)p)); }
__device__ __forceinline__ float rowmax(const f32x16&p0,const f32x16&p1){
  float a=max3f(p0[0],p0[1],p1[0]),b=max3f(p0[2],p0[3],p1[1]);a=max3f(a,p1[2],p1[3]);
  #pragma unroll
  for(int r=4;r<16;r+=4){a=max3f(a,p0[r],p0[r+1]);b=max3f(b,p0[r+2],p0[r+3]);a=max3f(a,p1[r],p1[r+1]);b=max3f(b,p1[r+2],p1[r+3]);}
  const float m=max2f(a,b);
  auto rr=__builtin_amdgcn_permlane32_swap(__float_as_uint(m),__float_as_uint(m),false,false);
  return max2f(__uint_as_float(rr[0]),__uint_as_float(rr[1]));
}
__device__ __forceinline__ void pv(f32x16*o,int vb,bf16x8 pa0,bf16x8 pa1,bf16x8 pa2,bf16x8 pa3){
  #pragma unroll
  for(int d0=0;d0<2;++d0){s16x4 lo[4],hi[4];
    #pragma unroll
    for(int ks=0;ks<4;++ks){
      asm volatile("ds_read_b64_tr_b16 %0,%1 offset:%c2":"=&v"(lo[ks]):"v"(vb),"i"(d0*4096+ks*1024):"memory");
      asm volatile("ds_read_b64_tr_b16 %0,%1 offset:%c2":"=&v"(hi[ks]):"v"(vb),"i"(d0*4096+ks*1024+512):"memory");}
    asm volatile("s_waitcnt lgkmcnt(0)":::"memory");SBAR();
    #define PK(k) (bf16x8){lo[k][0],lo[k][1],lo[k][2],lo[k][3],hi[k][0],hi[k][1],hi[k][2],hi[k][3]}
    o[d0]=__builtin_amdgcn_mfma_f32_32x32x16_bf16(pa0,PK(0),o[d0],0,0,0);
    o[d0]=__builtin_amdgcn_mfma_f32_32x32x16_bf16(pa1,PK(1),o[d0],0,0,0);
    o[d0]=__builtin_amdgcn_mfma_f32_32x32x16_bf16(pa2,PK(2),o[d0],0,0,0);
    o[d0]=__builtin_amdgcn_mfma_f32_32x32x16_bf16(pa3,PK(3),o[d0],0,0,0);
    #undef PK
  }
}

#ifndef ATTN_STORE16
#define ATTN_STORE16(p,v) (*(u32x4*)(p)=(v))
#endif
template<int THRL> __device__ __forceinline__ void attn_unit(int b,int qkoff,int voff,int qb,const bf16*Q,const bf16*__restrict__ K,const bf16*__restrict__ V,bf16*O,char*shm){
  const int tid=threadIdx.x,lane=tid&63,r32=lane&31,hi=lane>>5; const int wid=__builtin_amdgcn_readfirstlane(tid>>6);
  const long rowbase=(long)b*SEQ; const int q0=qb*QB;
  const bf16*Qw=Q+(rowbase+q0+wid*QBLK)*DM+qkoff;
  const bf16*Kh=K+rowbase*DM+qkoff,*Vh=V+rowbase*DM+voff;
  const unsigned lds0=(unsigned)(uintptr_t)shm;
  float*wsf=(float*)(shm+LDS_WS)+wid*64;
  const bf16*ksrc=Kh+(long)lane*DM+wid*8;
  const bf16*vsrc=Vh+(long)(16*(wid&3)+(lane>>2))*DM+(wid>>2)*32+(lane&3)*8;
  const unsigned kdst=lds0+LDS_K+wid*1024, vdst=lds0+LDS_V+wid*1024;
  #define DMA_K(t,slot) glds16(ksrc+(long)(t)*KVBLK*DM,(unsigned)__builtin_amdgcn_readfirstlane(kdst+(slot)))
  #define DMA_V(t,slot) glds16(vsrc+(long)(t)*KVBLK*DM,(unsigned)__builtin_amdgcn_readfirstlane(vdst+(slot)))
  const int vb0=(int)(lds0+LDS_V)+((lane>>4)&1)*32+(lane&3)*8+(4*hi+((lane&15)>>2))*64;
  const char*Kbase=shm+LDS_K; bf16x8 kf[8];
  const lds_cptr shm3=(lds_cptr)shm; const lds_cptr kp0=shm3+LDS_K+hi*1024+r32*16; const lds_cptr vp0=shm3+LDS_V+((lane>>4)&1)*32+(lane&3)*8+(4*hi+((lane&15)>>2))*64;
  const int NT=(q0+QB)/KVBLK;
  DMA_K(0,0);DMA_V(0,0);DMA_K(1,SLOTB);
  bf16x8 qr[4];
  #pragma unroll
  for(int d0=0;d0<4;++d0)qr[d0]=*reinterpret_cast<const bf16x8*>(&Qw[(long)r32*DM+d0*16+hi*8]);
  float mhat=0.f,l_reg=0.f;f32x16 o[2];o[0]=f32x16{};o[1]=f32x16{};f32x16 negm=f32x16{};asm volatile("":"+v"(negm));
  const int qrel=wid*QBLK+r32;
  #define CMASK(P0,P1,t) do{int jb_=(t)-(NT-4); if(jb_>=0)cmask(P0,P1,jb_,qrel,hi);}while(0)
  bool resc=false;
  #define START(P0,P1) do{ const float rm=rowmax(P0,P1); resc=false; \
    { const float dl=rm; mhat=fadd_s(mhat,dl); \
      _Pragma("unroll") for(int r=0;r<16;++r){P0[r]=fsub_s(P0[r],dl);P1[r]=fsub_s(P1[r],dl);} \
      _Pragma("unroll") for(int r=0;r<16;++r)negm[r]=-mhat; asm volatile("":"+v"(negm)); } \
    _Pragma("unroll") for(int r=0;r<16;++r)P0[r]=__builtin_amdgcn_exp2f(P0[r]); }while(0)
  #define RESC() do{ if(resc){ asm volatile("s_waitcnt lgkmcnt(0)":::"memory"); \
      _Pragma("unroll") for(int d_=0;d_<2;++d_) _Pragma("unroll") for(int r=0;r<16;++r)o[d_][r]*=wsf[crow(r,hi)]; } }while(0)
  f32x16 pA0,pA1,pB0,pB1;
  int sl_prev=0,sl_cur=0,sl_next=SLOTB;
  #define ROT() do{sl_prev=sl_cur;sl_cur=sl_next;sl_next=(sl_next==(NSLOT-1)*SLOTB)?0:sl_next+SLOTB;}while(0)
  DMA_K(2,2*SLOTB);
  WAIT_BAR(3);
  qkt(pA0,pA1,Kbase,qr,negm,r32,hi);asm volatile("s_nop 15\n\ts_nop 7":"+v"(pA0),"+v"(pA1));CMASK(pA0,pA1,0);
  START(pA0,pA1);
  _Pragma("unroll") for(int r=0;r<16;++r)pA1[r]=__builtin_amdgcn_exp2f(pA1[r]);
  WAIT_BAR(0);
  DMA_K(3,0);DMA_V(1,SLOTB);
  ROT();
  kload8(kf,kp0+sl_cur);
  WAIT_BAR(2);
  s16x4 vlo[8],vhi[8]; u32x4 pw0,pw1,pw2,pw3;
  #define PKW(P,B) cvtpk_s(P[B],P[B+1])
  #define PAF(k) __builtin_bit_cast(bf16x8,pw##k)
  #define VFR(i) (bf16x8){vlo[i][0],vlo[i][1],vlo[i][2],vlo[i][3],vhi[i][0],vhi[i][1],vhi[i][2],vhi[i][3]}
  #define PIN(x) asm volatile("":"+v"(x))
  #define MX3(a,b,c) __builtin_fmaxf(__builtin_fmaxf((a),(b)),(c))
  #define GAPA(MF,A0,A1,A2,A3,W0,W1,PW) do{ MF; sacc+=A0; sacc+=A1; sacc+=A2; sacc+=A3; PIN(sacc); W0; W1; PIN(PW); SBAR(); }while(0)
  #define EX(v) __builtin_amdgcn_exp2f(v)
  #define GAPB(MF,X,B) do{ MF; X[B]=EX(X[B]); X[B+1]=EX(X[B+1]); X[B+2]=EX(X[B+2]); X[B+3]=EX(X[B+3]); PIN(X); SBAR(); }while(0)
  #define VRD(i) do{ vlo[i]=vtr(vp_+(((i)>>2)*4096+((i)&3)*1024)); vhi[i]=vtr(vp_+(((i)>>2)*4096+((i)&3)*1024+512)); }while(0)
  #define KRD(G,j) do{ if(G){ kload2(kf,kp0+sl_next,j); SBAR(); } }while(0)
  #define STEP(C0,C1,P0,P1,t,GK,GV,GL) do{ SBAR(); \
    const lds_cptr vp_=vp0+sl_prev; \
    VRD(0); SBAR(); float sacc=(P0[0]+P0[1]); \
    GAPA(C0=__builtin_amdgcn_mfma_f32_32x32x16_bf16(kf[0],qr[0],negm,0,0,0), P0[2],P0[3],P0[4],P0[5],     pw0[0]=PKW(P0,0), pw0[1]=PKW(P0,2), pw0); \
    VRD(4); SBAR(); GAPA(C1=__builtin_amdgcn_mfma_f32_32x32x16_bf16(kf[1],qr[0],negm,0,0,0), P0[6],P0[7],P0[8],P0[9],     pw0[2]=PKW(P0,4), pw0[3]=PKW(P0,6), pw0); \
    VRD(1); SBAR(); GAPA(C0=__builtin_amdgcn_mfma_f32_32x32x16_bf16(kf[2],qr[1],C0,0,0,0),   P0[10],P0[11],P0[12],P0[13], pw1[0]=PKW(P0,8), pw1[1]=PKW(P0,10), pw1); \
    VRD(5); SBAR(); GAPA(C1=__builtin_amdgcn_mfma_f32_32x32x16_bf16(kf[3],qr[1],C1,0,0,0),   P0[14],P0[15],P1[0],P1[1],   pw1[2]=PKW(P0,12),pw1[3]=PKW(P0,14), pw1); \
    VRD(2); SBAR(); GAPA(C0=__builtin_amdgcn_mfma_f32_32x32x16_bf16(kf[4],qr[2],C0,0,0,0),   P1[2],P1[3],P1[4],P1[5],     pw2[0]=PKW(P1,0), pw2[1]=PKW(P1,2), pw2); \
    VRD(6); SBAR(); GAPA(C1=__builtin_amdgcn_mfma_f32_32x32x16_bf16(kf[5],qr[2],C1,0,0,0),   P1[6],P1[7],P1[8],P1[9],     pw2[2]=PKW(P1,4), pw2[3]=PKW(P1,6), pw2); \
    VRD(3); SBAR(); GAPA(C0=__builtin_amdgcn_mfma_f32_32x32x16_bf16(kf[6],qr[3],C0,0,0,0),   P1[10],P1[11],P1[12],P1[13], pw3[0]=PKW(P1,8), pw3[1]=PKW(P1,10), pw3); \
    VRD(7); SBAR(); GAPA(C1=__builtin_amdgcn_mfma_f32_32x32x16_bf16(kf[7],qr[3],C1,0,0,0),   P1[14],P1[15],0.f,0.f,       pw3[2]=PKW(P1,12),pw3[3]=PKW(P1,14), pw3); \
    l_reg+=sacc; \
    if(GK){DMA_K((t)+3,sl_cur);} if(GV){DMA_V((t)+1,sl_next);} \
    CMASK(C0,C1,t); \
    { float a=MX3(C0[0],C0[1],C1[0]),b=MX3(C0[2],C0[3],C1[1]); a=MX3(a,C1[2],C1[3]); \
      _Pragma("unroll") for(int r=4;r<16;r+=4){a=MX3(a,C0[r],C0[r+1]);b=MX3(b,C0[r+2],C0[r+3]);a=MX3(a,C1[r],C1[r+1]);b=MX3(b,C1[r+2],C1[r+3]);} \
      float rm=__builtin_fmaxf(a,b); { auto rr=__builtin_amdgcn_permlane32_swap(__float_as_uint(rm),__float_as_uint(rm),false,false); rm=__builtin_fmaxf(__uint_as_float(rr[0]),__uint_as_float(rr[1])); } \
      resc=false; \
      if(__builtin_expect(__any(rm>(float)THRL),0)){ const float dl=__builtin_fmaxf(rm,0.f); mhat+=dl; \
        _Pragma("unroll") for(int r=0;r<16;++r){C0[r]-=dl;C1[r]-=dl;} \
        _Pragma("unroll") for(int r=0;r<16;++r)negm[r]=-mhat; asm volatile("":"+v"(negm)); \
        const float f=__builtin_amdgcn_exp2f(-dl); l_reg*=f; if(hi==0)wsf[r32]=f; resc=true; } } \
    SBAR(); \
    GAPB(o[0]=__builtin_amdgcn_mfma_f32_32x32x16_bf16(PAF(0),VFR(0),o[0],0,0,0), C0,0); \
    GAPB(o[1]=__builtin_amdgcn_mfma_f32_32x32x16_bf16(PAF(0),VFR(4),o[1],0,0,0), C0,4); \
    KRD(GL,0); GAPB(o[0]=__builtin_amdgcn_mfma_f32_32x32x16_bf16(PAF(1),VFR(1),o[0],0,0,0), C0,8); \
    KRD(GL,1); GAPB(o[1]=__builtin_amdgcn_mfma_f32_32x32x16_bf16(PAF(1),VFR(5),o[1],0,0,0), C0,12); \
    KRD(GL,2); GAPB(o[0]=__builtin_amdgcn_mfma_f32_32x32x16_bf16(PAF(2),VFR(2),o[0],0,0,0), C1,0); \
    KRD(GL,3); GAPB(o[1]=__builtin_amdgcn_mfma_f32_32x32x16_bf16(PAF(2),VFR(6),o[1],0,0,0), C1,4); \
    GAPB(o[0]=__builtin_amdgcn_mfma_f32_32x32x16_bf16(PAF(3),VFR(3),o[0],0,0,0), C1,8); \
    GAPB(o[1]=__builtin_amdgcn_mfma_f32_32x32x16_bf16(PAF(3),VFR(7),o[1],0,0,0), C1,12); \
    }while(0)
  int t=1;
  #undef CMASK
  #define CMASK(P0,P1,t) do{}while(0)
  for(;t+5<NT;t+=2){
    STEP(pB0,pB1,pA0,pA1,t,true,true,true);     WAIT_BAR(2); RESC(); ROT();
    STEP(pA0,pA1,pB0,pB1,t+1,true,true,true);   WAIT_BAR(2); RESC(); ROT();
  }
  #undef CMASK
  #define CMASK(P0,P1,t) do{int jb_=(t)-(NT-4); if(jb_>=0)cmask(P0,P1,jb_,qrel,hi);}while(0)
  #define ENDW(tt) do{ if((tt)+3<NT){WAIT_BAR(2);} else if((tt)+2<NT){WAIT_BAR(1);} else {WAIT_BAR(0);} }while(0)
  for(;t+1<NT;t+=2){
    STEP(pB0,pB1,pA0,pA1,t,(t+3<NT),(t+1<NT),(t+1<NT));       ENDW(t);   RESC(); ROT();
    STEP(pA0,pA1,pB0,pB1,t+1,(t+4<NT),(t+2<NT),(t+2<NT));     ENDW(t+1); RESC(); ROT();
  }
  STEP(pB0,pB1,pA0,pA1,NT-1,false,false,false); RESC();
  { float sacc=pB0[0]+pB0[1]; _Pragma("unroll") for(int r=2;r<16;++r)sacc+=pB0[r]; _Pragma("unroll") for(int r=0;r<16;++r)sacc+=pB1[r]; l_reg+=sacc;
    pw0=(u32x4){PKW(pB0,0),PKW(pB0,2),PKW(pB0,4),PKW(pB0,6)};pw1=(u32x4){PKW(pB0,8),PKW(pB0,10),PKW(pB0,12),PKW(pB0,14)};pw2=(u32x4){PKW(pB1,0),PKW(pB1,2),PKW(pB1,4),PKW(pB1,6)};pw3=(u32x4){PKW(pB1,8),PKW(pB1,10),PKW(pB1,12),PKW(pB1,14)};
    SBAR(); pv(o,vb0+sl_cur,PAF(0),PAF(1),PAF(2),PAF(3)); }
  #undef PKW
  #undef PAF
  #undef VFR
  #undef PIN
  #undef MX3
  #undef GAPA
  #undef GAPB
  #undef EX
  #undef VRD
  #undef KRD
  #undef STEP
  #undef ENDW
  {auto rr=__builtin_amdgcn_permlane32_swap(__float_as_uint(l_reg),__float_as_uint(l_reg),false,false);l_reg=__uint_as_float(rr[0])+__uint_as_float(rr[1]);}
  if(hi==0)wsf[32+r32]=l_reg;asm volatile("s_waitcnt lgkmcnt(0)":::"memory");
  float rli[16];
  #pragma unroll
  for(int r=0;r<16;++r)rli[r]=__builtin_amdgcn_rcpf(wsf[32+crow(r,hi)]);
  bf16*Ow=O+(rowbase+q0+wid*QBLK)*DM+voff;
  { bf16*stg=(bf16*)(shm+LDS_OST)+wid*2048;
    #pragma unroll
    for(int r=0;r<16;++r){const int orow=crow(r,hi);
      #pragma unroll
      for(int d0=0;d0<2;++d0)stg[orow*64+d0*32+r32]=__float2bfloat16(o[d0][r]*rli[r]);}
    asm volatile("s_waitcnt lgkmcnt(0)":::"memory");
    #pragma unroll
    for(int i=0;i<4;++i){const int row=i*8+(lane>>3),ch=lane&7; const u32x4 v=*(const u32x4*)(stg+row*64+ch*8); ATTN_STORE16(Ow+(long)row*DM+ch*8,v);} }
  asm volatile("s_waitcnt lgkmcnt(0)\n\ts_barrier":::"memory");
  #undef DMA_K
  #undef DMA_V
  #undef CMASK
  #undef START
  #undef RESC
  #undef ROT
}
constexpr int ATTN_LDS_BYTES=LDS_BYTES;
struct AttnTensors { const bf16* Q; const bf16* K; const bf16* V; bf16* O0; bf16* O1; };
struct AttnUnit { int vh; int qb; };
struct StaticOrder {
  int vcu, G;
  __device__ __forceinline__ explicit StaticOrder(int grid,int vcu_):vcu(vcu_),G(grid){}
  __device__ __forceinline__ bool next(int i,AttnUnit&u)const{
    if(G==256){ if(i>=4)return false; const int s=vcu&3; u.vh=vcu>>2; u.qb=(i==0)?s:(i==1)?7-s:(i==2)?8+s:15-s; return true; }
    const int L=i*G+vcu; if(L>=64*NQB)return false; u.vh=L&63; u.qb=NQB-1-(L>>6); return true; }
  __device__ __forceinline__ void a_ready(const AttnUnit&)const{}
  __device__ __forceinline__ void done(const AttnUnit&)const{}
};
template<class Sched,int THRL=8> __device__ __forceinline__ void attn_phase(char*lds,const AttnTensors&T,const Sched&S){
  AttnUnit u;
  for(int i=0;S.next(i,u);++i){ S.a_ready(u);
    const int b=u.vh>>5,h=(u.vh>>2)&7,c=(u.vh>>1)&1,half=u.vh&1;
    attn_unit<THRL>(b,h*128+c*64,h*128+half*64,u.qb,T.Q,T.K,T.V,c?T.O1:T.O0,lds); S.done(u); }
}
#undef SBAR
#undef WAIT_BAR
}

#define GAS __attribute__((address_space(1)))
#define LAS __attribute__((address_space(3)))
typedef unsigned short bf16;
typedef unsigned v4u __attribute__((ext_vector_type(4)));
typedef float f32x4 __attribute__((ext_vector_type(4)));
typedef short bf16x8 __attribute__((ext_vector_type(8)));
typedef GAS unsigned gu32;
typedef GAS unsigned long long gu64;
#define RLX_AGENT __ATOMIC_RELAXED, __HIP_MEMORY_SCOPE_AGENT
#define LDS_WAIT() asm volatile("s_waitcnt lgkmcnt(0)" ::: "memory")
#define VM_WAIT() asm volatile("s_waitcnt vmcnt(0)" ::: "memory")
__device__ __forceinline__ unsigned long long rt() { return __builtin_amdgcn_s_memrealtime(); }
__device__ __forceinline__ unsigned f2bf(float f) { unsigned u = __builtin_bit_cast(unsigned, f); return (u + 0x7fffu + ((u >> 16) & 1u)) >> 16; }
__device__ __forceinline__ unsigned pk2(float lo, float hi) { return f2bf(lo) | (f2bf(hi) << 16); }

#define XB_TMO      128
#define XB_XCNT(j)  (256  + 64 * (j))
#define XB_XSUB(j)  (1280 + 64 * (j))
#define XB_XGEN(j)  (2304 + 64 * (j))
#define XB_TOP      3328
#define XB_TOPGEN   3392
#define XCD_BAR_WORDS 3456
#define XB_SPIN_CAP (1u << 18)

__device__ __forceinline__ unsigned xb_ld(unsigned* p)              { return __hip_atomic_load(p, __ATOMIC_RELAXED, __HIP_MEMORY_SCOPE_AGENT); }
__device__ __forceinline__ unsigned xb_add(unsigned* p, unsigned v) { return __hip_atomic_fetch_add(p, v, __ATOMIC_RELAXED, __HIP_MEMORY_SCOPE_AGENT); }
__device__ __forceinline__ unsigned xb_xcc_id() { return (unsigned)__builtin_amdgcn_s_getreg((3 << 11) | 20) & 0xFu; }
#define XB_SPIN(cond, bar) do { unsigned _sp = 0; while (cond) { __builtin_amdgcn_s_sleep(1); \
    if ((++_sp & 255u) == 0u) { if (xb_ld(&(bar)[XB_TMO])) break; if (_sp > XB_SPIN_CAP) { atomicAdd(&(bar)[XB_TMO], 1u); break; } } } } while (0)

struct XcdBarrier {
    unsigned* bar; unsigned x;
    volatile LAS unsigned* st;
};

__device__ __forceinline__ XcdBarrier xcd_barrier_post(unsigned* bar, volatile LAS unsigned* st) {
    XcdBarrier b; b.bar = bar; b.x = xb_xcc_id(); b.st = st;
    if (threadIdx.x == 0) (void)xb_add(&bar[XB_XCNT(b.x)], 1u);
    return b;
}
__device__ __forceinline__ void xcd_barrier_complete(unsigned* bar, unsigned x, unsigned& nloc, unsigned& nx) {
    const unsigned G = gridDim.x * gridDim.y * gridDim.z;
    unsigned sum, cnt, mine, sp = 0u;
    for (;;) {
        sum = 0u; cnt = 0u; mine = 0u;
#pragma unroll
        for (unsigned j = 0; j < 16; ++j) { const unsigned c = xb_ld(&bar[XB_XCNT(j)]); sum += c; cnt += (c > 0u) ? 1u : 0u; mine = (j == x) ? c : mine; }
        if (sum == G) break;
        __builtin_amdgcn_s_sleep(1);
        if ((++sp & 255u) == 0u) { if (xb_ld(&bar[XB_TMO])) break; if (sp > XB_SPIN_CAP) { atomicAdd(&bar[XB_TMO], 1u); break; } }
    }
    nloc = mine > 0u ? mine : 1u; nx = cnt > 0u ? cnt : 1u;
}

__device__ __forceinline__ void xcd_barrier(const XcdBarrier& b) {
    asm volatile("s_waitcnt vmcnt(0)" ::: "memory");
    __syncthreads();
    if (threadIdx.x == 0) {
        unsigned* bar = b.bar;
        __builtin_amdgcn_s_waitcnt(0);
        unsigned nloc = b.st[0], nx = b.st[1];
        if (nloc == 0u) { xcd_barrier_complete(bar, b.x, nloc, nx); b.st[0] = nloc; b.st[1] = nx; }
        const unsigned old = xb_add(&bar[XB_XSUB(b.x)], 1u);
        const unsigned gen = old / nloc;
        if (old + 1u == (gen + 1u) * nloc) {
            __builtin_amdgcn_fence(__ATOMIC_RELEASE, "agent");
            asm volatile("s_waitcnt vmcnt(0)" ::: "memory");
            const unsigned og = xb_add(&bar[XB_TOP], 1u);
            const unsigned tg = og / nx;
            if (og + 1u == (tg + 1u) * nx) xb_add(&bar[XB_TOPGEN], 1u);
            else XB_SPIN(xb_ld(&bar[XB_TOPGEN]) == tg, bar);
            __builtin_amdgcn_fence(__ATOMIC_ACQUIRE, "agent");
            xb_add(&bar[XB_XGEN(b.x)], 1u);
            asm volatile("s_waitcnt vmcnt(0)" ::: "memory");
        } else {
            XB_SPIN(xb_ld(&bar[XB_XGEN(b.x)]) == gen, bar);
            __builtin_amdgcn_fence(__ATOMIC_ACQUIRE, "agent");
            asm volatile("s_waitcnt vmcnt(0)" ::: "memory");
        }
    }
    __syncthreads();
}

constexpr int NWAVES = 8, NTHR = 512;
constexpr int BATCH = 2, SEQ = 4096, DM = 2048, M = BATCH * SEQ;
constexpr int ATT_W = 1024, RW_W = 1024, RW_COLS = 3328, GATE_COLS = 4096, IN_COLS = 10496;
constexpr int NEXP = 64, EFF = 1024, CAP = 8192;
constexpr float NORM_EPS = 1e-6f, SUBLN_EPS = 1e-5f, LNX_EPS = 64e-5f;
constexpr float LAMBDA_INIT = 0.2f;
#ifndef MK_ONE_LAUNCH
#define MK_ONE_LAUNCH 0
#endif
constexpr int NPHASE = 14;

constexpr size_t MiB = 1u << 20;
constexpr size_t WS_CTL = 0, CTL_ZERO_BYTES = 1 * MiB;
constexpr size_t WS_ADA = 1 * MiB;
constexpr size_t WS_ROPE = 1 * MiB + 512 * 1024;
constexpr size_t WS_W2T = 2 * MiB;
constexpr size_t WS_A2T = 2 * MiB + 128 * 1024;
constexpr size_t WS_G2T = 2 * MiB + 256 * 1024;
constexpr size_t WS_TOKE = 3 * MiB;
constexpr size_t WS_TOKP = 3 * MiB + 64 * 1024;
constexpr size_t WS_TOKW = 3 * MiB + 128 * 1024;
constexpr size_t WS_LIST = 4 * MiB;
constexpr size_t WS_WIN_T = 8 * MiB;
constexpr size_t WS_WUPA_T = 50 * MiB, WS_WUPB_T = 54 * MiB, WS_WOUT_T = 58 * MiB;
constexpr size_t WS_U = 68 * MiB;
constexpr size_t WS_Q = 100 * MiB, WS_K = 116 * MiB, WS_V = 132 * MiB;
constexpr size_t WS_PR = 148 * MiB;
constexpr size_t WS_G = 200 * MiB;
constexpr size_t WS_O0 = 264 * MiB, WS_O1 = 280 * MiB;
constexpr size_t WS_YATT = 296 * MiB, WS_YRW = 312 * MiB;
constexpr size_t WS_T1 = 328 * MiB;
constexpr size_t WS_MERGED = 392 * MiB;
constexpr size_t WS_H1 = 424 * MiB;
constexpr size_t WS_U2 = 488 * MiB;
constexpr size_t WS_ACT = 520 * MiB;
constexpr size_t WS_YS = 560 * MiB;
constexpr size_t WS_RW = 632 * MiB;
constexpr size_t RW_ARR = 32 * MiB;
constexpr size_t WS_END = WS_RW + 9 * RW_ARR;
constexpr int CW_TMO = 0, CW_CODE = 1, CW_BAR = 4096, CW_CNT = 8192;

constexpr int RING_OFF = 0, RING_BYTES = 131072;
constexpr int LDSCTL_OFF = RING_BYTES, MISC_OFF = LDSCTL_OFF + 320;
constexpr int LDS_BYTES = 147456;

__device__ __forceinline__ float bf2f(unsigned short h) { return __builtin_bit_cast(float, (unsigned)h << 16); }
__device__ __forceinline__ float bflo(unsigned w) { return __builtin_bit_cast(float, w << 16); }
__device__ __forceinline__ float bfhi(unsigned w) { return __builtin_bit_cast(float, w & 0xffff0000u); }
__device__ __forceinline__ float wave_sum(float v) {
#pragma unroll
    for (int o = 1; o < 64; o <<= 1) v += __shfl_xor(v, o);
    return v;
}
template <int CTRL> __device__ __forceinline__ float dpp_f(float x) { return __builtin_bit_cast(float, __builtin_amdgcn_update_dpp(0, __builtin_bit_cast(int, x), CTRL, 0xF, 0xF, true)); }
__device__ __forceinline__ float sum8(float x) {
    x += dpp_f<0xB1>(x); x += dpp_f<0x4E>(x); x += dpp_f<0x141>(x); return x; }
__device__ __forceinline__ float sum4(float x) { x += dpp_f<0xB1>(x); x += dpp_f<0x4E>(x); return x; }
__device__ __forceinline__ float sigmoidf_(float x) { return 1.f / (1.f + __expf(-x)); }

struct Frame {
    LAS unsigned char* lds;
    volatile LAS unsigned* MISC;
    gu32* ctl;
    int tid, lane, wave, vcu, G;
    unsigned char* ws;
};

namespace pg8 {
constexpr float QSCALE = 0.125f * 1.4426950408889634f;
struct EpiIn {
    static constexpr bool PERM = true, AFTER_DRAIN = false;
    unsigned char* ws; const float* rope;
    __device__ __forceinline__ void operator()(const f32x4 (&acc)[2][2][4][2], const Unit& u, int wr, int wc, int fr, int fq) const {
        const int row0 = u.pm * BM + wr * 64 + fr, pn = u.pn, cw = wc * 32 + 8 * fq;
        if (pn < 8) {
            const int isk = pn >= 4 ? 1 : 0;
            bf16_t* base = (bf16_t*)(ws + WS_Q + (size_t)isk * (WS_K - WS_Q)); const float sc = isk ? 1.f : QSCALE; const int colt = (pn & 3) * 256 + cw;
            const bool ropew = ((wc & 1) == 0);
#pragma unroll
            for (int ai = 0; ai < 2; ++ai)
#pragma unroll
                for (int m = 0; m < 4; ++m) { const int row = row0 + ai * HALF + m * 16; bf16_t* rowp = base + (size_t)row * 1024 + colt;
                    f32x4 c0 = {1.f, 1.f, 1.f, 1.f}, c1 = c0, s0 = {0.f, 0.f, 0.f, 0.f}, s1 = s0;
                    if (ropew) { const f32x4* rp = (const f32x4*)(rope + (size_t)row * 16); c0 = rp[0]; c1 = rp[1]; s0 = rp[2]; s1 = rp[3]; }
#pragma unroll
                    for (int bj = 0; bj < 2; ++bj) { f32x4 v0 = acc[ai][bj][m][0], v1 = acc[ai][bj][m][1];
                        if (ropew) { f32x4 p0, p1;
                            p0[0] = __shfl_xor(v0[0], 16); p0[1] = __shfl_xor(v0[1], 16); p0[2] = __shfl_xor(v0[2], 16); p0[3] = __shfl_xor(v0[3], 16);
                            p1[0] = __shfl_xor(v1[0], 16); p1[1] = __shfl_xor(v1[1], 16); p1[2] = __shfl_xor(v1[2], 16); p1[3] = __shfl_xor(v1[3], 16);
                            if (fq == 0) { v0 = v0 * c0 - p0 * s0; v1 = v1 * c1 - p1 * s1; }
                            else if (fq == 1) { v0 = p0 * s0 + v0 * c0; v1 = p1 * s1 + v1 * c1; } }
                        v0 = v0 * sc; v1 = v1 * sc; u32x4 w; w.x = cvt_pk_bf16(v0[0], v0[1]); w.y = cvt_pk_bf16(v0[2], v0[3]); w.z = cvt_pk_bf16(v1[0], v1[1]); w.w = cvt_pk_bf16(v1[2], v1[3]);
                        *(u32x4*)(rowp + bj * HALF) = w; } }
        } else {
            const int c1 = pn >= 12 ? 1 : 0, c2 = pn >= 25 ? 1 : 0;
            bf16_t* base = (bf16_t*)(ws + WS_V + (size_t)c1 * (WS_PR - WS_V) + (size_t)c2 * (WS_G - WS_PR));
            const int ldc = 1024 + c1 * (RW_COLS - 1024) + c2 * (GATE_COLS - RW_COLS);
            const int colt = (pn - 8 - 4 * c1 - 13 * c2) * 256 + cw;
            const bool sg = pn >= 25;
#pragma unroll
            for (int ai = 0; ai < 2; ++ai)
#pragma unroll
                for (int m = 0; m < 4; ++m) { bf16_t* rowp = base + (size_t)(row0 + ai * HALF + m * 16) * ldc + colt;
#pragma unroll
                    for (int bj = 0; bj < 2; ++bj) { f32x4 v0 = acc[ai][bj][m][0], v1 = acc[ai][bj][m][1];
                        if (sg) { v0[0] = sigmoidf_(v0[0]); v0[1] = sigmoidf_(v0[1]); v0[2] = sigmoidf_(v0[2]); v0[3] = sigmoidf_(v0[3]);
                                  v1[0] = sigmoidf_(v1[0]); v1[1] = sigmoidf_(v1[1]); v1[2] = sigmoidf_(v1[2]); v1[3] = sigmoidf_(v1[3]); }
                        u32x4 w; w.x = cvt_pk_bf16(v0[0], v0[1]); w.y = cvt_pk_bf16(v0[2], v0[3]); w.z = cvt_pk_bf16(v1[0], v1[1]); w.w = cvt_pk_bf16(v1[2], v1[3]);
                        *(u32x4*)(rowp + bj * HALF) = w; } }
        }
    }
};
struct EpiT1 {
    static constexpr bool PERM = false, AFTER_DRAIN = false;
    float* T1; const bf16_t* G;
    __device__ __forceinline__ void operator()(const f32x4 (&acc)[2][2][4][2], const Unit& u, int wr, int wc, int fr, int fq) const {
        const int row0 = u.pm * BM + wr * 64 + fr, col0 = u.pn * BM + wc * 32 + 4 * fq;
#pragma unroll
        for (int ai = 0; ai < 2; ++ai)
#pragma unroll
            for (int m = 0; m < 4; ++m) { const size_t row = (size_t)(row0 + ai * HALF + m * 16);
#pragma unroll
                for (int bj = 0; bj < 2; ++bj)
#pragma unroll
                    for (int n = 0; n < 2; ++n) { const int c = col0 + bj * HALF + n * 16; const uint2 gw = *(const uint2*)(G + row * GATE_COLS + c);
                        f32x4 a = acc[ai][bj][m][n]; a[0] *= bflo(gw.x); a[1] *= bfhi(gw.x); a[2] *= bflo(gw.y); a[3] *= bfhi(gw.y);
                        *(f32x4*)(T1 + row * DM + c) = a; } }
    }
};
struct EpiMerge {
    static constexpr bool PERM = true, AFTER_DRAIN = false;
    const float* T1; const bf16_t* G; bf16_t* O;
    __device__ __forceinline__ void operator()(const f32x4 (&acc)[2][2][4][2], const Unit& u, int wr, int wc, int fr, int fq) const {
        const int row0 = u.pm * BM + wr * 64 + fr, col0 = u.pn * BM + wc * 32 + 8 * fq;
#pragma unroll
        for (int ai = 0; ai < 2; ++ai)
#pragma unroll
            for (int m = 0; m < 4; ++m) { const size_t row = (size_t)(row0 + ai * HALF + m * 16);
#pragma unroll
                for (int bj = 0; bj < 2; ++bj) { const int c = col0 + bj * HALF; const u32x4 gw = *(const u32x4*)(G + row * GATE_COLS + 2048 + c);
                    const f32x4 t0 = *(const f32x4*)(T1 + row * DM + c), t1 = *(const f32x4*)(T1 + row * DM + c + 4);
                    f32x4 v0 = acc[ai][bj][m][0], v1 = acc[ai][bj][m][1];
                    v0[0] = t0[0] + bflo(gw.x) * v0[0]; v0[1] = t0[1] + bfhi(gw.x) * v0[1]; v0[2] = t0[2] + bflo(gw.y) * v0[2]; v0[3] = t0[3] + bfhi(gw.y) * v0[3];
                    v1[0] = t1[0] + bflo(gw.z) * v1[0]; v1[1] = t1[1] + bfhi(gw.z) * v1[1]; v1[2] = t1[2] + bflo(gw.w) * v1[2]; v1[3] = t1[3] + bfhi(gw.w) * v1[3];
                    u32x4 w; w.x = cvt_pk_bf16(v0[0], v0[1]); w.y = cvt_pk_bf16(v0[2], v0[3]); w.z = cvt_pk_bf16(v1[0], v1[1]); w.w = cvt_pk_bf16(v1[2], v1[3]);
                    *(u32x4*)(O + row * DM + c) = w; } }
    }
};
struct EpiH1 {
    static constexpr bool PERM = false, AFTER_DRAIN = false;
    const float* X; const float* ada; float* H1;
    __device__ __forceinline__ void operator()(const f32x4 (&acc)[2][2][4][2], const Unit& u, int wr, int wc, int fr, int fq) const {
        const int row0 = u.pm * BM + wr * 64 + fr, col0 = u.pn * BM + wc * 32 + 4 * fq;
        const float* gt = ada + (size_t)((u.pm * BM) / SEQ) * 12288 + 4096;
#pragma unroll
        for (int ai = 0; ai < 2; ++ai)
#pragma unroll
            for (int m = 0; m < 4; ++m) { const size_t row = (size_t)(row0 + ai * HALF + m * 16);
#pragma unroll
                for (int bj = 0; bj < 2; ++bj)
#pragma unroll
                    for (int n = 0; n < 2; ++n) { const int c = col0 + bj * HALF + n * 16;
                        const f32x4 xv = *(const f32x4*)(X + row * DM + c), g = *(const f32x4*)(gt + c);
                        *(f32x4*)(H1 + row * DM + c) = xv + g * acc[ai][bj][m][n]; } }
    }
};
}

__device__ __forceinline__ void p0_transpose_item(const float* W, int K, int N, bf16* WT, LAS float* scr, int item, int lane) {
    const int nblk = N / 32, kb = item / nblk, nb = item % nblk, k0 = 64 * kb, n0 = 32 * nb;
#pragma unroll 8
    for (int i = 0; i < 32; ++i) { const int kk = 2 * i + (lane >> 5); scr[kk * 33 + (lane & 31)] = W[(size_t)(k0 + kk) * N + n0 + (lane & 31)]; }
    LDS_WAIT(); asm volatile("" ::: "memory");
    const int c = lane & 7;
#pragma unroll
    for (int j = 0; j < 4; ++j) { const int n = (lane >> 3) + 8 * j; const LAS float* s = scr + (8 * c) * 33 + n;
        v4u o; o.x = pk2(s[0 * 33], s[1 * 33]); o.y = pk2(s[2 * 33], s[3 * 33]); o.z = pk2(s[4 * 33], s[5 * 33]); o.w = pk2(s[6 * 33], s[7 * 33]);
        *(GAS v4u*)(WT + (size_t)(n0 + n) * K + k0 + 8 * c) = o; }
    LDS_WAIT(); asm volatile("" ::: "memory");
}

__device__ __forceinline__ void p0_prologue(Frame& F, const float* const* in) {
    const float* c = in[1]; const int* pos = (const int*)in[2]; const float* ada_w = in[3]; const float* ada_b = in[4];
    float* ada = (float*)(F.ws + WS_ADA); float* rope = (float*)(F.ws + WS_ROPE);
    {
        LAS float* sc = (LAS float*)(F.lds);
        LAS float* red = (LAS float*)(F.lds + 16384);
        for (int i = F.tid; i < 2 * DM; i += NTHR) { const float v = c[i]; sc[i] = v / (1.f + __expf(-v)); }
        __syncthreads();
        const int rg = F.tid / 12, c4 = F.tid % 12;
        for (int cb = F.vcu; cb < 256; cb += F.G) {
            f32x4 a0 = {0.f, 0.f, 0.f, 0.f}, a1 = a0;
            if (rg < 42) {
                const float* wp = ada_w + (size_t)cb * 48 + c4 * 4;
#pragma unroll 7
                for (int k = rg; k < DM; k += 42) { const f32x4 w = *(const f32x4*)(wp + (size_t)k * 12288); a0 += w * sc[k]; a1 += w * sc[DM + k]; }
                LAS float* r = red + rg * 96 + c4 * 4;
                r[0] = a0[0]; r[1] = a0[1]; r[2] = a0[2]; r[3] = a0[3]; r[48] = a1[0]; r[49] = a1[1]; r[50] = a1[2]; r[51] = a1[3];
            }
            __syncthreads();
            if (F.tid < 96) { float s = 0.f; for (int g = 0; g < 42; ++g) s += red[g * 96 + F.tid];
                const int b = F.tid / 48, n = cb * 48 + F.tid % 48; ada[(size_t)b * 12288 + n] = s + ada_b[n]; }
            __syncthreads();
        }
    }
    {
        const int gt = F.vcu * NTHR + F.tid, NGT = F.G * NTHR;
        for (int idx = gt; idx < M * 8; idx += NGT) { const int m = idx >> 3, i = idx & 7;
            const double inv = (i == 0) ? 1.0 : (i == 1) ? 0.19392274474868576 : (i == 2) ? 0.03760603093086393 : (i == 3) ? 0.007292664737217109 : (i == 4) ? 0.001414213562373095
                             : (i == 5) ? 0.0002742481756762073 : (i == 6) ? 5.318295896944988e-05 : 1.031338537721246e-05;
            double a = (double)pos[m] * inv; const double k = __builtin_rint(a * 0.15915494309189535); a -= k * 6.283185307179586;
            const float af = (float)a; rope[(size_t)m * 16 + i] = cosf(af); rope[(size_t)m * 16 + 8 + i] = sinf(af); }
    }
    {
        LAS float* scr = (LAS float*)(F.lds + 49152 + F.wave * 8704);
        const int gw = F.vcu * NWAVES + F.wave, NGW = F.G * NWAVES;
        constexpr int I_IN = (DM / 64) * (IN_COLS / 32), I_UP = (1024 / 64) * (DM / 32), I_OUT = (DM / 64) * (DM / 32), I_LR = (64 / 64) * (1024 / 32), I_G2 = (128 / 64) * (1024 / 32);
        constexpr int NITEMS = I_IN + 2 * I_UP + I_OUT + 2 * I_LR + I_G2;
        for (int it = gw; it < NITEMS; it += NGW) {
            int r = it;
            if (r < I_IN) { p0_transpose_item(in[6], DM, IN_COLS, (bf16*)(F.ws + WS_WIN_T), scr, r, F.lane); continue; } r -= I_IN;
            if (r < I_UP) { p0_transpose_item(in[23], 1024, DM, (bf16*)(F.ws + WS_WUPA_T), scr, r, F.lane); continue; } r -= I_UP;
            if (r < I_UP) { p0_transpose_item(in[24], 1024, DM, (bf16*)(F.ws + WS_WUPB_T), scr, r, F.lane); continue; } r -= I_UP;
            if (r < I_OUT) { p0_transpose_item(in[25], DM, DM, (bf16*)(F.ws + WS_WOUT_T), scr, r, F.lane); continue; } r -= I_OUT;
            if (r < I_LR) { p0_transpose_item(in[14], 64, 1024, (bf16*)(F.ws + WS_W2T), scr, r, F.lane); continue; } r -= I_LR;
            if (r < I_LR) { p0_transpose_item(in[16], 64, 1024, (bf16*)(F.ws + WS_A2T), scr, r, F.lane); continue; } r -= I_LR;
            p0_transpose_item(in[17], 128, 1024, (bf16*)(F.ws + WS_G2T), scr, r, F.lane);
        }
    }
}

__device__ __forceinline__ void norm_mod_row(const float* xrow, const float* g, const float* sc, const float* sh, bf16* orow, int lane, f32x4 (&v)[8]) {
    const GAS f32x4* xr = (const GAS f32x4*)xrow + lane; float s2 = 0.f;
#pragma unroll
    for (int j = 0; j < 8; ++j) { v[j] = xr[64 * j]; s2 += (v[j].x * v[j].x + v[j].y * v[j].y) + (v[j].z * v[j].z + v[j].w * v[j].w); }
    const float rstd = 1.f / sqrtf(wave_sum(s2) * (1.f / DM) + NORM_EPS);
    GAS unsigned long long* o8 = (GAS unsigned long long*)orow + lane;
#pragma unroll
    for (int j = 0; j < 8; ++j) { const int i4 = lane + 64 * j; const f32x4 gg = ((const f32x4*)g)[i4], cc = ((const f32x4*)sc)[i4], hh = ((const f32x4*)sh)[i4];
        v[j] = (v[j] * rstd) * gg * (cc + 1.f) + hh;
        o8[64 * j] = (unsigned long long)pk2(v[j].x, v[j].y) | ((unsigned long long)pk2(v[j].z, v[j].w) << 32); }
}

constexpr int RWA_PITCH = 72, RWG_PITCH = 136, RWZ_PITCH = 68;
constexpr int RW_TW = 0, RW_AL = RW_TW + 64 * RWA_PITCH * 2, RW_GS = RW_AL + 64 * RWA_PITCH * 2, RW_Z1 = RW_GS + 64 * RWG_PITCH * 2,
              RW_Z2 = RW_Z1 + 64 * RWZ_PITCH * 4, RW_Z3 = RW_Z2 + 64 * RWZ_PITCH * 4, RW_LDS_END = RW_Z3 + 64 * RWZ_PITCH * 4;
static_assert(RW_LDS_END <= RING_BYTES, "rwkv prep LDS");
__device__ __forceinline__ void shift8(const bf16* cur, const bf16* prv, bool hasprev, const float* mu, float (&o)[8]) {
    const v4u c = *(const v4u*)cur; v4u p = {0u, 0u, 0u, 0u}; if (hasprev) p = *(const v4u*)prv;
    const f32x4 m0 = ((const f32x4*)mu)[0], m1 = ((const f32x4*)mu)[1];
    float cv[8] = {bflo(c.x), bfhi(c.x), bflo(c.y), bfhi(c.y), bflo(c.z), bfhi(c.z), bflo(c.w), bfhi(c.w)};
    float pv[8] = {bflo(p.x), bfhi(p.x), bflo(p.y), bfhi(p.y), bflo(p.z), bfhi(p.z), bflo(p.w), bfhi(p.w)};
    float mv[8] = {m0[0], m0[1], m0[2], m0[3], m1[0], m1[1], m1[2], m1[3]};
#pragma unroll
    for (int e = 0; e < 8; ++e) o[e] = cv[e] + (pv[e] - cv[e]) * mv[e];
}
__device__ __forceinline__ v4u pack8(const float (&x)[8]) { v4u o; o.x = pk2(x[0], x[1]); o.y = pk2(x[2], x[3]); o.z = pk2(x[4], x[5]); o.w = pk2(x[6], x[7]); return o; }
__device__ __forceinline__ void store8(float* p, const float (&x)[8]) { ((f32x4*)p)[0] = (f32x4){x[0], x[1], x[2], x[3]}; ((f32x4*)p)[1] = (f32x4){x[4], x[5], x[6], x[7]}; }

__device__ __forceinline__ void p3_rwkv_prep(Frame& F, const float* const* in) {
    const bf16* PR = (const bf16*)(F.ws + WS_PR);
    const float* mu = in[7]; const float* w0 = in[13]; const float* a0 = in[15]; const float* k_k = in[18]; const float* k_a = in[19]; const float* r_k = in[20];
    const bf16* w2t = (const bf16*)(F.ws + WS_W2T); const bf16* a2t = (const bf16*)(F.ws + WS_A2T); const bf16* g2t = (const bf16*)(F.ws + WS_G2T);
    float* RWb = (float*)(F.ws + WS_RW); constexpr size_t AS = RW_ARR / 4;
    float *oR = RWb, *oW = RWb + AS, *oK = RWb + 2 * AS, *oV = RWb + 3 * AS, *oA = RWb + 4 * AS, *oB = RWb + 5 * AS, *oG = RWb + 6 * AS, *oBo = RWb + 7 * AS;
    LAS unsigned char* L = F.lds;
    const int tt = F.tid >> 3, sub = F.tid & 7, fr = F.lane & 15, fq = F.lane >> 4;
    for (int u = F.vcu; u < 2048; u += F.G) {
        const int h = u & 15, ch = (u >> 4) & 63, b = u >> 10, s = ch * 64 + tt; const size_t m = (size_t)b * SEQ + s; const bool hp = s > 0;
        const bf16* cur = PR + m * RW_COLS; const bf16* prv = cur - RW_COLS;
        float r8[8], k8[8], v8[8], t8[8];
        shift8(cur + h * 64 + sub * 8, prv + h * 64 + sub * 8, hp, mu + h * 64 + sub * 8, r8);
        shift8(cur + 1024 + h * 64 + sub * 8, prv + 1024 + h * 64 + sub * 8, hp, mu + 1024 + h * 64 + sub * 8, k8);
        shift8(cur + 2048 + h * 64 + sub * 8, prv + 2048 + h * 64 + sub * 8, hp, mu + 2048 + h * 64 + sub * 8, v8);
        shift8(cur + 3072 + sub * 8, prv + 3072 + sub * 8, hp, mu + 3072 + sub * 8, t8);
#pragma unroll
        for (int e = 0; e < 8; ++e) t8[e] = tanhf(t8[e]);
        *(LAS v4u*)(L + RW_TW + (tt * RWA_PITCH + sub * 8) * 2) = pack8(t8);
        shift8(cur + 3136 + sub * 8, prv + 3136 + sub * 8, hp, mu + 3136 + sub * 8, t8);
        *(LAS v4u*)(L + RW_AL + (tt * RWA_PITCH + sub * 8) * 2) = pack8(t8);
#pragma unroll
        for (int hlf = 0; hlf < 2; ++hlf) { shift8(cur + 3200 + sub * 16 + hlf * 8, prv + 3200 + sub * 16 + hlf * 8, hp, mu + 3200 + sub * 16 + hlf * 8, t8);
#pragma unroll
            for (int e = 0; e < 8; ++e) t8[e] = sigmoidf_(t8[e]);
            *(LAS v4u*)(L + RW_GS + (tt * RWG_PITCH + sub * 16 + hlf * 8) * 2) = pack8(t8); }
        __syncthreads();
#pragma unroll 1
        for (int job = F.wave; job < 48; job += NWAVES) { const int mat = job >> 4, ti = (job >> 2) & 3, tj = job & 3;
            const int aoff = mat == 0 ? RW_TW : mat == 1 ? RW_AL : RW_GS, ap = mat == 2 ? RWG_PITCH : RWA_PITCH, kd = mat == 2 ? 128 : 64;
            const bf16* wt = (mat == 0 ? w2t : mat == 1 ? a2t : g2t) + (size_t)(h * 64 + tj * 16 + fr) * kd + fq * 8;
            f32x4 acc = {0.f, 0.f, 0.f, 0.f};
            for (int ks = 0; ks < kd / 32; ++ks) { const bf16x8 a = *(const LAS bf16x8*)(L + aoff + ((ti * 16 + fr) * ap + ks * 32 + fq * 8) * 2); const bf16x8 bb = *(const bf16x8*)(wt + ks * 32);
                acc = __builtin_amdgcn_mfma_f32_16x16x32_bf16(a, bb, acc, 0, 0, 0); }
            LAS float* z = (LAS float*)(L + (mat == 0 ? RW_Z1 : mat == 1 ? RW_Z2 : RW_Z3));
#pragma unroll
            for (int e = 0; e < 4; ++e) z[(ti * 16 + fq * 4 + e) * RWZ_PITCH + tj * 16 + fr] = acc[e]; }
        __syncthreads();
        {
            const int c0 = h * 64 + sub * 8; const LAS float* z1 = (const LAS float*)(L + RW_Z1) + tt * RWZ_PITCH + sub * 8; const LAS float* z2 = (const LAS float*)(L + RW_Z2) + tt * RWZ_PITCH + sub * 8;
            const LAS float* z3 = (const LAS float*)(L + RW_Z3) + tt * RWZ_PITCH + sub * 8;
            float dec[8], av[8], gv[8], kkv[8], km[8], bo[8], ss = 0.f, bs = 0.f;
#pragma unroll
            for (int e = 0; e < 8; ++e) { const float z = w0[c0 + e] + z1[e]; const float sp = fmaxf(-z, 0.f) + log1pf(__expf(-fabsf(z)));
                const float wl = -sp - 0.5f; dec[e] = __expf(-__expf(wl)); av[e] = sigmoidf_(a0[c0 + e] + z2[e]); gv[e] = z3[e];
                kkv[e] = k8[e] * k_k[c0 + e]; ss += kkv[e] * kkv[e]; km[e] = k8[e] * (1.f + (av[e] - 1.f) * k_a[c0 + e]); bs += r8[e] * km[e] * r_k[c0 + e]; }
            ss = sum8(ss); bs = sum8(bs); const float rn = 1.f / sqrtf(fmaxf(ss, 1e-24f));
            float na[8], nb[8];
#pragma unroll
            for (int e = 0; e < 8; ++e) { const float kk = kkv[e] * rn; na[e] = -kk; nb[e] = kk * av[e]; bo[e] = bs * v8[e]; }
            const size_t o = m * RW_W + c0;
            store8(oR + o, r8); store8(oW + o, dec); store8(oK + o, km); store8(oV + o, v8); store8(oA + o, na); store8(oB + o, nb); store8(oG + o, gv); store8(oBo + o, bo);
        }
        __syncthreads();
    }
}

__device__ __forceinline__ void p4_rwkv_scan(Frame& F) {
    float* RWb = (float*)(F.ws + WS_RW); constexpr size_t AS = RW_ARR / 4;
    const float *iR = RWb, *iW = RWb + AS, *iK = RWb + 2 * AS, *iV = RWb + 3 * AS, *iA = RWb + 4 * AS, *iB = RWb + 5 * AS; float* oY = RWb + 8 * AS;
    constexpr int TB = 16;
    LAS float* S = (LAS float*)F.lds;
    const int vr = F.tid >> 3, ks = F.tid & 7;
    for (int bh = blockIdx.x; bh < BATCH * 16; bh += F.G) {
        const int b = bh >> 4, h = bh & 15; const size_t base = (size_t)b * SEQ * RW_W + h * 64;
        float st[8];
#pragma unroll
        for (int e = 0; e < 8; ++e) st[e] = 0.f;
        f32x4 stg[3];
        auto gload = [&](int blk) {
#pragma unroll
            for (int i = 0; i < 3; ++i) { const int q = F.tid + i * NTHR, arr = q >> 8, rem = q & 255, t = rem >> 4, c4 = rem & 15;
                const float* src = (arr == 0 ? iR : arr == 1 ? iW : arr == 2 ? iK : arr == 3 ? iV : arr == 4 ? iA : iB) + base + (size_t)(blk * TB + t) * RW_W + c4 * 4;
                stg[i] = *(const f32x4*)src; } };
        auto lstore = [&](int buf) {
#pragma unroll
            for (int i = 0; i < 3; ++i) { const int q = F.tid + i * NTHR; *(LAS f32x4*)(S + buf * (6 * TB * 64) + q * 4) = stg[i]; } };
        gload(0);
        for (int blk = 0; blk < SEQ / TB; ++blk) {
            const int buf = blk & 1;
            lstore(buf);
            if (blk + 1 < SEQ / TB) gload(blk + 1);
            __syncthreads();
            const LAS float* sb = S + buf * (6 * TB * 64);
#pragma unroll 4
            for (int t = 0; t < TB; ++t) {
                const LAS float* p = sb + t * 64 + ks * 8;
                const f32x4 r0 = *(const LAS f32x4*)(p), r1 = *(const LAS f32x4*)(p + 4);
                const f32x4 w0 = *(const LAS f32x4*)(p + TB * 64), w1 = *(const LAS f32x4*)(p + TB * 64 + 4);
                const f32x4 k0 = *(const LAS f32x4*)(p + 2 * TB * 64), k1 = *(const LAS f32x4*)(p + 2 * TB * 64 + 4);
                const float vv = sb[3 * TB * 64 + t * 64 + vr];
                const f32x4 a0 = *(const LAS f32x4*)(p + 4 * TB * 64), a1 = *(const LAS f32x4*)(p + 4 * TB * 64 + 4);
                const f32x4 b0 = *(const LAS f32x4*)(p + 5 * TB * 64), b1 = *(const LAS f32x4*)(p + 5 * TB * 64 + 4);
                float sa = 0.f;
#pragma unroll
                for (int e = 0; e < 4; ++e) { sa += st[e] * a0[e]; sa += st[4 + e] * a1[e]; }
                sa = sum8(sa);
                float y = 0.f;
#pragma unroll
                for (int e = 0; e < 4; ++e) { st[e] = st[e] * w0[e] + sa * b0[e] + vv * k0[e]; st[4 + e] = st[4 + e] * w1[e] + sa * b1[e] + vv * k1[e]; y += st[e] * r0[e]; y += st[4 + e] * r1[e]; }
                y = sum8(y);
                if (ks == 0) oY[base + (size_t)(blk * TB + t) * RW_W + vr] = y;
            }
        }
        __syncthreads();
    }
}

__device__ __forceinline__ void p6_combine(Frame& F, const float* const* in) {
    const bf16* O0 = (const bf16*)(F.ws + WS_O0); const bf16* O1 = (const bf16*)(F.ws + WS_O1); bf16* YA = (bf16*)(F.ws + WS_YATT); bf16* YR = (bf16*)(F.ws + WS_YRW);
    const float* subg = in[12]; const float* lnx_g = in[21]; const float* lnx_b = in[22];
    float* RWb = (float*)(F.ws + WS_RW); constexpr size_t AS = RW_ARR / 4; const float *iG = RWb + 6 * AS, *iBo = RWb + 7 * AS, *iY = RWb + 8 * AS;
    const float d1 = wave_sum(in[8][F.lane] * in[9][F.lane]), d2 = wave_sum(in[10][F.lane] * in[11][F.lane]);
    const float lam = expf(d1) - expf(d2) + LAMBDA_INIT;
    const int gw = F.vcu * NWAVES + F.wave, NGW = F.G * NWAVES, lane = F.lane;
    for (int m = gw; m < M; m += NGW) {
        {
            const size_t o = (size_t)m * ATT_W + lane * 16; float d[16]; float ss = 0.f;
#pragma unroll
            for (int hf = 0; hf < 2; ++hf) { const v4u a = *(const v4u*)(O0 + o + hf * 8), bq = *(const v4u*)(O1 + o + hf * 8);
                const unsigned aw[4] = {a.x, a.y, a.z, a.w}, bw[4] = {bq.x, bq.y, bq.z, bq.w};
#pragma unroll
                for (int e = 0; e < 4; ++e) { d[hf * 8 + 2 * e] = bflo(aw[e]) - lam * bflo(bw[e]); d[hf * 8 + 2 * e + 1] = bfhi(aw[e]) - lam * bfhi(bw[e]); } }
#pragma unroll
            for (int e = 0; e < 16; ++e) ss += d[e] * d[e];
            ss = sum8(ss); const float rs = (1.f - LAMBDA_INIT) / sqrtf(ss * (1.f / 128.f) + SUBLN_EPS);
            const float* sg = subg + (lane & 7) * 16; float y[16];
#pragma unroll
            for (int e = 0; e < 16; ++e) y[e] = d[e] * rs * sg[e];
            v4u w0, w1; w0.x = pk2(y[0], y[1]); w0.y = pk2(y[2], y[3]); w0.z = pk2(y[4], y[5]); w0.w = pk2(y[6], y[7]); w1.x = pk2(y[8], y[9]); w1.y = pk2(y[10], y[11]); w1.z = pk2(y[12], y[13]); w1.w = pk2(y[14], y[15]);
            *(v4u*)(YA + o) = w0; *(v4u*)(YA + o + 8) = w1;
        }
        {
            const size_t o = (size_t)m * RW_W + lane * 16; float yv[16]; float s1 = 0.f;
#pragma unroll
            for (int q = 0; q < 4; ++q) { const f32x4 t = *(const f32x4*)(iY + o + q * 4); yv[q * 4] = t[0]; yv[q * 4 + 1] = t[1]; yv[q * 4 + 2] = t[2]; yv[q * 4 + 3] = t[3]; s1 += (t[0] + t[1]) + (t[2] + t[3]); }
            const float mean = sum4(s1) * (1.f / 64.f); float s2 = 0.f;
#pragma unroll
            for (int e = 0; e < 16; ++e) { yv[e] -= mean; s2 += yv[e] * yv[e]; }
            const float rs = 1.f / sqrtf(sum4(s2) * (1.f / 64.f) + LNX_EPS); float y[16];
#pragma unroll
            for (int q = 0; q < 4; ++q) { const f32x4 lg = *(const f32x4*)(lnx_g + lane * 16 + q * 4), lb = *(const f32x4*)(lnx_b + lane * 16 + q * 4), bo = *(const f32x4*)(iBo + o + q * 4), gg = *(const f32x4*)(iG + o + q * 4);
#pragma unroll
                for (int e = 0; e < 4; ++e) y[q * 4 + e] = (yv[q * 4 + e] * rs * lg[e] + lb[e] + bo[e]) * gg[e]; }
            v4u w0, w1; w0.x = pk2(y[0], y[1]); w0.y = pk2(y[2], y[3]); w0.z = pk2(y[4], y[5]); w0.w = pk2(y[6], y[7]); w1.x = pk2(y[8], y[9]); w1.y = pk2(y[10], y[11]); w1.z = pk2(y[12], y[13]); w1.w = pk2(y[14], y[15]);
            *(v4u*)(YR + o) = w0; *(v4u*)(YR + o + 8) = w1;
        }
    }
}

__device__ __forceinline__ void p10_route(Frame& F, const float* const* in) {
    const float* H1 = (const float*)(F.ws + WS_H1); bf16* U2 = (bf16*)(F.ws + WS_U2); const float* ada = (const float*)(F.ws + WS_ADA);
    const float* gffn = in[26]; const float* wrg = in[27]; const float* brg = in[28]; const float* wre = in[29]; const float* bre = in[30];
    int* tokE = (int*)(F.ws + WS_TOKE); int* tokP = (int*)(F.ws + WS_TOKP); float* tokW = (float*)(F.ws + WS_TOKW); int* list = (int*)(F.ws + WS_LIST);
    unsigned* cnt = (unsigned*)(F.ctl + CW_CNT);
    LAS float* wT = (LAS float*)F.lds;
    for (int i = F.tid; i < DM * 8; i += NTHR) { const int d = i >> 3, g = i & 7; wT[g * DM + d] = wrg[i]; }
    __syncthreads();
    const int gw = F.vcu * NWAVES + F.wave, NGW = F.G * NWAVES, lane = F.lane;
    for (int m = gw; m < M; m += NGW) {
        const int b = m / SEQ; const float* ad = ada + (size_t)b * 12288;
        f32x4 v[8];
        norm_mod_row(H1 + (size_t)m * DM, gffn, ad + 8192, ad + 6144, U2 + (size_t)m * DM, lane, v);
        float lg[8];
#pragma unroll
        for (int g = 0; g < 8; ++g) lg[g] = 0.f;
#pragma unroll
        for (int j = 0; j < 8; ++j) {
#pragma unroll
            for (int g = 0; g < 8; ++g) { const f32x4 w = *(const LAS f32x4*)(wT + g * DM + (lane + 64 * j) * 4); lg[g] += (v[j].x * w.x + v[j].y * w.y) + (v[j].z * w.z + v[j].w * w.w); }
            asm volatile("" ::: "memory"); }
#pragma unroll
        for (int g = 0; g < 8; ++g) lg[g] = wave_sum(lg[g]) + brg[g];
        int gi = 0; float gmax = lg[0];
#pragma unroll
        for (int g = 1; g < 8; ++g) if (lg[g] > gmax) { gmax = lg[g]; gi = g; }
        float gz = 0.f;
#pragma unroll
        for (int g = 0; g < 8; ++g) gz += __expf(lg[g] - gmax);
        const float gp = 1.f / gz;
        float el[8];
#pragma unroll
        for (int i = 0; i < 8; ++i) el[i] = 0.f;
        const float* wsel = wre + gi * 8;
#pragma unroll
        for (int j = 0; j < 8; ++j) { const int d0 = (lane + 64 * j) * 4; const float xv[4] = {v[j].x, v[j].y, v[j].z, v[j].w};
#pragma unroll
            for (int e = 0; e < 4; ++e) { const f32x4 wa = *(const f32x4*)(wsel + (size_t)(d0 + e) * 64), wb = *(const f32x4*)(wsel + (size_t)(d0 + e) * 64 + 4);
                el[0] += xv[e] * wa[0]; el[1] += xv[e] * wa[1]; el[2] += xv[e] * wa[2]; el[3] += xv[e] * wa[3]; el[4] += xv[e] * wb[0]; el[5] += xv[e] * wb[1]; el[6] += xv[e] * wb[2]; el[7] += xv[e] * wb[3]; }
            asm volatile("" ::: "memory"); }
#pragma unroll
        for (int i = 0; i < 8; ++i) el[i] = wave_sum(el[i]) + bre[gi * 8 + i];
        int i0 = 0; float e0 = el[0];
#pragma unroll
        for (int i = 1; i < 8; ++i) if (el[i] > e0) { e0 = el[i]; i0 = i; }
        int i1 = -1; float e1 = -INFINITY;
#pragma unroll
        for (int i = 0; i < 8; ++i) if (i != i0 && el[i] > e1) { e1 = el[i]; i1 = i; }
        const float x1 = __expf(e1 - e0), w0 = gp / (1.f + x1), w1 = gp * x1 / (1.f + x1);
        if (lane == 0) {
            const int ea = gi * 8 + i0, eb = gi * 8 + i1;
            const unsigned pa = atomicAdd(cnt + ea, 1u), pb = atomicAdd(cnt + eb, 1u);
            list[(size_t)ea * CAP + pa] = m * 2; list[(size_t)eb * CAP + pb] = m * 2 + 1;
            tokE[m * 2] = ea; tokE[m * 2 + 1] = eb; tokP[m * 2] = (int)pa; tokP[m * 2 + 1] = (int)pb; tokW[m * 2] = w0; tokW[m * 2 + 1] = w1;
        }
    }
}

constexpr int MOE_RCH = 384, MOE_AP = 72, MOE_BP = 72;
constexpr int MOE_AS = 0, MOE_ABYTES = MOE_RCH * MOE_AP * 2, MOE_BS = 2 * MOE_ABYTES, MOE_BBYTES = 64 * MOE_BP * 2, MOE_ROWP = MOE_BS + 2 * MOE_BBYTES, MOE_OFF = MOE_ROWP + MOE_RCH * 4, MOE_END = MOE_OFF + 65 * 4;
static_assert(MOE_END <= RING_BYTES, "moe LDS");
template <int MODE> __device__ __forceinline__ void moe_gemm(Frame& F, const float* const* in) {
    constexpr int KD = MODE == 1 ? DM : EFF, NSTEP = KD / 64;
    const bf16* Asrc = (const bf16*)(F.ws + (MODE == 1 ? WS_U2 : WS_ACT));
    const float* Wg = in[31]; const float* Wu = in[32]; const float* Wd = in[33];
    bf16* ACT = (bf16*)(F.ws + WS_ACT); bf16* YS = (bf16*)(F.ws + WS_YS);
    const int* list = (const int*)(F.ws + WS_LIST); const unsigned* cnt = (const unsigned*)(F.ctl + CW_CNT);
    LAS unsigned char* L = F.lds; LAS int* rowp = (LAS int*)(L + MOE_ROWP); LAS int* offs = (LAS int*)(L + MOE_OFF);
    const int tid = F.tid, lane = F.lane, w = F.wave, fr = lane & 15, fq = lane >> 4;
    if (tid == 0) { int s = 0; for (int e = 0; e < NEXP; ++e) { offs[e] = s; s += (int)__hip_atomic_load(cnt + e, __ATOMIC_RELAXED, __HIP_MEMORY_SCOPE_AGENT); } offs[NEXP] = s; }
    __syncthreads();
    const int bkp = tid >> 4, bc4 = (tid & 15) * 4;
    for (int un = F.vcu; un < NEXP * 32; un += F.G) {
        const int e = un >> 5, ct = un & 31; const int count = offs[e + 1] - offs[e], slot0 = offs[e];
        const float* bsrc0; const float* bsrc1; size_t bld;
        if (MODE == 1) { const float* Wm = (bc4 < 32 ? Wg : Wu) + (size_t)e * DM * EFF + ct * 32 + (bc4 & 31); bld = EFF; bsrc0 = Wm + (size_t)(2 * bkp) * EFF; bsrc1 = bsrc0 + EFF; }
        else { const float* Wm = Wd + (size_t)e * EFF * DM + ct * 64 + bc4; bld = DM; bsrc0 = Wm + (size_t)(2 * bkp) * DM; bsrc1 = bsrc0 + DM; }
        for (int r0 = 0; r0 < count; r0 += MOE_RCH) {
            const int nrows = (count - r0) < MOE_RCH ? (count - r0) : MOE_RCH, nf = (nrows + 15) >> 4, nrp = nf * 16;
            __syncthreads();
            for (int r = tid; r < MOE_RCH; r += NTHR) { const int rr = r < nrows ? r : 0;
                rowp[r] = (MODE == 1) ? (list[(size_t)e * CAP + r0 + rr] >> 1) : (slot0 + r0 + rr); }
            __syncthreads();
            const bf16* asrc[6]; bool aval[6];
#pragma unroll
            for (int i = 0; i < 6; ++i) { const int q = tid + i * NTHR, r = q >> 3; aval[i] = r < nrp; asrc[i] = Asrc + (size_t)rowp[r] * KD + (q & 7) * 8; }
            v4u areg[6]; f32x4 breg[2];
            f32x4 acc[3][4];
#pragma unroll
            for (int a = 0; a < 3; ++a)
#pragma unroll
                for (int n = 0; n < 4; ++n) acc[a][n] = (f32x4){0.f, 0.f, 0.f, 0.f};
#define MOE_GLOAD(st) do { _Pragma("unroll") for (int i = 0; i < 6; ++i) if (aval[i]) areg[i] = *(const v4u*)(asrc[i] + (st) * 64); \
                breg[0] = *(const f32x4*)(bsrc0 + (size_t)(st) * 64 * bld); breg[1] = *(const f32x4*)(bsrc1 + (size_t)(st) * 64 * bld); } while (0)
            MOE_GLOAD(0);
#pragma unroll 1
            for (int st = 0; st < NSTEP; ++st) {
                const int buf = st & 1; LAS unsigned char* As = L + MOE_AS + buf * MOE_ABYTES; LAS unsigned char* Bs = L + MOE_BS + buf * MOE_BBYTES;
#pragma unroll
                for (int i = 0; i < 6; ++i) if (aval[i]) { const int q = tid + i * NTHR; *(LAS v4u*)(As + ((q >> 3) * MOE_AP + (q & 7) * 8) * 2) = areg[i]; }
#pragma unroll
                for (int c = 0; c < 4; ++c) *(LAS unsigned*)(Bs + ((bc4 + c) * MOE_BP + 2 * bkp) * 2) = pk2(breg[0][c], breg[1][c]);
                if (st + 1 < NSTEP) MOE_GLOAD(st + 1);
                __syncthreads();
#pragma unroll
                for (int ks = 0; ks < 2; ++ks) {
                    bf16x8 bfrag[4];
#pragma unroll
                    for (int n = 0; n < 4; ++n) bfrag[n] = *(const LAS bf16x8*)(Bs + ((n * 16 + fr) * MOE_BP + ks * 32 + fq * 8) * 2);
#pragma unroll
                    for (int a = 0; a < 3; ++a) { const int f = w + 8 * a;
                        if (f < nf) { const bf16x8 af = *(const LAS bf16x8*)(As + ((f * 16 + fr) * MOE_AP + ks * 32 + fq * 8) * 2);
#pragma unroll
                            for (int n = 0; n < 4; ++n) acc[a][n] = __builtin_amdgcn_mfma_f32_16x16x32_bf16(bfrag[n], af, acc[a][n], 0, 0, 0); } }
                }
            }
#undef MOE_GLOAD
#pragma unroll
            for (int a = 0; a < 3; ++a) { const int r = (w + 8 * a) * 16 + fr;
                if (r < nrows) { const size_t slot = (size_t)(slot0 + r0 + r);
                    if (MODE == 1) {
#pragma unroll
                        for (int n = 0; n < 2; ++n) { const f32x4 g = acc[a][n], uu = acc[a][n + 2]; float o[4];
#pragma unroll
                            for (int x = 0; x < 4; ++x) o[x] = g[x] / (1.f + __expf(-g[x])) * uu[x];
                            uint2 pw; pw.x = pk2(o[0], o[1]); pw.y = pk2(o[2], o[3]); *(uint2*)(ACT + slot * EFF + ct * 32 + n * 16 + fq * 4) = pw; }
                    } else {
#pragma unroll
                        for (int n = 0; n < 4; ++n) { const f32x4 o = acc[a][n]; uint2 pw; pw.x = pk2(o[0], o[1]); pw.y = pk2(o[2], o[3]); *(uint2*)(YS + slot * DM + ct * 64 + n * 16 + fq * 4) = pw; }
                    } } }
        }
    }
}

__device__ __forceinline__ void p14_final(Frame& F, const float* const* in, float* out) {
    const float* H1 = (const float*)(F.ws + WS_H1); const bf16* YS = (const bf16*)(F.ws + WS_YS); const float* ada = (const float*)(F.ws + WS_ADA); const float* fg = in[34];
    const int* tokE = (const int*)(F.ws + WS_TOKE); const int* tokP = (const int*)(F.ws + WS_TOKP); const float* tokW = (const float*)(F.ws + WS_TOKW);
    const unsigned* cnt = (const unsigned*)(F.ctl + CW_CNT);
    LAS int* offs = (LAS int*)F.lds;
    if (F.tid == 0) { int s = 0; for (int e = 0; e < NEXP; ++e) { offs[e] = s; s += (int)__hip_atomic_load(cnt + e, __ATOMIC_RELAXED, __HIP_MEMORY_SCOPE_AGENT); } }
    __syncthreads();
    const int gw = F.vcu * NWAVES + F.wave, NGW = F.G * NWAVES, lane = F.lane;
    for (int m = gw; m < M; m += NGW) {
        const int b = m / SEQ; const float* gt2 = ada + (size_t)b * 12288 + 10240;
        const int s0 = offs[tokE[m * 2]] + tokP[m * 2], s1 = offs[tokE[m * 2 + 1]] + tokP[m * 2 + 1]; const float w0 = tokW[m * 2], w1 = tokW[m * 2 + 1];
        const uint2* y0 = (const uint2*)(YS + (size_t)s0 * DM) + lane; const uint2* y1 = (const uint2*)(YS + (size_t)s1 * DM) + lane;
        const f32x4* hr = (const f32x4*)(H1 + (size_t)m * DM) + lane; f32x4 v[8]; float s2 = 0.f;
#pragma unroll
        for (int j = 0; j < 8; ++j) { const uint2 a = y0[64 * j], c = y1[64 * j]; const f32x4 g = ((const f32x4*)gt2)[lane + 64 * j];
            f32x4 mo; mo[0] = w0 * bflo(a.x) + w1 * bflo(c.x); mo[1] = w0 * bfhi(a.x) + w1 * bfhi(c.x); mo[2] = w0 * bflo(a.y) + w1 * bflo(c.y); mo[3] = w0 * bfhi(a.y) + w1 * bfhi(c.y);
            v[j] = hr[64 * j] + g * mo; s2 += (v[j].x * v[j].x + v[j].y * v[j].y) + (v[j].z * v[j].z + v[j].w * v[j].w); }
        const float rstd = 1.f / sqrtf(wave_sum(s2) * (1.f / DM) + NORM_EPS);
        f32x4* orow = (f32x4*)(out + (size_t)m * DM) + lane;
#pragma unroll
        for (int j = 0; j < 8; ++j) orow[64 * j] = v[j] * rstd * ((const f32x4*)fg)[lane + 64 * j];
    }
}

struct Args { const float* in[35]; float* out; unsigned char* ws; int ph_lo, ph_hi, use_bar, pad; };
__global__ void __launch_bounds__(NTHR, 2) fwd_kernel(Args args) {
    extern __shared__ __attribute__((aligned(16))) unsigned char lds[];
    Frame F;
    F.lds = (LAS unsigned char*)lds; F.MISC = (volatile LAS unsigned*)(F.lds + MISC_OFF);
    F.tid = threadIdx.x; F.lane = F.tid & 63; F.wave = __builtin_amdgcn_readfirstlane(F.tid >> 6);
    F.G = gridDim.x; { const int bx = blockIdx.x; F.vcu = (F.G % 8 == 0) ? (bx % 8) * (F.G / 8) + bx / 8 : bx; }
    F.ws = args.ws; F.ctl = (gu32*)(args.ws + WS_CTL);
    for (int u = F.tid; u < (LDS_BYTES - LDSCTL_OFF) / 4; u += NTHR) ((LAS unsigned*)(F.lds + LDSCTL_OFF))[u] = 0u;
    __syncthreads();
    XcdBarrier bar; bar.bar = (unsigned*)(F.ctl + CW_BAR); bar.x = 0; bar.st = nullptr;
    if (args.use_bar) bar = xcd_barrier_post((unsigned*)(F.ctl + CW_BAR), F.MISC + 8);
    const int lo = args.ph_lo, hi = args.ph_hi;
    const float* const* in = args.in;
#ifndef PHASE_MASK
#define PHASE_MASK 0xFFFF
#endif
#define IN(k) ((((PHASE_MASK) >> (k)) & 1) && lo <= (k) && (k) < hi)
#define SEAM(k) do { if (IN(k) && IN((k) + 1)) xcd_barrier(bar); } while (0)
    const float* ada = (const float*)(F.ws + WS_ADA);

    if (IN(0)) { p0_prologue(F, in); } SEAM(0);
    if (IN(1)) {
        const int gw = F.vcu * NWAVES + F.wave, NGW = F.G * NWAVES; bf16* U = (bf16*)(F.ws + WS_U);
        for (int m = gw; m < M; m += NGW) { const float* ad = ada + (size_t)(m / SEQ) * 12288; f32x4 v[8];
            norm_mod_row(in[0] + (size_t)m * DM, in[5], ad + 2048, ad, U + (size_t)m * DM, F.lane, v); }
    } SEAM(1);
    if (IN(2)) {
        pg8::Gemm g{(const pg8::bf16_t*)(F.ws + WS_U), (const pg8::bf16_t*)(F.ws + WS_WIN_T), M, IN_COLS, DM}; pg8::StaticOrder S; S.init(M, IN_COLS, F.G, (int)blockIdx.x);
        pg8::EpiIn E{F.ws, (const float*)(F.ws + WS_ROPE)};
        pg8::gemm_phase<pg8::EpiIn, pg8::StaticOrder, PG8_ALIGN, PG8_SP2>(F.lds + RING_OFF, g, S, E);
    } SEAM(2);
    if (IN(3)) { p3_rwkv_prep(F, in); } SEAM(3);
    if (IN(4)) { p4_rwkv_scan(F); } SEAM(4);
    if (IN(5)) {
        const attn_body::AttnTensors AT{(const attn_body::bf16*)(F.ws + WS_Q), (const attn_body::bf16*)(F.ws + WS_K), (const attn_body::bf16*)(F.ws + WS_V), (attn_body::bf16*)(F.ws + WS_O0), (attn_body::bf16*)(F.ws + WS_O1)};
        const attn_body::StaticOrder S((int)F.G, F.vcu);
        attn_body::attn_phase<attn_body::StaticOrder>((char*)lds + RING_OFF, AT, S);
    } SEAM(5);
    if (IN(6)) { p6_combine(F, in); } SEAM(6);
    if (IN(7)) {
        pg8::Gemm g{(const pg8::bf16_t*)(F.ws + WS_YATT), (const pg8::bf16_t*)(F.ws + WS_WUPA_T), M, DM, ATT_W}; pg8::StaticOrder S; S.init(M, DM, F.G, (int)blockIdx.x);
        pg8::EpiT1 E{(float*)(F.ws + WS_T1), (const pg8::bf16_t*)(F.ws + WS_G)};
        pg8::gemm_phase<pg8::EpiT1, pg8::StaticOrder, PG8_ALIGN, PG8_SP2>(F.lds + RING_OFF, g, S, E);
    } SEAM(7);
    if (IN(8)) {
        pg8::Gemm g{(const pg8::bf16_t*)(F.ws + WS_YRW), (const pg8::bf16_t*)(F.ws + WS_WUPB_T), M, DM, RW_W}; pg8::StaticOrder S; S.init(M, DM, F.G, (int)blockIdx.x);
        pg8::EpiMerge E{(const float*)(F.ws + WS_T1), (const pg8::bf16_t*)(F.ws + WS_G), (pg8::bf16_t*)(F.ws + WS_MERGED)};
        pg8::gemm_phase<pg8::EpiMerge, pg8::StaticOrder, PG8_ALIGN, PG8_SP2>(F.lds + RING_OFF, g, S, E);
    } SEAM(8);
    if (IN(9)) {
        pg8::Gemm g{(const pg8::bf16_t*)(F.ws + WS_MERGED), (const pg8::bf16_t*)(F.ws + WS_WOUT_T), M, DM, DM}; pg8::StaticOrder S; S.init(M, DM, F.G, (int)blockIdx.x);
        pg8::EpiH1 E{in[0], ada, (float*)(F.ws + WS_H1)};
        pg8::gemm_phase<pg8::EpiH1, pg8::StaticOrder, PG8_ALIGN, PG8_SP2>(F.lds + RING_OFF, g, S, E);
    } SEAM(9);
    if (IN(10)) { p10_route(F, in); } SEAM(10);
    if (IN(11)) { moe_gemm<1>(F, in); } SEAM(11);
    if (IN(12)) { moe_gemm<2>(F, in); } SEAM(12);
    if (IN(13)) { p14_final(F, in, args.out); }
#undef IN
#undef SEAM
}

extern "C" void kernel_launch(void* const* d_in, const int* in_sizes, int n_in, void* d_out, int out_size, void* d_ws, size_t ws_size, hipStream_t stream) {
    static int grid = 0;
    if (grid == 0) {
        if (n_in != 35 || out_size != M * DM || ws_size < WS_END) { fprintf(stderr, "kernel_launch: unexpected shapes (n_in %d out %d ws %zu)\n", n_in, out_size, ws_size); grid = -1; return; }
        int dev = 0, cus = 0;
        if (hipGetDevice(&dev) != hipSuccess || hipDeviceGetAttribute(&cus, hipDeviceAttributeMultiprocessorCount, dev) != hipSuccess) { grid = -1; return; }
        if (hipFuncSetAttribute((const void*)fwd_kernel, hipFuncAttributeMaxDynamicSharedMemorySize, LDS_BYTES) != hipSuccess) { fprintf(stderr, "kernel_launch: hipFuncSetAttribute failed\n"); grid = -1; return; }
        int per_cu = 0; (void)hipOccupancyMaxActiveBlocksPerMultiprocessor(&per_cu, (const void*)fwd_kernel, NTHR, LDS_BYTES); (void)hipGetLastError();
        if (per_cu < 1) fprintf(stderr, "kernel_launch: occupancy query says %d\n", per_cu);
        grid = cus;
    }
    if (grid < 0) return;
    (void)hipMemsetAsync((char*)d_ws + WS_CTL, 0, CTL_ZERO_BYTES, stream);
    Args a{};
    for (int i = 0; i < 35; ++i) a.in[i] = (const float*)d_in[i];
    a.out = (float*)d_out; a.ws = (unsigned char*)d_ws; a.pad = 0;
#if MK_ONE_LAUNCH
    a.ph_lo = 0; a.ph_hi = 14; a.use_bar = 1;
    hipLaunchKernelGGL(fwd_kernel, dim3(grid), dim3(NTHR), LDS_BYTES, stream, a);
#else
    for (int p = 0; p < 14; ++p) { a.ph_lo = p; a.ph_hi = p + 1; a.use_bar = 0;
        hipLaunchKernelGGL(fwd_kernel, dim3(grid), dim3(NTHR), LDS_BYTES, stream, a); }
#endif
}
```

```cpp
#include <hip/hip_runtime.h>
#include <hip/hip_bf16.h>
#include <cstdio>
#include <cstdint>
#include <cmath>
namespace pg8 {
#define PG8_LAS __attribute__((address_space(3)))
typedef unsigned short bf16_t;
typedef short bf16x8 __attribute__((ext_vector_type(8)));
typedef float f32x4 __attribute__((ext_vector_type(4)));
typedef unsigned u32x4 __attribute__((ext_vector_type(4)));
constexpr int BM = 256, BK = 64, HALF = 128, HTB = HALF * BK * 2  , STAGE_BYTES = 8 * HTB, NXCD = 8, WGM = 8;

__host__ __device__ __forceinline__ int lds_byte(int r, int c) { const int st = (r >> 4) * 2 + (c >> 5), rr = r & 15, cc = c & 31, ob = rr * 64 + cc * 2; return st * 1024 + (ob ^ (((ob >> 9) & 1) << 5)); }
__host__ __device__ __forceinline__ void stage_rc(int b, int& R, int& C) { const int st = b / 1024, sb = b % 1024, swz = sb ^ (((sb >> 9) & 1) << 5); R = (st >> 1) * 16 + swz / 64; C = (st & 1) * 32 + (swz % 64) / 2; }
__host__ __device__ __forceinline__ int perm32(int rho) { const int n = rho >> 4, i = rho & 15; return 8 * (i >> 2) + 4 * n + (i & 3); }

struct Unit { int pm, pn; };
struct Gemm { const bf16_t* A; const bf16_t* Bt; int M, N, K; };

struct StaticOrder {
    int nM, nN, nwg, G, c;
    __host__ __device__ void init(int M, int N, int G_, int c_) { nM = M / BM; nN = N / BM; nwg = nM * nN; G = G_; c = c_; }
    __host__ __device__ bool next(int i, Unit& u) const {
        const long L = (long)i * G + c; if (L >= nwg) return false;
        int wgid = (int)L; { const int q = nwg / NXCD, r = nwg % NXCD, xcd = wgid % NXCD, off = wgid / NXCD; wgid = (xcd < r ? xcd * (q + 1) : r * (q + 1) + (xcd - r) * q) + off; }
        const int nig = WGM * nN, gid = wgid / nig, fm = gid * WGM, gsz = (nM - fm) < WGM ? (nM - fm) : WGM;
        u.pm = fm + ((wgid % nig) % gsz); u.pn = (wgid % nig) / gsz; return true;
    }
    __device__ __forceinline__ void a_ready(const Unit&) const {}
    __device__ __forceinline__ void done(const Unit&) const {}
};

__device__ __forceinline__ unsigned cvt_pk_bf16(float lo, float hi) { unsigned r; asm volatile("v_cvt_pk_bf16_f32 %0, %1, %2" : "=v"(r) : "v"(lo), "v"(hi)); return r; }
typedef float f32x2 __attribute__((ext_vector_type(2)));
__device__ __forceinline__ f32x2 gelu_pk(f32x2 v) {
    const f32x2 av = __builtin_elementwise_abs(v), d = av * 0.2316418882f + 1.0f;
    f32x2 t; t.x = __builtin_amdgcn_rcpf(d.x); t.y = __builtin_amdgcn_rcpf(d.y);
    f32x2 q = t * 0.5307027145f + (-0.7265760135f); q = q * t + 0.7107068705f; q = q * t + (-0.142248368f); q = q * t + 0.127414796f; q = q * t;
    const f32x2 s = (v * v) * (-0.72134752044f);
    f32x2 e; e.x = __builtin_amdgcn_exp2f(s.x); e.y = __builtin_amdgcn_exp2f(s.y);
    const f32x2 m = v * (q * e), r = v - m;
    f32x2 o; o.x = v.x < 0.f ? m.x : r.x; o.y = v.y < 0.f ? m.y : r.y; return o;
}


template <class Epi, class Sched, bool ALIGN_EPI = false, bool SP2 = false>
__device__ __forceinline__ void gemm_phase(PG8_LAS unsigned char* lds, const Gemm g, const Sched& S, const Epi& E) {
    int tid_ = threadIdx.x; asm volatile("" : "+v"(tid_));
    const int tid = tid_, wid = __builtin_amdgcn_readfirstlane(tid >> 6), lane = tid & 63, wr = wid >> 2, wc = wid & 3, fr = lane & 15, fq = lane >> 4;
    const int K = g.K, nt = K / BK;
    unsigned voffA[2], voffB[2];
#pragma unroll
    for (int i = 0; i < 2; ++i) { int R, C; stage_rc(tid * 16 + i * 8192, R, C); const int Rb = Epi::PERM ? ((R & ~31) + perm32(R & 31)) : R;
        voffA[i] = (unsigned)(R * K + C) * 2u; voffB[i] = (unsigned)(Rb * K + C) * 2u; }
    const size_t kstep = (size_t)(BK * 2);
    const size_t hstep = (size_t)HALF * K * 2;
    const size_t tstep = 2 * hstep;
    const unsigned ldsw = (unsigned)wid * 1024u;
    const int aoff = lds_byte(wr * 64 + fr, fq * 8), boff = lds_byte(wc * 32 + fr, fq * 8);
#define PG8_SA(b, h) (((b) * 2 + (h)) * HTB)
#define PG8_SB(b, h) ((4 + (b) * 2 + (h)) * HTB)
#define PG8_STAGE(bufoff, gbase, voff) do { _Pragma("unroll") for (int _i = 0; _i < 2; ++_i) \
        __builtin_amdgcn_global_load_lds((const unsigned*)((const char*)(gbase) + (voff)[_i]), (PG8_LAS unsigned*)(lds + (bufoff) + ldsw + _i * 8192), 16, 0, 0); } while (0)
#define PG8_LDA(dst, b, h) do { _Pragma("unroll") for (int m = 0; m < 4; ++m) _Pragma("unroll") for (int k = 0; k < 2; ++k) dst[m][k] = *(const PG8_LAS bf16x8*)(lds + PG8_SA(b, h) + aoff + m * 2048 + k * 1024); } while (0)
#define PG8_LDB(dst, b, h) do { _Pragma("unroll") for (int n = 0; n < 2; ++n) _Pragma("unroll") for (int k = 0; k < 2; ++k) dst[n][k] = *(const PG8_LAS bf16x8*)(lds + PG8_SB(b, h) + boff + n * 2048 + k * 1024); } while (0)
#define PG8_MMA(ai, bj, At, Bt) do { __builtin_amdgcn_s_setprio(1); _Pragma("unroll") for (int m = 0; m < 4; ++m) _Pragma("unroll") for (int n = 0; n < 2; ++n) _Pragma("unroll") for (int k = 0; k < 2; ++k) \
        acc[ai][bj][m][n] = __builtin_amdgcn_mfma_f32_16x16x32_bf16(Bt[n][k], At[m][k], acc[ai][bj][m][n], 0, 0, 0); __builtin_amdgcn_s_setprio(0); } while (0)
#define PG8_WAIT_V(n) asm volatile("s_waitcnt vmcnt(" #n ")" ::: "memory")
#define PG8_WAIT_L(n) asm volatile("s_waitcnt lgkmcnt(" #n ")" ::: "memory")
#define PG8_BAR __builtin_amdgcn_s_barrier()
#define PG8_SCHED __builtin_amdgcn_sched_barrier(0)
    Unit cur, nxt; int ui = 0;
    if (!S.next(0, cur)) return;
    f32x4 acc[2][2][4][2];
#pragma unroll
    for (int a = 0; a < 2; ++a)
#pragma unroll
        for (int b = 0; b < 2; ++b)
#pragma unroll
            for (int m = 0; m < 4; ++m)
#pragma unroll
                for (int n = 0; n < 2; ++n) acc[a][b][m][n] = (f32x4){0.f, 0.f, 0.f, 0.f};
    bf16x8 At[4][2], B0[2][2], B1[2][2];
    const char* cA = (const char*)g.A + (size_t)cur.pm * tstep; const char* cB = (const char*)g.Bt + (size_t)cur.pn * tstep;
    S.a_ready(cur);
    if constexpr (SP2) {
        PG8_STAGE(PG8_SB(0, 0), cB, voffB); PG8_STAGE(PG8_SB(0, 1), cB + hstep, voffB); PG8_STAGE(PG8_SA(0, 0), cA, voffA); PG8_STAGE(PG8_SA(0, 1), cA + hstep, voffA);
        if (wr == 1) PG8_BAR;
        PG8_WAIT_V(2); PG8_BAR;
        PG8_STAGE(PG8_SB(1, 0), cB + kstep, voffB); PG8_STAGE(PG8_SA(1, 0), cA + kstep, voffA); PG8_STAGE(PG8_SB(1, 1), cB + hstep + kstep, voffB);
        PG8_WAIT_V(6); PG8_BAR;
    } else {
        PG8_STAGE(PG8_SB(0, 0), cB, voffB); PG8_STAGE(PG8_SA(0, 0), cA, voffA); PG8_STAGE(PG8_SB(0, 1), cB + hstep, voffB); PG8_STAGE(PG8_SA(0, 1), cA + hstep, voffA);
        if (wr == 1) PG8_BAR;
        PG8_WAIT_V(4); PG8_BAR;
        PG8_STAGE(PG8_SB(1, 0), cB + kstep, voffB); PG8_STAGE(PG8_SA(1, 0), cA + kstep, voffA); PG8_STAGE(PG8_SB(1, 1), cB + hstep + kstep, voffB);
        PG8_WAIT_V(6); PG8_BAR;
    }
    for (;;) {
        const bool has_next = S.next(ui + 1, nxt);
        const char* nA = has_next ? (const char*)g.A + (size_t)nxt.pm * tstep : cA; const char* nB = has_next ? (const char*)g.Bt + (size_t)nxt.pn * tstep : cB;
        for (int t = 0; t < nt; t += 2) {
            const bool last = (t == nt - 2);
            const char* a1 = cA + (size_t)(t + 1) * kstep;
            const char* a2 = last ? nA : cA + (size_t)(t + 2) * kstep; const char* b2 = last ? nB : cB + (size_t)(t + 2) * kstep;
            const char* a3 = a2 + kstep; const char* b3 = b2 + kstep;
            if (last && has_next) S.a_ready(nxt);
            if constexpr (SP2) {
            PG8_LDB(B0, 0, 0); PG8_LDB(B1, 0, 1); PG8_SCHED; PG8_LDA(At, 0, 0); PG8_STAGE(PG8_SA(1, 1), a1 + hstep, voffA);
            PG8_WAIT_V(8); PG8_WAIT_L(0); PG8_BAR; PG8_MMA(0, 0, At, B0); PG8_MMA(0, 1, At, B1); PG8_BAR; PG8_SCHED;
            PG8_LDA(At, 0, 1); PG8_STAGE(PG8_SB(0, 0), b2, voffB); PG8_STAGE(PG8_SB(0, 1), b2 + hstep, voffB); PG8_STAGE(PG8_SA(0, 0), a2, voffA);
            PG8_WAIT_V(8); PG8_WAIT_L(0); PG8_BAR; PG8_MMA(1, 0, At, B0); PG8_MMA(1, 1, At, B1); PG8_BAR; PG8_SCHED;
            PG8_LDB(B0, 1, 0); PG8_LDB(B1, 1, 1); PG8_SCHED; PG8_LDA(At, 1, 0); PG8_STAGE(PG8_SA(0, 1), a2 + hstep, voffA);
            PG8_WAIT_V(8); PG8_WAIT_L(0); PG8_BAR; PG8_MMA(0, 0, At, B0); PG8_MMA(0, 1, At, B1); PG8_BAR; PG8_SCHED;
            PG8_LDA(At, 1, 1); PG8_STAGE(PG8_SB(1, 0), b3, voffB); PG8_STAGE(PG8_SB(1, 1), b3 + hstep, voffB); PG8_STAGE(PG8_SA(1, 0), a3, voffA);
            PG8_WAIT_V(8); PG8_WAIT_L(0); PG8_BAR; PG8_MMA(1, 0, At, B0); PG8_MMA(1, 1, At, B1); PG8_BAR; PG8_SCHED;
            } else {
            PG8_LDB(B0, 0, 0); PG8_SCHED; PG8_LDA(At, 0, 0); PG8_STAGE(PG8_SA(1, 1), a1 + hstep, voffA);
            PG8_WAIT_L(8); PG8_BAR; PG8_WAIT_L(0); PG8_MMA(0, 0, At, B0); PG8_BAR; PG8_SCHED;
            PG8_LDB(B1, 0, 1); PG8_STAGE(PG8_SB(0, 0), b2, voffB);
            PG8_BAR; PG8_WAIT_L(0); PG8_MMA(0, 1, At, B1); PG8_BAR;
            PG8_LDA(At, 0, 1); PG8_STAGE(PG8_SA(0, 0), a2, voffA);
            PG8_BAR; PG8_WAIT_L(0); PG8_MMA(1, 0, At, B0); PG8_BAR; PG8_SCHED;
            PG8_STAGE(PG8_SB(0, 1), b2 + hstep, voffB);
            PG8_WAIT_V(6); PG8_BAR; PG8_MMA(1, 1, At, B1); PG8_BAR;
            PG8_LDB(B0, 1, 0); PG8_SCHED; PG8_LDA(At, 1, 0); PG8_STAGE(PG8_SA(0, 1), a2 + hstep, voffA);
            PG8_WAIT_L(8); PG8_BAR; PG8_WAIT_L(0); PG8_MMA(0, 0, At, B0); PG8_BAR; PG8_SCHED;
            PG8_LDB(B1, 1, 1); PG8_STAGE(PG8_SB(1, 0), b3, voffB);
            PG8_BAR; PG8_WAIT_L(0); PG8_MMA(0, 1, At, B1); PG8_BAR;
            PG8_LDA(At, 1, 1); PG8_STAGE(PG8_SA(1, 0), a3, voffA);
            PG8_BAR; PG8_WAIT_L(0); PG8_MMA(1, 0, At, B0); PG8_BAR; PG8_SCHED;
            PG8_STAGE(PG8_SB(1, 1), b3 + hstep, voffB);
            PG8_WAIT_V(6); PG8_BAR; PG8_MMA(1, 1, At, B1); PG8_BAR;
            }
        }
        if constexpr (ALIGN_EPI) { if (wr == 0) PG8_BAR; }
        if constexpr (!Epi::AFTER_DRAIN) { E(acc, cur, wr, wc, fr, fq); S.done(cur); }
        if (!has_next) break;
#pragma unroll
        for (int a = 0; a < 2; ++a)
#pragma unroll
            for (int b = 0; b < 2; ++b)
#pragma unroll
                for (int m = 0; m < 4; ++m)
#pragma unroll
                    for (int n = 0; n < 2; ++n) acc[a][b][m][n] = (f32x4){0.f, 0.f, 0.f, 0.f};
        cur = nxt; cA = nA; cB = nB; ++ui;
        if constexpr (ALIGN_EPI) { if (wr == 1) PG8_BAR; }
    }
    PG8_WAIT_V(0);
    if constexpr (!ALIGN_EPI) { if (wr == 0) PG8_BAR; }
    PG8_BAR;
    if constexpr (Epi::AFTER_DRAIN) { E.fused(acc, cur, wr, wc, fr, fq, lds, wid, lane); S.done(cur); }
#undef PG8_SA
#undef PG8_SB
#undef PG8_STAGE
#undef PG8_LDA
#undef PG8_LDB
#undef PG8_MMA
#undef PG8_WAIT_V
#undef PG8_WAIT_L
#undef PG8_BAR
#undef PG8_SCHED
}
template <class Epi, class Sched, bool ALIGN_EPI = false, bool SP2 = false>
__device__ __forceinline__ void gemm_phase_pair(PG8_LAS unsigned char* lds, const Gemm g, const bf16_t* A2, const bf16_t* Bt2, const Sched& S, const Epi& E) {
    int tid_ = threadIdx.x; asm volatile("" : "+v"(tid_));
    const int tid = tid_, wid = __builtin_amdgcn_readfirstlane(tid >> 6), lane = tid & 63, wr = wid >> 2, wc = wid & 3, fr = lane & 15, fq = lane >> 4;
    const int K = g.K, nt = K / BK;
    unsigned voffA[2], voffB[2];
#pragma unroll
    for (int i = 0; i < 2; ++i) { int R, C; stage_rc(tid * 16 + i * 8192, R, C); const int Rb = Epi::PERM ? ((R & ~31) + perm32(R & 31)) : R;
        voffA[i] = (unsigned)(R * K + C) * 2u; voffB[i] = (unsigned)(Rb * K + C) * 2u; }
    const size_t kstep = (size_t)(BK * 2);
    const size_t hstep = (size_t)HALF * K * 2;
    const size_t tstep = 2 * hstep;
    const unsigned ldsw = (unsigned)wid * 1024u;
    const int aoff = lds_byte(wr * 64 + fr, fq * 8), boff = lds_byte(wc * 32 + fr, fq * 8);
#define PG8_SA(b, h) (((b) * 2 + (h)) * HTB)
#define PG8_SB(b, h) ((4 + (b) * 2 + (h)) * HTB)
#define PG8_STAGE(bufoff, gbase, voff) do { _Pragma("unroll") for (int _i = 0; _i < 2; ++_i) \
        __builtin_amdgcn_global_load_lds((const unsigned*)((const char*)(gbase) + (voff)[_i]), (PG8_LAS unsigned*)(lds + (bufoff) + ldsw + _i * 8192), 16, 0, 0); } while (0)
#define PG8_LDA(dst, b, h) do { _Pragma("unroll") for (int m = 0; m < 4; ++m) _Pragma("unroll") for (int k = 0; k < 2; ++k) dst[m][k] = *(const PG8_LAS bf16x8*)(lds + PG8_SA(b, h) + aoff + m * 2048 + k * 1024); } while (0)
#define PG8_LDB(dst, b, h) do { _Pragma("unroll") for (int n = 0; n < 2; ++n) _Pragma("unroll") for (int k = 0; k < 2; ++k) dst[n][k] = *(const PG8_LAS bf16x8*)(lds + PG8_SB(b, h) + boff + n * 2048 + k * 1024); } while (0)
#define PG8_MMA(ai, bj, At, Bt) do { __builtin_amdgcn_s_setprio(1); _Pragma("unroll") for (int m = 0; m < 4; ++m) _Pragma("unroll") for (int n = 0; n < 2; ++n) _Pragma("unroll") for (int k = 0; k < 2; ++k) \
        acc[ai][bj][m][n] = __builtin_amdgcn_mfma_f32_16x16x32_bf16(Bt[n][k], At[m][k], acc[ai][bj][m][n], 0, 0, 0); __builtin_amdgcn_s_setprio(0); } while (0)
#define PG8_WAIT_V(n) asm volatile("s_waitcnt vmcnt(" #n ")" ::: "memory")
#define PG8_WAIT_L(n) asm volatile("s_waitcnt lgkmcnt(" #n ")" ::: "memory")
#define PG8_BAR __builtin_amdgcn_s_barrier()
#define PG8_SCHED __builtin_amdgcn_sched_barrier(0)
    Unit cur, nxt; int ui = 0;
    if (!S.next(0, cur)) return;
    f32x4 acc[2][2][4][2];
#pragma unroll
    for (int a = 0; a < 2; ++a)
#pragma unroll
        for (int b = 0; b < 2; ++b)
#pragma unroll
            for (int m = 0; m < 4; ++m)
#pragma unroll
                for (int n = 0; n < 2; ++n) acc[a][b][m][n] = (f32x4){0.f, 0.f, 0.f, 0.f};
    bf16x8 At[4][2], B0[2][2], B1[2][2];
    const char* cA = (const char*)g.A + (size_t)cur.pm * tstep; const char* cB = (const char*)g.Bt + (size_t)cur.pn * tstep;
    S.a_ready(cur);
    if constexpr (SP2) {
        PG8_STAGE(PG8_SB(0, 0), cB, voffB); PG8_STAGE(PG8_SB(0, 1), cB + hstep, voffB); PG8_STAGE(PG8_SA(0, 0), cA, voffA); PG8_STAGE(PG8_SA(0, 1), cA + hstep, voffA);
        if (wr == 1) PG8_BAR;
        PG8_WAIT_V(2); PG8_BAR;
        PG8_STAGE(PG8_SB(1, 0), cB + kstep, voffB); PG8_STAGE(PG8_SA(1, 0), cA + kstep, voffA); PG8_STAGE(PG8_SB(1, 1), cB + hstep + kstep, voffB);
        PG8_WAIT_V(6); PG8_BAR;
    } else {
        PG8_STAGE(PG8_SB(0, 0), cB, voffB); PG8_STAGE(PG8_SA(0, 0), cA, voffA); PG8_STAGE(PG8_SB(0, 1), cB + hstep, voffB); PG8_STAGE(PG8_SA(0, 1), cA + hstep, voffA);
        if (wr == 1) PG8_BAR;
        PG8_WAIT_V(4); PG8_BAR;
        PG8_STAGE(PG8_SB(1, 0), cB + kstep, voffB); PG8_STAGE(PG8_SA(1, 0), cA + kstep, voffA); PG8_STAGE(PG8_SB(1, 1), cB + hstep + kstep, voffB);
        PG8_WAIT_V(6); PG8_BAR;
    }
    for (;;) {
        const int sel = ui & 1; bool has_next = true;
        if (sel == 0) nxt = cur; else has_next = S.next((ui + 1) >> 1, nxt);
        const char* nA = has_next ? (const char*)(sel == 0 ? A2 : g.A) + (size_t)nxt.pm * tstep : cA; const char* nB = has_next ? (const char*)(sel == 0 ? Bt2 : g.Bt) + (size_t)nxt.pn * tstep : cB;
        for (int t = 0; t < nt; t += 2) {
            const bool last = (t == nt - 2);
            const char* a1 = cA + (size_t)(t + 1) * kstep;
            const char* a2 = last ? nA : cA + (size_t)(t + 2) * kstep; const char* b2 = last ? nB : cB + (size_t)(t + 2) * kstep;
            const char* a3 = a2 + kstep; const char* b3 = b2 + kstep;
            if (last && has_next) S.a_ready(nxt);
            if constexpr (SP2) {
            PG8_LDB(B0, 0, 0); PG8_LDB(B1, 0, 1); PG8_SCHED; PG8_LDA(At, 0, 0); PG8_STAGE(PG8_SA(1, 1), a1 + hstep, voffA);
            PG8_WAIT_V(8); PG8_WAIT_L(0); PG8_BAR; PG8_MMA(0, 0, At, B0); PG8_MMA(0, 1, At, B1); PG8_BAR; PG8_SCHED;
            PG8_LDA(At, 0, 1); PG8_STAGE(PG8_SB(0, 0), b2, voffB); PG8_STAGE(PG8_SB(0, 1), b2 + hstep, voffB); PG8_STAGE(PG8_SA(0, 0), a2, voffA);
            PG8_WAIT_V(8); PG8_WAIT_L(0); PG8_BAR; PG8_MMA(1, 0, At, B0); PG8_MMA(1, 1, At, B1); PG8_BAR; PG8_SCHED;
            PG8_LDB(B0, 1, 0); PG8_LDB(B1, 1, 1); PG8_SCHED; PG8_LDA(At, 1, 0); PG8_STAGE(PG8_SA(0, 1), a2 + hstep, voffA);
            PG8_WAIT_V(8); PG8_WAIT_L(0); PG8_BAR; PG8_MMA(0, 0, At, B0); PG8_MMA(0, 1, At, B1); PG8_BAR; PG8_SCHED;
            PG8_LDA(At, 1, 1); PG8_STAGE(PG8_SB(1, 0), b3, voffB); PG8_STAGE(PG8_SB(1, 1), b3 + hstep, voffB); PG8_STAGE(PG8_SA(1, 0), a3, voffA);
            PG8_WAIT_V(8); PG8_WAIT_L(0); PG8_BAR; PG8_MMA(1, 0, At, B0); PG8_MMA(1, 1, At, B1); PG8_BAR; PG8_SCHED;
            } else {
            PG8_LDB(B0, 0, 0); PG8_SCHED; PG8_LDA(At, 0, 0); PG8_STAGE(PG8_SA(1, 1), a1 + hstep, voffA);
            PG8_WAIT_L(8); PG8_BAR; PG8_WAIT_L(0); PG8_MMA(0, 0, At, B0); PG8_BAR; PG8_SCHED;
            PG8_LDB(B1, 0, 1); PG8_STAGE(PG8_SB(0, 0), b2, voffB);
            PG8_BAR; PG8_WAIT_L(0); PG8_MMA(0, 1, At, B1); PG8_BAR;
            PG8_LDA(At, 0, 1); PG8_STAGE(PG8_SA(0, 0), a2, voffA);
            PG8_BAR; PG8_WAIT_L(0); PG8_MMA(1, 0, At, B0); PG8_BAR; PG8_SCHED;
            PG8_STAGE(PG8_SB(0, 1), b2 + hstep, voffB);
            PG8_WAIT_V(6); PG8_BAR; PG8_MMA(1, 1, At, B1); PG8_BAR;
            PG8_LDB(B0, 1, 0); PG8_SCHED; PG8_LDA(At, 1, 0); PG8_STAGE(PG8_SA(0, 1), a2 + hstep, voffA);
            PG8_WAIT_L(8); PG8_BAR; PG8_WAIT_L(0); PG8_MMA(0, 0, At, B0); PG8_BAR; PG8_SCHED;
            PG8_LDB(B1, 1, 1); PG8_STAGE(PG8_SB(1, 0), b3, voffB);
            PG8_BAR; PG8_WAIT_L(0); PG8_MMA(0, 1, At, B1); PG8_BAR;
            PG8_LDA(At, 1, 1); PG8_STAGE(PG8_SA(1, 0), a3, voffA);
            PG8_BAR; PG8_WAIT_L(0); PG8_MMA(1, 0, At, B0); PG8_BAR; PG8_SCHED;
            PG8_STAGE(PG8_SB(1, 1), b3 + hstep, voffB);
            PG8_WAIT_V(6); PG8_BAR; PG8_MMA(1, 1, At, B1); PG8_BAR;
            }
        }
        if constexpr (ALIGN_EPI) { if (wr == 0) PG8_BAR; }
        if (sel == 0) E.mid(acc, cur, wr, wc, fr, fq); else { E(acc, cur, wr, wc, fr, fq); S.done(cur); }
        if (!has_next) break;
        if (sel == 1) {
#pragma unroll
        for (int a = 0; a < 2; ++a)
#pragma unroll
            for (int b = 0; b < 2; ++b)
#pragma unroll
                for (int m = 0; m < 4; ++m)
#pragma unroll
                    for (int n = 0; n < 2; ++n) acc[a][b][m][n] = (f32x4){0.f, 0.f, 0.f, 0.f};
        }
        cur = nxt; cA = nA; cB = nB; ++ui;
        if constexpr (ALIGN_EPI) { if (wr == 1) PG8_BAR; }
    }
    PG8_WAIT_V(0);
    if constexpr (!ALIGN_EPI) { if (wr == 0) PG8_BAR; }
    PG8_BAR;
    if constexpr (Epi::AFTER_DRAIN) { E.fused(acc, cur, wr, wc, fr, fq, lds, wid, lane); S.done(cur); }
#undef PG8_SA
#undef PG8_SB
#undef PG8_STAGE
#undef PG8_LDA
#undef PG8_LDB
#undef PG8_MMA
#undef PG8_WAIT_V
#undef PG8_WAIT_L
#undef PG8_BAR
#undef PG8_SCHED
}
}

#ifndef PG8_SP2
#define PG8_SP2 true
#endif
#ifndef PG8_ALIGN
#define PG8_ALIGN true
#endif

namespace attn_body {
using bf16=__hip_bfloat16;
using bf16x8=__attribute__((ext_vector_type(8)))short;
using s16x4=__attribute__((ext_vector_type(4)))short;
using f32x16=__attribute__((ext_vector_type(16)))float;
using u32x4=__attribute__((ext_vector_type(4)))unsigned;
constexpr int BATCH=2,NHEAD=16,SEQ=4096,D=64,DM=NHEAD*D;
constexpr int NW=8,QBLK=32,QB=QBLK*NW,KVBLK=64,NQB=SEQ/QB;
constexpr int ATTN_PITCH=DM, ATTN_UNIT_ROWS=QB;
__device__ __forceinline__ int crow(int r,int hi){return (r&3)+8*(r>>2)+4*hi;}
#define SBAR() __builtin_amdgcn_sched_barrier(0)
__device__ __forceinline__ void cmask(f32x16&p0,f32x16&p1,int jb,int qrel,int hi){
  const float NEG=-INFINITY; int kb=64*jb+4*hi;
  #pragma unroll
  for(int r=0;r<16;++r){int kv=kb+(r&3)+8*(r>>2); if(kv>qrel)p0[r]=NEG; if(kv+32>qrel)p1[r]=NEG;}
}

constexpr int NSLOT=3, SLOTB=8192;
constexpr int LDS_K=0, LDS_V=NSLOT*SLOTB, LDS_WS=2*NSLOT*SLOTB, LDS_OST=LDS_WS+NW*64*4, LDS_BYTES=LDS_OST+NW*4096;
constexpr float C2=0.125f*1.4426950408889634f;
__device__ __forceinline__ void glds16(const void*gsrc,unsigned lds_dst){unsigned keep;
  asm volatile("s_mov_b32 %0, m0\n\ts_mov_b32 m0, %2\n\ts_nop 0\n\tglobal_load_lds_dwordx4 %1, off\n\ts_mov_b32 m0, %0":"=&s"(keep):"v"(gsrc),"s"(lds_dst):"memory");}
__device__ __forceinline__ float max3f(float a,float b,float c){float r;asm("v_max3_f32 %0, %1, %2, %3":"=v"(r):"v"(a),"v"(b),"v"(c));return r;}
__device__ __forceinline__ float max2f(float a,float b){float r;asm("v_max_f32_e32 %0, %1, %2":"=v"(r):"v"(a),"v"(b));return r;}
__device__ __forceinline__ float fadd_s(float a,float b){float r;asm("v_add_f32_e32 %0, %1, %2":"=v"(r):"v"(a),"v"(b));return r;}
__device__ __forceinline__ float fsub_s(float a,float b){float r;asm("v_sub_f32_e32 %0, %1, %2":"=v"(r):"v"(a),"v"(b));return r;}
typedef float f32x2_t __attribute__((ext_vector_type(2))); typedef __bf16 bf16x2_t __attribute__((ext_vector_type(2)));
__device__ __forceinline__ unsigned cvtpk_s(float lo,float hi){f32x2_t v={lo,hi};bf16x2_t b=__builtin_convertvector(v,bf16x2_t);return __builtin_bit_cast(unsigned,b);}
#define WAIT_BAR(N) asm volatile("s_waitcnt vmcnt(" #N ") lgkmcnt(0)\n\ts_barrier":::"memory")

__device__ __forceinline__ void qkt(f32x16&p0,f32x16&p1,const char*Kslot,const bf16x8*qr,const f32x16&negm,int r32,int hi){
  const char*kb=Kslot+hi*1024+r32*16;
  #pragma unroll
  for(int d0=0;d0<4;++d0){
    const bf16x8 b0=*reinterpret_cast<const bf16x8*>(kb+d0*2048);
    const bf16x8 b1=*reinterpret_cast<const bf16x8*>(kb+d0*2048+512);
    if(d0==0){p0=__builtin_amdgcn_mfma_f32_32x32x16_bf16(b0,qr[0],negm,0,0,0);p1=__builtin_amdgcn_mfma_f32_32x32x16_bf16(b1,qr[0],negm,0,0,0);}
    else{p0=__builtin_amdgcn_mfma_f32_32x32x16_bf16(b0,qr[d0],p0,0,0,0);p1=__builtin_amdgcn_mfma_f32_32x32x16_bf16(b1,qr[d0],p1,0,0,0);}}
}
typedef __attribute__((address_space(3))) const char* lds_cptr;
typedef short v4i16_t __attribute__((ext_vector_type(4)));
__device__ __forceinline__ void kload8(bf16x8*kf,lds_cptr kp){
  kf[0]=*(const __attribute__((address_space(3))) bf16x8*)(kp);      kf[1]=*(const __attribute__((address_space(3))) bf16x8*)(kp+512);
  kf[2]=*(const __attribute__((address_space(3))) bf16x8*)(kp+2048); kf[3]=*(const __attribute__((address_space(3))) bf16x8*)(kp+2560);
  kf[4]=*(const __attribute__((address_space(3))) bf16x8*)(kp+4096); kf[5]=*(const __attribute__((address_space(3))) bf16x8*)(kp+4608);
  kf[6]=*(const __attribute__((address_space(3))) bf16x8*)(kp+6144); kf[7]=*(const __attribute__((address_space(3))) bf16x8*)(kp+6656);
}
__device__ __forceinline__ void kload2(bf16x8*kf,lds_cptr kp,int j){ kf[2*j]=*(const __attribute__((address_space(3))) bf16x8*)(kp+j*2048); kf[2*j+1]=*(const __attribute__((address_space(3))) bf16x8*)(kp+j*2048+512); }
__device__ __forceinline__ s16x4 vtr(lds_cptr p){ return __builtin_bit_cast(s16x4,__builtin_amdgcn_ds_read_tr16_b64_v4i16((__attribute__((address_space(3))) v4i16_t*)p)); }
__device__ __forceinline__ float rowmax(const f32x16&p0,const f32x16&p1){
  float a=max3f(p0[0],p0[1],p1[0]),b=max3f(p0[2],p0[3],p1[1]);a=max3f(a,p1[2],p1[3]);
  #pragma unroll
  for(int r=4;r<16;r+=4){a=max3f(a,p0[r],p0[r+1]);b=max3f(b,p0[r+2],p0[r+3]);a=max3f(a,p1[r],p1[r+1]);b=max3f(b,p1[r+2],p1[r+3]);}
  const float m=max2f(a,b);
  auto rr=__builtin_amdgcn_permlane32_swap(__float_as_uint(m),__float_as_uint(m),false,false);
  return max2f(__uint_as_float(rr[0]),__uint_as_float(rr[1]));
}
__device__ __forceinline__ void pv(f32x16*o,int vb,bf16x8 pa0,bf16x8 pa1,bf16x8 pa2,bf16x8 pa3){
  #pragma unroll
  for(int d0=0;d0<2;++d0){s16x4 lo[4],hi[4];
    #pragma unroll
    for(int ks=0;ks<4;++ks){
      asm volatile("ds_read_b64_tr_b16 %0,%1 offset:%c2":"=&v"(lo[ks]):"v"(vb),"i"(d0*4096+ks*1024):"memory");
      asm volatile("ds_read_b64_tr_b16 %0,%1 offset:%c2":"=&v"(hi[ks]):"v"(vb),"i"(d0*4096+ks*1024+512):"memory");}
    asm volatile("s_waitcnt lgkmcnt(0)":::"memory");SBAR();
    #define PK(k) (bf16x8){lo[k][0],lo[k][1],lo[k][2],lo[k][3],hi[k][0],hi[k][1],hi[k][2],hi[k][3]}
    o[d0]=__builtin_amdgcn_mfma_f32_32x32x16_bf16(pa0,PK(0),o[d0],0,0,0);
    o[d0]=__builtin_amdgcn_mfma_f32_32x32x16_bf16(pa1,PK(1),o[d0],0,0,0);
    o[d0]=__builtin_amdgcn_mfma_f32_32x32x16_bf16(pa2,PK(2),o[d0],0,0,0);
    o[d0]=__builtin_amdgcn_mfma_f32_32x32x16_bf16(pa3,PK(3),o[d0],0,0,0);
    #undef PK
  }
}

#ifndef ATTN_STORE16
#define ATTN_STORE16(p,v) (*(u32x4*)(p)=(v))
#endif
template<int THRL> __device__ __forceinline__ void attn_unit(int b,int qkoff,int voff,int qb,const bf16*Q,const bf16*__restrict__ K,const bf16*__restrict__ V,bf16*O,char*shm){
  const int tid=threadIdx.x,lane=tid&63,r32=lane&31,hi=lane>>5; const int wid=__builtin_amdgcn_readfirstlane(tid>>6);
  const long rowbase=(long)b*SEQ; const int q0=qb*QB;
  const bf16*Qw=Q+(rowbase+q0+wid*QBLK)*DM+qkoff;
  const bf16*Kh=K+rowbase*DM+qkoff,*Vh=V+rowbase*DM+voff;
  const unsigned lds0=(unsigned)(uintptr_t)shm;
  float*wsf=(float*)(shm+LDS_WS)+wid*64;
  const bf16*ksrc=Kh+(long)lane*DM+wid*8;
  const bf16*vsrc=Vh+(long)(16*(wid&3)+(lane>>2))*DM+(wid>>2)*32+(lane&3)*8;
  const unsigned kdst=lds0+LDS_K+wid*1024, vdst=lds0+LDS_V+wid*1024;
  #define DMA_K(t,slot) glds16(ksrc+(long)(t)*KVBLK*DM,(unsigned)__builtin_amdgcn_readfirstlane(kdst+(slot)))
  #define DMA_V(t,slot) glds16(vsrc+(long)(t)*KVBLK*DM,(unsigned)__builtin_amdgcn_readfirstlane(vdst+(slot)))
  const int vb0=(int)(lds0+LDS_V)+((lane>>4)&1)*32+(lane&3)*8+(4*hi+((lane&15)>>2))*64;
  const char*Kbase=shm+LDS_K; bf16x8 kf[8];
  const lds_cptr shm3=(lds_cptr)shm; const lds_cptr kp0=shm3+LDS_K+hi*1024+r32*16; const lds_cptr vp0=shm3+LDS_V+((lane>>4)&1)*32+(lane&3)*8+(4*hi+((lane&15)>>2))*64;
  const int NT=(q0+QB)/KVBLK;
  DMA_K(0,0);DMA_V(0,0);DMA_K(1,SLOTB);
  bf16x8 qr[4];
  #pragma unroll
  for(int d0=0;d0<4;++d0)qr[d0]=*reinterpret_cast<const bf16x8*>(&Qw[(long)r32*DM+d0*16+hi*8]);
  float mhat=0.f,l_reg=0.f;f32x16 o[2];o[0]=f32x16{};o[1]=f32x16{};f32x16 negm=f32x16{};asm volatile("":"+v"(negm));
  const int qrel=wid*QBLK+r32;
  #define CMASK(P0,P1,t) do{int jb_=(t)-(NT-4); if(jb_>=0)cmask(P0,P1,jb_,qrel,hi);}while(0)
  bool resc=false;
  #define START(P0,P1) do{ const float rm=rowmax(P0,P1); resc=false; \
    { const float dl=rm; mhat=fadd_s(mhat,dl); \
      _Pragma("unroll") for(int r=0;r<16;++r){P0[r]=fsub_s(P0[r],dl);P1[r]=fsub_s(P1[r],dl);} \
      _Pragma("unroll") for(int r=0;r<16;++r)negm[r]=-mhat; asm volatile("":"+v"(negm)); } \
    _Pragma("unroll") for(int r=0;r<16;++r)P0[r]=__builtin_amdgcn_exp2f(P0[r]); }while(0)
  #define RESC() do{ if(resc){ asm volatile("s_waitcnt lgkmcnt(0)":::"memory"); \
      _Pragma("unroll") for(int d_=0;d_<2;++d_) _Pragma("unroll") for(int r=0;r<16;++r)o[d_][r]*=wsf[crow(r,hi)]; } }while(0)
  f32x16 pA0,pA1,pB0,pB1;
  int sl_prev=0,sl_cur=0,sl_next=SLOTB;
  #define ROT() do{sl_prev=sl_cur;sl_cur=sl_next;sl_next=(sl_next==(NSLOT-1)*SLOTB)?0:sl_next+SLOTB;}while(0)
  DMA_K(2,2*SLOTB);
  WAIT_BAR(3);
  qkt(pA0,pA1,Kbase,qr,negm,r32,hi);asm volatile("s_nop 15\n\ts_nop 7":"+v"(pA0),"+v"(pA1));CMASK(pA0,pA1,0);
  START(pA0,pA1);
  _Pragma("unroll") for(int r=0;r<16;++r)pA1[r]=__builtin_amdgcn_exp2f(pA1[r]);
  WAIT_BAR(0);
  DMA_K(3,0);DMA_V(1,SLOTB);
  ROT();
  kload8(kf,kp0+sl_cur);
  WAIT_BAR(2);
  s16x4 vlo[8],vhi[8]; u32x4 pw0,pw1,pw2,pw3;
  #define PKW(P,B) cvtpk_s(P[B],P[B+1])
  #define PAF(k) __builtin_bit_cast(bf16x8,pw##k)
  #define VFR(i) (bf16x8){vlo[i][0],vlo[i][1],vlo[i][2],vlo[i][3],vhi[i][0],vhi[i][1],vhi[i][2],vhi[i][3]}
  #define PIN(x) asm volatile("":"+v"(x))
  #define MX3(a,b,c) __builtin_fmaxf(__builtin_fmaxf((a),(b)),(c))
  #define GAPA(MF,A0,A1,A2,A3,W0,W1,PW) do{ MF; sacc+=A0; sacc+=A1; sacc+=A2; sacc+=A3; PIN(sacc); W0; W1; PIN(PW); SBAR(); }while(0)
  #define EX(v) __builtin_amdgcn_exp2f(v)
  #define GAPB(MF,X,B) do{ MF; X[B]=EX(X[B]); X[B+1]=EX(X[B+1]); X[B+2]=EX(X[B+2]); X[B+3]=EX(X[B+3]); PIN(X); SBAR(); }while(0)
  #define VRD(i) do{ vlo[i]=vtr(vp_+(((i)>>2)*4096+((i)&3)*1024)); vhi[i]=vtr(vp_+(((i)>>2)*4096+((i)&3)*1024+512)); }while(0)
  #define KRD(G,j) do{ if(G){ kload2(kf,kp0+sl_next,j); SBAR(); } }while(0)
  #define STEP(C0,C1,P0,P1,t,GK,GV,GL) do{ SBAR(); \
    const lds_cptr vp_=vp0+sl_prev; \
    VRD(0); SBAR(); float sacc=(P0[0]+P0[1]); \
    GAPA(C0=__builtin_amdgcn_mfma_f32_32x32x16_bf16(kf[0],qr[0],negm,0,0,0), P0[2],P0[3],P0[4],P0[5],     pw0[0]=PKW(P0,0), pw0[1]=PKW(P0,2), pw0); \
    VRD(4); SBAR(); GAPA(C1=__builtin_amdgcn_mfma_f32_32x32x16_bf16(kf[1],qr[0],negm,0,0,0), P0[6],P0[7],P0[8],P0[9],     pw0[2]=PKW(P0,4), pw0[3]=PKW(P0,6), pw0); \
    VRD(1); SBAR(); GAPA(C0=__builtin_amdgcn_mfma_f32_32x32x16_bf16(kf[2],qr[1],C0,0,0,0),   P0[10],P0[11],P0[12],P0[13], pw1[0]=PKW(P0,8), pw1[1]=PKW(P0,10), pw1); \
    VRD(5); SBAR(); GAPA(C1=__builtin_amdgcn_mfma_f32_32x32x16_bf16(kf[3],qr[1],C1,0,0,0),   P0[14],P0[15],P1[0],P1[1],   pw1[2]=PKW(P0,12),pw1[3]=PKW(P0,14), pw1); \
    VRD(2); SBAR(); GAPA(C0=__builtin_amdgcn_mfma_f32_32x32x16_bf16(kf[4],qr[2],C0,0,0,0),   P1[2],P1[3],P1[4],P1[5],     pw2[0]=PKW(P1,0), pw2[1]=PKW(P1,2), pw2); \
    VRD(6); SBAR(); GAPA(C1=__builtin_amdgcn_mfma_f32_32x32x16_bf16(kf[5],qr[2],C1,0,0,0),   P1[6],P1[7],P1[8],P1[9],     pw2[2]=PKW(P1,4), pw2[3]=PKW(P1,6), pw2); \
    VRD(3); SBAR(); GAPA(C0=__builtin_amdgcn_mfma_f32_32x32x16_bf16(kf[6],qr[3],C0,0,0,0),   P1[10],P1[11],P1[12],P1[13], pw3[0]=PKW(P1,8), pw3[1]=PKW(P1,10), pw3); \
    VRD(7); SBAR(); GAPA(C1=__builtin_amdgcn_mfma_f32_32x32x16_bf16(kf[7],qr[3],C1,0,0,0),   P1[14],P1[15],0.f,0.f,       pw3[2]=PKW(P1,12),pw3[3]=PKW(P1,14), pw3); \
    l_reg+=sacc; \
    if(GK){DMA_K((t)+3,sl_cur);} if(GV){DMA_V((t)+1,sl_next);} \
    CMASK(C0,C1,t); \
    { float a=MX3(C0[0],C0[1],C1[0]),b=MX3(C0[2],C0[3],C1[1]); a=MX3(a,C1[2],C1[3]); \
      _Pragma("unroll") for(int r=4;r<16;r+=4){a=MX3(a,C0[r],C0[r+1]);b=MX3(b,C0[r+2],C0[r+3]);a=MX3(a,C1[r],C1[r+1]);b=MX3(b,C1[r+2],C1[r+3]);} \
      float rm=__builtin_fmaxf(a,b); { auto rr=__builtin_amdgcn_permlane32_swap(__float_as_uint(rm),__float_as_uint(rm),false,false); rm=__builtin_fmaxf(__uint_as_float(rr[0]),__uint_as_float(rr[1])); } \
      resc=false; \
      if(__builtin_expect(__any(rm>(float)THRL),0)){ const float dl=__builtin_fmaxf(rm,0.f); mhat+=dl; \
        _Pragma("unroll") for(int r=0;r<16;++r){C0[r]-=dl;C1[r]-=dl;} \
        _Pragma("unroll") for(int r=0;r<16;++r)negm[r]=-mhat; asm volatile("":"+v"(negm)); \
        const float f=__builtin_amdgcn_exp2f(-dl); l_reg*=f; if(hi==0)wsf[r32]=f; resc=true; } } \
    SBAR(); \
    GAPB(o[0]=__builtin_amdgcn_mfma_f32_32x32x16_bf16(PAF(0),VFR(0),o[0],0,0,0), C0,0); \
    GAPB(o[1]=__builtin_amdgcn_mfma_f32_32x32x16_bf16(PAF(0),VFR(4),o[1],0,0,0), C0,4); \
    KRD(GL,0); GAPB(o[0]=__builtin_amdgcn_mfma_f32_32x32x16_bf16(PAF(1),VFR(1),o[0],0,0,0), C0,8); \
    KRD(GL,1); GAPB(o[1]=__builtin_amdgcn_mfma_f32_32x32x16_bf16(PAF(1),VFR(5),o[1],0,0,0), C0,12); \
    KRD(GL,2); GAPB(o[0]=__builtin_amdgcn_mfma_f32_32x32x16_bf16(PAF(2),VFR(2),o[0],0,0,0), C1,0); \
    KRD(GL,3); GAPB(o[1]=__builtin_amdgcn_mfma_f32_32x32x16_bf16(PAF(2),VFR(6),o[1],0,0,0), C1,4); \
    GAPB(o[0]=__builtin_amdgcn_mfma_f32_32x32x16_bf16(PAF(3),VFR(3),o[0],0,0,0), C1,8); \
    GAPB(o[1]=__builtin_amdgcn_mfma_f32_32x32x16_bf16(PAF(3),VFR(7),o[1],0,0,0), C1,12); \
    }while(0)
  int t=1;
  #undef CMASK
  #define CMASK(P0,P1,t) do{}while(0)
  for(;t+5<NT;t+=2){
    STEP(pB0,pB1,pA0,pA1,t,true,true,true);     WAIT_BAR(2); RESC(); ROT();
    STEP(pA0,pA1,pB0,pB1,t+1,true,true,true);   WAIT_BAR(2); RESC(); ROT();
  }
  #undef CMASK
  #define CMASK(P0,P1,t) do{int jb_=(t)-(NT-4); if(jb_>=0)cmask(P0,P1,jb_,qrel,hi);}while(0)
  #define ENDW(tt) do{ if((tt)+3<NT){WAIT_BAR(2);} else if((tt)+2<NT){WAIT_BAR(1);} else {WAIT_BAR(0);} }while(0)
  for(;t+1<NT;t+=2){
    STEP(pB0,pB1,pA0,pA1,t,(t+3<NT),(t+1<NT),(t+1<NT));       ENDW(t);   RESC(); ROT();
    STEP(pA0,pA1,pB0,pB1,t+1,(t+4<NT),(t+2<NT),(t+2<NT));     ENDW(t+1); RESC(); ROT();
  }
  STEP(pB0,pB1,pA0,pA1,NT-1,false,false,false); RESC();
  { float sacc=pB0[0]+pB0[1]; _Pragma("unroll") for(int r=2;r<16;++r)sacc+=pB0[r]; _Pragma("unroll") for(int r=0;r<16;++r)sacc+=pB1[r]; l_reg+=sacc;
    pw0=(u32x4){PKW(pB0,0),PKW(pB0,2),PKW(pB0,4),PKW(pB0,6)};pw1=(u32x4){PKW(pB0,8),PKW(pB0,10),PKW(pB0,12),PKW(pB0,14)};pw2=(u32x4){PKW(pB1,0),PKW(pB1,2),PKW(pB1,4),PKW(pB1,6)};pw3=(u32x4){PKW(pB1,8),PKW(pB1,10),PKW(pB1,12),PKW(pB1,14)};
    SBAR(); pv(o,vb0+sl_cur,PAF(0),PAF(1),PAF(2),PAF(3)); }
  #undef PKW
  #undef PAF
  #undef VFR
  #undef PIN
  #undef MX3
  #undef GAPA
  #undef GAPB
  #undef EX
  #undef VRD
  #undef KRD
  #undef STEP
  #undef ENDW
  {auto rr=__builtin_amdgcn_permlane32_swap(__float_as_uint(l_reg),__float_as_uint(l_reg),false,false);l_reg=__uint_as_float(rr[0])+__uint_as_float(rr[1]);}
  if(hi==0)wsf[32+r32]=l_reg;asm volatile("s_waitcnt lgkmcnt(0)":::"memory");
  float rli[16];
  #pragma unroll
  for(int r=0;r<16;++r)rli[r]=__builtin_amdgcn_rcpf(wsf[32+crow(r,hi)]);
  bf16*Ow=O+(rowbase+q0+wid*QBLK)*DM+voff;
  { bf16*stg=(bf16*)(shm+LDS_OST)+wid*2048;
    #pragma unroll
    for(int r=0;r<16;++r){const int orow=crow(r,hi);
      #pragma unroll
      for(int d0=0;d0<2;++d0)stg[orow*64+d0*32+r32]=__float2bfloat16(o[d0][r]*rli[r]);}
    asm volatile("s_waitcnt lgkmcnt(0)":::"memory");
    #pragma unroll
    for(int i=0;i<4;++i){const int row=i*8+(lane>>3),ch=lane&7; const u32x4 v=*(const u32x4*)(stg+row*64+ch*8); ATTN_STORE16(Ow+(long)row*DM+ch*8,v);} }
  asm volatile("s_waitcnt lgkmcnt(0)\n\ts_barrier":::"memory");
  #undef DMA_K
  #undef DMA_V
  #undef CMASK
  #undef START
  #undef RESC
  #undef ROT
}
constexpr int ATTN_LDS_BYTES=LDS_BYTES;
struct AttnTensors { const bf16* Q; const bf16* K; const bf16* V; bf16* O0; bf16* O1; };
struct AttnUnit { int vh; int qb; };
struct StaticOrder {
  int vcu, G;
  __device__ __forceinline__ explicit StaticOrder(int grid,int vcu_):vcu(vcu_),G(grid){}
  __device__ __forceinline__ bool next(int i,AttnUnit&u)const{
    if(G==256){ if(i>=4)return false; const int s=vcu&3; u.vh=vcu>>2; u.qb=(i==0)?s:(i==1)?7-s:(i==2)?8+s:15-s; return true; }
    const int L=i*G+vcu; if(L>=64*NQB)return false; u.vh=L&63; u.qb=NQB-1-(L>>6); return true; }
  __device__ __forceinline__ void a_ready(const AttnUnit&)const{}
  __device__ __forceinline__ void done(const AttnUnit&)const{}
};
template<class Sched,int THRL=8> __device__ __forceinline__ void attn_phase(char*lds,const AttnTensors&T,const Sched&S){
  AttnUnit u;
  for(int i=0;S.next(i,u);++i){ S.a_ready(u);
    const int b=u.vh>>5,h=(u.vh>>2)&7,c=(u.vh>>1)&1,half=u.vh&1;
    attn_unit<THRL>(b,h*128+c*64,h*128+half*64,u.qb,T.Q,T.K,T.V,c?T.O1:T.O0,lds); S.done(u); }
}
#undef SBAR
#undef WAIT_BAR
}

#define GAS __attribute__((address_space(1)))
#define LAS __attribute__((address_space(3)))
typedef unsigned short bf16;
typedef unsigned v4u __attribute__((ext_vector_type(4)));
typedef unsigned v2u __attribute__((ext_vector_type(2)));
typedef float f32x4 __attribute__((ext_vector_type(4)));
typedef short bf16x8 __attribute__((ext_vector_type(8)));
typedef GAS unsigned gu32;
typedef GAS unsigned long long gu64;
#define RLX_AGENT __ATOMIC_RELAXED, __HIP_MEMORY_SCOPE_AGENT
#define LDS_WAIT() asm volatile("s_waitcnt lgkmcnt(0)" ::: "memory")
#define VM_WAIT() asm volatile("s_waitcnt vmcnt(0)" ::: "memory")
__device__ __forceinline__ unsigned long long rt() { return __builtin_amdgcn_s_memrealtime(); }
__device__ __forceinline__ unsigned f2bf(float f) { unsigned u = __builtin_bit_cast(unsigned, f); return (u + 0x7fffu + ((u >> 16) & 1u)) >> 16; }
typedef float f32x2_hw __attribute__((ext_vector_type(2))); typedef __bf16 bf16x2_hw __attribute__((ext_vector_type(2)));
__device__ __forceinline__ unsigned pk2(float lo, float hi) { const f32x2_hw v = {lo, hi}; return __builtin_bit_cast(unsigned, __builtin_convertvector(v, bf16x2_hw)); }

#define XB_TMO      128
#define XB_XCNT(j)  (256  + 64 * (j))
#define XB_XSUB(j)  (1280 + 64 * (j))
#define XB_XGEN(j)  (2304 + 64 * (j))
#define XB_TOP      3328
#define XB_TOPGEN   3392
#define XCD_BAR_WORDS 3456
#define XB_SPIN_CAP (1u << 18)

__device__ __forceinline__ unsigned xb_ld(unsigned* p)              { return __hip_atomic_load(p, __ATOMIC_RELAXED, __HIP_MEMORY_SCOPE_AGENT); }
__device__ __forceinline__ unsigned xb_add(unsigned* p, unsigned v) { return __hip_atomic_fetch_add(p, v, __ATOMIC_RELAXED, __HIP_MEMORY_SCOPE_AGENT); }
__device__ __forceinline__ unsigned xb_xcc_id() { return (unsigned)__builtin_amdgcn_s_getreg((3 << 11) | 20) & 0xFu; }
#define XB_SPIN(cond, bar) do { unsigned _sp = 0; while (cond) { __builtin_amdgcn_s_sleep(1); \
    if ((++_sp & 255u) == 0u) { if (xb_ld(&(bar)[XB_TMO])) break; if (_sp > XB_SPIN_CAP) { atomicAdd(&(bar)[XB_TMO], 1u); break; } } } } while (0)

struct XcdBarrier {
    unsigned* bar; unsigned x;
    volatile LAS unsigned* st;
};

__device__ __forceinline__ XcdBarrier xcd_barrier_post(unsigned* bar, volatile LAS unsigned* st) {
    XcdBarrier b; b.bar = bar; b.x = xb_xcc_id(); b.st = st;
    if (threadIdx.x == 0) (void)xb_add(&bar[XB_XCNT(b.x)], 1u);
    return b;
}
__device__ __forceinline__ void xcd_barrier_complete(unsigned* bar, unsigned x, unsigned& nloc, unsigned& nx) {
    const unsigned G = gridDim.x * gridDim.y * gridDim.z;
    unsigned sum, cnt, mine, sp = 0u;
    for (;;) {
        sum = 0u; cnt = 0u; mine = 0u;
#pragma unroll
        for (unsigned j = 0; j < 16; ++j) { const unsigned c = xb_ld(&bar[XB_XCNT(j)]); sum += c; cnt += (c > 0u) ? 1u : 0u; mine = (j == x) ? c : mine; }
        if (sum == G) break;
        __builtin_amdgcn_s_sleep(1);
        if ((++sp & 255u) == 0u) { if (xb_ld(&bar[XB_TMO])) break; if (sp > XB_SPIN_CAP) { atomicAdd(&bar[XB_TMO], 1u); break; } }
    }
    nloc = mine > 0u ? mine : 1u; nx = cnt > 0u ? cnt : 1u;
}

__device__ __forceinline__ void xcd_barrier(const XcdBarrier& b) {
    asm volatile("s_waitcnt vmcnt(0)" ::: "memory");
    __syncthreads();
    if (threadIdx.x == 0) {
        unsigned* bar = b.bar;
        __builtin_amdgcn_s_waitcnt(0);
        unsigned nloc = b.st[0], nx = b.st[1];
        if (nloc == 0u) { xcd_barrier_complete(bar, b.x, nloc, nx); b.st[0] = nloc; b.st[1] = nx; }
        const unsigned old = xb_add(&bar[XB_XSUB(b.x)], 1u);
        const unsigned gen = old / nloc;
        if (old + 1u == (gen + 1u) * nloc) {
            __builtin_amdgcn_fence(__ATOMIC_RELEASE, "agent");
            asm volatile("s_waitcnt vmcnt(0)" ::: "memory");
            const unsigned og = xb_add(&bar[XB_TOP], 1u);
            const unsigned tg = og / nx;
            if (og + 1u == (tg + 1u) * nx) xb_add(&bar[XB_TOPGEN], 1u);
            else XB_SPIN(xb_ld(&bar[XB_TOPGEN]) == tg, bar);
            __builtin_amdgcn_fence(__ATOMIC_ACQUIRE, "agent");
            xb_add(&bar[XB_XGEN(b.x)], 1u);
            asm volatile("s_waitcnt vmcnt(0)" ::: "memory");
        } else {
            XB_SPIN(xb_ld(&bar[XB_XGEN(b.x)]) == gen, bar);
            __builtin_amdgcn_fence(__ATOMIC_ACQUIRE, "agent");
            asm volatile("s_waitcnt vmcnt(0)" ::: "memory");
        }
    }
    __syncthreads();
}

constexpr int NWAVES = 8, NTHR = 512;
constexpr int BATCH = 2, SEQ = 4096, DM = 2048, M = BATCH * SEQ;
constexpr int ATT_W = 1024, RW_W = 1024, RW_COLS = 3328, GATE_COLS = 4096, IN_COLS = 10496;
constexpr int NEXP = 64, EFF = 1024, CAP = 8192;
constexpr float NORM_EPS = 1e-6f, SUBLN_EPS = 1e-5f, LNX_EPS = 64e-5f;
constexpr float LAMBDA_INIT = 0.2f;
#ifndef RWKV_SEQ
#define RWKV_SEQ 0
#endif
#ifndef MK_ONE_LAUNCH
#define MK_ONE_LAUNCH 1
#endif
constexpr int NPHASE = 14;

constexpr size_t MiB = 1u << 20;
constexpr size_t WS_CTL = 0, CTL_ZERO_BYTES = 1 * MiB;
constexpr size_t WS_ADA = 1 * MiB;
constexpr size_t WS_ROPE = 1 * MiB + 512 * 1024;
constexpr size_t WS_W2T = 2 * MiB;
constexpr size_t WS_A2T = 2 * MiB + 128 * 1024;
constexpr size_t WS_G2T = 2 * MiB + 256 * 1024;
constexpr size_t WS_TOKE = 3 * MiB;
constexpr size_t WS_TOKP = 3 * MiB + 64 * 1024;
constexpr size_t WS_TOKW = 3 * MiB + 128 * 1024;
constexpr size_t WS_LIST = 4 * MiB;
constexpr size_t WS_WRH = 6 * MiB, WS_WRL = 7 * MiB;
constexpr size_t WS_WIN_T = 8 * MiB;
constexpr size_t WS_WUPA_T = 50 * MiB, WS_WUPB_T = 54 * MiB, WS_WOUT_T = 58 * MiB;
constexpr size_t WS_U = 68 * MiB;
constexpr size_t WS_Q = 100 * MiB, WS_K = 116 * MiB, WS_V = 132 * MiB;
constexpr size_t WS_PR = 148 * MiB;
constexpr size_t WS_G = 200 * MiB;
constexpr size_t WS_O0 = 264 * MiB, WS_O1 = 280 * MiB;
constexpr size_t WS_YATT = 296 * MiB, WS_YRW = 312 * MiB;
constexpr size_t WS_MERGED = 392 * MiB;
constexpr size_t WS_H1 = 424 * MiB;
constexpr size_t WS_U2 = 328 * MiB;
constexpr size_t WS_ACT = 520 * MiB;
constexpr int U2P = 2048 + 64, ACTP = 1024 + 64;
constexpr size_t WS_YS = 560 * MiB;
constexpr size_t WS_RW = 632 * MiB;
constexpr size_t RW_ARR = 32 * MiB;
constexpr size_t WS_END = WS_RW + 9 * RW_ARR;
constexpr int CW_TMO = 0, CW_CODE = 1, CW_BAR = 4096, CW_CNT = 8192, CW_P3Q = 8192 + 128;

constexpr int RING_OFF = 0, RING_BYTES = 159744;
constexpr int LDSCTL_OFF = RING_BYTES, MISC_OFF = LDSCTL_OFF + 320;
constexpr int LDS_BYTES = 163840;

__device__ __forceinline__ float bf2f(unsigned short h) { return __builtin_bit_cast(float, (unsigned)h << 16); }
__device__ __forceinline__ float bflo(unsigned w) { return __builtin_bit_cast(float, w << 16); }
__device__ __forceinline__ float bfhi(unsigned w) { return __builtin_bit_cast(float, w & 0xffff0000u); }
__device__ __forceinline__ float wave_sum(float v) {
#pragma unroll
    for (int o = 1; o < 64; o <<= 1) v += __shfl_xor(v, o);
    return v;
}
template <int CTRL> __device__ __forceinline__ float dpp_f(float x) { return __builtin_bit_cast(float, __builtin_amdgcn_update_dpp(0, __builtin_bit_cast(int, x), CTRL, 0xF, 0xF, true)); }
__device__ __forceinline__ float sum8(float x) {
    x += dpp_f<0xB1>(x); x += dpp_f<0x4E>(x); x += dpp_f<0x141>(x); return x; }
__device__ __forceinline__ float sum4(float x) { x += dpp_f<0xB1>(x); x += dpp_f<0x4E>(x); return x; }
__device__ __forceinline__ float sigmoidf_(float x) { return 1.f / (1.f + __expf(-x)); }

struct Frame {
    LAS unsigned char* lds;
    volatile LAS unsigned* MISC;
    gu32* ctl;
    int tid, lane, wave, vcu, G, probe;
    unsigned char* ws;
};

namespace pg8 {
constexpr float QSCALE = 0.125f * 1.4426950408889634f;
struct EpiIn {
    static constexpr bool PERM = true, AFTER_DRAIN = false;
    unsigned char* ws; const float* rope; int pn_off;
    __device__ __forceinline__ void operator()(const f32x4 (&acc)[2][2][4][2], const Unit& u, int wr, int wc, int fr, int fq) const {
        const int row0 = u.pm * BM + wr * 64 + fr, pn = u.pn + pn_off, cw = wc * 32 + 8 * fq;
        if (pn < 8) {
            const int isk = pn >= 4 ? 1 : 0;
            bf16_t* base = (bf16_t*)(ws + WS_Q + (size_t)isk * (WS_K - WS_Q)); const float sc = isk ? 1.f : QSCALE; const int colt = (pn & 3) * 256 + cw;
            const bool ropew = ((wc & 1) == 0);
#pragma unroll
            for (int ai = 0; ai < 2; ++ai)
#pragma unroll
                for (int m = 0; m < 4; ++m) { const int row = row0 + ai * HALF + m * 16; bf16_t* rowp = base + (size_t)row * 1024 + colt;
                    f32x4 c0 = {1.f, 1.f, 1.f, 1.f}, c1 = c0, s0 = {0.f, 0.f, 0.f, 0.f}, s1 = s0;
                    if (ropew) { const f32x4* rp = (const f32x4*)(rope + (size_t)row * 16); c0 = rp[0]; c1 = rp[1]; s0 = rp[2]; s1 = rp[3]; }
#pragma unroll
                    for (int bj = 0; bj < 2; ++bj) { f32x4 v0 = acc[ai][bj][m][0], v1 = acc[ai][bj][m][1];
                        if (ropew) { f32x4 p0, p1;
                            p0[0] = __shfl_xor(v0[0], 16); p0[1] = __shfl_xor(v0[1], 16); p0[2] = __shfl_xor(v0[2], 16); p0[3] = __shfl_xor(v0[3], 16);
                            p1[0] = __shfl_xor(v1[0], 16); p1[1] = __shfl_xor(v1[1], 16); p1[2] = __shfl_xor(v1[2], 16); p1[3] = __shfl_xor(v1[3], 16);
                            if (fq == 0) { v0 = v0 * c0 - p0 * s0; v1 = v1 * c1 - p1 * s1; }
                            else if (fq == 1) { v0 = p0 * s0 + v0 * c0; v1 = p1 * s1 + v1 * c1; } }
                        v0 = v0 * sc; v1 = v1 * sc; u32x4 w; w.x = cvt_pk_bf16(v0[0], v0[1]); w.y = cvt_pk_bf16(v0[2], v0[3]); w.z = cvt_pk_bf16(v1[0], v1[1]); w.w = cvt_pk_bf16(v1[2], v1[3]);
                        *(u32x4*)(rowp + bj * HALF) = w; } }
        } else {
            const int c1 = pn >= 12 ? 1 : 0, c2 = pn >= 25 ? 1 : 0;
            bf16_t* base = (bf16_t*)(ws + WS_V + (size_t)c1 * (WS_PR - WS_V) + (size_t)c2 * (WS_G - WS_PR));
            const int ldc = 1024 + c1 * (RW_COLS - 1024) + c2 * (GATE_COLS - RW_COLS);
            const int colt = (pn - 8 - 4 * c1 - 13 * c2) * 256 + cw;
            const bool sg = pn >= 25;
#pragma unroll
            for (int ai = 0; ai < 2; ++ai)
#pragma unroll
                for (int m = 0; m < 4; ++m) { bf16_t* rowp = base + (size_t)(row0 + ai * HALF + m * 16) * ldc + colt;
#pragma unroll
                    for (int bj = 0; bj < 2; ++bj) { f32x4 v0 = acc[ai][bj][m][0], v1 = acc[ai][bj][m][1];
                        if (sg) { v0[0] = sigmoidf_(v0[0]); v0[1] = sigmoidf_(v0[1]); v0[2] = sigmoidf_(v0[2]); v0[3] = sigmoidf_(v0[3]);
                                  v1[0] = sigmoidf_(v1[0]); v1[1] = sigmoidf_(v1[1]); v1[2] = sigmoidf_(v1[2]); v1[3] = sigmoidf_(v1[3]); }
                        u32x4 w; w.x = cvt_pk_bf16(v0[0], v0[1]); w.y = cvt_pk_bf16(v0[2], v0[3]); w.z = cvt_pk_bf16(v1[0], v1[1]); w.w = cvt_pk_bf16(v1[2], v1[3]);
                        *(u32x4*)(rowp + bj * HALF) = w; } }
        }
    }
};
struct EpiT1 {
    static constexpr bool PERM = false, AFTER_DRAIN = false;
    float* T1; const bf16_t* G;
    __device__ __forceinline__ void operator()(const f32x4 (&acc)[2][2][4][2], const Unit& u, int wr, int wc, int fr, int fq) const {
        const int row0 = u.pm * BM + wr * 64 + fr, col0 = u.pn * BM + wc * 32 + 4 * fq;
#pragma unroll
        for (int ai = 0; ai < 2; ++ai)
#pragma unroll
            for (int m = 0; m < 4; ++m) { const size_t row = (size_t)(row0 + ai * HALF + m * 16);
#pragma unroll
                for (int bj = 0; bj < 2; ++bj)
#pragma unroll
                    for (int n = 0; n < 2; ++n) { const int c = col0 + bj * HALF + n * 16; const uint2 gw = *(const uint2*)(G + row * GATE_COLS + c);
                        f32x4 a = acc[ai][bj][m][n]; a[0] *= bflo(gw.x); a[1] *= bfhi(gw.x); a[2] *= bflo(gw.y); a[3] *= bfhi(gw.y);
                        *(f32x4*)(T1 + row * DM + c) = a; } }
    }
};
struct EpiMerge {
    static constexpr bool PERM = true, AFTER_DRAIN = false;
    const float* T1; const bf16_t* G; bf16_t* O;
    __device__ __forceinline__ void operator()(const f32x4 (&acc)[2][2][4][2], const Unit& u, int wr, int wc, int fr, int fq) const {
        const int row0 = u.pm * BM + wr * 64 + fr, col0 = u.pn * BM + wc * 32 + 8 * fq;
#pragma unroll
        for (int ai = 0; ai < 2; ++ai)
#pragma unroll
            for (int m = 0; m < 4; ++m) { const size_t row = (size_t)(row0 + ai * HALF + m * 16);
#pragma unroll
                for (int bj = 0; bj < 2; ++bj) { const int c = col0 + bj * HALF; const u32x4 gw = *(const u32x4*)(G + row * GATE_COLS + 2048 + c);
                    const f32x4 t0 = *(const f32x4*)(T1 + row * DM + c), t1 = *(const f32x4*)(T1 + row * DM + c + 4);
                    f32x4 v0 = acc[ai][bj][m][0], v1 = acc[ai][bj][m][1];
                    v0[0] = t0[0] + bflo(gw.x) * v0[0]; v0[1] = t0[1] + bfhi(gw.x) * v0[1]; v0[2] = t0[2] + bflo(gw.y) * v0[2]; v0[3] = t0[3] + bfhi(gw.y) * v0[3];
                    v1[0] = t1[0] + bflo(gw.z) * v1[0]; v1[1] = t1[1] + bfhi(gw.z) * v1[1]; v1[2] = t1[2] + bflo(gw.w) * v1[2]; v1[3] = t1[3] + bfhi(gw.w) * v1[3];
                    u32x4 w; w.x = cvt_pk_bf16(v0[0], v0[1]); w.y = cvt_pk_bf16(v0[2], v0[3]); w.z = cvt_pk_bf16(v1[0], v1[1]); w.w = cvt_pk_bf16(v1[2], v1[3]);
                    *(u32x4*)(O + row * DM + c) = w; } }
    }
};
struct EpiPair {
    static constexpr bool PERM = true, AFTER_DRAIN = false;
    const bf16_t* G; bf16_t* O;
    __device__ __forceinline__ void mid(f32x4 (&acc)[2][2][4][2], const Unit& u, int wr, int wc, int fr, int fq) const {
        const int row0 = u.pm * BM + wr * 64 + fr, col0 = u.pn * BM + wc * 32 + 8 * fq;
#pragma unroll
        for (int ai = 0; ai < 2; ++ai)
#pragma unroll
            for (int m = 0; m < 4; ++m) { const size_t row = (size_t)(row0 + ai * HALF + m * 16);
#pragma unroll
                for (int bj = 0; bj < 2; ++bj) { const int c = col0 + bj * HALF; const u32x4 ga = *(const u32x4*)(G + row * GATE_COLS + c), gr = *(const u32x4*)(G + row * GATE_COLS + 2048 + c);
                    f32x4 v0 = acc[ai][bj][m][0], v1 = acc[ai][bj][m][1];
                    v0[0] *= bflo(ga.x) / bflo(gr.x); v0[1] *= bfhi(ga.x) / bfhi(gr.x); v0[2] *= bflo(ga.y) / bflo(gr.y); v0[3] *= bfhi(ga.y) / bfhi(gr.y);
                    v1[0] *= bflo(ga.z) / bflo(gr.z); v1[1] *= bfhi(ga.z) / bfhi(gr.z); v1[2] *= bflo(ga.w) / bflo(gr.w); v1[3] *= bfhi(ga.w) / bfhi(gr.w);
                    acc[ai][bj][m][0] = v0; acc[ai][bj][m][1] = v1; } }
    }
    __device__ __forceinline__ void operator()(const f32x4 (&acc)[2][2][4][2], const Unit& u, int wr, int wc, int fr, int fq) const {
        const int row0 = u.pm * BM + wr * 64 + fr, col0 = u.pn * BM + wc * 32 + 8 * fq;
#pragma unroll
        for (int ai = 0; ai < 2; ++ai)
#pragma unroll
            for (int m = 0; m < 4; ++m) { const size_t row = (size_t)(row0 + ai * HALF + m * 16);
#pragma unroll
                for (int bj = 0; bj < 2; ++bj) { const int c = col0 + bj * HALF; const u32x4 gw = *(const u32x4*)(G + row * GATE_COLS + 2048 + c);
                    f32x4 v0 = acc[ai][bj][m][0], v1 = acc[ai][bj][m][1];
                    v0[0] *= bflo(gw.x); v0[1] *= bfhi(gw.x); v0[2] *= bflo(gw.y); v0[3] *= bfhi(gw.y); v1[0] *= bflo(gw.z); v1[1] *= bfhi(gw.z); v1[2] *= bflo(gw.w); v1[3] *= bfhi(gw.w);
                    u32x4 w; w.x = cvt_pk_bf16(v0[0], v0[1]); w.y = cvt_pk_bf16(v0[2], v0[3]); w.z = cvt_pk_bf16(v1[0], v1[1]); w.w = cvt_pk_bf16(v1[2], v1[3]);
                    *(u32x4*)(O + row * DM + c) = w; } }
    }
};
struct EpiH1 {
    static constexpr bool PERM = false, AFTER_DRAIN = false;
    const float* X; const float* ada; float* H1;
    __device__ __forceinline__ void operator()(const f32x4 (&acc)[2][2][4][2], const Unit& u, int wr, int wc, int fr, int fq) const {
        const int row0 = u.pm * BM + wr * 64 + fr, col0 = u.pn * BM + wc * 32 + 4 * fq;
        const float* gt = ada + (size_t)((u.pm * BM) / SEQ) * 12288 + 4096;
#pragma unroll
        for (int ai = 0; ai < 2; ++ai)
#pragma unroll
            for (int m = 0; m < 4; ++m) { const size_t row = (size_t)(row0 + ai * HALF + m * 16);
#pragma unroll
                for (int bj = 0; bj < 2; ++bj)
#pragma unroll
                    for (int n = 0; n < 2; ++n) { const int c = col0 + bj * HALF + n * 16;
                        const f32x4 xv = *(const f32x4*)(X + row * DM + c), g = *(const f32x4*)(gt + c);
                        *(f32x4*)(H1 + row * DM + c) = xv + g * acc[ai][bj][m][n]; } }
    }
};
}

__device__ __forceinline__ void p0_transpose_item(const float* W, int K, int N, bf16* WT, LAS float* scr, int item, int lane) {
    const int nblk = N / 32, kb = item / nblk, nb = item % nblk, k0 = 64 * kb, n0 = 32 * nb;
#pragma unroll 8
    for (int i = 0; i < 32; ++i) { const int kk = 2 * i + (lane >> 5); scr[kk * 33 + (lane & 31)] = W[(size_t)(k0 + kk) * N + n0 + (lane & 31)]; }
    LDS_WAIT(); asm volatile("" ::: "memory");
    const int c = lane & 7;
#pragma unroll
    for (int j = 0; j < 4; ++j) { const int n = (lane >> 3) + 8 * j; const LAS float* s = scr + (8 * c) * 33 + n;
        v4u o; o.x = pk2(s[0 * 33], s[1 * 33]); o.y = pk2(s[2 * 33], s[3 * 33]); o.z = pk2(s[4 * 33], s[5 * 33]); o.w = pk2(s[6 * 33], s[7 * 33]);
        *(GAS v4u*)(WT + (size_t)(n0 + n) * K + k0 + 8 * c) = o; }
    LDS_WAIT(); asm volatile("" ::: "memory");
}

__device__ __forceinline__ void p0_prologue(Frame& F, const float* const* in) {
    const float* c = in[1]; const int* pos = (const int*)in[2]; const float* ada_w = in[3]; const float* ada_b = in[4];
    float* ada = (float*)(F.ws + WS_ADA); float* rope = (float*)(F.ws + WS_ROPE);
    {
        LAS float* sc = (LAS float*)(F.lds);
        LAS float* red = (LAS float*)(F.lds + 16384);
        for (int i = F.tid; i < 2 * DM; i += NTHR) { const float v = c[i]; sc[i] = v / (1.f + __expf(-v)); }
        __syncthreads();
        const int rg = F.tid / 12, c4 = F.tid % 12;
        for (int cb = F.vcu; cb < 256; cb += F.G) {
            f32x4 a0 = {0.f, 0.f, 0.f, 0.f}, a1 = a0;
            if (rg < 42) {
                const float* wp = ada_w + (size_t)cb * 48 + c4 * 4;
#pragma unroll 7
                for (int k = rg; k < DM; k += 42) { const f32x4 w = *(const f32x4*)(wp + (size_t)k * 12288); a0 += w * sc[k]; a1 += w * sc[DM + k]; }
                LAS float* r = red + rg * 96 + c4 * 4;
                r[0] = a0[0]; r[1] = a0[1]; r[2] = a0[2]; r[3] = a0[3]; r[48] = a1[0]; r[49] = a1[1]; r[50] = a1[2]; r[51] = a1[3];
            }
            __syncthreads();
            if (F.tid < 96) { float s = 0.f; for (int g = 0; g < 42; ++g) s += red[g * 96 + F.tid];
                const int b = F.tid / 48, n = cb * 48 + F.tid % 48; ada[(size_t)b * 12288 + n] = s + ada_b[n]; }
            __syncthreads();
        }
    }
    {
        const int gt = F.vcu * NTHR + F.tid, NGT = F.G * NTHR;
        for (int idx = gt; idx < M * 8; idx += NGT) { const int m = idx >> 3, i = idx & 7;
            const double inv = (i == 0) ? 1.0 : (i == 1) ? 0.19392274474868576 : (i == 2) ? 0.03760603093086393 : (i == 3) ? 0.007292664737217109 : (i == 4) ? 0.001414213562373095
                             : (i == 5) ? 0.0002742481756762073 : (i == 6) ? 5.318295896944988e-05 : 1.031338537721246e-05;
            double a = (double)pos[m] * inv; const double k = __builtin_rint(a * 0.15915494309189535); a -= k * 6.283185307179586;
            const float af = (float)a; rope[(size_t)m * 16 + i] = cosf(af); rope[(size_t)m * 16 + 8 + i] = sinf(af); }
    }
    {
        const int gt = F.vcu * NTHR + F.tid, NGT = F.G * NTHR; bf16* WRH = (bf16*)(F.ws + WS_WRH); bf16* WRL = (bf16*)(F.ws + WS_WRL);
        for (int idx = gt; idx < 80 * DM; idx += NGT) { const int k = idx / 80, col = idx % 80;
            const float wv = col < 8 ? in[27][k * 8 + col] : col < 72 ? in[29][k * 64 + col - 8] : 0.f;
            const unsigned h = f2bf(wv); WRH[(size_t)col * DM + k] = (bf16)h; WRL[(size_t)col * DM + k] = (bf16)f2bf(wv - bf2f((unsigned short)h)); }
    }
    {
        LAS float* scr = (LAS float*)(F.lds + 49152 + F.wave * 8704);
        const int gw = F.vcu * NWAVES + F.wave, NGW = F.G * NWAVES;
        constexpr int I_IN = (DM / 64) * (IN_COLS / 32), I_UP = (1024 / 64) * (DM / 32), I_OUT = (DM / 64) * (DM / 32), I_LR = (64 / 64) * (1024 / 32), I_G2 = (128 / 64) * (1024 / 32);
        constexpr int NITEMS = I_IN + 2 * I_UP + I_OUT + 2 * I_LR + I_G2;
        for (int it = gw; it < NITEMS; it += NGW) {
            int r = it;
            if (r < I_IN) { p0_transpose_item(in[6], DM, IN_COLS, (bf16*)(F.ws + WS_WIN_T), scr, r, F.lane); continue; } r -= I_IN;
            if (r < I_UP) { p0_transpose_item(in[23], 1024, DM, (bf16*)(F.ws + WS_WUPA_T), scr, r, F.lane); continue; } r -= I_UP;
            if (r < I_UP) { p0_transpose_item(in[24], 1024, DM, (bf16*)(F.ws + WS_WUPB_T), scr, r, F.lane); continue; } r -= I_UP;
            if (r < I_OUT) { p0_transpose_item(in[25], DM, DM, (bf16*)(F.ws + WS_WOUT_T), scr, r, F.lane); continue; } r -= I_OUT;
            if (r < I_LR) { p0_transpose_item(in[14], 64, 1024, (bf16*)(F.ws + WS_W2T), scr, r, F.lane); continue; } r -= I_LR;
            if (r < I_LR) { p0_transpose_item(in[16], 64, 1024, (bf16*)(F.ws + WS_A2T), scr, r, F.lane); continue; } r -= I_LR;
            p0_transpose_item(in[17], 128, 1024, (bf16*)(F.ws + WS_G2T), scr, r, F.lane);
        }
    }
}

__device__ __forceinline__ void norm_mod_row(const float* xrow, const float* g, const float* sc, const float* sh, bf16* orow, int lane, f32x4 (&v)[8]) {
    const GAS f32x4* xr = (const GAS f32x4*)xrow + lane; float s2 = 0.f;
#pragma unroll
    for (int j = 0; j < 8; ++j) { v[j] = xr[64 * j]; s2 += (v[j].x * v[j].x + v[j].y * v[j].y) + (v[j].z * v[j].z + v[j].w * v[j].w); }
    const float rstd = 1.f / sqrtf(wave_sum(s2) * (1.f / DM) + NORM_EPS);
    GAS unsigned long long* o8 = (GAS unsigned long long*)orow + lane;
#pragma unroll
    for (int j = 0; j < 8; ++j) { const int i4 = lane + 64 * j; const f32x4 gg = ((const f32x4*)g)[i4], cc = ((const f32x4*)sc)[i4], hh = ((const f32x4*)sh)[i4];
        v[j] = (v[j] * rstd) * gg * (cc + 1.f) + hh;
        o8[64 * j] = (unsigned long long)pk2(v[j].x, v[j].y) | ((unsigned long long)pk2(v[j].z, v[j].w) << 32); }
}

__device__ __forceinline__ void norm_mod_row2v(const float* x0, const float* x1, const float* g, const float* sc0, const float* sh0, const float* sc1, const float* sh1, bf16* o0, bf16* o1, int lane, f32x4 (&va)[8], f32x4 (&vb)[8]) {
    const GAS f32x4* xa = (const GAS f32x4*)x0 + lane; const GAS f32x4* xb = (const GAS f32x4*)x1 + lane; float sa = 0.f, sb = 0.f;
#pragma unroll
    for (int j = 0; j < 8; ++j) { va[j] = xa[64 * j]; vb[j] = xb[64 * j]; }
#pragma unroll
    for (int j = 0; j < 8; ++j) { sa += (va[j].x * va[j].x + va[j].y * va[j].y) + (va[j].z * va[j].z + va[j].w * va[j].w); sb += (vb[j].x * vb[j].x + vb[j].y * vb[j].y) + (vb[j].z * vb[j].z + vb[j].w * vb[j].w); }
    const float ra = 1.f / sqrtf(wave_sum(sa) * (1.f / DM) + NORM_EPS), rb = 1.f / sqrtf(wave_sum(sb) * (1.f / DM) + NORM_EPS);
    GAS unsigned long long* pa = (GAS unsigned long long*)o0 + lane; GAS unsigned long long* pb = (GAS unsigned long long*)o1 + lane;
#pragma unroll
    for (int j = 0; j < 8; ++j) { const int i4 = lane + 64 * j; const f32x4 gg = ((const f32x4*)g)[i4];
        const f32x4 ya = (va[j] * ra) * gg * (((const f32x4*)sc0)[i4] + 1.f) + ((const f32x4*)sh0)[i4], yb = (vb[j] * rb) * gg * (((const f32x4*)sc1)[i4] + 1.f) + ((const f32x4*)sh1)[i4];
        va[j] = ya; vb[j] = yb;
        pa[64 * j] = (unsigned long long)pk2(ya.x, ya.y) | ((unsigned long long)pk2(ya.z, ya.w) << 32); pb[64 * j] = (unsigned long long)pk2(yb.x, yb.y) | ((unsigned long long)pk2(yb.z, yb.w) << 32); }
}
__device__ __forceinline__ void norm_mod_row2(const float* x0, const float* x1, const float* g, const float* sc0, const float* sh0, const float* sc1, const float* sh1, bf16* o0, bf16* o1, int lane) {
    f32x4 va[8], vb[8]; norm_mod_row2v(x0, x1, g, sc0, sh0, sc1, sh1, o0, o1, lane, va, vb); }

constexpr int RWA_PITCH = 72, RWG_PITCH = 136, RWZ_PITCH = 68;
constexpr int RW_TW = 0, RW_AL = RW_TW + 64 * RWA_PITCH * 2, RW_GS = RW_AL + 64 * RWA_PITCH * 2, RW_Z1 = RW_GS + 64 * RWG_PITCH * 2,
              RW_Z2 = RW_Z1 + 64 * RWZ_PITCH * 4, RW_Z3 = RW_Z2 + 64 * RWZ_PITCH * 4, RW_LDS_END = RW_Z3 + 64 * RWZ_PITCH * 4;
static_assert(RW_LDS_END <= RING_BYTES, "rwkv prep LDS");
__device__ __forceinline__ void shift8(const bf16* cur, const bf16* prv, bool hasprev, const float* mu, float (&o)[8]) {
    const v4u c = *(const v4u*)cur; v4u p = {0u, 0u, 0u, 0u}; if (hasprev) p = *(const v4u*)prv;
    const f32x4 m0 = ((const f32x4*)mu)[0], m1 = ((const f32x4*)mu)[1];
    float cv[8] = {bflo(c.x), bfhi(c.x), bflo(c.y), bfhi(c.y), bflo(c.z), bfhi(c.z), bflo(c.w), bfhi(c.w)};
    float pv[8] = {bflo(p.x), bfhi(p.x), bflo(p.y), bfhi(p.y), bflo(p.z), bfhi(p.z), bflo(p.w), bfhi(p.w)};
    float mv[8] = {m0[0], m0[1], m0[2], m0[3], m1[0], m1[1], m1[2], m1[3]};
#pragma unroll
    for (int e = 0; e < 8; ++e) o[e] = cv[e] + (pv[e] - cv[e]) * mv[e];
}
__device__ __forceinline__ v4u pack8(const float (&x)[8]) { v4u o; o.x = pk2(x[0], x[1]); o.y = pk2(x[2], x[3]); o.z = pk2(x[4], x[5]); o.w = pk2(x[6], x[7]); return o; }
__device__ __forceinline__ void store8(float* p, const float (&x)[8]) { ((f32x4*)p)[0] = (f32x4){x[0], x[1], x[2], x[3]}; ((f32x4*)p)[1] = (f32x4){x[4], x[5], x[6], x[7]}; }

__device__ __forceinline__ void p3_rwkv_prep(Frame& F, const float* const* in) {
    const bf16* PR = (const bf16*)(F.ws + WS_PR);
    const float* mu = in[7]; const float* w0 = in[13]; const float* a0 = in[15]; const float* k_k = in[18]; const float* k_a = in[19]; const float* r_k = in[20];
    const bf16* w2t = (const bf16*)(F.ws + WS_W2T); const bf16* a2t = (const bf16*)(F.ws + WS_A2T); const bf16* g2t = (const bf16*)(F.ws + WS_G2T);
    float* RWb = (float*)(F.ws + WS_RW); constexpr size_t AS = RW_ARR / 4;
    float *oR = RWb, *oW = RWb + AS, *oK = RWb + 2 * AS, *oV = RWb + 3 * AS, *oA = RWb + 4 * AS, *oB = RWb + 5 * AS, *oG = RWb + 6 * AS, *oBo = RWb + 7 * AS;
    LAS unsigned char* L = F.lds;
    const int tt = F.tid >> 3, sub = F.tid & 7, fr = F.lane & 15, fq = F.lane >> 4;
    for (int u = F.vcu; u < 2048; u += F.G) {
        const int h = u & 15, ch = (u >> 4) & 63, b = u >> 10, s = ch * 64 + tt; const size_t m = (size_t)b * SEQ + s; const bool hp = s > 0;
        const bf16* cur = PR + m * RW_COLS; const bf16* prv = cur - RW_COLS;
        float r8[8], k8[8], v8[8], t8[8];
        shift8(cur + h * 64 + sub * 8, prv + h * 64 + sub * 8, hp, mu + h * 64 + sub * 8, r8);
        shift8(cur + 1024 + h * 64 + sub * 8, prv + 1024 + h * 64 + sub * 8, hp, mu + 1024 + h * 64 + sub * 8, k8);
        shift8(cur + 2048 + h * 64 + sub * 8, prv + 2048 + h * 64 + sub * 8, hp, mu + 2048 + h * 64 + sub * 8, v8);
        shift8(cur + 3072 + sub * 8, prv + 3072 + sub * 8, hp, mu + 3072 + sub * 8, t8);
#pragma unroll
        for (int e = 0; e < 8; ++e) t8[e] = tanhf(t8[e]);
        *(LAS v4u*)(L + RW_TW + (tt * RWA_PITCH + sub * 8) * 2) = pack8(t8);
        shift8(cur + 3136 + sub * 8, prv + 3136 + sub * 8, hp, mu + 3136 + sub * 8, t8);
        *(LAS v4u*)(L + RW_AL + (tt * RWA_PITCH + sub * 8) * 2) = pack8(t8);
#pragma unroll
        for (int hlf = 0; hlf < 2; ++hlf) { shift8(cur + 3200 + sub * 16 + hlf * 8, prv + 3200 + sub * 16 + hlf * 8, hp, mu + 3200 + sub * 16 + hlf * 8, t8);
#pragma unroll
            for (int e = 0; e < 8; ++e) t8[e] = sigmoidf_(t8[e]);
            *(LAS v4u*)(L + RW_GS + (tt * RWG_PITCH + sub * 16 + hlf * 8) * 2) = pack8(t8); }
        __syncthreads();
#pragma unroll 1
        for (int job = F.wave; job < 48; job += NWAVES) { const int mat = job >> 4, ti = (job >> 2) & 3, tj = job & 3;
            const int aoff = mat == 0 ? RW_TW : mat == 1 ? RW_AL : RW_GS, ap = mat == 2 ? RWG_PITCH : RWA_PITCH, kd = mat == 2 ? 128 : 64;
            const bf16* wt = (mat == 0 ? w2t : mat == 1 ? a2t : g2t) + (size_t)(h * 64 + tj * 16 + fr) * kd + fq * 8;
            f32x4 acc = {0.f, 0.f, 0.f, 0.f};
            for (int ks = 0; ks < kd / 32; ++ks) { const bf16x8 a = *(const LAS bf16x8*)(L + aoff + ((ti * 16 + fr) * ap + ks * 32 + fq * 8) * 2); const bf16x8 bb = *(const bf16x8*)(wt + ks * 32);
                acc = __builtin_amdgcn_mfma_f32_16x16x32_bf16(a, bb, acc, 0, 0, 0); }
            LAS float* z = (LAS float*)(L + (mat == 0 ? RW_Z1 : mat == 1 ? RW_Z2 : RW_Z3));
#pragma unroll
            for (int e = 0; e < 4; ++e) z[(ti * 16 + fq * 4 + e) * RWZ_PITCH + tj * 16 + fr] = acc[e]; }
        __syncthreads();
        {
            const int c0 = h * 64 + sub * 8; const LAS float* z1 = (const LAS float*)(L + RW_Z1) + tt * RWZ_PITCH + sub * 8; const LAS float* z2 = (const LAS float*)(L + RW_Z2) + tt * RWZ_PITCH + sub * 8;
            const LAS float* z3 = (const LAS float*)(L + RW_Z3) + tt * RWZ_PITCH + sub * 8;
            float dec[8], av[8], gv[8], kkv[8], km[8], bo[8], ss = 0.f, bs = 0.f;
#pragma unroll
            for (int e = 0; e < 8; ++e) { const float z = w0[c0 + e] + z1[e]; const float sp = fmaxf(-z, 0.f) + log1pf(__expf(-fabsf(z)));
                const float wl = -sp - 0.5f; dec[e] = __expf(-__expf(wl)); av[e] = sigmoidf_(a0[c0 + e] + z2[e]); gv[e] = z3[e];
                kkv[e] = k8[e] * k_k[c0 + e]; ss += kkv[e] * kkv[e]; km[e] = k8[e] * (1.f + (av[e] - 1.f) * k_a[c0 + e]); bs += r8[e] * km[e] * r_k[c0 + e]; }
            ss = sum8(ss); bs = sum8(bs); const float rn = 1.f / sqrtf(fmaxf(ss, 1e-24f));
            float na[8], nb[8];
#pragma unroll
            for (int e = 0; e < 8; ++e) { const float kk = kkv[e] * rn; na[e] = -kk; nb[e] = kk * av[e]; bo[e] = bs * v8[e]; }
            const size_t o = m * RW_W + c0;
            store8(oR + o, r8); store8(oW + o, dec); store8(oK + o, km); store8(oV + o, v8); store8(oA + o, na); store8(oB + o, nb); store8(oG + o, gv); store8(oBo + o, bo);
        }
        __syncthreads();
    }
}

__device__ __forceinline__ void p4_rwkv_scan(Frame& F) {
    float* RWb = (float*)(F.ws + WS_RW); constexpr size_t AS = RW_ARR / 4;
    const float *iR = RWb, *iW = RWb + AS, *iK = RWb + 2 * AS, *iV = RWb + 3 * AS, *iA = RWb + 4 * AS, *iB = RWb + 5 * AS; float* oY = RWb + 8 * AS;
    constexpr int TB = 16;
    LAS float* S = (LAS float*)F.lds;
    const int vr = F.tid >> 3, ks = F.tid & 7;
    for (int bh = blockIdx.x; bh < BATCH * 16; bh += F.G) {
        const int b = bh >> 4, h = bh & 15; const size_t base = (size_t)b * SEQ * RW_W + h * 64;
        float st[8];
#pragma unroll
        for (int e = 0; e < 8; ++e) st[e] = 0.f;
        f32x4 stg[3];
        auto gload = [&](int blk) {
#pragma unroll
            for (int i = 0; i < 3; ++i) { const int q = F.tid + i * NTHR, arr = q >> 8, rem = q & 255, t = rem >> 4, c4 = rem & 15;
                const float* src = (arr == 0 ? iR : arr == 1 ? iW : arr == 2 ? iK : arr == 3 ? iV : arr == 4 ? iA : iB) + base + (size_t)(blk * TB + t) * RW_W + c4 * 4;
                stg[i] = *(const f32x4*)src; } };
        auto lstore = [&](int buf) {
#pragma unroll
            for (int i = 0; i < 3; ++i) { const int q = F.tid + i * NTHR; *(LAS f32x4*)(S + buf * (6 * TB * 64) + q * 4) = stg[i]; } };
        gload(0);
        for (int blk = 0; blk < SEQ / TB; ++blk) {
            const int buf = blk & 1;
            lstore(buf);
            if (blk + 1 < SEQ / TB) gload(blk + 1);
            __syncthreads();
            const LAS float* sb = S + buf * (6 * TB * 64);
#pragma unroll 4
            for (int t = 0; t < TB; ++t) {
                const LAS float* p = sb + t * 64 + ks * 8;
                const f32x4 r0 = *(const LAS f32x4*)(p), r1 = *(const LAS f32x4*)(p + 4);
                const f32x4 w0 = *(const LAS f32x4*)(p + TB * 64), w1 = *(const LAS f32x4*)(p + TB * 64 + 4);
                const f32x4 k0 = *(const LAS f32x4*)(p + 2 * TB * 64), k1 = *(const LAS f32x4*)(p + 2 * TB * 64 + 4);
                const float vv = sb[3 * TB * 64 + t * 64 + vr];
                const f32x4 a0 = *(const LAS f32x4*)(p + 4 * TB * 64), a1 = *(const LAS f32x4*)(p + 4 * TB * 64 + 4);
                const f32x4 b0 = *(const LAS f32x4*)(p + 5 * TB * 64), b1 = *(const LAS f32x4*)(p + 5 * TB * 64 + 4);
                float sa = 0.f;
#pragma unroll
                for (int e = 0; e < 4; ++e) { sa += st[e] * a0[e]; sa += st[4 + e] * a1[e]; }
                sa = sum8(sa);
                float y = 0.f;
#pragma unroll
                for (int e = 0; e < 4; ++e) { st[e] = st[e] * w0[e] + sa * b0[e] + vv * k0[e]; st[4 + e] = st[4 + e] * w1[e] + sa * b1[e] + vv * k1[e]; y += st[e] * r0[e]; y += st[4 + e] * r1[e]; }
                y = sum8(y);
                if (ks == 0) oY[base + (size_t)(blk * TB + t) * RW_W + vr] = y;
            }
        }
        __syncthreads();
    }
}


constexpr int RP = 72, SLOTB = 64 * RP * 2;
constexpr int H_AH = 0, H_AHT = 1, H_BH = 2, H_KH = 3, H_RH = 4, H_VT = 5, H_BTT = 6, H_KTT = 7, S_0 = 8, S_1 = 9, S_2 = 10, S_3 = 11, S_4 = 12, S_5 = 13;
constexpr int RC_LW = RW_LDS_END, RC_SEG = RC_LW + 64 * 65 * 4, RC_STAGE0_END = RC_SEG + 8 * 64 * 4;
constexpr int RC_PC = 14 * SLOTB;
static_assert(RC_STAGE0_END <= RING_BYTES && RC_PC + 256 <= RING_BYTES && 8 * SLOTB <= RC_LW, "rwkv chunk LDS map");
constexpr size_t WS_CRT = WS_RW, WS_CMM = WS_RW + 16 * MiB, WS_CY0 = WS_RW + 32 * MiB, WS_CN0 = WS_RW + 64 * MiB;

__device__ __forceinline__ f32x4 tmm(const LAS unsigned char* L, int Xs, int Ys, int tx, int ty, f32x4 acc, int fr, int fq) {
#pragma unroll
    for (int ks = 0; ks < 2; ++ks) { const bf16x8 a = *(const LAS bf16x8*)(L + Xs + ((tx * 16 + fr) * RP + ks * 32 + fq * 8) * 2); const bf16x8 b = *(const LAS bf16x8*)(L + Ys + ((ty * 16 + fr) * RP + ks * 32 + fq * 8) * 2);
        acc = __builtin_amdgcn_mfma_f32_16x16x32_bf16(a, b, acc, 0, 0, 0); }
    return acc;
}
__device__ __forceinline__ void st_rowY(LAS unsigned char* L, int dst, f32x4 v, int tx, int ty, int fr, int fq) {
    v2u w; w.x = pk2(v[0], v[1]); w.y = pk2(v[2], v[3]); *(LAS v2u*)(L + dst + ((ty * 16 + fr) * RP + tx * 16 + fq * 4) * 2) = w; }
__device__ __forceinline__ void st_rowX(LAS unsigned char* L, int dst, f32x4 v, int tx, int ty, int fr, int fq) {
#pragma unroll
    for (int e = 0; e < 4; ++e) *(LAS unsigned short*)(L + dst + ((tx * 16 + fq * 4 + e) * RP + ty * 16 + fr) * 2) = (unsigned short)f2bf(v[e]); }
__device__ __forceinline__ f32x4 ld_rowY(const LAS unsigned char* L, int src, int tx, int ty, int fr, int fq) {
    const v2u w = *(const LAS v2u*)(L + src + ((ty * 16 + fr) * RP + tx * 16 + fq * 4) * 2); return (f32x4){bflo(w.x), bfhi(w.x), bflo(w.y), bfhi(w.y)}; }
__device__ __forceinline__ void inv_iter(LAS unsigned char* L, int wave, int fr, int fq, int PA, int PT, int PnA, int PnT, int Tp, int Tn, bool doP, bool doPA, bool doT) {
#pragma unroll
    for (int i = 0; i < 4; ++i) { const int which = i >> 1, tl = wave + 8 * (i & 1), ty = tl >> 2, tx = tl & 3;
        if (which == 0) { if (!doP) continue;
            f32x4 acc = {0.f, 0.f, 0.f, 0.f}; acc = tmm(L, PT, PA, tx, ty, acc, fr, fq);
            if (doPA) st_rowY(L, PnA, acc, tx, ty, fr, fq); st_rowX(L, PnT, acc, tx, ty, fr, fq);
        } else { if (!doT) continue;
            f32x4 acc = ld_rowY(L, Tp, tx, ty, fr, fq); acc = tmm(L, PT, Tp, tx, ty, acc, fr, fq);
            st_rowY(L, Tn, acc, tx, ty, fr, fq); }
    }
}

__device__ __forceinline__ void p3_rwkv_chunk(Frame& F, const float* const* in) {
    const bf16* PR = (const bf16*)(F.ws + WS_PR);
    const float* mu = in[7]; const float* w0 = in[13]; const float* a0 = in[15]; const float* k_k = in[18]; const float* k_a = in[19]; const float* r_k = in[20];
    const bf16* w2t = (const bf16*)(F.ws + WS_W2T); const bf16* a2t = (const bf16*)(F.ws + WS_A2T); const bf16* g2t = (const bf16*)(F.ws + WS_G2T);
    float* RWb = (float*)(F.ws + WS_RW); constexpr size_t AS = RW_ARR / 4; float *oG = RWb + 6 * AS, *oBo = RWb + 7 * AS;
    LAS unsigned char* L = F.lds;
    int tt = F.tid >> 3, sub = F.tid & 7, fr = F.lane & 15, fq = F.lane >> 4, lane = F.lane;
#define P3_OPAQUE() asm volatile("" : "+v"(tt), "+v"(sub), "+v"(fr), "+v"(fq), "+v"(lane))
    v4u pc[7], pp[7];
#define P3_COLS(h_, g_) ((g_) < 3 ? (g_) * 1024 + (h_) * 64 + sub * 8 : (g_) == 3 ? 3072 + sub * 8 : (g_) == 4 ? 3136 + sub * 8 : 3200 + sub * 16 + ((g_) - 5) * 8)
#define P3_LOADS(u_) do { const int h_ = (u_) & 15, s_ = (((u_) >> 4) & 63) * 64 + tt; const bf16* cur_ = PR + ((size_t)((u_) >> 10) * SEQ + s_) * RW_COLS; \
        _Pragma("unroll") for (int g = 0; g < 7; ++g) { const int co = P3_COLS(h_, g); pc[g] = *(const v4u*)(cur_ + co); const v4u q_ = *(const v4u*)(cur_ - (s_ > 0 ? RW_COLS : 0) + co); pp[g] = s_ > 0 ? q_ : (v4u){0u, 0u, 0u, 0u}; } } while (0)
    if (F.tid == 0) { F.MISC[0] = __hip_atomic_fetch_add((unsigned*)(F.ctl + CW_P3Q), 1u, __ATOMIC_RELAXED, __HIP_MEMORY_SCOPE_AGENT);
                      F.MISC[1] = __hip_atomic_fetch_add((unsigned*)(F.ctl + CW_P3Q), 1u, __ATOMIC_RELAXED, __HIP_MEMORY_SCOPE_AGENT); }
    __syncthreads();
    int u = (int)F.MISC[0], unx = (int)F.MISC[1];
    if (u < 2048) P3_LOADS(u);
    for (int it = 0;; ++it) {
        if (u >= 2048) break;
        if (F.tid == 0) F.MISC[2 + (it & 1)] = __hip_atomic_fetch_add((unsigned*)(F.ctl + CW_P3Q), 1u, __ATOMIC_RELAXED, __HIP_MEMORY_SCOPE_AGENT);
        const int h = u & 15, ch = (u >> 4) & 63, b = u >> 10, s = ch * 64 + tt; const size_t m = (size_t)b * SEQ + s;
        const size_t unit = (size_t)((b * 16 + h) * 64 + ch);
        float r8[8], k8[8], v8[8], t8[8];
#define P3_SHIFT(g_, o_) do { const f32x4 m0_ = ((const f32x4*)(mu + P3_COLS(h, g_)))[0], m1_ = ((const f32x4*)(mu + P3_COLS(h, g_)))[1]; const v4u c_ = pc[g_], p_ = pp[g_]; \
        const float cv_[8] = {bflo(c_.x), bfhi(c_.x), bflo(c_.y), bfhi(c_.y), bflo(c_.z), bfhi(c_.z), bflo(c_.w), bfhi(c_.w)}, pv_[8] = {bflo(p_.x), bfhi(p_.x), bflo(p_.y), bfhi(p_.y), bflo(p_.z), bfhi(p_.z), bflo(p_.w), bfhi(p_.w)}; \
        const float mv_[8] = {m0_[0], m0_[1], m0_[2], m0_[3], m1_[0], m1_[1], m1_[2], m1_[3]}; \
        _Pragma("unroll") for (int e = 0; e < 8; ++e) o_[e] = cv_[e] + (pv_[e] - cv_[e]) * mv_[e]; } while (0)
        P3_SHIFT(0, r8); P3_SHIFT(1, k8); P3_SHIFT(2, v8); P3_SHIFT(3, t8);
#pragma unroll
        for (int e = 0; e < 8; ++e) t8[e] = 1.f - 2.f / (1.f + __expf(2.f * t8[e]));
        *(LAS v4u*)(L + RW_TW + (tt * RWA_PITCH + sub * 8) * 2) = pack8(t8);
        P3_SHIFT(4, t8);
        *(LAS v4u*)(L + RW_AL + (tt * RWA_PITCH + sub * 8) * 2) = pack8(t8);
#pragma unroll
        for (int hlf = 0; hlf < 2; ++hlf) { if (hlf == 0) P3_SHIFT(5, t8); else P3_SHIFT(6, t8);
#pragma unroll
            for (int e = 0; e < 8; ++e) t8[e] = sigmoidf_(t8[e]);
            *(LAS v4u*)(L + RW_GS + (tt * RWG_PITCH + sub * 16 + hlf * 8) * 2) = pack8(t8); }
        __syncthreads();
#pragma unroll
        for (int i = 0; i < 6; ++i) { const int mat = i >> 1, tl = F.wave + 8 * (i & 1), ti = tl >> 2, tj = tl & 3;
            const int aoff = mat == 0 ? RW_TW : mat == 1 ? RW_AL : RW_GS, ap = mat == 2 ? RWG_PITCH : RWA_PITCH, kd = mat == 2 ? 128 : 64;
            const bf16* wt = (mat == 0 ? w2t : mat == 1 ? a2t : g2t) + (size_t)(h * 64 + tj * 16 + fr) * kd + fq * 8;
            f32x4 acc = {0.f, 0.f, 0.f, 0.f};
#pragma unroll
            for (int ks = 0; ks < 4; ++ks) if (ks < kd / 32) { const bf16x8 a = *(const LAS bf16x8*)(L + aoff + ((ti * 16 + fr) * ap + ks * 32 + fq * 8) * 2); const bf16x8 bb = *(const bf16x8*)(wt + ks * 32);
                acc = __builtin_amdgcn_mfma_f32_16x16x32_bf16(a, bb, acc, 0, 0, 0); }
            LAS float* z = (LAS float*)(L + (mat == 0 ? RW_Z1 : mat == 1 ? RW_Z2 : RW_Z3));
#pragma unroll
            for (int e = 0; e < 4; ++e) z[(ti * 16 + fq * 4 + e) * RWZ_PITCH + tj * 16 + fr] = acc[e]; }
        __syncthreads();
        P3_OPAQUE();
        const int c0 = h * 64 + sub * 8;
        float lw[8], na[8], nb[8], km[8];
        {
            const LAS float* z1 = (const LAS float*)(L + RW_Z1) + tt * RWZ_PITCH + sub * 8; const LAS float* z2 = (const LAS float*)(L + RW_Z2) + tt * RWZ_PITCH + sub * 8;
            const LAS float* z3 = (const LAS float*)(L + RW_Z3) + tt * RWZ_PITCH + sub * 8;
            float av[8], gv[8], kkv[8], bo[8], ss = 0.f, bs = 0.f;
#pragma unroll
            for (int e = 0; e < 8; ++e) { const float z = w0[c0 + e] + z1[e]; const float sp = fmaxf(-z, 0.f) + __logf(1.f + __expf(-fabsf(z)));
                lw[e] = -__expf(-sp - 0.5f); av[e] = sigmoidf_(a0[c0 + e] + z2[e]); gv[e] = z3[e];
                kkv[e] = k8[e] * k_k[c0 + e]; ss += kkv[e] * kkv[e]; km[e] = k8[e] * (1.f + (av[e] - 1.f) * k_a[c0 + e]); bs += r8[e] * km[e] * r_k[c0 + e]; }
            ss = sum8(ss); bs = sum8(bs); const float rn = 1.f / sqrtf(fmaxf(ss, 1e-24f));
#pragma unroll
            for (int e = 0; e < 8; ++e) { const float kk = kkv[e] * rn; na[e] = -kk; nb[e] = kk * av[e]; bo[e] = bs * v8[e]; }
            const size_t o = m * RW_W + c0; store8(oG + o, gv); store8(oBo + o, bo);
            LAS float* lwp = (LAS float*)(L + RC_LW) + tt * 65 + sub * 8;
#pragma unroll
            for (int e = 0; e < 8; ++e) lwp[e] = lw[e];
        }
        __syncthreads();
        {
            const int cc = F.tid & 63, sg = F.tid >> 6; LAS float* p = (LAS float*)(L + RC_LW) + (sg * 8) * 65 + cc; float run = 0.f;
#pragma unroll
            for (int i = 0; i < 8; ++i) { run += p[i * 65]; p[i * 65] = run; }
            ((LAS float*)(L + RC_SEG))[sg * 64 + cc] = run;
        }
        __syncthreads();
        {
            const LAS float* lwp = (const LAS float*)(L + RC_LW) + tt * 65 + sub * 8; const LAS float* sgp = (const LAS float*)(L + RC_SEG) + sub * 8; const int sg = tt >> 3;
            float ah[8], rh[8], bh[8], kh[8], bt[8], kt[8];
            float basev[8], totv[8];
#pragma unroll
            for (int e = 0; e < 8; ++e) { basev[e] = 0.f; totv[e] = 0.f; }
#pragma unroll
            for (int q = 0; q < 8; ++q) { const f32x4 s0 = *(const LAS f32x4*)(sgp + q * 64), s1 = *(const LAS f32x4*)(sgp + q * 64 + 4); const float sv[8] = {s0[0], s0[1], s0[2], s0[3], s1[0], s1[1], s1[2], s1[3]};
#pragma unroll
                for (int e = 0; e < 8; ++e) { totv[e] += sv[e]; basev[e] += (q < sg) ? sv[e] : 0.f; } }
#pragma unroll
            for (int e = 0; e < 8; ++e) { const float base = basev[e], tot = totv[e];
                const float cl = lwp[e] + base, clx = cl - lw[e];
                const float ep = __expf(cl), en = __expf(-cl), ee = __expf(tot - cl);
                ah[e] = na[e] * __expf(clx); rh[e] = r8[e] * ep; bh[e] = nb[e] * en; kh[e] = km[e] * en; bt[e] = nb[e] * ee; kt[e] = km[e] * ee;
                if (tt == 63) ((LAS float*)(L + RC_PC))[sub * 8 + e] = __expf(tot); }
            *(LAS v4u*)(L + H_AH * SLOTB + (tt * RP + sub * 8) * 2) = pack8(ah);
            *(LAS v4u*)(L + H_BH * SLOTB + (tt * RP + sub * 8) * 2) = pack8(bh);
            *(LAS v4u*)(L + H_KH * SLOTB + (tt * RP + sub * 8) * 2) = pack8(kh);
            *(LAS v4u*)(L + H_RH * SLOTB + (tt * RP + sub * 8) * 2) = pack8(rh);
#pragma unroll
            for (int e = 0; e < 8; ++e) { const int o = ((sub * 8 + e) * RP + tt) * 2;
                *(LAS unsigned short*)(L + H_AHT * SLOTB + o) = (unsigned short)f2bf(ah[e]); *(LAS unsigned short*)(L + H_VT * SLOTB + o) = (unsigned short)f2bf(v8[e]);
                *(LAS unsigned short*)(L + H_BTT * SLOTB + o) = (unsigned short)f2bf(bt[e]); *(LAS unsigned short*)(L + H_KTT * SLOTB + o) = (unsigned short)f2bf(kt[e]); }
        }
        __syncthreads();
        P3_OPAQUE();
#pragma unroll
        for (int i = 0; i < 8; ++i) { const int mat = i >> 1, tl = F.wave + 8 * (i & 1), ty = tl >> 2, tx = tl & 3;
            const int Xs = ((mat & 1) ? H_KH : H_BH) * SLOTB, Ys = (mat < 2 ? H_AH : H_RH) * SLOTB;
            f32x4 acc = {0.f, 0.f, 0.f, 0.f}; acc = tmm(L, Xs, Ys, tx, ty, acc, fr, fq);
            const int t = ty * 16 + fr, j0 = tx * 16 + fq * 4;
#pragma unroll
            for (int e = 0; e < 4; ++e) { const bool keep = (mat < 2) ? (j0 + e < t) : (j0 + e <= t); acc[e] = keep ? acc[e] : 0.f; }
            const int dst = (mat == 0 ? S_0 : mat == 1 ? S_2 : mat == 2 ? S_3 : S_4) * SLOTB;
            st_rowY(L, dst, acc, tx, ty, fr, fq);
            if (mat == 0) { st_rowX(L, S_1 * SLOTB, acc, tx, ty, fr, fq);
#pragma unroll
                for (int e = 0; e < 4; ++e) acc[e] += (j0 + e == t) ? 1.f : 0.f;
                st_rowY(L, S_5 * SLOTB, acc, tx, ty, fr, fq); }
        }
        __syncthreads();
        P3_OPAQUE();
        if (unx < 2048) P3_LOADS(unx);
        inv_iter(L, F.wave, fr, fq, S_0 * SLOTB, S_1 * SLOTB, H_AH * SLOTB, H_BH * SLOTB, 0, 0, true, true, false);                                  __syncthreads();
        inv_iter(L, F.wave, fr, fq, H_AH * SLOTB, H_BH * SLOTB, S_0 * SLOTB, S_1 * SLOTB, S_5 * SLOTB, H_KH * SLOTB, true, true, true);              __syncthreads();
        inv_iter(L, F.wave, fr, fq, S_0 * SLOTB, S_1 * SLOTB, H_AH * SLOTB, H_BH * SLOTB, H_KH * SLOTB, S_5 * SLOTB, true, true, true);              __syncthreads();
        inv_iter(L, F.wave, fr, fq, H_AH * SLOTB, H_BH * SLOTB, S_0 * SLOTB, S_1 * SLOTB, S_5 * SLOTB, H_KH * SLOTB, true, true, true);              __syncthreads();
        inv_iter(L, F.wave, fr, fq, S_0 * SLOTB, S_1 * SLOTB, 0, H_BH * SLOTB, H_KH * SLOTB, S_5 * SLOTB, true, false, true);                        __syncthreads();
        inv_iter(L, F.wave, fr, fq, 0, H_BH * SLOTB, 0, 0, S_5 * SLOTB, H_KH * SLOTB, false, false, true);                                           __syncthreads();
        P3_OPAQUE();
        constexpr int TS = H_KH * SLOTB;
#pragma unroll
        for (int i = 0; i < 4; ++i) { const int which = i >> 1, tl = F.wave + 8 * (i & 1), ty = tl >> 2, tx = tl & 3;
            f32x4 acc = {0.f, 0.f, 0.f, 0.f};
            if (which == 0) { acc = tmm(L, TS, H_AHT * SLOTB, tx, ty, acc, fr, fq); st_rowY(L, S_0 * SLOTB, acc, tx, ty, fr, fq); }
            else { acc = tmm(L, S_2 * SLOTB, H_VT * SLOTB, tx, ty, acc, fr, fq); st_rowY(L, S_1 * SLOTB, acc, tx, ty, fr, fq); }
        }
        __syncthreads();
        {
            unsigned char* gR = F.ws + WS_CRT + unit * 8192; unsigned char* gM = F.ws + WS_CMM + unit * 8192;
#pragma unroll
            for (int i = 0; i < 6; ++i) { const int which = i >> 1, tl = F.wave + 8 * (i & 1), ty = tl >> 2, tx = tl & 3;
                f32x4 acc = {0.f, 0.f, 0.f, 0.f};
                if (which == 0) { acc = tmm(L, TS, S_1 * SLOTB, tx, ty, acc, fr, fq); st_rowY(L, H_AH * SLOTB, acc, tx, ty, fr, fq); }
                else if (which == 1) {
                    acc = ld_rowY(L, H_RH * SLOTB, tx, ty, fr, fq); acc = tmm(L, S_0 * SLOTB, S_3 * SLOTB, tx, ty, acc, fr, fq);
                    uint2 w; w.x = pk2(acc[0], acc[1]); w.y = pk2(acc[2], acc[3]);
                    *(uint2*)(gR + ((ty * 2 + (tx >> 1)) * 64 + lane) * 16 + (tx & 1) * 8) = w; }
                else {
                    acc = tmm(L, S_0 * SLOTB, H_BTT * SLOTB, tx, ty, acc, fr, fq);
                    const int kr = ty * 16 + fr, kc0 = tx * 16 + fq * 4; const float pc = ((const LAS float*)(L + RC_PC))[kr];
#pragma unroll
                    for (int e = 0; e < 4; ++e) acc[e] += (kc0 + e == kr) ? pc : 0.f;
                    uint2 w; w.x = pk2(acc[0], acc[1]); w.y = pk2(acc[2], acc[3]);
                    *(uint2*)(gM + ((ty * 2 + (tx >> 1)) * 64 + lane) * 16 + (tx & 1) * 8) = w; }
            }
        }
        __syncthreads();
        {
            unsigned char* gY = F.ws + WS_CY0 + unit * 16384; unsigned char* gN = F.ws + WS_CN0 + unit * 16384;
#pragma unroll
            for (int i = 0; i < 4; ++i) { const int which = i >> 1, tl = F.wave + 8 * (i & 1), ty = tl >> 2, tx = tl & 3;
                f32x4 acc = {0.f, 0.f, 0.f, 0.f};
                if (which == 0) { acc = tmm(L, S_3 * SLOTB, H_AH * SLOTB, tx, ty, acc, fr, fq); acc = tmm(L, S_4 * SLOTB, H_VT * SLOTB, tx, ty, acc, fr, fq);
                    *(f32x4*)(gY + ((ty * 4 + tx) * 64 + lane) * 16) = acc; }
                else { acc = tmm(L, H_BTT * SLOTB, H_AH * SLOTB, tx, ty, acc, fr, fq); acc = tmm(L, H_KTT * SLOTB, H_VT * SLOTB, tx, ty, acc, fr, fq);
                    *(f32x4*)(gN + ((ty * 4 + tx) * 64 + lane) * 16) = acc; }
            }
        }
        __syncthreads();
        u = unx; unx = (int)F.MISC[2 + (it & 1)];
    }
#undef P3_COLS
#undef P3_LOADS
#undef P3_SHIFT
#undef P3_OPAQUE
}

constexpr size_t WS_CX = WS_RW + 96 * MiB;
struct ChainOps { bf16x8 mf[4][2]; f32x4 n0[4]; };
__device__ __forceinline__ void chain_load(ChainOps& o, const unsigned char* ws, size_t unit, int vb, int lane) {
    const unsigned char* gM = ws + WS_CMM + unit * 8192; const unsigned char* gN = ws + WS_CN0 + unit * 16384;
#pragma unroll
    for (int ti = 0; ti < 4; ++ti) {
#pragma unroll
        for (int s = 0; s < 2; ++s) o.mf[ti][s] = *(const bf16x8*)(gM + ((ti * 2 + s) * 64 + lane) * 16);
        o.n0[ti] = *(const f32x4*)(gN + ((vb * 4 + ti) * 64 + lane) * 16); }
}
__device__ __forceinline__ void chain_step(const ChainOps& o, f32x4 (&X)[4], unsigned char* gX, int vb, int lane) {
    bf16x8 xb[2];
#pragma unroll
    for (int s = 0; s < 2; ++s) { v4u w; w.x = pk2(X[2 * s][0], X[2 * s][1]); w.y = pk2(X[2 * s][2], X[2 * s][3]); w.z = pk2(X[2 * s + 1][0], X[2 * s + 1][1]); w.w = pk2(X[2 * s + 1][2], X[2 * s + 1][3]);
        xb[s] = __builtin_bit_cast(bf16x8, w); *(v4u*)(gX + ((vb * 2 + s) * 64 + lane) * 16) = w; }
#pragma unroll
    for (int ti = 0; ti < 4; ++ti) { f32x4 xn = __builtin_amdgcn_mfma_f32_16x16x32_bf16(o.mf[ti][0], xb[0], o.n0[ti], 0, 0, 0); X[ti] = __builtin_amdgcn_mfma_f32_16x16x32_bf16(o.mf[ti][1], xb[1], xn, 0, 0, 0); }
}
__device__ __forceinline__ void p4_rwkv_chain(Frame& F) {
    for (int bh = blockIdx.x; bh < BATCH * 16; bh += F.G) {
        if (F.wave < 4) {
            const int vb = F.wave;
            f32x4 X[4];
#pragma unroll
            for (int i = 0; i < 4; ++i) X[i] = (f32x4){0.f, 0.f, 0.f, 0.f};
            unsigned char* gX = F.ws + WS_CX + (size_t)bh * 64 * 8192;
            ChainOps o0, o1;
            chain_load(o0, F.ws, (size_t)bh * 64, vb, F.lane);
#pragma unroll 1
            for (int c = 0; c < 64; c += 2) {
                chain_load(o1, F.ws, (size_t)bh * 64 + c + 1, vb, F.lane);
                chain_step(o0, X, gX + (size_t)c * 8192, vb, F.lane);
                if (c + 2 < 64) chain_load(o0, F.ws, (size_t)bh * 64 + c + 2, vb, F.lane);
                chain_step(o1, X, gX + (size_t)(c + 1) * 8192, vb, F.lane);
            }
        }
    }
}
__device__ __forceinline__ float sum16(float x) { x += dpp_f<0xB1>(x); x += dpp_f<0x4E>(x); x += dpp_f<0x141>(x); x += dpp_f<0x140>(x); return x; }
__device__ __forceinline__ void rwkv_out_job(Frame& F, const float* lnx_g, const float* lnx_b, int job) {
    const int unit = job >> 2, ti = job & 3, bh = unit >> 6, c = unit & 63, b = bh >> 4, h = bh & 15, lane = F.lane, fr = lane & 15, fq = lane >> 4;
    const unsigned char* gR = F.ws + WS_CRT + (size_t)unit * 8192; const unsigned char* gX = F.ws + WS_CX + (size_t)unit * 8192; const unsigned char* gY = F.ws + WS_CY0 + (size_t)unit * 16384;
    float* RWb = (float*)(F.ws + WS_RW); constexpr size_t AS = RW_ARR / 4; const float *iG = RWb + 6 * AS, *iBo = RWb + 7 * AS; bf16* YR = (bf16*)(F.ws + WS_YRW);
    const bf16x8 r0 = *(const bf16x8*)(gR + ((ti * 2 + 0) * 64 + lane) * 16), r1 = *(const bf16x8*)(gR + ((ti * 2 + 1) * 64 + lane) * 16);
    f32x4 y[4];
#pragma unroll
    for (int vb = 0; vb < 4; ++vb) { const bf16x8 x0 = *(const bf16x8*)(gX + ((vb * 2 + 0) * 64 + lane) * 16), x1 = *(const bf16x8*)(gX + ((vb * 2 + 1) * 64 + lane) * 16);
        f32x4 acc = *(const f32x4*)(gY + ((vb * 4 + ti) * 64 + lane) * 16);
        acc = __builtin_amdgcn_mfma_f32_16x16x32_bf16(r0, x0, acc, 0, 0, 0); y[vb] = __builtin_amdgcn_mfma_f32_16x16x32_bf16(r1, x1, acc, 0, 0, 0); }
    float mean[4], rs[4];
#pragma unroll
    for (int e = 0; e < 4; ++e) { mean[e] = sum16((y[0][e] + y[1][e]) + (y[2][e] + y[3][e])) * (1.f / 64.f); float q = 0.f;
#pragma unroll
        for (int vb = 0; vb < 4; ++vb) { const float d = y[vb][e] - mean[e]; q += d * d; }
        rs[e] = 1.f / sqrtf(sum16(q) * (1.f / 64.f) + LNX_EPS); }
#pragma unroll
    for (int vb = 0; vb < 4; ++vb) { const int col = h * 64 + vb * 16 + fr; const float lg = lnx_g[col], lb = lnx_b[col];
#pragma unroll
        for (int e = 0; e < 4; ++e) { const size_t o = ((size_t)b * SEQ + c * 64 + ti * 16 + fq * 4 + e) * RW_W + col;
            YR[o] = (bf16)f2bf(((y[vb][e] - mean[e]) * rs[e] * lg + lb + iBo[o]) * iG[o]); } }
}

__device__ __forceinline__ void p6_combine(Frame& F, const float* const* in) {
    const bf16* O0 = (const bf16*)(F.ws + WS_O0); const bf16* O1 = (const bf16*)(F.ws + WS_O1); bf16* YA = (bf16*)(F.ws + WS_YATT); bf16* YR = (bf16*)(F.ws + WS_YRW);
    const float* subg = in[12]; const float* lnx_g = in[21]; const float* lnx_b = in[22];
    const float d1 = wave_sum(in[8][F.lane] * in[9][F.lane]), d2 = wave_sum(in[10][F.lane] * in[11][F.lane]);
    const float lam = expf(d1) - expf(d2) + LAMBDA_INIT;
    const int gw = F.vcu * NWAVES + F.wave, NGW = F.G * NWAVES, lane = F.lane;
    for (int m = gw; m < M; m += NGW) {
        {
            const size_t o = (size_t)m * ATT_W + lane * 16; float d[16]; float ss = 0.f;
#pragma unroll
            for (int hf = 0; hf < 2; ++hf) { const v4u a = *(const v4u*)(O0 + o + hf * 8), bq = *(const v4u*)(O1 + o + hf * 8);
                const unsigned aw[4] = {a.x, a.y, a.z, a.w}, bw[4] = {bq.x, bq.y, bq.z, bq.w};
#pragma unroll
                for (int e = 0; e < 4; ++e) { d[hf * 8 + 2 * e] = bflo(aw[e]) - lam * bflo(bw[e]); d[hf * 8 + 2 * e + 1] = bfhi(aw[e]) - lam * bfhi(bw[e]); } }
#pragma unroll
            for (int e = 0; e < 16; ++e) ss += d[e] * d[e];
            ss = sum8(ss); const float rs = (1.f - LAMBDA_INIT) / sqrtf(ss * (1.f / 128.f) + SUBLN_EPS);
            const float* sg = subg + (lane & 7) * 16; float y[16];
#pragma unroll
            for (int e = 0; e < 16; ++e) y[e] = d[e] * rs * sg[e];
            v4u w0, w1; w0.x = pk2(y[0], y[1]); w0.y = pk2(y[2], y[3]); w0.z = pk2(y[4], y[5]); w0.w = pk2(y[6], y[7]); w1.x = pk2(y[8], y[9]); w1.y = pk2(y[10], y[11]); w1.z = pk2(y[12], y[13]); w1.w = pk2(y[14], y[15]);
            *(v4u*)(YA + o) = w0; *(v4u*)(YA + o + 8) = w1;
        }
    }
#if RWKV_SEQ
    for (int m = gw; m < M; m += NGW) {
        float* RWb = (float*)(F.ws + WS_RW); constexpr size_t AS = RW_ARR / 4; const float *iG = RWb + 6 * AS, *iBo = RWb + 7 * AS, *iY = RWb + 8 * AS;
        const size_t o = (size_t)m * RW_W + lane * 16; float yv[16]; float s1 = 0.f;
#pragma unroll
        for (int q = 0; q < 4; ++q) { const f32x4 t = *(const f32x4*)(iY + o + q * 4); yv[q * 4] = t[0]; yv[q * 4 + 1] = t[1]; yv[q * 4 + 2] = t[2]; yv[q * 4 + 3] = t[3]; s1 += (t[0] + t[1]) + (t[2] + t[3]); }
        const float mean = sum4(s1) * (1.f / 64.f); float s2 = 0.f;
#pragma unroll
        for (int e = 0; e < 16; ++e) { yv[e] -= mean; s2 += yv[e] * yv[e]; }
        const float rs = 1.f / sqrtf(sum4(s2) * (1.f / 64.f) + LNX_EPS); float y[16];
#pragma unroll
        for (int q = 0; q < 4; ++q) { const f32x4 lg = *(const f32x4*)(lnx_g + lane * 16 + q * 4), lb = *(const f32x4*)(lnx_b + lane * 16 + q * 4), bo = *(const f32x4*)(iBo + o + q * 4), gg = *(const f32x4*)(iG + o + q * 4);
#pragma unroll
            for (int e = 0; e < 4; ++e) y[q * 4 + e] = (yv[q * 4 + e] * rs * lg[e] + lb[e] + bo[e]) * gg[e]; }
        v4u w0, w1; w0.x = pk2(y[0], y[1]); w0.y = pk2(y[2], y[3]); w0.z = pk2(y[4], y[5]); w0.w = pk2(y[6], y[7]); w1.x = pk2(y[8], y[9]); w1.y = pk2(y[10], y[11]); w1.z = pk2(y[12], y[13]); w1.w = pk2(y[14], y[15]);
        *(v4u*)(YR + o) = w0; *(v4u*)(YR + o + 8) = w1;
    }
#else
    for (int job = gw; job < 2048 * 4; job += NGW) rwkv_out_job(F, lnx_g, lnx_b, job);
#endif
}

constexpr int RT_XP = 520;
constexpr int RT_XH = 0, RT_XL = RT_XH + 16 * RT_XP * 2, RT_PART = RT_XL + 16 * RT_XP * 2, RT_LG = RT_PART + 8 * 5 * 1024, RT_END = RT_LG + 16 * 80 * 4;
static_assert(RT_END <= RING_BYTES, "router LDS");
__device__ __forceinline__ void p10_route(Frame& F, const float* const* in) {
    const float* H1 = (const float*)(F.ws + WS_H1); bf16* U2 = (bf16*)(F.ws + WS_U2); const float* ada = (const float*)(F.ws + WS_ADA);
    const float* gffn = in[26]; const float* brg = in[28]; const float* bre = in[30];
    const bf16* WRH = (const bf16*)(F.ws + WS_WRH); const bf16* WRL = (const bf16*)(F.ws + WS_WRL);
    int* tokE = (int*)(F.ws + WS_TOKE); int* tokP = (int*)(F.ws + WS_TOKP); float* tokW = (float*)(F.ws + WS_TOKW); int* list = (int*)(F.ws + WS_LIST);
    unsigned* cnt = (unsigned*)(F.ctl + CW_CNT);
    LAS unsigned char* L = F.lds;
    const int lane = F.lane, w = F.wave, fr = lane & 15, fq = lane >> 4;
    const __amdgpu_buffer_rsrc_t rsH = __builtin_amdgcn_make_buffer_rsrc((void*)WRH, 0, 80 * DM * 2, 0x00020000), rsL = __builtin_amdgcn_make_buffer_rsrc((void*)WRL, 0, 80 * DM * 2, 0x00020000);
    const int voff = (fr * DM + fq * 8) * 2;
#pragma unroll 1
    for (int blk = F.vcu; blk < M / 16; blk += F.G) {
        const int m0 = blk * 16 + w * 2;
        const int b = m0 / SEQ; const float* ad = ada + (size_t)b * 12288;
        bf16x8 wh[2][5], wl[2][5];
#define RT_WLOAD(j_, S_) do { _Pragma("unroll") for (int ct = 0; ct < 5; ++ct) { const int so = __builtin_amdgcn_readfirstlane(((ct * 16) * DM + ((j_) >> 1) * 512 + (w + 8 * ((j_) & 1)) * 32) * 2); \
        wh[S_][ct] = __builtin_bit_cast(bf16x8, __builtin_amdgcn_raw_buffer_load_b128(rsH, voff, so, 0)); wl[S_][ct] = __builtin_bit_cast(bf16x8, __builtin_amdgcn_raw_buffer_load_b128(rsL, voff, so, 0)); } } while (0)
        RT_WLOAD(0, 0);
        f32x4 v0[8], v1[8];
        norm_mod_row2v(H1 + (size_t)m0 * DM, H1 + (size_t)(m0 + 1) * DM, gffn, ad + 8192, ad + 6144, ad + 8192, ad + 6144, U2 + (size_t)m0 * U2P, U2 + (size_t)(m0 + 1) * U2P, lane, v0, v1);
        f32x4 acc[5];
#pragma unroll
        for (int ct = 0; ct < 5; ++ct) acc[ct] = (f32x4){0.f, 0.f, 0.f, 0.f};
#pragma unroll
        for (int kq = 0; kq < 4; ++kq) {
            __syncthreads();
#pragma unroll
            for (int r = 0; r < 2; ++r)
#pragma unroll
                for (int jj = 0; jj < 2; ++jj) { const f32x4 x = r ? v1[2 * kq + jj] : v0[2 * kq + jj]; const int off = ((w * 2 + r) * RT_XP + 4 * lane + 256 * jj) * 2;
                    const unsigned h0 = f2bf(x[0]), h1 = f2bf(x[1]), h2 = f2bf(x[2]), h3 = f2bf(x[3]);
                    v2u hw; hw.x = h0 | (h1 << 16); hw.y = h2 | (h3 << 16); *(LAS v2u*)(L + RT_XH + off) = hw;
                    v2u lw; lw.x = pk2(x[0] - bf2f((unsigned short)h0), x[1] - bf2f((unsigned short)h1)); lw.y = pk2(x[2] - bf2f((unsigned short)h2), x[3] - bf2f((unsigned short)h3)); *(LAS v2u*)(L + RT_XL + off) = lw; }
            __syncthreads();
#pragma unroll
            for (int kk = 0; kk < 2; ++kk) { const int j = 2 * kq + kk, ks = w + 8 * kk;
                if (j < 7) RT_WLOAD(j + 1, (j + 1) & 1);
                const int o = (fr * RT_XP + ks * 32 + fq * 8) * 2; const bf16x8 xh = *(const LAS bf16x8*)(L + RT_XH + o), xl = *(const LAS bf16x8*)(L + RT_XL + o);
#pragma unroll
                for (int ct = 0; ct < 5; ++ct) { f32x4 a = acc[ct];
                    a = __builtin_amdgcn_mfma_f32_16x16x32_bf16(wh[j & 1][ct], xh, a, 0, 0, 0); a = __builtin_amdgcn_mfma_f32_16x16x32_bf16(wh[j & 1][ct], xl, a, 0, 0, 0); a = __builtin_amdgcn_mfma_f32_16x16x32_bf16(wl[j & 1][ct], xh, a, 0, 0, 0);
                    acc[ct] = a; }
                __builtin_amdgcn_sched_barrier(0);
            }
        }
#undef RT_WLOAD
#pragma unroll
        for (int ct = 0; ct < 5; ++ct) *(LAS f32x4*)(L + RT_PART + ((w * 5 + ct) * 64 + lane) * 16) = acc[ct];
        __syncthreads();
        if (F.tid < 320) { const int ct = F.tid >> 6, l = F.tid & 63; f32x4 s = {0.f, 0.f, 0.f, 0.f};
#pragma unroll
            for (int ww = 0; ww < 8; ++ww) s += *(const LAS f32x4*)(L + RT_PART + ((ww * 5 + ct) * 64 + l) * 16);
            const int tok = l & 15, col = ct * 16 + (l >> 4) * 4;
            LAS float* lg = (LAS float*)(L + RT_LG) + tok * 80 + col; lg[0] = s[0]; lg[1] = s[1]; lg[2] = s[2]; lg[3] = s[3]; }
        __syncthreads();
        if (F.tid < 16) {
            const int m = blk * 16 + F.tid; const LAS float* lgp = (const LAS float*)(L + RT_LG) + F.tid * 80;
            float lg[8];
#pragma unroll
            for (int g = 0; g < 8; ++g) lg[g] = lgp[g] + brg[g];
            int gi = 0; float gmax = lg[0];
#pragma unroll
            for (int g = 1; g < 8; ++g) if (lg[g] > gmax) { gmax = lg[g]; gi = g; }
            float gz = 0.f;
#pragma unroll
            for (int g = 0; g < 8; ++g) gz += __expf(lg[g] - gmax);
            const float gp = 1.f / gz;
            float el[8];
#pragma unroll
            for (int i = 0; i < 8; ++i) el[i] = lgp[8 + gi * 8 + i] + bre[gi * 8 + i];
            int i0 = 0; float e0 = el[0];
#pragma unroll
            for (int i = 1; i < 8; ++i) if (el[i] > e0) { e0 = el[i]; i0 = i; }
            int i1 = -1; float e1 = -INFINITY;
#pragma unroll
            for (int i = 0; i < 8; ++i) if (i != i0 && el[i] > e1) { e1 = el[i]; i1 = i; }
            const float x1 = __expf(e1 - e0), w0 = gp / (1.f + x1), w1 = gp * x1 / (1.f + x1);
            const int ea = gi * 8 + i0, eb = gi * 8 + i1;
            const unsigned pa = atomicAdd(cnt + ea, 1u), pb = atomicAdd(cnt + eb, 1u);
            list[(size_t)ea * CAP + pa] = m * 2; list[(size_t)eb * CAP + pb] = m * 2 + 1;
            tokE[m * 2] = ea; tokE[m * 2 + 1] = eb; tokP[m * 2] = (int)pa; tokP[m * 2 + 1] = (int)pb; tokW[m * 2] = w0; tokW[m * 2 + 1] = w1;
        }
    }
}

static_assert(NEXP == 64, "one wave = one lane per expert");
__device__ __forceinline__ int lane_excl_prefix(int v, int lane) {
    int s = 0;
#pragma unroll
    for (int e = 0; e < 64; ++e) { const int c = __builtin_amdgcn_readlane(v, e); s += (e < lane) ? c : 0; }
    return s; }
__device__ __forceinline__ void expert_offsets(const unsigned* cnt, LAS int* offs, LAS int* raw, int tid) {
    asm volatile("" : "+v"(tid));
    if (tid < NEXP) { const int mine = (int)__hip_atomic_load(cnt + tid, __ATOMIC_RELAXED, __HIP_MEMORY_SCOPE_AGENT); const int s = lane_excl_prefix(mine, tid);
        offs[tid] = s; if (tid == NEXP - 1) offs[NEXP] = s + mine; }
    __syncthreads();
}
constexpr int MOE_RCH = 512;
constexpr int MOE_ROWP = 2 * MOE_RCH * 128 + 2 * 64 * 144, MOE_TAB = MOE_ROWP + MOE_RCH * 4, MOE_END = MOE_TAB + 4 * 68 * 4;
static_assert(MOE_END <= RING_BYTES, "moe LDS");
__device__ __forceinline__ const float* uniform_ptr(const float* p) {
    const unsigned long long v = (unsigned long long)p; const unsigned lo = __builtin_amdgcn_readfirstlane((unsigned)v), hi = __builtin_amdgcn_readfirstlane((unsigned)(v >> 32));
    return (const float*)(((unsigned long long)hi << 32) | lo); }
template <int MODE> __device__ __forceinline__ void moe_gemm_pc(Frame& F, const float* const* in, bool tables_ready) {
    constexpr int KD = MODE == 1 ? DM : EFF, NSTEP = KD / 64, ABYTES = 256 * 128, BBYTES = 128 * 128;
    constexpr int bld = MODE == 1 ? EFF : DM, APITCH = (MODE == 1 ? U2P : ACTP) * 2; constexpr size_t out_ld = MODE == 1 ? ACTP : DM;
    static_assert(NSTEP % 2 == 0 && NSTEP >= 8, "steps");
    const bf16* Asrc = (const bf16*)(F.ws + (MODE == 1 ? WS_U2 : WS_ACT));
    const float* Wg = in[31]; const float* Wu = in[32]; const float* Wd = in[33];
    bf16* ACT = (bf16*)(F.ws + WS_ACT); bf16* YS = (bf16*)(F.ws + WS_YS);
    const int* list = (const int*)(F.ws + WS_LIST); const unsigned* cnt = (const unsigned*)(F.ctl + CW_CNT);
    LAS unsigned char* L = F.lds; LAS int* rowp = (LAS int*)(L + MOE_ROWP);
    LAS int* offs = (LAS int*)(L + MOE_TAB); LAS int* srt = offs + 68; LAS int* ust = srt + 68; LAS int* raw = ust + 68;
    int tid_ = F.tid; asm volatile("" : "+v"(tid_));
    const int tid = tid_, w = F.wave;
    if (!tables_ready) {
    if (tid < NEXP) {
        const int mine = (int)__hip_atomic_load(cnt + tid, __ATOMIC_RELAXED, __HIP_MEMORY_SCOPE_AGENT); int s = 0, rank = 0;
#pragma unroll
        for (int e = 0; e < NEXP; ++e) { const int c = __builtin_amdgcn_readlane(mine, e); s += (e < tid) ? c : 0; rank += (c > mine || (c == mine && e < tid)) ? 1 : 0; }
        offs[tid] = s; if (tid == NEXP - 1) offs[NEXP] = s + mine;
        const int pos = rank < NEXP / 2 ? 2 * rank : 2 * (NEXP - 1 - rank) + 1;
        srt[pos] = tid; raw[pos] = 16 * ((mine + 255) >> 8);
        __builtin_amdgcn_s_waitcnt(0xc07f);
        const int u = raw[tid]; const int su = lane_excl_prefix(u, tid);
        ust[tid] = su; if (tid == NEXP - 1) ust[NEXP] = su + u; }
    __syncthreads();
    }
    const int NU = ust[NEXP];
    int un = F.vcu;
    if (un >= NU) return;
#define MOE_DECODE(un_, e_, ct_, r0_, nrows_, slot0_) do { const int pos_ = __popcll(__ballot(F.lane >= 1 && ust[F.lane] <= (un_))); \
        e_ = srt[pos_]; const int ul_ = (un_) - ust[pos_], cnt_ = offs[e_ + 1] - offs[e_]; slot0_ = offs[e_]; const int nch_ = (cnt_ + 255) >> 8; \
        ct_ = ul_ / nch_; r0_ = (ul_ - ct_ * nch_) * 256; nrows_ = (cnt_ - r0_) < 256 ? (cnt_ - r0_) : 256; } while (0)
#define MOE_BBASE(e_, ct_) uniform_ptr(MODE == 1 ? ((w & 2) ? Wu : Wg) + (size_t)(e_) * DM * EFF + (ct_) * 64 : Wd + (size_t)(e_) * EFF * DM + (ct_) * 128)
#define MOE_ROWOF(e_, r0_, nrows_, slot0_, t_) ((MODE == 1) ? (list[(size_t)(e_) * CAP + (r0_) + ((t_) < (nrows_) ? (t_) : 0)] >> 1) : ((slot0_) + (r0_) + ((t_) < (nrows_) ? (t_) : 0)))
    if (w >= 4) {
        const int t8 = tid & 255;
        int kc, gcol, bcol;
        if (MODE == 1) { const int t7 = tid & 127; kc = t7 >> 4; gcol = (t7 & 15) * 4; bcol = ((w >> 1) & 1) * 64 + gcol; }
        else { kc = t8 >> 5; gcol = (t8 & 31) * 4; bcol = gcol; }
        const int bvoff = (kc * 8 * bld + gcol) * 4;
        int e, ct, r0, nrows, slot0; MOE_DECODE(un, e, ct, r0, nrows, slot0);
        rowp[t8] = MOE_ROWOF(e, r0, nrows, slot0, t8);
        __syncthreads();
        const __amdgpu_buffer_rsrc_t rsA = __builtin_amdgcn_make_buffer_rsrc((void*)Asrc, 0, 0x7fffffff, 0x00020000);
        __amdgpu_buffer_rsrc_t rsB = __builtin_amdgcn_make_buffer_rsrc((void*)MOE_BBASE(e, ct), 0, 0x7fffffff, 0x00020000);
        int avoff[8];
#define PC_AVOFF(PB) do { _Pragma("unroll") for (int i = 0; i < 8; ++i) { const int q = t8 + i * 256; avoff[i] = rowp[(PB) * 256 + (q >> 3)] * APITCH + (q & 7) * 16; } } while (0)
        PC_AVOFF(0);
        v4u areg[8]; f32x4 breg[2][8];
#define PC_ALOAD(st) do { _Pragma("unroll") for (int i = 0; i < 8; ++i) areg[i] = __builtin_bit_cast(v4u, __builtin_amdgcn_raw_buffer_load_b128(rsA, avoff[i], (st) * 128, 0)); } while (0)
#define PC_BLOAD(st, S) do { _Pragma("unroll") for (int j = 0; j < 8; ++j) breg[S][j] = __builtin_bit_cast(f32x4, __builtin_amdgcn_raw_buffer_load_b128(rsB, bvoff, ((st) * 64 + j) * bld * 4, 0)); } while (0)
#define PC_WRITE(st, SB) do { \
        const int wb = (st) & 1; LAS unsigned char* Aw = L + wb * ABYTES; LAS unsigned char* Bw = L + 2 * ABYTES + wb * BBYTES; \
        _Pragma("unroll") for (int i = 0; i < 8; ++i) { const int q = t8 + i * 256, r = q >> 3; *(LAS v4u*)(Aw + r * 128 + 16 * ((q & 7) ^ (r & 7))) = areg[i]; } \
        _Pragma("unroll") for (int c = 0; c < 4; ++c) { v4u pw; pw.x = pk2(breg[SB][0][c], breg[SB][1][c]); pw.y = pk2(breg[SB][2][c], breg[SB][3][c]); pw.z = pk2(breg[SB][4][c], breg[SB][5][c]); pw.w = pk2(breg[SB][6][c], breg[SB][7][c]); \
            *(LAS v4u*)(Bw + (bcol + c) * 128 + 16 * (kc ^ (((bcol + c) ^ (bcol >> 2)) & 7))) = pw; } } while (0)
        PC_ALOAD(0); PC_BLOAD(0, 0); PC_BLOAD(1, 1);
        PC_WRITE(0, 0); PC_ALOAD(1); PC_BLOAD(2, 0);
        int pb = 0;
        while (true) {
            const int unn = un + F.G; const bool hasn = unn < NU;
            int e2 = 0, ct2 = 0, r02 = 0, nrows2 = 0, slot02 = 0, rp2 = 0;
            if (hasn) { MOE_DECODE(unn, e2, ct2, r02, nrows2, slot02); rp2 = MOE_ROWOF(e2, r02, nrows2, slot02, t8); }
#pragma unroll 1
            for (int st = 0; st < NSTEP - 4; st += 2) {
                __syncthreads(); PC_WRITE(st + 1, 1); PC_ALOAD(st + 2); PC_BLOAD(st + 3, 1); __builtin_amdgcn_sched_barrier(0);
                __syncthreads(); PC_WRITE(st + 2, 0); PC_ALOAD(st + 3); PC_BLOAD(st + 4, 0); __builtin_amdgcn_sched_barrier(0);
            }
            __syncthreads(); PC_WRITE(NSTEP - 3, 1); PC_ALOAD(NSTEP - 2); PC_BLOAD(NSTEP - 1, 1); rowp[(pb ^ 1) * 256 + t8] = rp2; __builtin_amdgcn_sched_barrier(0);
            __syncthreads(); PC_WRITE(NSTEP - 2, 0); PC_ALOAD(NSTEP - 1);
            if (hasn) { rsB = __builtin_amdgcn_make_buffer_rsrc((void*)MOE_BBASE(e2, ct2), 0, 0x7fffffff, 0x00020000); PC_BLOAD(0, 0); }
            __builtin_amdgcn_sched_barrier(0);
            __syncthreads(); PC_WRITE(NSTEP - 1, 1);
            if (hasn) { PC_AVOFF(pb ^ 1); PC_ALOAD(0); PC_BLOAD(1, 1); }
            __builtin_amdgcn_sched_barrier(0);
            __syncthreads();
            if (!hasn) break;
            PC_WRITE(0, 0); PC_ALOAD(1); PC_BLOAD(2, 0); __builtin_amdgcn_sched_barrier(0);
            un = unn; pb ^= 1;
        }
#undef PC_AVOFF
#undef PC_ALOAD
#undef PC_BLOAD
#undef PC_WRITE
    } else {
        int fr = tid & 15, fq = (tid >> 4) & 3;
        __syncthreads();
        while (true) {
            int e, ct, r0, nrows, slot0; MOE_DECODE(un, e, ct, r0, nrows, slot0);
            bf16* outp = (MODE == 1) ? ACT + (size_t)(slot0 + r0) * ACTP + ct * 64 : YS + (size_t)(slot0 + r0) * DM + ct * 128;
            f32x4 acc[4][8];
#pragma unroll
            for (int a = 0; a < 4; ++a)
#pragma unroll
                for (int n = 0; n < 8; ++n) acc[a][n] = (f32x4){0.f, 0.f, 0.f, 0.f};
            bf16x8 af0[4], af1[4], bfr[8];
#pragma unroll
            for (int a = 0; a < 4; ++a) af1[a] = (bf16x8){0, 0, 0, 0, 0, 0, 0, 0};
#pragma unroll
            for (int n = 4; n < 8; ++n) bfr[n] = (bf16x8){0, 0, 0, 0, 0, 0, 0, 0};
#define PC_SB() __builtin_amdgcn_sched_barrier(0)
#define PC_RDA(ks, a) (*(const LAS bf16x8*)(As + ((w + 4 * (a)) * 16 + fr) * 128 + 16 * (((ks) * 4 + fq) ^ (fr & 7))))
#define PC_RDB(ks, n) (*(const LAS bf16x8*)(Bs + ((n) * 16 + fr) * 128 + 16 * (((ks) * 4 + fq) ^ ((fr ^ (((n) & 1) * 4 + (fr >> 2))) & 7))))
#define PC_MM(AF, N0) do { _Pragma("unroll") for (int n = (N0); n < (N0) + 4; ++n) _Pragma("unroll") for (int a = 0; a < 4; ++a) acc[a][n] = __builtin_amdgcn_mfma_f32_16x16x32_bf16(bfr[n], AF[a], acc[a][n], 0, 0, 0); } while (0)
#define PC_COMPUTE(st) do { \
            const int buf = (st) & 1; const LAS unsigned char* As = L + buf * ABYTES; const LAS unsigned char* Bs = L + 2 * ABYTES + buf * BBYTES; \
            _Pragma("unroll") for (int a = 0; a < 4; ++a) af0[a] = PC_RDA(0, a); \
            _Pragma("unroll") for (int n = 0; n < 4; ++n) bfr[n] = PC_RDB(0, n); \
            PC_SB(); PC_MM(af1, 4); PC_SB();                                     \
            _Pragma("unroll") for (int n = 4; n < 8; ++n) bfr[n] = PC_RDB(0, n); \
            _Pragma("unroll") for (int a = 0; a < 4; ++a) af1[a] = PC_RDA(1, a); \
            PC_SB(); PC_MM(af0, 0); PC_SB();                                     \
            _Pragma("unroll") for (int n = 0; n < 4; ++n) bfr[n] = PC_RDB(1, n); \
            PC_SB(); PC_MM(af0, 4); PC_SB();                                     \
            _Pragma("unroll") for (int n = 4; n < 8; ++n) bfr[n] = PC_RDB(1, n); \
            PC_SB(); PC_MM(af1, 0); PC_SB();                                     \
            } while (0)
#pragma unroll 1
            for (int st = 0; st < NSTEP; st += 2) {
                asm volatile("" : "+v"(fr), "+v"(fq));
                __syncthreads(); PC_COMPUTE(st);
                __syncthreads(); PC_COMPUTE(st + 1);
            }
            PC_MM(af1, 4);
#undef PC_COMPUTE
#undef PC_MM
#undef PC_RDA
#undef PC_RDB
#undef PC_SB
#pragma unroll
            for (int a = 0; a < 4; ++a) { const int r = (w + 4 * a) * 16 + fr;
                if (r < nrows) { bf16* orow = outp + (size_t)r * out_ld;
                    if (MODE == 1) {
#pragma unroll
                        for (int n = 0; n < 4; ++n) { const f32x4 g = acc[a][n], uu = acc[a][n + 4]; float o[4];
#pragma unroll
                            for (int x = 0; x < 4; ++x) o[x] = g[x] / (1.f + __expf(-g[x])) * uu[x];
                            uint2 pw; pw.x = pk2(o[0], o[1]); pw.y = pk2(o[2], o[3]); *(uint2*)(orow + n * 16 + fq * 4) = pw; }
                    } else {
#pragma unroll
                        for (int n = 0; n < 8; ++n) { const f32x4 o = acc[a][n]; uint2 pw; pw.x = pk2(o[0], o[1]); pw.y = pk2(o[2], o[3]); *(uint2*)(orow + n * 16 + fq * 4) = pw; }
                    } } }
            un += F.G; if (un >= NU) break;
        }
    }
#undef MOE_DECODE
#undef MOE_BBASE
#undef MOE_ROWOF
}

__device__ __forceinline__ void p14_final(Frame& F, const float* const* in, float* out) {
    const float* H1 = (const float*)(F.ws + WS_H1); const bf16* YS = (const bf16*)(F.ws + WS_YS); const float* ada = (const float*)(F.ws + WS_ADA); const float* fg = in[34];
    const int* tokE = (const int*)(F.ws + WS_TOKE); const int* tokP = (const int*)(F.ws + WS_TOKP); const float* tokW = (const float*)(F.ws + WS_TOKW);
    const unsigned* cnt = (const unsigned*)(F.ctl + CW_CNT);
    LAS int* offs = (LAS int*)F.lds;
    expert_offsets(cnt, offs, offs + 128, F.tid);
    const int gw = F.vcu * NWAVES + F.wave, NGW = F.G * NWAVES, lane = F.lane;
    for (int m0 = gw; m0 < M; m0 += 2 * NGW) {
        int mm[2], sa[2], sb[2]; float wa[2], wb[2];
#pragma unroll
        for (int r = 0; r < 2; ++r) { const int m = m0 + r * NGW < M ? m0 + r * NGW : m0; mm[r] = m;
            sa[r] = offs[tokE[m * 2]] + tokP[m * 2]; sb[r] = offs[tokE[m * 2 + 1]] + tokP[m * 2 + 1]; wa[r] = tokW[m * 2]; wb[r] = tokW[m * 2 + 1]; }
        f32x4 v[2][8]; float s2[2] = {0.f, 0.f};
#pragma unroll
        for (int r = 0; r < 2; ++r) { const float* gt2 = ada + (size_t)(mm[r] / SEQ) * 12288 + 10240;
            const uint2* y0 = (const uint2*)(YS + (size_t)sa[r] * DM) + lane; const uint2* y1 = (const uint2*)(YS + (size_t)sb[r] * DM) + lane;
            const f32x4* hr = (const f32x4*)(H1 + (size_t)mm[r] * DM) + lane;
#pragma unroll
            for (int j = 0; j < 8; ++j) { const uint2 a = y0[64 * j], c = y1[64 * j]; const f32x4 g = ((const f32x4*)gt2)[lane + 64 * j]; const float w0 = wa[r], w1 = wb[r];
                f32x4 mo; mo[0] = w0 * bflo(a.x) + w1 * bflo(c.x); mo[1] = w0 * bfhi(a.x) + w1 * bfhi(c.x); mo[2] = w0 * bflo(a.y) + w1 * bflo(c.y); mo[3] = w0 * bfhi(a.y) + w1 * bfhi(c.y);
                v[r][j] = hr[64 * j] + g * mo; s2[r] += (v[r][j].x * v[r][j].x + v[r][j].y * v[r][j].y) + (v[r][j].z * v[r][j].z + v[r][j].w * v[r][j].w); } }
#pragma unroll
        for (int r = 0; r < 2; ++r) { if (r == 1 && m0 + NGW >= M) break;
            const float rstd = 1.f / sqrtf(wave_sum(s2[r]) * (1.f / DM) + NORM_EPS);
            f32x4* orow = (f32x4*)(out + (size_t)mm[r] * DM) + lane;
#pragma unroll
            for (int j = 0; j < 8; ++j) orow[64 * j] = v[r][j] * rstd * ((const f32x4*)fg)[lane + 64 * j]; }
    }
}

struct Args { const float* in[35]; float* out; unsigned char* ws; int ph_lo, ph_hi, use_bar, pad; };
__global__ void __launch_bounds__(NTHR, 2) fwd_kernel(Args args) {
    extern __shared__ __attribute__((aligned(16))) unsigned char lds[];
    Frame F;
    F.lds = (LAS unsigned char*)lds; F.MISC = (volatile LAS unsigned*)(F.lds + MISC_OFF);
    F.tid = threadIdx.x; F.lane = F.tid & 63; F.wave = __builtin_amdgcn_readfirstlane(F.tid >> 6);
    F.G = gridDim.x; { const int bx = blockIdx.x; F.vcu = (F.G % 8 == 0) ? (bx % 8) * (F.G / 8) + bx / 8 : bx; }
    F.ws = args.ws; F.ctl = (gu32*)(args.ws + WS_CTL); F.probe = args.pad;
    for (int u = F.tid; u < (LDS_BYTES - LDSCTL_OFF) / 4; u += NTHR) ((LAS unsigned*)(F.lds + LDSCTL_OFF))[u] = 0u;
    __syncthreads();
    XcdBarrier bar; bar.bar = (unsigned*)(F.ctl + CW_BAR); bar.x = 0; bar.st = nullptr;
    if (args.use_bar) bar = xcd_barrier_post((unsigned*)(F.ctl + CW_BAR), F.MISC + 8);
    const int lo = args.ph_lo, hi = args.ph_hi;
    const float* const* in = args.in;
#ifndef PHASE_MASK
#define PHASE_MASK 0xFFFF
#endif
#define IN(k) ((((PHASE_MASK) >> (k)) & 1) && lo <= (k) && (k) < hi)
#define SEAM(k) do { if (IN(k) && IN((k) + 1)) xcd_barrier(bar); } while (0)
#ifndef PROBE_REPEAT_MASK
#define PROBE_REPEAT_MASK 0
#endif
#define REPS(k) for (int rep_ = 0; rep_ < 1 + (((PROBE_REPEAT_MASK) >> (k)) & 1); ++rep_, (rep_ < 1 + (((PROBE_REPEAT_MASK) >> (k)) & 1)) ? xcd_barrier(bar) : (void)0)
    const float* ada = (const float*)(F.ws + WS_ADA);

    if (IN(0)) REPS(0) { p0_prologue(F, in); } SEAM(0);
    if (IN(1)) REPS(1) {
        const int gw = F.vcu * NWAVES + F.wave, NGW = F.G * NWAVES; bf16* U = (bf16*)(F.ws + WS_U);
        for (int m = gw; m < M; m += 2 * NGW) { const int m2 = m + NGW < M ? m + NGW : m; const float* ad = ada + (size_t)(m / SEQ) * 12288; const float* ad2 = ada + (size_t)(m2 / SEQ) * 12288;
            norm_mod_row2(in[0] + (size_t)m * DM, in[0] + (size_t)m2 * DM, in[5], ad + 2048, ad, ad2 + 2048, ad2, U + (size_t)m * DM, U + (size_t)m2 * DM, F.lane); }
    } SEAM(1);
    if (IN(2)) REPS(2) {
        pg8::Gemm g{(const pg8::bf16_t*)(F.ws + WS_U), (const pg8::bf16_t*)(F.ws + WS_WIN_T), M, IN_COLS - 256, DM}; pg8::StaticOrder S; S.init(M, IN_COLS - 256, F.G, (int)blockIdx.x);
        pg8::EpiIn E{F.ws, (const float*)(F.ws + WS_ROPE), 0};
        pg8::gemm_phase<pg8::EpiIn, pg8::StaticOrder, PG8_ALIGN, PG8_SP2>(F.lds + RING_OFF, g, S, E);
    } SEAM(2);
#if RWKV_SEQ
    if (IN(3)) REPS(3) { p3_rwkv_prep(F, in); } SEAM(3);
    if (IN(4)) REPS(4) { p4_rwkv_scan(F); } SEAM(4);
#else
    if (IN(3)) REPS(3) {
        {
            pg8::Gemm g{(const pg8::bf16_t*)(F.ws + WS_U), (const pg8::bf16_t*)(F.ws + WS_WIN_T) + (size_t)(IN_COLS - 256) * DM, M, 256, DM}; pg8::StaticOrder S; S.init(M, 256, F.G, (int)blockIdx.x);
            pg8::EpiIn E{F.ws, (const float*)(F.ws + WS_ROPE), 40};
            pg8::gemm_phase<pg8::EpiIn, pg8::StaticOrder, PG8_ALIGN, PG8_SP2>(F.lds + RING_OFF, g, S, E);
        }
        p3_rwkv_chunk(F, in); } SEAM(3);
    if (IN(4)) REPS(4) { p4_rwkv_chain(F); } SEAM(4);
#endif
    if (IN(5)) REPS(5) {
        const attn_body::AttnTensors AT{(const attn_body::bf16*)(F.ws + WS_Q), (const attn_body::bf16*)(F.ws + WS_K), (const attn_body::bf16*)(F.ws + WS_V), (attn_body::bf16*)(F.ws + WS_O0), (attn_body::bf16*)(F.ws + WS_O1)};
        const attn_body::StaticOrder S((int)F.G, F.vcu);
        attn_body::attn_phase<attn_body::StaticOrder>((char*)lds + RING_OFF, AT, S);
    } SEAM(5);
    if (IN(6)) REPS(6) { p6_combine(F, in); } SEAM(6);
    if (IN(7)) REPS(7) {
        pg8::Gemm g{(const pg8::bf16_t*)(F.ws + WS_YATT), (const pg8::bf16_t*)(F.ws + WS_WUPA_T), M, DM, ATT_W}; pg8::StaticOrder S; S.init(M, DM, F.G, (int)blockIdx.x);
        pg8::EpiPair E{(const pg8::bf16_t*)(F.ws + WS_G), (pg8::bf16_t*)(F.ws + WS_MERGED)};
        pg8::gemm_phase_pair<pg8::EpiPair, pg8::StaticOrder, PG8_ALIGN, PG8_SP2>(F.lds + RING_OFF, g, (const pg8::bf16_t*)(F.ws + WS_YRW), (const pg8::bf16_t*)(F.ws + WS_WUPB_T), S, E);
    } SEAM(7);
    if (IN(8)) REPS(8) { }
    if (IN(9)) REPS(9) {
        pg8::Gemm g{(const pg8::bf16_t*)(F.ws + WS_MERGED), (const pg8::bf16_t*)(F.ws + WS_WOUT_T), M, DM, DM}; pg8::StaticOrder S; S.init(M, DM, F.G, (int)blockIdx.x);
        pg8::EpiH1 E{in[0], ada, (float*)(F.ws + WS_H1)};
        pg8::gemm_phase<pg8::EpiH1, pg8::StaticOrder, PG8_ALIGN, PG8_SP2>(F.lds + RING_OFF, g, S, E);
    } SEAM(9);
    if (IN(10)) REPS(10) { p10_route(F, in); } SEAM(10);
    if (IN(11)) REPS(11) { moe_gemm_pc<1>(F, in, false); } SEAM(11);
    if (IN(12)) REPS(12) { moe_gemm_pc<2>(F, in, IN(11)); } SEAM(12);
    if (IN(13)) REPS(13) { p14_final(F, in, args.out); }
#undef IN
#undef SEAM
}

extern "C" void kernel_launch(void* const* d_in, const int* in_sizes, int n_in, void* d_out, int out_size, void* d_ws, size_t ws_size, hipStream_t stream) {
    static int grid = 0;
    if (grid == 0) {
        if (n_in != 35 || out_size != M * DM || ws_size < WS_END) { fprintf(stderr, "kernel_launch: unexpected shapes (n_in %d out %d ws %zu)\n", n_in, out_size, ws_size); grid = -1; return; }
        int dev = 0, cus = 0;
        if (hipGetDevice(&dev) != hipSuccess || hipDeviceGetAttribute(&cus, hipDeviceAttributeMultiprocessorCount, dev) != hipSuccess) { grid = -1; return; }
        if (hipFuncSetAttribute((const void*)fwd_kernel, hipFuncAttributeMaxDynamicSharedMemorySize, LDS_BYTES) != hipSuccess) { fprintf(stderr, "kernel_launch: hipFuncSetAttribute failed\n"); grid = -1; return; }
        int per_cu = 0; (void)hipOccupancyMaxActiveBlocksPerMultiprocessor(&per_cu, (const void*)fwd_kernel, NTHR, LDS_BYTES); (void)hipGetLastError();
        if (per_cu < 1) fprintf(stderr, "kernel_launch: occupancy query says %d\n", per_cu);
        grid = cus;
    }
    if (grid < 0) return;
    (void)hipMemsetAsync((char*)d_ws + WS_CTL, 0, CTL_ZERO_BYTES, stream);
    Args a{};
    for (int i = 0; i < 35; ++i) a.in[i] = (const float*)d_in[i];
    a.out = (float*)d_out; a.ws = (unsigned char*)d_ws; a.pad = 0;
#if MK_ONE_LAUNCH
    a.ph_lo = 0; a.ph_hi = 14; a.use_bar = 1;
    hipLaunchKernelGGL(fwd_kernel, dim3(grid), dim3(NTHR), LDS_BYTES, stream, a);
#ifdef PROBE_PHASE
    a.ph_lo = PROBE_PHASE; a.ph_hi = PROBE_PHASE + 1; a.use_bar = 0; a.pad = 1;
    (void)hipMemsetAsync((char*)d_ws + WS_CTL + CW_P3Q * 4, 0, 16, stream);
    hipLaunchKernelGGL(fwd_kernel, dim3(grid), dim3(NTHR), LDS_BYTES, stream, a);
#endif
#else
    for (int p = 0; p < 14; ++p) { a.ph_lo = p; a.ph_hi = p + 1; a.use_bar = 0;
        hipLaunchKernelGGL(fwd_kernel, dim3(grid), dim3(NTHR), LDS_BYTES, stream, a); }
#endif
}
```

```cpp
#include <hip/hip_runtime.h>
#include <hip/hip_bf16.h>
#include <cstdio>
#include <cstdint>
#include <cmath>
namespace pg8 {
#define PG8_LAS __attribute__((address_space(3)))
typedef unsigned short bf16_t;
typedef short bf16x8 __attribute__((ext_vector_type(8)));
typedef float f32x4 __attribute__((ext_vector_type(4)));
typedef unsigned u32x4 __attribute__((ext_vector_type(4)));
constexpr int BM = 256, BK = 64, HALF = 128, HTB = HALF * BK * 2  , STAGE_BYTES = 8 * HTB, NXCD = 8, WGM = 8;

__host__ __device__ __forceinline__ int lds_byte(int r, int c) { const int st = (r >> 4) * 2 + (c >> 5), rr = r & 15, cc = c & 31, ob = rr * 64 + cc * 2; return st * 1024 + (ob ^ (((ob >> 9) & 1) << 5)); }
__host__ __device__ __forceinline__ void stage_rc(int b, int& R, int& C) { const int st = b / 1024, sb = b % 1024, swz = sb ^ (((sb >> 9) & 1) << 5); R = (st >> 1) * 16 + swz / 64; C = (st & 1) * 32 + (swz % 64) / 2; }
__host__ __device__ __forceinline__ int perm32(int rho) { const int n = rho >> 4, i = rho & 15; return 8 * (i >> 2) + 4 * n + (i & 3); }

struct Unit { int pm, pn; };
struct Gemm { const bf16_t* A; const bf16_t* Bt; int M, N, K; };

struct StaticOrder {
    int nM, nN, nwg, G, c;
    __host__ __device__ void init(int M, int N, int G_, int c_) { nM = M / BM; nN = N / BM; nwg = nM * nN; G = G_; c = c_; }
    __host__ __device__ bool next(int i, Unit& u) const {
        const long L = (long)i * G + c; if (L >= nwg) return false;
        int wgid = (int)L; { const int q = nwg / NXCD, r = nwg % NXCD, xcd = wgid % NXCD, off = wgid / NXCD; wgid = (xcd < r ? xcd * (q + 1) : r * (q + 1) + (xcd - r) * q) + off; }
        const int nig = WGM * nN, gid = wgid / nig, fm = gid * WGM, gsz = (nM - fm) < WGM ? (nM - fm) : WGM;
        u.pm = fm + ((wgid % nig) % gsz); u.pn = (wgid % nig) / gsz; return true;
    }
    __device__ __forceinline__ void a_ready(const Unit&) const {}
    __device__ __forceinline__ void done(const Unit&) const {}
};

__device__ __forceinline__ unsigned cvt_pk_bf16(float lo, float hi) { unsigned r; asm volatile("v_cvt_pk_bf16_f32 %0, %1, %2" : "=v"(r) : "v"(lo), "v"(hi)); return r; }
typedef float f32x2 __attribute__((ext_vector_type(2)));
__device__ __forceinline__ f32x2 gelu_pk(f32x2 v) {
    const f32x2 av = __builtin_elementwise_abs(v), d = av * 0.2316418882f + 1.0f;
    f32x2 t; t.x = __builtin_amdgcn_rcpf(d.x); t.y = __builtin_amdgcn_rcpf(d.y);
    f32x2 q = t * 0.5307027145f + (-0.7265760135f); q = q * t + 0.7107068705f; q = q * t + (-0.142248368f); q = q * t + 0.127414796f; q = q * t;
    const f32x2 s = (v * v) * (-0.72134752044f);
    f32x2 e; e.x = __builtin_amdgcn_exp2f(s.x); e.y = __builtin_amdgcn_exp2f(s.y);
    const f32x2 m = v * (q * e), r = v - m;
    f32x2 o; o.x = v.x < 0.f ? m.x : r.x; o.y = v.y < 0.f ? m.y : r.y; return o;
}


template <class Epi, class Sched, bool ALIGN_EPI = false, bool SP2 = false>
__device__ __forceinline__ void gemm_phase(PG8_LAS unsigned char* lds, const Gemm g, const Sched& S, const Epi& E) {
    int tid_ = threadIdx.x; asm volatile("" : "+v"(tid_));
    const int tid = tid_, wid = __builtin_amdgcn_readfirstlane(tid >> 6), lane = tid & 63, wr = wid >> 2, wc = wid & 3, fr = lane & 15, fq = lane >> 4;
    const int K = g.K, nt = K / BK;
    unsigned voffA[2], voffB[2];
#pragma unroll
    for (int i = 0; i < 2; ++i) { int R, C; stage_rc(tid * 16 + i * 8192, R, C); const int Rb = Epi::PERM ? ((R & ~31) + perm32(R & 31)) : R;
        voffA[i] = (unsigned)(R * K + C) * 2u; voffB[i] = (unsigned)(Rb * K + C) * 2u; }
    const size_t kstep = (size_t)(BK * 2);
    const size_t hstep = (size_t)HALF * K * 2;
    const size_t tstep = 2 * hstep;
    const unsigned ldsw = (unsigned)wid * 1024u;
    const int aoff = lds_byte(wr * 64 + fr, fq * 8), boff = lds_byte(wc * 32 + fr, fq * 8);
#define PG8_SA(b, h) (((b) * 2 + (h)) * HTB)
#define PG8_SB(b, h) ((4 + (b) * 2 + (h)) * HTB)
#define PG8_STAGE(bufoff, gbase, voff) do { _Pragma("unroll") for (int _i = 0; _i < 2; ++_i) \
        __builtin_amdgcn_global_load_lds((const unsigned*)((const char*)(gbase) + (voff)[_i]), (PG8_LAS unsigned*)(lds + (bufoff) + ldsw + _i * 8192), 16, 0, 0); } while (0)
#define PG8_LDA(dst, b, h) do { _Pragma("unroll") for (int m = 0; m < 4; ++m) _Pragma("unroll") for (int k = 0; k < 2; ++k) dst[m][k] = *(const PG8_LAS bf16x8*)(lds + PG8_SA(b, h) + aoff + m * 2048 + k * 1024); } while (0)
#define PG8_LDB(dst, b, h) do { _Pragma("unroll") for (int n = 0; n < 2; ++n) _Pragma("unroll") for (int k = 0; k < 2; ++k) dst[n][k] = *(const PG8_LAS bf16x8*)(lds + PG8_SB(b, h) + boff + n * 2048 + k * 1024); } while (0)
#define PG8_MMA(ai, bj, At, Bt) do { __builtin_amdgcn_s_setprio(1); _Pragma("unroll") for (int m = 0; m < 4; ++m) _Pragma("unroll") for (int n = 0; n < 2; ++n) _Pragma("unroll") for (int k = 0; k < 2; ++k) \
        acc[ai][bj][m][n] = __builtin_amdgcn_mfma_f32_16x16x32_bf16(Bt[n][k], At[m][k], acc[ai][bj][m][n], 0, 0, 0); __builtin_amdgcn_s_setprio(0); } while (0)
#define PG8_WAIT_V(n) asm volatile("s_waitcnt vmcnt(" #n ")" ::: "memory")
#define PG8_WAIT_L(n) asm volatile("s_waitcnt lgkmcnt(" #n ")" ::: "memory")
#define PG8_BAR __builtin_amdgcn_s_barrier()
#define PG8_SCHED __builtin_amdgcn_sched_barrier(0)
    Unit cur, nxt; int ui = 0;
    if (!S.next(0, cur)) return;
    f32x4 acc[2][2][4][2];
#pragma unroll
    for (int a = 0; a < 2; ++a)
#pragma unroll
        for (int b = 0; b < 2; ++b)
#pragma unroll
            for (int m = 0; m < 4; ++m)
#pragma unroll
                for (int n = 0; n < 2; ++n) acc[a][b][m][n] = (f32x4){0.f, 0.f, 0.f, 0.f};
    bf16x8 At[4][2], B0[2][2], B1[2][2];
    const char* cA = (const char*)g.A + (size_t)cur.pm * tstep; const char* cB = (const char*)g.Bt + (size_t)cur.pn * tstep;
    S.a_ready(cur);
    if constexpr (SP2) {
        PG8_STAGE(PG8_SB(0, 0), cB, voffB); PG8_STAGE(PG8_SB(0, 1), cB + hstep, voffB); PG8_STAGE(PG8_SA(0, 0), cA, voffA); PG8_STAGE(PG8_SA(0, 1), cA + hstep, voffA);
        if (wr == 1) PG8_BAR;
        PG8_WAIT_V(2); PG8_BAR;
        PG8_STAGE(PG8_SB(1, 0), cB + kstep, voffB); PG8_STAGE(PG8_SA(1, 0), cA + kstep, voffA); PG8_STAGE(PG8_SB(1, 1), cB + hstep + kstep, voffB);
        PG8_WAIT_V(6); PG8_BAR;
    } else {
        PG8_STAGE(PG8_SB(0, 0), cB, voffB); PG8_STAGE(PG8_SA(0, 0), cA, voffA); PG8_STAGE(PG8_SB(0, 1), cB + hstep, voffB); PG8_STAGE(PG8_SA(0, 1), cA + hstep, voffA);
        if (wr == 1) PG8_BAR;
        PG8_WAIT_V(4); PG8_BAR;
        PG8_STAGE(PG8_SB(1, 0), cB + kstep, voffB); PG8_STAGE(PG8_SA(1, 0), cA + kstep, voffA); PG8_STAGE(PG8_SB(1, 1), cB + hstep + kstep, voffB);
        PG8_WAIT_V(6); PG8_BAR;
    }
    for (;;) {
        const bool has_next = S.next(ui + 1, nxt);
        const char* nA = has_next ? (const char*)g.A + (size_t)nxt.pm * tstep : cA; const char* nB = has_next ? (const char*)g.Bt + (size_t)nxt.pn * tstep : cB;
        for (int t = 0; t < nt; t += 2) {
            const bool last = (t == nt - 2);
            const char* a1 = cA + (size_t)(t + 1) * kstep;
            const char* a2 = last ? nA : cA + (size_t)(t + 2) * kstep; const char* b2 = last ? nB : cB + (size_t)(t + 2) * kstep;
            const char* a3 = a2 + kstep; const char* b3 = b2 + kstep;
            if (last && has_next) S.a_ready(nxt);
            if constexpr (SP2) {
            PG8_LDB(B0, 0, 0); PG8_LDB(B1, 0, 1); PG8_SCHED; PG8_LDA(At, 0, 0); PG8_STAGE(PG8_SA(1, 1), a1 + hstep, voffA);
            PG8_WAIT_V(8); PG8_WAIT_L(0); PG8_BAR; PG8_MMA(0, 0, At, B0); PG8_MMA(0, 1, At, B1); PG8_BAR; PG8_SCHED;
            PG8_LDA(At, 0, 1); PG8_STAGE(PG8_SB(0, 0), b2, voffB); PG8_STAGE(PG8_SB(0, 1), b2 + hstep, voffB); PG8_STAGE(PG8_SA(0, 0), a2, voffA);
            PG8_WAIT_V(8); PG8_WAIT_L(0); PG8_BAR; PG8_MMA(1, 0, At, B0); PG8_MMA(1, 1, At, B1); PG8_BAR; PG8_SCHED;
            PG8_LDB(B0, 1, 0); PG8_LDB(B1, 1, 1); PG8_SCHED; PG8_LDA(At, 1, 0); PG8_STAGE(PG8_SA(0, 1), a2 + hstep, voffA);
            PG8_WAIT_V(8); PG8_WAIT_L(0); PG8_BAR; PG8_MMA(0, 0, At, B0); PG8_MMA(0, 1, At, B1); PG8_BAR; PG8_SCHED;
            PG8_LDA(At, 1, 1); PG8_STAGE(PG8_SB(1, 0), b3, voffB); PG8_STAGE(PG8_SB(1, 1), b3 + hstep, voffB); PG8_STAGE(PG8_SA(1, 0), a3, voffA);
            PG8_WAIT_V(8); PG8_WAIT_L(0); PG8_BAR; PG8_MMA(1, 0, At, B0); PG8_MMA(1, 1, At, B1); PG8_BAR; PG8_SCHED;
            } else {
            PG8_LDB(B0, 0, 0); PG8_SCHED; PG8_LDA(At, 0, 0); PG8_STAGE(PG8_SA(1, 1), a1 + hstep, voffA);
            PG8_WAIT_L(8); PG8_BAR; PG8_WAIT_L(0); PG8_MMA(0, 0, At, B0); PG8_BAR; PG8_SCHED;
            PG8_LDB(B1, 0, 1); PG8_STAGE(PG8_SB(0, 0), b2, voffB);
            PG8_BAR; PG8_WAIT_L(0); PG8_MMA(0, 1, At, B1); PG8_BAR;
            PG8_LDA(At, 0, 1); PG8_STAGE(PG8_SA(0, 0), a2, voffA);
            PG8_BAR; PG8_WAIT_L(0); PG8_MMA(1, 0, At, B0); PG8_BAR; PG8_SCHED;
            PG8_STAGE(PG8_SB(0, 1), b2 + hstep, voffB);
            PG8_WAIT_V(6); PG8_BAR; PG8_MMA(1, 1, At, B1); PG8_BAR;
            PG8_LDB(B0, 1, 0); PG8_SCHED; PG8_LDA(At, 1, 0); PG8_STAGE(PG8_SA(0, 1), a2 + hstep, voffA);
            PG8_WAIT_L(8); PG8_BAR; PG8_WAIT_L(0); PG8_MMA(0, 0, At, B0); PG8_BAR; PG8_SCHED;
            PG8_LDB(B1, 1, 1); PG8_STAGE(PG8_SB(1, 0), b3, voffB);
            PG8_BAR; PG8_WAIT_L(0); PG8_MMA(0, 1, At, B1); PG8_BAR;
            PG8_LDA(At, 1, 1); PG8_STAGE(PG8_SA(1, 0), a3, voffA);
            PG8_BAR; PG8_WAIT_L(0); PG8_MMA(1, 0, At, B0); PG8_BAR; PG8_SCHED;
            PG8_STAGE(PG8_SB(1, 1), b3 + hstep, voffB);
            PG8_WAIT_V(6); PG8_BAR; PG8_MMA(1, 1, At, B1); PG8_BAR;
            }
        }
        if constexpr (ALIGN_EPI) { if (wr == 0) PG8_BAR; }
        if constexpr (!Epi::AFTER_DRAIN) { E(acc, cur, wr, wc, fr, fq); S.done(cur); }
        if (!has_next) break;
#pragma unroll
        for (int a = 0; a < 2; ++a)
#pragma unroll
            for (int b = 0; b < 2; ++b)
#pragma unroll
                for (int m = 0; m < 4; ++m)
#pragma unroll
                    for (int n = 0; n < 2; ++n) acc[a][b][m][n] = (f32x4){0.f, 0.f, 0.f, 0.f};
        cur = nxt; cA = nA; cB = nB; ++ui;
        if constexpr (ALIGN_EPI) { if (wr == 1) PG8_BAR; }
    }
    PG8_WAIT_V(0);
    if constexpr (!ALIGN_EPI) { if (wr == 0) PG8_BAR; }
    PG8_BAR;
    if constexpr (Epi::AFTER_DRAIN) { E.fused(acc, cur, wr, wc, fr, fq, lds, wid, lane); S.done(cur); }
#undef PG8_SA
#undef PG8_SB
#undef PG8_STAGE
#undef PG8_LDA
#undef PG8_LDB
#undef PG8_MMA
#undef PG8_WAIT_V
#undef PG8_WAIT_L
#undef PG8_BAR
#undef PG8_SCHED
}
template <class Epi, class Sched, bool ALIGN_EPI = false, bool SP2 = false>
__device__ __forceinline__ void gemm_phase_pair(PG8_LAS unsigned char* lds, const Gemm g, const bf16_t* A2, const bf16_t* Bt2, const Sched& S, const Epi& E) {
    int tid_ = threadIdx.x; asm volatile("" : "+v"(tid_));
    const int tid = tid_, wid = __builtin_amdgcn_readfirstlane(tid >> 6), lane = tid & 63, wr = wid >> 2, wc = wid & 3, fr = lane & 15, fq = lane >> 4;
    const int K = g.K, nt = K / BK;
    unsigned voffA[2], voffB[2];
#pragma unroll
    for (int i = 0; i < 2; ++i) { int R, C; stage_rc(tid * 16 + i * 8192, R, C); const int Rb = Epi::PERM ? ((R & ~31) + perm32(R & 31)) : R;
        voffA[i] = (unsigned)(R * K + C) * 2u; voffB[i] = (unsigned)(Rb * K + C) * 2u; }
    const size_t kstep = (size_t)(BK * 2);
    const size_t hstep = (size_t)HALF * K * 2;
    const size_t tstep = 2 * hstep;
    const unsigned ldsw = (unsigned)wid * 1024u;
    const int aoff = lds_byte(wr * 64 + fr, fq * 8), boff = lds_byte(wc * 32 + fr, fq * 8);
#define PG8_SA(b, h) (((b) * 2 + (h)) * HTB)
#define PG8_SB(b, h) ((4 + (b) * 2 + (h)) * HTB)
#define PG8_STAGE(bufoff, gbase, voff) do { _Pragma("unroll") for (int _i = 0; _i < 2; ++_i) \
        __builtin_amdgcn_global_load_lds((const unsigned*)((const char*)(gbase) + (voff)[_i]), (PG8_LAS unsigned*)(lds + (bufoff) + ldsw + _i * 8192), 16, 0, 0); } while (0)
#define PG8_LDA(dst, b, h) do { _Pragma("unroll") for (int m = 0; m < 4; ++m) _Pragma("unroll") for (int k = 0; k < 2; ++k) dst[m][k] = *(const PG8_LAS bf16x8*)(lds + PG8_SA(b, h) + aoff + m * 2048 + k * 1024); } while (0)
#define PG8_LDB(dst, b, h) do { _Pragma("unroll") for (int n = 0; n < 2; ++n) _Pragma("unroll") for (int k = 0; k < 2; ++k) dst[n][k] = *(const PG8_LAS bf16x8*)(lds + PG8_SB(b, h) + boff + n * 2048 + k * 1024); } while (0)
#define PG8_MMA(ai, bj, At, Bt) do { __builtin_amdgcn_s_setprio(1); _Pragma("unroll") for (int m = 0; m < 4; ++m) _Pragma("unroll") for (int n = 0; n < 2; ++n) _Pragma("unroll") for (int k = 0; k < 2; ++k) \
        acc[ai][bj][m][n] = __builtin_amdgcn_mfma_f32_16x16x32_bf16(Bt[n][k], At[m][k], acc[ai][bj][m][n], 0, 0, 0); __builtin_amdgcn_s_setprio(0); } while (0)
#define PG8_WAIT_V(n) asm volatile("s_waitcnt vmcnt(" #n ")" ::: "memory")
#define PG8_WAIT_L(n) asm volatile("s_waitcnt lgkmcnt(" #n ")" ::: "memory")
#define PG8_BAR __builtin_amdgcn_s_barrier()
#define PG8_SCHED __builtin_amdgcn_sched_barrier(0)
    Unit cur, nxt; int ui = 0;
    if (!S.next(0, cur)) return;
    f32x4 acc[2][2][4][2];
#pragma unroll
    for (int a = 0; a < 2; ++a)
#pragma unroll
        for (int b = 0; b < 2; ++b)
#pragma unroll
            for (int m = 0; m < 4; ++m)
#pragma unroll
                for (int n = 0; n < 2; ++n) acc[a][b][m][n] = (f32x4){0.f, 0.f, 0.f, 0.f};
    bf16x8 At[4][2], B0[2][2], B1[2][2];
    const char* cA = (const char*)g.A + (size_t)cur.pm * tstep; const char* cB = (const char*)g.Bt + (size_t)cur.pn * tstep;
    S.a_ready(cur);
    if constexpr (SP2) {
        PG8_STAGE(PG8_SB(0, 0), cB, voffB); PG8_STAGE(PG8_SB(0, 1), cB + hstep, voffB); PG8_STAGE(PG8_SA(0, 0), cA, voffA); PG8_STAGE(PG8_SA(0, 1), cA + hstep, voffA);
        if (wr == 1) PG8_BAR;
        PG8_WAIT_V(2); PG8_BAR;
        PG8_STAGE(PG8_SB(1, 0), cB + kstep, voffB); PG8_STAGE(PG8_SA(1, 0), cA + kstep, voffA); PG8_STAGE(PG8_SB(1, 1), cB + hstep + kstep, voffB);
        PG8_WAIT_V(6); PG8_BAR;
    } else {
        PG8_STAGE(PG8_SB(0, 0), cB, voffB); PG8_STAGE(PG8_SA(0, 0), cA, voffA); PG8_STAGE(PG8_SB(0, 1), cB + hstep, voffB); PG8_STAGE(PG8_SA(0, 1), cA + hstep, voffA);
        if (wr == 1) PG8_BAR;
        PG8_WAIT_V(4); PG8_BAR;
        PG8_STAGE(PG8_SB(1, 0), cB + kstep, voffB); PG8_STAGE(PG8_SA(1, 0), cA + kstep, voffA); PG8_STAGE(PG8_SB(1, 1), cB + hstep + kstep, voffB);
        PG8_WAIT_V(6); PG8_BAR;
    }
    for (;;) {
        const int sel = ui & 1; bool has_next = true;
        if (sel == 0) nxt = cur; else has_next = S.next((ui + 1) >> 1, nxt);
        const char* nA = has_next ? (const char*)(sel == 0 ? A2 : g.A) + (size_t)nxt.pm * tstep : cA; const char* nB = has_next ? (const char*)(sel == 0 ? Bt2 : g.Bt) + (size_t)nxt.pn * tstep : cB;
        for (int t = 0; t < nt; t += 2) {
            const bool last = (t == nt - 2);
            const char* a1 = cA + (size_t)(t + 1) * kstep;
            const char* a2 = last ? nA : cA + (size_t)(t + 2) * kstep; const char* b2 = last ? nB : cB + (size_t)(t + 2) * kstep;
            const char* a3 = a2 + kstep; const char* b3 = b2 + kstep;
            if (last && has_next) S.a_ready(nxt);
            if constexpr (SP2) {
            PG8_LDB(B0, 0, 0); PG8_LDB(B1, 0, 1); PG8_SCHED; PG8_LDA(At, 0, 0); PG8_STAGE(PG8_SA(1, 1), a1 + hstep, voffA);
            PG8_WAIT_V(8); PG8_WAIT_L(0); PG8_BAR; PG8_MMA(0, 0, At, B0); PG8_MMA(0, 1, At, B1); PG8_BAR; PG8_SCHED;
            PG8_LDA(At, 0, 1); PG8_STAGE(PG8_SB(0, 0), b2, voffB); PG8_STAGE(PG8_SB(0, 1), b2 + hstep, voffB); PG8_STAGE(PG8_SA(0, 0), a2, voffA);
            PG8_WAIT_V(8); PG8_WAIT_L(0); PG8_BAR; PG8_MMA(1, 0, At, B0); PG8_MMA(1, 1, At, B1); PG8_BAR; PG8_SCHED;
            PG8_LDB(B0, 1, 0); PG8_LDB(B1, 1, 1); PG8_SCHED; PG8_LDA(At, 1, 0); PG8_STAGE(PG8_SA(0, 1), a2 + hstep, voffA);
            PG8_WAIT_V(8); PG8_WAIT_L(0); PG8_BAR; PG8_MMA(0, 0, At, B0); PG8_MMA(0, 1, At, B1); PG8_BAR; PG8_SCHED;
            PG8_LDA(At, 1, 1); PG8_STAGE(PG8_SB(1, 0), b3, voffB); PG8_STAGE(PG8_SB(1, 1), b3 + hstep, voffB); PG8_STAGE(PG8_SA(1, 0), a3, voffA);
            PG8_WAIT_V(8); PG8_WAIT_L(0); PG8_BAR; PG8_MMA(1, 0, At, B0); PG8_MMA(1, 1, At, B1); PG8_BAR; PG8_SCHED;
            } else {
            PG8_LDB(B0, 0, 0); PG8_SCHED; PG8_LDA(At, 0, 0); PG8_STAGE(PG8_SA(1, 1), a1 + hstep, voffA);
            PG8_WAIT_L(8); PG8_BAR; PG8_WAIT_L(0); PG8_MMA(0, 0, At, B0); PG8_BAR; PG8_SCHED;
            PG8_LDB(B1, 0, 1); PG8_STAGE(PG8_SB(0, 0), b2, voffB);
            PG8_BAR; PG8_WAIT_L(0); PG8_MMA(0, 1, At, B1); PG8_BAR;
            PG8_LDA(At, 0, 1); PG8_STAGE(PG8_SA(0, 0), a2, voffA);
            PG8_BAR; PG8_WAIT_L(0); PG8_MMA(1, 0, At, B0); PG8_BAR; PG8_SCHED;
            PG8_STAGE(PG8_SB(0, 1), b2 + hstep, voffB);
            PG8_WAIT_V(6); PG8_BAR; PG8_MMA(1, 1, At, B1); PG8_BAR;
            PG8_LDB(B0, 1, 0); PG8_SCHED; PG8_LDA(At, 1, 0); PG8_STAGE(PG8_SA(0, 1), a2 + hstep, voffA);
            PG8_WAIT_L(8); PG8_BAR; PG8_WAIT_L(0); PG8_MMA(0, 0, At, B0); PG8_BAR; PG8_SCHED;
            PG8_LDB(B1, 1, 1); PG8_STAGE(PG8_SB(1, 0), b3, voffB);
            PG8_BAR; PG8_WAIT_L(0); PG8_MMA(0, 1, At, B1); PG8_BAR;
            PG8_LDA(At, 1, 1); PG8_STAGE(PG8_SA(1, 0), a3, voffA);
            PG8_BAR; PG8_WAIT_L(0); PG8_MMA(1, 0, At, B0); PG8_BAR; PG8_SCHED;
            PG8_STAGE(PG8_SB(1, 1), b3 + hstep, voffB);
            PG8_WAIT_V(6); PG8_BAR; PG8_MMA(1, 1, At, B1); PG8_BAR;
            }
        }
        if constexpr (ALIGN_EPI) { if (wr == 0) PG8_BAR; }
        if (sel == 0) E.mid(acc, cur, wr, wc, fr, fq); else { E(acc, cur, wr, wc, fr, fq); S.done(cur); }
        if (!has_next) break;
        if (sel == 1) {
#pragma unroll
        for (int a = 0; a < 2; ++a)
#pragma unroll
            for (int b = 0; b < 2; ++b)
#pragma unroll
                for (int m = 0; m < 4; ++m)
#pragma unroll
                    for (int n = 0; n < 2; ++n) acc[a][b][m][n] = (f32x4){0.f, 0.f, 0.f, 0.f};
        }
        cur = nxt; cA = nA; cB = nB; ++ui;
        if constexpr (ALIGN_EPI) { if (wr == 1) PG8_BAR; }
    }
    PG8_WAIT_V(0);
    if constexpr (!ALIGN_EPI) { if (wr == 0) PG8_BAR; }
    PG8_BAR;
    if constexpr (Epi::AFTER_DRAIN) { E.fused(acc, cur, wr, wc, fr, fq, lds, wid, lane); S.done(cur); }
#undef PG8_SA
#undef PG8_SB
#undef PG8_STAGE
#undef PG8_LDA
#undef PG8_LDB
#undef PG8_MMA
#undef PG8_WAIT_V
#undef PG8_WAIT_L
#undef PG8_BAR
#undef PG8_SCHED
}
}

#ifndef PG8_SP2
#define PG8_SP2 true
#endif
#ifndef PG8_ALIGN
#define PG8_ALIGN true
#endif

namespace attn_body {
using bf16=__hip_bfloat16;
using bf16x8=__attribute__((ext_vector_type(8)))short;
using s16x4=__attribute__((ext_vector_type(4)))short;
using f32x16=__attribute__((ext_vector_type(16)))float;
using u32x4=__attribute__((ext_vector_type(4)))unsigned;
constexpr int BATCH=2,NHEAD=16,SEQ=4096,D=64,DM=NHEAD*D;
constexpr int NW=8,QBLK=32,QB=QBLK*NW,KVBLK=64,NQB=SEQ/QB;
constexpr int ATTN_PITCH=DM, ATTN_UNIT_ROWS=QB;
__device__ __forceinline__ int crow(int r,int hi){return (r&3)+8*(r>>2)+4*hi;}
#define SBAR() __builtin_amdgcn_sched_barrier(0)
__device__ __forceinline__ void cmask(f32x16&p0,f32x16&p1,int jb,int qrel,int hi){
  const float NEG=-INFINITY; int kb=64*jb+4*hi;
  #pragma unroll
  for(int r=0;r<16;++r){int kv=kb+(r&3)+8*(r>>2); if(kv>qrel)p0[r]=NEG; if(kv+32>qrel)p1[r]=NEG;}
}

constexpr int NSLOT=3, SLOTB=8192;
constexpr int LDS_K=0, LDS_V=NSLOT*SLOTB, LDS_WS=2*NSLOT*SLOTB, LDS_OST=LDS_WS+NW*64*4, LDS_BYTES=LDS_OST+NW*4096;
constexpr float C2=0.125f*1.4426950408889634f;
__device__ __forceinline__ void glds16(const void*gsrc,unsigned lds_dst){unsigned keep;
  asm volatile("s_mov_b32 %0, m0\n\ts_mov_b32 m0, %2\n\ts_nop 0\n\tglobal_load_lds_dwordx4 %1, off\n\ts_mov_b32 m0, %0":"=&s"(keep):"v"(gsrc),"s"(lds_dst):"memory");}
__device__ __forceinline__ float max3f(float a,float b,float c){float r;asm("v_max3_f32 %0, %1, %2, %3":"=v"(r):"v"(a),"v"(b),"v"(c));return r;}
__device__ __forceinline__ float max2f(float a,float b){float r;asm("v_max_f32_e32 %0, %1, %2":"=v"(r):"v"(a),"v"(b));return r;}
__device__ __forceinline__ float fadd_s(float a,float b){float r;asm("v_add_f32_e32 %0, %1, %2":"=v"(r):"v"(a),"v"(b));return r;}
__device__ __forceinline__ float fsub_s(float a,float b){float r;asm("v_sub_f32_e32 %0, %1, %2":"=v"(r):"v"(a),"v"(b));return r;}
typedef float f32x2_t __attribute__((ext_vector_type(2))); typedef __bf16 bf16x2_t __attribute__((ext_vector_type(2)));
__device__ __forceinline__ unsigned cvtpk_s(float lo,float hi){f32x2_t v={lo,hi};bf16x2_t b=__builtin_convertvector(v,bf16x2_t);return __builtin_bit_cast(unsigned,b);}
#define WAIT_BAR(N) asm volatile("s_waitcnt vmcnt(" #N ") lgkmcnt(0)\n\ts_barrier":::"memory")

__device__ __forceinline__ void qkt(f32x16&p0,f32x16&p1,const char*Kslot,const bf16x8*qr,const f32x16&negm,int r32,int hi){
  const char*kb=Kslot+hi*1024+r32*16;
  #pragma unroll
  for(int d0=0;d0<4;++d0){
    const bf16x8 b0=*reinterpret_cast<const bf16x8*>(kb+d0*2048);
    const bf16x8 b1=*reinterpret_cast<const bf16x8*>(kb+d0*2048+512);
    if(d0==0){p0=__builtin_amdgcn_mfma_f32_32x32x16_bf16(b0,qr[0],negm,0,0,0);p1=__builtin_amdgcn_mfma_f32_32x32x16_bf16(b1,qr[0],negm,0,0,0);}
    else{p0=__builtin_amdgcn_mfma_f32_32x32x16_bf16(b0,qr[d0],p0,0,0,0);p1=__builtin_amdgcn_mfma_f32_32x32x16_bf16(b1,qr[d0],p1,0,0,0);}}
}
typedef __attribute__((address_space(3))) const char* lds_cptr;
typedef short v4i16_t __attribute__((ext_vector_type(4)));
__device__ __forceinline__ void kload8(bf16x8*kf,lds_cptr kp){
  kf[0]=*(const __attribute__((address_space(3))) bf16x8*)(kp);      kf[1]=*(const __attribute__((address_space(3))) bf16x8*)(kp+512);
  kf[2]=*(const __attribute__((address_space(3))) bf16x8*)(kp+2048); kf[3]=*(const __attribute__((address_space(3))) bf16x8*)(kp+2560);
  kf[4]=*(const __attribute__((address_space(3))) bf16x8*)(kp+4096); kf[5]=*(const __attribute__((address_space(3))) bf16x8*)(kp+4608);
  kf[6]=*(const __attribute__((address_space(3))) bf16x8*)(kp+6144); kf[7]=*(const __attribute__((address_space(3))) bf16x8*)(kp+6656);
}
__device__ __forceinline__ void kload2(bf16x8*kf,lds_cptr kp,int j){ kf[2*j]=*(const __attribute__((address_space(3))) bf16x8*)(kp+j*2048); kf[2*j+1]=*(const __attribute__((address_space(3))) bf16x8*)(kp+j*2048+512); }
__device__ __forceinline__ s16x4 vtr(lds_cptr p){ return __builtin_bit_cast(s16x4,__builtin_amdgcn_ds_read_tr16_b64_v4i16((__attribute__((address_space(3))) v4i16_t*)p)); }
__device__ __forceinline__ float rowmax(const f32x16&p0,const f32x16&p1){
  float a=max3f(p0[0],p0[1],p1[0]),b=max3f(p0[2],p0[3],p1[1]);a=max3f(a,p1[2],p1[3]);
  #pragma unroll
  for(int r=4;r<16;r+=4){a=max3f(a,p0[r],p0[r+1]);b=max3f(b,p0[r+2],p0[r+3]);a=max3f(a,p1[r],p1[r+1]);b=max3f(b,p1[r+2],p1[r+3]);}
  const float m=max2f(a,b);
  auto rr=__builtin_amdgcn_permlane32_swap(__float_as_uint(m),__float_as_uint(m),false,false);
  return max2f(__uint_as_float(rr[0]),__uint_as_float(rr[1]));
}
__device__ __forceinline__ void pv(f32x16*o,int vb,bf16x8 pa0,bf16x8 pa1,bf16x8 pa2,bf16x8 pa3){
  #pragma unroll
  for(int d0=0;d0<2;++d0){s16x4 lo[4],hi[4];
    #pragma unroll
    for(int ks=0;ks<4;++ks){
      asm volatile("ds_read_b64_tr_b16 %0,%1 offset:%c2":"=&v"(lo[ks]):"v"(vb),"i"(d0*4096+ks*1024):"memory");
      asm volatile("ds_read_b64_tr_b16 %0,%1 offset:%c2":"=&v"(hi[ks]):"v"(vb),"i"(d0*4096+ks*1024+512):"memory");}
    asm volatile("s_waitcnt lgkmcnt(0)":::"memory");SBAR();
    #define PK(k) (bf16x8){lo[k][0],lo[k][1],lo[k][2],lo[k][3],hi[k][0],hi[k][1],hi[k][2],hi[k][3]}
    o[d0]=__builtin_amdgcn_mfma_f32_32x32x16_bf16(pa0,PK(0),o[d0],0,0,0);
    o[d0]=__builtin_amdgcn_mfma_f32_32x32x16_bf16(pa1,PK(1),o[d0],0,0,0);
    o[d0]=__builtin_amdgcn_mfma_f32_32x32x16_bf16(pa2,PK(2),o[d0],0,0,0);
    o[d0]=__builtin_amdgcn_mfma_f32_32x32x16_bf16(pa3,PK(3),o[d0],0,0,0);
    #undef PK
  }
}

#ifndef ATTN_STORE16
#define ATTN_STORE16(p,v) (*(u32x4*)(p)=(v))
#endif
template<int THRL> __device__ __forceinline__ void attn_unit(int b,int qkoff,int voff,int qb,const bf16*Q,const bf16*__restrict__ K,const bf16*__restrict__ V,bf16*O,char*shm){
  const int tid=threadIdx.x,lane=tid&63,r32=lane&31,hi=lane>>5; const int wid=__builtin_amdgcn_readfirstlane(tid>>6);
  const long rowbase=(long)b*SEQ; const int q0=qb*QB;
  const bf16*Qw=Q+(rowbase+q0+wid*QBLK)*DM+qkoff;
  const bf16*Kh=K+rowbase*DM+qkoff,*Vh=V+rowbase*DM+voff;
  const unsigned lds0=(unsigned)(uintptr_t)shm;
  float*wsf=(float*)(shm+LDS_WS)+wid*64;
  const bf16*ksrc=Kh+(long)lane*DM+wid*8;
  const bf16*vsrc=Vh+(long)(16*(wid&3)+(lane>>2))*DM+(wid>>2)*32+(lane&3)*8;
  const unsigned kdst=lds0+LDS_K+wid*1024, vdst=lds0+LDS_V+wid*1024;
  #define DMA_K(t,slot) glds16(ksrc+(long)(t)*KVBLK*DM,(unsigned)__builtin_amdgcn_readfirstlane(kdst+(slot)))
  #define DMA_V(t,slot) glds16(vsrc+(long)(t)*KVBLK*DM,(unsigned)__builtin_amdgcn_readfirstlane(vdst+(slot)))
  const int vb0=(int)(lds0+LDS_V)+((lane>>4)&1)*32+(lane&3)*8+(4*hi+((lane&15)>>2))*64;
  const char*Kbase=shm+LDS_K; bf16x8 kf[8];
  const lds_cptr shm3=(lds_cptr)shm; const lds_cptr kp0=shm3+LDS_K+hi*1024+r32*16; const lds_cptr vp0=shm3+LDS_V+((lane>>4)&1)*32+(lane&3)*8+(4*hi+((lane&15)>>2))*64;
  const int NT=(q0+QB)/KVBLK;
  DMA_K(0,0);DMA_V(0,0);DMA_K(1,SLOTB);
  bf16x8 qr[4];
  #pragma unroll
  for(int d0=0;d0<4;++d0)qr[d0]=*reinterpret_cast<const bf16x8*>(&Qw[(long)r32*DM+d0*16+hi*8]);
  float mhat=0.f,l_reg=0.f;f32x16 o[2];o[0]=f32x16{};o[1]=f32x16{};f32x16 negm=f32x16{};asm volatile("":"+v"(negm));
  const int qrel=wid*QBLK+r32;
  #define CMASK(P0,P1,t) do{int jb_=(t)-(NT-4); if(jb_>=0)cmask(P0,P1,jb_,qrel,hi);}while(0)
  bool resc=false;
  #define START(P0,P1) do{ const float rm=rowmax(P0,P1); resc=false; \
    { const float dl=rm; mhat=fadd_s(mhat,dl); \
      _Pragma("unroll") for(int r=0;r<16;++r){P0[r]=fsub_s(P0[r],dl);P1[r]=fsub_s(P1[r],dl);} \
      _Pragma("unroll") for(int r=0;r<16;++r)negm[r]=-mhat; asm volatile("":"+v"(negm)); } \
    _Pragma("unroll") for(int r=0;r<16;++r)P0[r]=__builtin_amdgcn_exp2f(P0[r]); }while(0)
  #define RESC() do{ if(resc){ asm volatile("s_waitcnt lgkmcnt(0)":::"memory"); \
      _Pragma("unroll") for(int d_=0;d_<2;++d_) _Pragma("unroll") for(int r=0;r<16;++r)o[d_][r]*=wsf[crow(r,hi)]; } }while(0)
  f32x16 pA0,pA1,pB0,pB1;
  int sl_prev=0,sl_cur=0,sl_next=SLOTB;
  #define ROT() do{sl_prev=sl_cur;sl_cur=sl_next;sl_next=(sl_next==(NSLOT-1)*SLOTB)?0:sl_next+SLOTB;}while(0)
  DMA_K(2,2*SLOTB);
  WAIT_BAR(3);
  qkt(pA0,pA1,Kbase,qr,negm,r32,hi);asm volatile("s_nop 15\n\ts_nop 7":"+v"(pA0),"+v"(pA1));CMASK(pA0,pA1,0);
  START(pA0,pA1);
  _Pragma("unroll") for(int r=0;r<16;++r)pA1[r]=__builtin_amdgcn_exp2f(pA1[r]);
  WAIT_BAR(0);
  DMA_K(3,0);DMA_V(1,SLOTB);
  ROT();
  kload8(kf,kp0+sl_cur);
  WAIT_BAR(2);
  s16x4 vlo[8],vhi[8]; u32x4 pw0,pw1,pw2,pw3;
  #define PKW(P,B) cvtpk_s(P[B],P[B+1])
  #define PAF(k) __builtin_bit_cast(bf16x8,pw##k)
  #define VFR(i) (bf16x8){vlo[i][0],vlo[i][1],vlo[i][2],vlo[i][3],vhi[i][0],vhi[i][1],vhi[i][2],vhi[i][3]}
  #define PIN(x) asm volatile("":"+v"(x))
  #define MX3(a,b,c) __builtin_fmaxf(__builtin_fmaxf((a),(b)),(c))
  #define GAPA(MF,A0,A1,A2,A3,W0,W1,PW) do{ MF; sacc+=A0; sacc+=A1; sacc+=A2; sacc+=A3; PIN(sacc); W0; W1; PIN(PW); SBAR(); }while(0)
  #define EX(v) __builtin_amdgcn_exp2f(v)
  #define GAPB(MF,X,B) do{ MF; X[B]=EX(X[B]); X[B+1]=EX(X[B+1]); X[B+2]=EX(X[B+2]); X[B+3]=EX(X[B+3]); PIN(X); SBAR(); }while(0)
  #define VRD(i) do{ vlo[i]=vtr(vp_+(((i)>>2)*4096+((i)&3)*1024)); vhi[i]=vtr(vp_+(((i)>>2)*4096+((i)&3)*1024+512)); }while(0)
  #define KRD(G,j) do{ if(G){ kload2(kf,kp0+sl_next,j); SBAR(); } }while(0)
  #define STEP(C0,C1,P0,P1,t,GK,GV,GL) do{ SBAR(); \
    const lds_cptr vp_=vp0+sl_prev; \
    VRD(0); SBAR(); float sacc=(P0[0]+P0[1]); \
    GAPA(C0=__builtin_amdgcn_mfma_f32_32x32x16_bf16(kf[0],qr[0],negm,0,0,0), P0[2],P0[3],P0[4],P0[5],     pw0[0]=PKW(P0,0), pw0[1]=PKW(P0,2), pw0); \
    VRD(4); SBAR(); GAPA(C1=__builtin_amdgcn_mfma_f32_32x32x16_bf16(kf[1],qr[0],negm,0,0,0), P0[6],P0[7],P0[8],P0[9],     pw0[2]=PKW(P0,4), pw0[3]=PKW(P0,6), pw0); \
    VRD(1); SBAR(); GAPA(C0=__builtin_amdgcn_mfma_f32_32x32x16_bf16(kf[2],qr[1],C0,0,0,0),   P0[10],P0[11],P0[12],P0[13], pw1[0]=PKW(P0,8), pw1[1]=PKW(P0,10), pw1); \
    VRD(5); SBAR(); GAPA(C1=__builtin_amdgcn_mfma_f32_32x32x16_bf16(kf[3],qr[1],C1,0,0,0),   P0[14],P0[15],P1[0],P1[1],   pw1[2]=PKW(P0,12),pw1[3]=PKW(P0,14), pw1); \
    VRD(2); SBAR(); GAPA(C0=__builtin_amdgcn_mfma_f32_32x32x16_bf16(kf[4],qr[2],C0,0,0,0),   P1[2],P1[3],P1[4],P1[5],     pw2[0]=PKW(P1,0), pw2[1]=PKW(P1,2), pw2); \
    VRD(6); SBAR(); GAPA(C1=__builtin_amdgcn_mfma_f32_32x32x16_bf16(kf[5],qr[2],C1,0,0,0),   P1[6],P1[7],P1[8],P1[9],     pw2[2]=PKW(P1,4), pw2[3]=PKW(P1,6), pw2); \
    VRD(3); SBAR(); GAPA(C0=__builtin_amdgcn_mfma_f32_32x32x16_bf16(kf[6],qr[3],C0,0,0,0),   P1[10],P1[11],P1[12],P1[13], pw3[0]=PKW(P1,8), pw3[1]=PKW(P1,10), pw3); \
    VRD(7); SBAR(); GAPA(C1=__builtin_amdgcn_mfma_f32_32x32x16_bf16(kf[7],qr[3],C1,0,0,0),   P1[14],P1[15],0.f,0.f,       pw3[2]=PKW(P1,12),pw3[3]=PKW(P1,14), pw3); \
    l_reg+=sacc; \
    if(GK){DMA_K((t)+3,sl_cur);} if(GV){DMA_V((t)+1,sl_next);} \
    CMASK(C0,C1,t); \
    { float a=MX3(C0[0],C0[1],C1[0]),b=MX3(C0[2],C0[3],C1[1]); a=MX3(a,C1[2],C1[3]); \
      _Pragma("unroll") for(int r=4;r<16;r+=4){a=MX3(a,C0[r],C0[r+1]);b=MX3(b,C0[r+2],C0[r+3]);a=MX3(a,C1[r],C1[r+1]);b=MX3(b,C1[r+2],C1[r+3]);} \
      float rm=__builtin_fmaxf(a,b); { auto rr=__builtin_amdgcn_permlane32_swap(__float_as_uint(rm),__float_as_uint(rm),false,false); rm=__builtin_fmaxf(__uint_as_float(rr[0]),__uint_as_float(rr[1])); } \
      resc=false; \
      if(__builtin_expect(__any(rm>(float)THRL),0)){ const float dl=__builtin_fmaxf(rm,0.f); mhat+=dl; \
        _Pragma("unroll") for(int r=0;r<16;++r){C0[r]-=dl;C1[r]-=dl;} \
        _Pragma("unroll") for(int r=0;r<16;++r)negm[r]=-mhat; asm volatile("":"+v"(negm)); \
        const float f=__builtin_amdgcn_exp2f(-dl); l_reg*=f; if(hi==0)wsf[r32]=f; resc=true; } } \
    SBAR(); \
    GAPB(o[0]=__builtin_amdgcn_mfma_f32_32x32x16_bf16(PAF(0),VFR(0),o[0],0,0,0), C0,0); \
    GAPB(o[1]=__builtin_amdgcn_mfma_f32_32x32x16_bf16(PAF(0),VFR(4),o[1],0,0,0), C0,4); \
    KRD(GL,0); GAPB(o[0]=__builtin_amdgcn_mfma_f32_32x32x16_bf16(PAF(1),VFR(1),o[0],0,0,0), C0,8); \
    KRD(GL,1); GAPB(o[1]=__builtin_amdgcn_mfma_f32_32x32x16_bf16(PAF(1),VFR(5),o[1],0,0,0), C0,12); \
    KRD(GL,2); GAPB(o[0]=__builtin_amdgcn_mfma_f32_32x32x16_bf16(PAF(2),VFR(2),o[0],0,0,0), C1,0); \
    KRD(GL,3); GAPB(o[1]=__builtin_amdgcn_mfma_f32_32x32x16_bf16(PAF(2),VFR(6),o[1],0,0,0), C1,4); \
    GAPB(o[0]=__builtin_amdgcn_mfma_f32_32x32x16_bf16(PAF(3),VFR(3),o[0],0,0,0), C1,8); \
    GAPB(o[1]=__builtin_amdgcn_mfma_f32_32x32x16_bf16(PAF(3),VFR(7),o[1],0,0,0), C1,12); \
    }while(0)
  int t=1;
  #undef CMASK
  #define CMASK(P0,P1,t) do{}while(0)
  for(;t+5<NT;t+=2){
    STEP(pB0,pB1,pA0,pA1,t,true,true,true);     WAIT_BAR(2); RESC(); ROT();
    STEP(pA0,pA1,pB0,pB1,t+1,true,true,true);   WAIT_BAR(2); RESC(); ROT();
  }
  #undef CMASK
  #define CMASK(P0,P1,t) do{int jb_=(t)-(NT-4); if(jb_>=0)cmask(P0,P1,jb_,qrel,hi);}while(0)
  #define ENDW(tt) do{ if((tt)+3<NT){WAIT_BAR(2);} else if((tt)+2<NT){WAIT_BAR(1);} else {WAIT_BAR(0);} }while(0)
  for(;t+1<NT;t+=2){
    STEP(pB0,pB1,pA0,pA1,t,(t+3<NT),(t+1<NT),(t+1<NT));       ENDW(t);   RESC(); ROT();
    STEP(pA0,pA1,pB0,pB1,t+1,(t+4<NT),(t+2<NT),(t+2<NT));     ENDW(t+1); RESC(); ROT();
  }
  STEP(pB0,pB1,pA0,pA1,NT-1,false,false,false); RESC();
  { float sacc=pB0[0]+pB0[1]; _Pragma("unroll") for(int r=2;r<16;++r)sacc+=pB0[r]; _Pragma("unroll") for(int r=0;r<16;++r)sacc+=pB1[r]; l_reg+=sacc;
    pw0=(u32x4){PKW(pB0,0),PKW(pB0,2),PKW(pB0,4),PKW(pB0,6)};pw1=(u32x4){PKW(pB0,8),PKW(pB0,10),PKW(pB0,12),PKW(pB0,14)};pw2=(u32x4){PKW(pB1,0),PKW(pB1,2),PKW(pB1,4),PKW(pB1,6)};pw3=(u32x4){PKW(pB1,8),PKW(pB1,10),PKW(pB1,12),PKW(pB1,14)};
    SBAR(); pv(o,vb0+sl_cur,PAF(0),PAF(1),PAF(2),PAF(3)); }
  #undef PKW
  #undef PAF
  #undef VFR
  #undef PIN
  #undef MX3
  #undef GAPA
  #undef GAPB
  #undef EX
  #undef VRD
  #undef KRD
  #undef STEP
  #undef ENDW
  {auto rr=__builtin_amdgcn_permlane32_swap(__float_as_uint(l_reg),__float_as_uint(l_reg),false,false);l_reg=__uint_as_float(rr[0])+__uint_as_float(rr[1]);}
  if(hi==0)wsf[32+r32]=l_reg;asm volatile("s_waitcnt lgkmcnt(0)":::"memory");
  float rli[16];
  #pragma unroll
  for(int r=0;r<16;++r)rli[r]=__builtin_amdgcn_rcpf(wsf[32+crow(r,hi)]);
  bf16*Ow=O+(rowbase+q0+wid*QBLK)*DM+voff;
  { bf16*stg=(bf16*)(shm+LDS_OST)+wid*2048;
    #pragma unroll
    for(int r=0;r<16;++r){const int orow=crow(r,hi);
      #pragma unroll
      for(int d0=0;d0<2;++d0)stg[orow*64+d0*32+r32]=__float2bfloat16(o[d0][r]*rli[r]);}
    asm volatile("s_waitcnt lgkmcnt(0)":::"memory");
    #pragma unroll
    for(int i=0;i<4;++i){const int row=i*8+(lane>>3),ch=lane&7; const u32x4 v=*(const u32x4*)(stg+row*64+ch*8); ATTN_STORE16(Ow+(long)row*DM+ch*8,v);} }
  asm volatile("s_waitcnt lgkmcnt(0)\n\ts_barrier":::"memory");
  #undef DMA_K
  #undef DMA_V
  #undef CMASK
  #undef START
  #undef RESC
  #undef ROT
}
constexpr int ATTN_LDS_BYTES=LDS_BYTES;
struct AttnTensors { const bf16* Q; const bf16* K; const bf16* V; bf16* O0; bf16* O1; };
struct AttnUnit { int vh; int qb; };
struct StaticOrder {
  int vcu, G;
  __device__ __forceinline__ explicit StaticOrder(int grid,int vcu_):vcu(vcu_),G(grid){}
  __device__ __forceinline__ bool next(int i,AttnUnit&u)const{
    if(G==256){ if(i>=4)return false; const int s=vcu&3; u.vh=vcu>>2; u.qb=(i==0)?s:(i==1)?7-s:(i==2)?8+s:15-s; return true; }
    const int L=i*G+vcu; if(L>=64*NQB)return false; u.vh=L&63; u.qb=NQB-1-(L>>6); return true; }
  __device__ __forceinline__ void a_ready(const AttnUnit&)const{}
  __device__ __forceinline__ void done(const AttnUnit&)const{}
};
template<class Sched,int THRL=8> __device__ __forceinline__ void attn_phase(char*lds,const AttnTensors&T,const Sched&S){
  AttnUnit u;
  for(int i=0;S.next(i,u);++i){ S.a_ready(u);
    const int b=u.vh>>5,h=(u.vh>>2)&7,c=(u.vh>>1)&1,half=u.vh&1;
    attn_unit<THRL>(b,h*128+c*64,h*128+half*64,u.qb,T.Q,T.K,T.V,c?T.O1:T.O0,lds); S.done(u); }
}
#undef SBAR
#undef WAIT_BAR
}

#define GAS __attribute__((address_space(1)))
#define LAS __attribute__((address_space(3)))
typedef unsigned short bf16;
typedef unsigned v4u __attribute__((ext_vector_type(4)));
typedef unsigned v2u __attribute__((ext_vector_type(2)));
typedef float f32x4 __attribute__((ext_vector_type(4)));
typedef short bf16x8 __attribute__((ext_vector_type(8)));
typedef GAS unsigned gu32;
typedef GAS unsigned long long gu64;
#define RLX_AGENT __ATOMIC_RELAXED, __HIP_MEMORY_SCOPE_AGENT
#define LDS_WAIT() asm volatile("s_waitcnt lgkmcnt(0)" ::: "memory")
#define VM_WAIT() asm volatile("s_waitcnt vmcnt(0)" ::: "memory")
__device__ __forceinline__ unsigned long long rt() { return __builtin_amdgcn_s_memrealtime(); }
__device__ __forceinline__ unsigned f2bf(float f) { unsigned u = __builtin_bit_cast(unsigned, f); return (u + 0x7fffu + ((u >> 16) & 1u)) >> 16; }
typedef float f32x2_hw __attribute__((ext_vector_type(2))); typedef __bf16 bf16x2_hw __attribute__((ext_vector_type(2)));
__device__ __forceinline__ unsigned pk2(float lo, float hi) { const f32x2_hw v = {lo, hi}; return __builtin_bit_cast(unsigned, __builtin_convertvector(v, bf16x2_hw)); }

#define XB_TMO      128
#define XB_XCNT(j)  (256  + 64 * (j))
#define XB_XSUB(j)  (1280 + 64 * (j))
#define XB_XGEN(j)  (2304 + 64 * (j))
#define XB_TOP      3328
#define XB_TOPGEN   3392
#define XCD_BAR_WORDS 3456
#define XB_SPIN_CAP (1u << 18)

__device__ __forceinline__ unsigned xb_ld(unsigned* p)              { return __hip_atomic_load(p, __ATOMIC_RELAXED, __HIP_MEMORY_SCOPE_AGENT); }
__device__ __forceinline__ unsigned xb_add(unsigned* p, unsigned v) { return __hip_atomic_fetch_add(p, v, __ATOMIC_RELAXED, __HIP_MEMORY_SCOPE_AGENT); }
__device__ __forceinline__ unsigned xb_xcc_id() { return (unsigned)__builtin_amdgcn_s_getreg((3 << 11) | 20) & 0xFu; }
#define XB_SPIN(cond, bar) do { unsigned _sp = 0; while (cond) { __builtin_amdgcn_s_sleep(1); \
    if ((++_sp & 255u) == 0u) { if (xb_ld(&(bar)[XB_TMO])) break; if (_sp > XB_SPIN_CAP) { atomicAdd(&(bar)[XB_TMO], 1u); break; } } } } while (0)

struct XcdBarrier {
    unsigned* bar; unsigned x;
    volatile LAS unsigned* st;
};

__device__ __forceinline__ XcdBarrier xcd_barrier_post(unsigned* bar, volatile LAS unsigned* st) {
    XcdBarrier b; b.bar = bar; b.x = xb_xcc_id(); b.st = st;
    if (threadIdx.x == 0) (void)xb_add(&bar[XB_XCNT(b.x)], 1u);
    return b;
}
__device__ __forceinline__ void xcd_barrier_complete(unsigned* bar, unsigned x, unsigned& nloc, unsigned& nx) {
    const unsigned G = gridDim.x * gridDim.y * gridDim.z;
    unsigned sum, cnt, mine, sp = 0u;
    for (;;) {
        sum = 0u; cnt = 0u; mine = 0u;
#pragma unroll
        for (unsigned j = 0; j < 16; ++j) { const unsigned c = xb_ld(&bar[XB_XCNT(j)]); sum += c; cnt += (c > 0u) ? 1u : 0u; mine = (j == x) ? c : mine; }
        if (sum == G) break;
        __builtin_amdgcn_s_sleep(1);
        if ((++sp & 255u) == 0u) { if (xb_ld(&bar[XB_TMO])) break; if (sp > XB_SPIN_CAP) { atomicAdd(&bar[XB_TMO], 1u); break; } }
    }
    nloc = mine > 0u ? mine : 1u; nx = cnt > 0u ? cnt : 1u;
}

__device__ __forceinline__ void xcd_barrier(const XcdBarrier& b) {
    asm volatile("s_waitcnt vmcnt(0)" ::: "memory");
    __syncthreads();
    if (threadIdx.x == 0) {
        unsigned* bar = b.bar;
        __builtin_amdgcn_s_waitcnt(0);
        unsigned nloc = b.st[0], nx = b.st[1];
        if (nloc == 0u) { xcd_barrier_complete(bar, b.x, nloc, nx); b.st[0] = nloc; b.st[1] = nx; }
        const unsigned old = xb_add(&bar[XB_XSUB(b.x)], 1u);
        const unsigned gen = old / nloc;
        if (old + 1u == (gen + 1u) * nloc) {
            __builtin_amdgcn_fence(__ATOMIC_RELEASE, "agent");
            asm volatile("s_waitcnt vmcnt(0)" ::: "memory");
            const unsigned og = xb_add(&bar[XB_TOP], 1u);
            const unsigned tg = og / nx;
            if (og + 1u == (tg + 1u) * nx) xb_add(&bar[XB_TOPGEN], 1u);
            else XB_SPIN(xb_ld(&bar[XB_TOPGEN]) == tg, bar);
            __builtin_amdgcn_fence(__ATOMIC_ACQUIRE, "agent");
            xb_add(&bar[XB_XGEN(b.x)], 1u);
            asm volatile("s_waitcnt vmcnt(0)" ::: "memory");
        } else {
            XB_SPIN(xb_ld(&bar[XB_XGEN(b.x)]) == gen, bar);
            __builtin_amdgcn_fence(__ATOMIC_ACQUIRE, "agent");
            asm volatile("s_waitcnt vmcnt(0)" ::: "memory");
        }
    }
    __syncthreads();
}

constexpr int NWAVES = 8, NTHR = 512;
constexpr int BATCH = 2, SEQ = 4096, DM = 2048, M = BATCH * SEQ;
constexpr int ATT_W = 1024, RW_W = 1024, RW_COLS = 3328, GATE_COLS = 4096, IN_COLS = 10496;
constexpr int NEXP = 64, EFF = 1024, CAP = 8192;
constexpr float NORM_EPS = 1e-6f, SUBLN_EPS = 1e-5f, LNX_EPS = 64e-5f;
constexpr float LAMBDA_INIT = 0.2f;
#ifndef RWKV_SEQ
#define RWKV_SEQ 0
#endif
#ifndef MK_ONE_LAUNCH
#define MK_ONE_LAUNCH 1
#endif
constexpr int NPHASE = 14;

constexpr size_t MiB = 1u << 20;
constexpr size_t WS_CTL = 0, CTL_ZERO_BYTES = 1 * MiB;
constexpr size_t WS_ADA = 1 * MiB;
constexpr size_t WS_ROPE = 1 * MiB + 512 * 1024;
constexpr size_t WS_W2T = 2 * MiB;
constexpr size_t WS_A2T = 2 * MiB + 128 * 1024;
constexpr size_t WS_G2T = 2 * MiB + 256 * 1024;
constexpr size_t WS_TOKE = 3 * MiB;
constexpr size_t WS_TOKP = 3 * MiB + 64 * 1024;
constexpr size_t WS_TOKW = 3 * MiB + 128 * 1024;
constexpr size_t WS_LIST = 4 * MiB;
constexpr size_t WS_WRH = 6 * MiB, WS_WRL = 7 * MiB;
constexpr size_t WS_WIN_T = 8 * MiB;
constexpr size_t WS_WUPA_T = 50 * MiB, WS_WUPB_T = 54 * MiB, WS_WOUT_T = 58 * MiB;
constexpr size_t WS_U = 68 * MiB;
constexpr size_t WS_Q = 100 * MiB, WS_K = 116 * MiB, WS_V = 132 * MiB;
constexpr size_t WS_PR = 148 * MiB;
constexpr size_t WS_G = 200 * MiB;
constexpr size_t WS_O0 = 264 * MiB, WS_O1 = 280 * MiB;
constexpr size_t WS_YATT = 296 * MiB, WS_YRW = 312 * MiB;
constexpr size_t WS_MERGED = 392 * MiB;
constexpr size_t WS_H1 = 424 * MiB;
constexpr size_t WS_U2 = 328 * MiB;
constexpr size_t WS_ACT = 520 * MiB;
constexpr int U2P = 2048 + 64, ACTP = 1024 + 64;
constexpr size_t WS_YS = 560 * MiB;
constexpr size_t WS_RW = 632 * MiB;
constexpr size_t RW_ARR = 32 * MiB;
constexpr size_t WS_END = WS_RW + 9 * RW_ARR;
constexpr int CW_TMO = 0, CW_CODE = 1, CW_BAR = 4096, CW_CNT = 8192, CW_P3Q = 8192 + 128;

constexpr int RING_OFF = 0, RING_BYTES = 159744;
constexpr int LDSCTL_OFF = RING_BYTES, MISC_OFF = LDSCTL_OFF + 320;
constexpr int LDS_BYTES = 163840;

__device__ __forceinline__ float bf2f(unsigned short h) { return __builtin_bit_cast(float, (unsigned)h << 16); }
__device__ __forceinline__ float bflo(unsigned w) { return __builtin_bit_cast(float, w << 16); }
__device__ __forceinline__ float bfhi(unsigned w) { return __builtin_bit_cast(float, w & 0xffff0000u); }
__device__ __forceinline__ float wave_sum(float v) {
#pragma unroll
    for (int o = 1; o < 64; o <<= 1) v += __shfl_xor(v, o);
    return v;
}
template <int CTRL> __device__ __forceinline__ float dpp_f(float x) { return __builtin_bit_cast(float, __builtin_amdgcn_update_dpp(0, __builtin_bit_cast(int, x), CTRL, 0xF, 0xF, true)); }
__device__ __forceinline__ float sum8(float x) {
    x += dpp_f<0xB1>(x); x += dpp_f<0x4E>(x); x += dpp_f<0x141>(x); return x; }
__device__ __forceinline__ float sum4(float x) { x += dpp_f<0xB1>(x); x += dpp_f<0x4E>(x); return x; }
__device__ __forceinline__ float sigmoidf_(float x) { return 1.f / (1.f + __expf(-x)); }

struct Frame {
    LAS unsigned char* lds;
    volatile LAS unsigned* MISC;
    gu32* ctl;
    int tid, lane, wave, vcu, G, probe;
    unsigned char* ws;
};

namespace pg8 {
constexpr float QSCALE = 0.125f * 1.4426950408889634f;
struct EpiIn {
    static constexpr bool PERM = true, AFTER_DRAIN = false;
    unsigned char* ws; const float* rope; int pn_off;
    __device__ __forceinline__ void operator()(const f32x4 (&acc)[2][2][4][2], const Unit& u, int wr, int wc, int fr, int fq) const {
        const int row0 = u.pm * BM + wr * 64 + fr, pn = u.pn + pn_off, cw = wc * 32 + 8 * fq;
        if (pn < 8) {
            const int isk = pn >= 4 ? 1 : 0;
            bf16_t* base = (bf16_t*)(ws + WS_Q + (size_t)isk * (WS_K - WS_Q)); const float sc = isk ? 1.f : QSCALE; const int colt = (pn & 3) * 256 + cw;
            const bool ropew = ((wc & 1) == 0);
#pragma unroll
            for (int ai = 0; ai < 2; ++ai)
#pragma unroll
                for (int m = 0; m < 4; ++m) { const int row = row0 + ai * HALF + m * 16; bf16_t* rowp = base + (size_t)row * 1024 + colt;
                    f32x4 c0 = {1.f, 1.f, 1.f, 1.f}, c1 = c0, s0 = {0.f, 0.f, 0.f, 0.f}, s1 = s0;
                    if (ropew) { const f32x4* rp = (const f32x4*)(rope + (size_t)row * 16); c0 = rp[0]; c1 = rp[1]; s0 = rp[2]; s1 = rp[3]; }
#pragma unroll
                    for (int bj = 0; bj < 2; ++bj) { f32x4 v0 = acc[ai][bj][m][0], v1 = acc[ai][bj][m][1];
                        if (ropew) { f32x4 p0, p1;
                            p0[0] = __shfl_xor(v0[0], 16); p0[1] = __shfl_xor(v0[1], 16); p0[2] = __shfl_xor(v0[2], 16); p0[3] = __shfl_xor(v0[3], 16);
                            p1[0] = __shfl_xor(v1[0], 16); p1[1] = __shfl_xor(v1[1], 16); p1[2] = __shfl_xor(v1[2], 16); p1[3] = __shfl_xor(v1[3], 16);
                            if (fq == 0) { v0 = v0 * c0 - p0 * s0; v1 = v1 * c1 - p1 * s1; }
                            else if (fq == 1) { v0 = p0 * s0 + v0 * c0; v1 = p1 * s1 + v1 * c1; } }
                        v0 = v0 * sc; v1 = v1 * sc; u32x4 w; w.x = cvt_pk_bf16(v0[0], v0[1]); w.y = cvt_pk_bf16(v0[2], v0[3]); w.z = cvt_pk_bf16(v1[0], v1[1]); w.w = cvt_pk_bf16(v1[2], v1[3]);
                        *(u32x4*)(rowp + bj * HALF) = w; } }
        } else {
            const int c1 = pn >= 12 ? 1 : 0, c2 = pn >= 25 ? 1 : 0;
            bf16_t* base = (bf16_t*)(ws + WS_V + (size_t)c1 * (WS_PR - WS_V) + (size_t)c2 * (WS_G - WS_PR));
            const int ldc = 1024 + c1 * (RW_COLS - 1024) + c2 * (GATE_COLS - RW_COLS);
            const int colt = (pn - 8 - 4 * c1 - 13 * c2) * 256 + cw;
            const bool sg = pn >= 25;
#pragma unroll
            for (int ai = 0; ai < 2; ++ai)
#pragma unroll
                for (int m = 0; m < 4; ++m) { bf16_t* rowp = base + (size_t)(row0 + ai * HALF + m * 16) * ldc + colt;
#pragma unroll
                    for (int bj = 0; bj < 2; ++bj) { f32x4 v0 = acc[ai][bj][m][0], v1 = acc[ai][bj][m][1];
                        if (sg) { v0[0] = sigmoidf_(v0[0]); v0[1] = sigmoidf_(v0[1]); v0[2] = sigmoidf_(v0[2]); v0[3] = sigmoidf_(v0[3]);
                                  v1[0] = sigmoidf_(v1[0]); v1[1] = sigmoidf_(v1[1]); v1[2] = sigmoidf_(v1[2]); v1[3] = sigmoidf_(v1[3]); }
                        u32x4 w; w.x = cvt_pk_bf16(v0[0], v0[1]); w.y = cvt_pk_bf16(v0[2], v0[3]); w.z = cvt_pk_bf16(v1[0], v1[1]); w.w = cvt_pk_bf16(v1[2], v1[3]);
                        *(u32x4*)(rowp + bj * HALF) = w; } }
        }
    }
};
struct EpiT1 {
    static constexpr bool PERM = false, AFTER_DRAIN = false;
    float* T1; const bf16_t* G;
    __device__ __forceinline__ void operator()(const f32x4 (&acc)[2][2][4][2], const Unit& u, int wr, int wc, int fr, int fq) const {
        const int row0 = u.pm * BM + wr * 64 + fr, col0 = u.pn * BM + wc * 32 + 4 * fq;
#pragma unroll
        for (int ai = 0; ai < 2; ++ai)
#pragma unroll
            for (int m = 0; m < 4; ++m) { const size_t row = (size_t)(row0 + ai * HALF + m * 16);
#pragma unroll
                for (int bj = 0; bj < 2; ++bj)
#pragma unroll
                    for (int n = 0; n < 2; ++n) { const int c = col0 + bj * HALF + n * 16; const uint2 gw = *(const uint2*)(G + row * GATE_COLS + c);
                        f32x4 a = acc[ai][bj][m][n]; a[0] *= bflo(gw.x); a[1] *= bfhi(gw.x); a[2] *= bflo(gw.y); a[3] *= bfhi(gw.y);
                        *(f32x4*)(T1 + row * DM + c) = a; } }
    }
};
struct EpiMerge {
    static constexpr bool PERM = true, AFTER_DRAIN = false;
    const float* T1; const bf16_t* G; bf16_t* O;
    __device__ __forceinline__ void operator()(const f32x4 (&acc)[2][2][4][2], const Unit& u, int wr, int wc, int fr, int fq) const {
        const int row0 = u.pm * BM + wr * 64 + fr, col0 = u.pn * BM + wc * 32 + 8 * fq;
#pragma unroll
        for (int ai = 0; ai < 2; ++ai)
#pragma unroll
            for (int m = 0; m < 4; ++m) { const size_t row = (size_t)(row0 + ai * HALF + m * 16);
#pragma unroll
                for (int bj = 0; bj < 2; ++bj) { const int c = col0 + bj * HALF; const u32x4 gw = *(const u32x4*)(G + row * GATE_COLS + 2048 + c);
                    const f32x4 t0 = *(const f32x4*)(T1 + row * DM + c), t1 = *(const f32x4*)(T1 + row * DM + c + 4);
                    f32x4 v0 = acc[ai][bj][m][0], v1 = acc[ai][bj][m][1];
                    v0[0] = t0[0] + bflo(gw.x) * v0[0]; v0[1] = t0[1] + bfhi(gw.x) * v0[1]; v0[2] = t0[2] + bflo(gw.y) * v0[2]; v0[3] = t0[3] + bfhi(gw.y) * v0[3];
                    v1[0] = t1[0] + bflo(gw.z) * v1[0]; v1[1] = t1[1] + bfhi(gw.z) * v1[1]; v1[2] = t1[2] + bflo(gw.w) * v1[2]; v1[3] = t1[3] + bfhi(gw.w) * v1[3];
                    u32x4 w; w.x = cvt_pk_bf16(v0[0], v0[1]); w.y = cvt_pk_bf16(v0[2], v0[3]); w.z = cvt_pk_bf16(v1[0], v1[1]); w.w = cvt_pk_bf16(v1[2], v1[3]);
                    *(u32x4*)(O + row * DM + c) = w; } }
    }
};
struct EpiPair {
    static constexpr bool PERM = true, AFTER_DRAIN = false;
    const bf16_t* G; bf16_t* O;
    __device__ __forceinline__ void mid(f32x4 (&acc)[2][2][4][2], const Unit& u, int wr, int wc, int fr, int fq) const {
        const int row0 = u.pm * BM + wr * 64 + fr, col0 = u.pn * BM + wc * 32 + 8 * fq;
#pragma unroll
        for (int ai = 0; ai < 2; ++ai)
#pragma unroll
            for (int m = 0; m < 4; ++m) { const size_t row = (size_t)(row0 + ai * HALF + m * 16);
#pragma unroll
                for (int bj = 0; bj < 2; ++bj) { const int c = col0 + bj * HALF; const u32x4 ga = *(const u32x4*)(G + row * GATE_COLS + c), gr = *(const u32x4*)(G + row * GATE_COLS + 2048 + c);
                    f32x4 v0 = acc[ai][bj][m][0], v1 = acc[ai][bj][m][1];
                    v0[0] *= bflo(ga.x) / bflo(gr.x); v0[1] *= bfhi(ga.x) / bfhi(gr.x); v0[2] *= bflo(ga.y) / bflo(gr.y); v0[3] *= bfhi(ga.y) / bfhi(gr.y);
                    v1[0] *= bflo(ga.z) / bflo(gr.z); v1[1] *= bfhi(ga.z) / bfhi(gr.z); v1[2] *= bflo(ga.w) / bflo(gr.w); v1[3] *= bfhi(ga.w) / bfhi(gr.w);
                    acc[ai][bj][m][0] = v0; acc[ai][bj][m][1] = v1; } }
    }
    __device__ __forceinline__ void operator()(const f32x4 (&acc)[2][2][4][2], const Unit& u, int wr, int wc, int fr, int fq) const {
        const int row0 = u.pm * BM + wr * 64 + fr, col0 = u.pn * BM + wc * 32 + 8 * fq;
#pragma unroll
        for (int ai = 0; ai < 2; ++ai)
#pragma unroll
            for (int m = 0; m < 4; ++m) { const size_t row = (size_t)(row0 + ai * HALF + m * 16);
#pragma unroll
                for (int bj = 0; bj < 2; ++bj) { const int c = col0 + bj * HALF; const u32x4 gw = *(const u32x4*)(G + row * GATE_COLS + 2048 + c);
                    f32x4 v0 = acc[ai][bj][m][0], v1 = acc[ai][bj][m][1];
                    v0[0] *= bflo(gw.x); v0[1] *= bfhi(gw.x); v0[2] *= bflo(gw.y); v0[3] *= bfhi(gw.y); v1[0] *= bflo(gw.z); v1[1] *= bfhi(gw.z); v1[2] *= bflo(gw.w); v1[3] *= bfhi(gw.w);
                    u32x4 w; w.x = cvt_pk_bf16(v0[0], v0[1]); w.y = cvt_pk_bf16(v0[2], v0[3]); w.z = cvt_pk_bf16(v1[0], v1[1]); w.w = cvt_pk_bf16(v1[2], v1[3]);
                    *(u32x4*)(O + row * DM + c) = w; } }
    }
};
struct EpiH1 {
    static constexpr bool PERM = false, AFTER_DRAIN = false;
    const float* X; const float* ada; float* H1;
    __device__ __forceinline__ void operator()(const f32x4 (&acc)[2][2][4][2], const Unit& u, int wr, int wc, int fr, int fq) const {
        const int row0 = u.pm * BM + wr * 64 + fr, col0 = u.pn * BM + wc * 32 + 4 * fq;
        const float* gt = ada + (size_t)((u.pm * BM) / SEQ) * 12288 + 4096;
#pragma unroll
        for (int ai = 0; ai < 2; ++ai)
#pragma unroll
            for (int m = 0; m < 4; ++m) { const size_t row = (size_t)(row0 + ai * HALF + m * 16);
#pragma unroll
                for (int bj = 0; bj < 2; ++bj)
#pragma unroll
                    for (int n = 0; n < 2; ++n) { const int c = col0 + bj * HALF + n * 16;
                        const f32x4 xv = *(const f32x4*)(X + row * DM + c), g = *(const f32x4*)(gt + c);
                        *(f32x4*)(H1 + row * DM + c) = xv + g * acc[ai][bj][m][n]; } }
    }
};
}

__device__ __forceinline__ void p0_transpose_item(const float* W, int K, int N, bf16* WT, LAS float* scr, int item, int lane) {
    const int nblk = N / 32, kb = item / nblk, nb = item % nblk, k0 = 64 * kb, n0 = 32 * nb;
#pragma unroll 8
    for (int i = 0; i < 32; ++i) { const int kk = 2 * i + (lane >> 5); scr[kk * 33 + (lane & 31)] = W[(size_t)(k0 + kk) * N + n0 + (lane & 31)]; }
    LDS_WAIT(); asm volatile("" ::: "memory");
    const int c = lane & 7;
#pragma unroll
    for (int j = 0; j < 4; ++j) { const int n = (lane >> 3) + 8 * j; const LAS float* s = scr + (8 * c) * 33 + n;
        v4u o; o.x = pk2(s[0 * 33], s[1 * 33]); o.y = pk2(s[2 * 33], s[3 * 33]); o.z = pk2(s[4 * 33], s[5 * 33]); o.w = pk2(s[6 * 33], s[7 * 33]);
        *(GAS v4u*)(WT + (size_t)(n0 + n) * K + k0 + 8 * c) = o; }
    LDS_WAIT(); asm volatile("" ::: "memory");
}

__device__ __forceinline__ void p0_prologue(Frame& F, const float* const* in) {
    const float* c = in[1]; const int* pos = (const int*)in[2]; const float* ada_w = in[3]; const float* ada_b = in[4];
    float* ada = (float*)(F.ws + WS_ADA); float* rope = (float*)(F.ws + WS_ROPE);
    {
        LAS float* sc = (LAS float*)(F.lds);
        LAS float* red = (LAS float*)(F.lds + 16384);
        for (int i = F.tid; i < 2 * DM; i += NTHR) { const float v = c[i]; sc[i] = v / (1.f + __expf(-v)); }
        __syncthreads();
        const int rg = F.tid / 12, c4 = F.tid % 12;
        for (int cb = F.vcu; cb < 256; cb += F.G) {
            f32x4 a0 = {0.f, 0.f, 0.f, 0.f}, a1 = a0;
            if (rg < 42) {
                const float* wp = ada_w + (size_t)cb * 48 + c4 * 4;
#pragma unroll 7
                for (int k = rg; k < DM; k += 42) { const f32x4 w = *(const f32x4*)(wp + (size_t)k * 12288); a0 += w * sc[k]; a1 += w * sc[DM + k]; }
                LAS float* r = red + rg * 96 + c4 * 4;
                r[0] = a0[0]; r[1] = a0[1]; r[2] = a0[2]; r[3] = a0[3]; r[48] = a1[0]; r[49] = a1[1]; r[50] = a1[2]; r[51] = a1[3];
            }
            __syncthreads();
            if (F.tid < 96) { float s = 0.f; for (int g = 0; g < 42; ++g) s += red[g * 96 + F.tid];
                const int b = F.tid / 48, n = cb * 48 + F.tid % 48; ada[(size_t)b * 12288 + n] = s + ada_b[n]; }
            __syncthreads();
        }
    }
    {
        const int gt = F.vcu * NTHR + F.tid, NGT = F.G * NTHR;
        for (int idx = gt; idx < M * 8; idx += NGT) { const int m = idx >> 3, i = idx & 7;
            const double inv = (i == 0) ? 1.0 : (i == 1) ? 0.19392274474868576 : (i == 2) ? 0.03760603093086393 : (i == 3) ? 0.007292664737217109 : (i == 4) ? 0.001414213562373095
                             : (i == 5) ? 0.0002742481756762073 : (i == 6) ? 5.318295896944988e-05 : 1.031338537721246e-05;
            double a = (double)pos[m] * inv; const double k = __builtin_rint(a * 0.15915494309189535); a -= k * 6.283185307179586;
            const float af = (float)a; rope[(size_t)m * 16 + i] = cosf(af); rope[(size_t)m * 16 + 8 + i] = sinf(af); }
    }
    {
        const int gt = F.vcu * NTHR + F.tid, NGT = F.G * NTHR; bf16* WRH = (bf16*)(F.ws + WS_WRH); bf16* WRL = (bf16*)(F.ws + WS_WRL);
        for (int idx = gt; idx < 80 * DM; idx += NGT) { const int k = idx / 80, col = idx % 80;
            const float wv = col < 8 ? in[27][k * 8 + col] : col < 72 ? in[29][k * 64 + col - 8] : 0.f;
            const unsigned h = f2bf(wv); WRH[(size_t)col * DM + k] = (bf16)h; WRL[(size_t)col * DM + k] = (bf16)f2bf(wv - bf2f((unsigned short)h)); }
    }
    {
        LAS float* scr = (LAS float*)(F.lds + 49152 + F.wave * 8704);
        const int gw = F.vcu * NWAVES + F.wave, NGW = F.G * NWAVES;
        constexpr int I_IN = (DM / 64) * (IN_COLS / 32), I_UP = (1024 / 64) * (DM / 32), I_OUT = (DM / 64) * (DM / 32), I_LR = (64 / 64) * (1024 / 32), I_G2 = (128 / 64) * (1024 / 32);
        constexpr int NITEMS = I_IN + 2 * I_UP + I_OUT + 2 * I_LR + I_G2;
        for (int it = gw; it < NITEMS; it += NGW) {
            int r = it;
            if (r < I_IN) { p0_transpose_item(in[6], DM, IN_COLS, (bf16*)(F.ws + WS_WIN_T), scr, r, F.lane); continue; } r -= I_IN;
            if (r < I_UP) { p0_transpose_item(in[23], 1024, DM, (bf16*)(F.ws + WS_WUPA_T), scr, r, F.lane); continue; } r -= I_UP;
            if (r < I_UP) { p0_transpose_item(in[24], 1024, DM, (bf16*)(F.ws + WS_WUPB_T), scr, r, F.lane); continue; } r -= I_UP;
            if (r < I_OUT) { p0_transpose_item(in[25], DM, DM, (bf16*)(F.ws + WS_WOUT_T), scr, r, F.lane); continue; } r -= I_OUT;
            if (r < I_LR) { p0_transpose_item(in[14], 64, 1024, (bf16*)(F.ws + WS_W2T), scr, r, F.lane); continue; } r -= I_LR;
            if (r < I_LR) { p0_transpose_item(in[16], 64, 1024, (bf16*)(F.ws + WS_A2T), scr, r, F.lane); continue; } r -= I_LR;
            p0_transpose_item(in[17], 128, 1024, (bf16*)(F.ws + WS_G2T), scr, r, F.lane);
        }
    }
}

__device__ __forceinline__ void norm_mod_row(const float* xrow, const float* g, const float* sc, const float* sh, bf16* orow, int lane, f32x4 (&v)[8]) {
    const GAS f32x4* xr = (const GAS f32x4*)xrow + lane; float s2 = 0.f;
#pragma unroll
    for (int j = 0; j < 8; ++j) { v[j] = xr[64 * j]; s2 += (v[j].x * v[j].x + v[j].y * v[j].y) + (v[j].z * v[j].z + v[j].w * v[j].w); }
    const float rstd = 1.f / sqrtf(wave_sum(s2) * (1.f / DM) + NORM_EPS);
    GAS unsigned long long* o8 = (GAS unsigned long long*)orow + lane;
#pragma unroll
    for (int j = 0; j < 8; ++j) { const int i4 = lane + 64 * j; const f32x4 gg = ((const f32x4*)g)[i4], cc = ((const f32x4*)sc)[i4], hh = ((const f32x4*)sh)[i4];
        v[j] = (v[j] * rstd) * gg * (cc + 1.f) + hh;
        o8[64 * j] = (unsigned long long)pk2(v[j].x, v[j].y) | ((unsigned long long)pk2(v[j].z, v[j].w) << 32); }
}

__device__ __forceinline__ void norm_mod_row2v(const float* x0, const float* x1, const float* g, const float* sc0, const float* sh0, const float* sc1, const float* sh1, bf16* o0, bf16* o1, int lane, f32x4 (&va)[8], f32x4 (&vb)[8]) {
    const GAS f32x4* xa = (const GAS f32x4*)x0 + lane; const GAS f32x4* xb = (const GAS f32x4*)x1 + lane; float sa = 0.f, sb = 0.f;
#pragma unroll
    for (int j = 0; j < 8; ++j) { va[j] = xa[64 * j]; vb[j] = xb[64 * j]; }
#pragma unroll
    for (int j = 0; j < 8; ++j) { sa += (va[j].x * va[j].x + va[j].y * va[j].y) + (va[j].z * va[j].z + va[j].w * va[j].w); sb += (vb[j].x * vb[j].x + vb[j].y * vb[j].y) + (vb[j].z * vb[j].z + vb[j].w * vb[j].w); }
    const float ra = 1.f / sqrtf(wave_sum(sa) * (1.f / DM) + NORM_EPS), rb = 1.f / sqrtf(wave_sum(sb) * (1.f / DM) + NORM_EPS);
    GAS unsigned long long* pa = (GAS unsigned long long*)o0 + lane; GAS unsigned long long* pb = (GAS unsigned long long*)o1 + lane;
#pragma unroll
    for (int j = 0; j < 8; ++j) { const int i4 = lane + 64 * j; const f32x4 gg = ((const f32x4*)g)[i4];
        const f32x4 ya = (va[j] * ra) * gg * (((const f32x4*)sc0)[i4] + 1.f) + ((const f32x4*)sh0)[i4], yb = (vb[j] * rb) * gg * (((const f32x4*)sc1)[i4] + 1.f) + ((const f32x4*)sh1)[i4];
        va[j] = ya; vb[j] = yb;
        pa[64 * j] = (unsigned long long)pk2(ya.x, ya.y) | ((unsigned long long)pk2(ya.z, ya.w) << 32); pb[64 * j] = (unsigned long long)pk2(yb.x, yb.y) | ((unsigned long long)pk2(yb.z, yb.w) << 32); }
}
__device__ __forceinline__ void norm_mod_row2(const float* x0, const float* x1, const float* g, const float* sc0, const float* sh0, const float* sc1, const float* sh1, bf16* o0, bf16* o1, int lane) {
    f32x4 va[8], vb[8]; norm_mod_row2v(x0, x1, g, sc0, sh0, sc1, sh1, o0, o1, lane, va, vb); }

constexpr int RWA_PITCH = 72, RWG_PITCH = 136, RWZ_PITCH = 68;
constexpr int RW_TW = 0, RW_AL = RW_TW + 64 * RWA_PITCH * 2, RW_GS = RW_AL + 64 * RWA_PITCH * 2, RW_Z1 = RW_GS + 64 * RWG_PITCH * 2,
              RW_Z2 = RW_Z1 + 64 * RWZ_PITCH * 4, RW_Z3 = RW_Z2 + 64 * RWZ_PITCH * 4, RW_LDS_END = RW_Z3 + 64 * RWZ_PITCH * 4;
static_assert(RW_LDS_END <= RING_BYTES, "rwkv prep LDS");
__device__ __forceinline__ void shift8(const bf16* cur, const bf16* prv, bool hasprev, const float* mu, float (&o)[8]) {
    const v4u c = *(const v4u*)cur; v4u p = {0u, 0u, 0u, 0u}; if (hasprev) p = *(const v4u*)prv;
    const f32x4 m0 = ((const f32x4*)mu)[0], m1 = ((const f32x4*)mu)[1];
    float cv[8] = {bflo(c.x), bfhi(c.x), bflo(c.y), bfhi(c.y), bflo(c.z), bfhi(c.z), bflo(c.w), bfhi(c.w)};
    float pv[8] = {bflo(p.x), bfhi(p.x), bflo(p.y), bfhi(p.y), bflo(p.z), bfhi(p.z), bflo(p.w), bfhi(p.w)};
    float mv[8] = {m0[0], m0[1], m0[2], m0[3], m1[0], m1[1], m1[2], m1[3]};
#pragma unroll
    for (int e = 0; e < 8; ++e) o[e] = cv[e] + (pv[e] - cv[e]) * mv[e];
}
__device__ __forceinline__ v4u pack8(const float (&x)[8]) { v4u o; o.x = pk2(x[0], x[1]); o.y = pk2(x[2], x[3]); o.z = pk2(x[4], x[5]); o.w = pk2(x[6], x[7]); return o; }
__device__ __forceinline__ void store8(float* p, const float (&x)[8]) { ((f32x4*)p)[0] = (f32x4){x[0], x[1], x[2], x[3]}; ((f32x4*)p)[1] = (f32x4){x[4], x[5], x[6], x[7]}; }

__device__ __forceinline__ void p3_rwkv_prep(Frame& F, const float* const* in) {
    const bf16* PR = (const bf16*)(F.ws + WS_PR);
    const float* mu = in[7]; const float* w0 = in[13]; const float* a0 = in[15]; const float* k_k = in[18]; const float* k_a = in[19]; const float* r_k = in[20];
    const bf16* w2t = (const bf16*)(F.ws + WS_W2T); const bf16* a2t = (const bf16*)(F.ws + WS_A2T); const bf16* g2t = (const bf16*)(F.ws + WS_G2T);
    float* RWb = (float*)(F.ws + WS_RW); constexpr size_t AS = RW_ARR / 4;
    float *oR = RWb, *oW = RWb + AS, *oK = RWb + 2 * AS, *oV = RWb + 3 * AS, *oA = RWb + 4 * AS, *oB = RWb + 5 * AS, *oG = RWb + 6 * AS, *oBo = RWb + 7 * AS;
    LAS unsigned char* L = F.lds;
    const int tt = F.tid >> 3, sub = F.tid & 7, fr = F.lane & 15, fq = F.lane >> 4;
    for (int u = F.vcu; u < 2048; u += F.G) {
        const int h = u & 15, ch = (u >> 4) & 63, b = u >> 10, s = ch * 64 + tt; const size_t m = (size_t)b * SEQ + s; const bool hp = s > 0;
        const bf16* cur = PR + m * RW_COLS; const bf16* prv = cur - RW_COLS;
        float r8[8], k8[8], v8[8], t8[8];
        shift8(cur + h * 64 + sub * 8, prv + h * 64 + sub * 8, hp, mu + h * 64 + sub * 8, r8);
        shift8(cur + 1024 + h * 64 + sub * 8, prv + 1024 + h * 64 + sub * 8, hp, mu + 1024 + h * 64 + sub * 8, k8);
        shift8(cur + 2048 + h * 64 + sub * 8, prv + 2048 + h * 64 + sub * 8, hp, mu + 2048 + h * 64 + sub * 8, v8);
        shift8(cur + 3072 + sub * 8, prv + 3072 + sub * 8, hp, mu + 3072 + sub * 8, t8);
#pragma unroll
        for (int e = 0; e < 8; ++e) t8[e] = tanhf(t8[e]);
        *(LAS v4u*)(L + RW_TW + (tt * RWA_PITCH + sub * 8) * 2) = pack8(t8);
        shift8(cur + 3136 + sub * 8, prv + 3136 + sub * 8, hp, mu + 3136 + sub * 8, t8);
        *(LAS v4u*)(L + RW_AL + (tt * RWA_PITCH + sub * 8) * 2) = pack8(t8);
#pragma unroll
        for (int hlf = 0; hlf < 2; ++hlf) { shift8(cur + 3200 + sub * 16 + hlf * 8, prv + 3200 + sub * 16 + hlf * 8, hp, mu + 3200 + sub * 16 + hlf * 8, t8);
#pragma unroll
            for (int e = 0; e < 8; ++e) t8[e] = sigmoidf_(t8[e]);
            *(LAS v4u*)(L + RW_GS + (tt * RWG_PITCH + sub * 16 + hlf * 8) * 2) = pack8(t8); }
        __syncthreads();
#pragma unroll 1
        for (int job = F.wave; job < 48; job += NWAVES) { const int mat = job >> 4, ti = (job >> 2) & 3, tj = job & 3;
            const int aoff = mat == 0 ? RW_TW : mat == 1 ? RW_AL : RW_GS, ap = mat == 2 ? RWG_PITCH : RWA_PITCH, kd = mat == 2 ? 128 : 64;
            const bf16* wt = (mat == 0 ? w2t : mat == 1 ? a2t : g2t) + (size_t)(h * 64 + tj * 16 + fr) * kd + fq * 8;
            f32x4 acc = {0.f, 0.f, 0.f, 0.f};
            for (int ks = 0; ks < kd / 32; ++ks) { const bf16x8 a = *(const LAS bf16x8*)(L + aoff + ((ti * 16 + fr) * ap + ks * 32 + fq * 8) * 2); const bf16x8 bb = *(const bf16x8*)(wt + ks * 32);
                acc = __builtin_amdgcn_mfma_f32_16x16x32_bf16(a, bb, acc, 0, 0, 0); }
            LAS float* z = (LAS float*)(L + (mat == 0 ? RW_Z1 : mat == 1 ? RW_Z2 : RW_Z3));
#pragma unroll
            for (int e = 0; e < 4; ++e) z[(ti * 16 + fq * 4 + e) * RWZ_PITCH + tj * 16 + fr] = acc[e]; }
        __syncthreads();
        {
            const int c0 = h * 64 + sub * 8; const LAS float* z1 = (const LAS float*)(L + RW_Z1) + tt * RWZ_PITCH + sub * 8; const LAS float* z2 = (const LAS float*)(L + RW_Z2) + tt * RWZ_PITCH + sub * 8;
            const LAS float* z3 = (const LAS float*)(L + RW_Z3) + tt * RWZ_PITCH + sub * 8;
            float dec[8], av[8], gv[8], kkv[8], km[8], bo[8], ss = 0.f, bs = 0.f;
#pragma unroll
            for (int e = 0; e < 8; ++e) { const float z = w0[c0 + e] + z1[e]; const float sp = fmaxf(-z, 0.f) + log1pf(__expf(-fabsf(z)));
                const float wl = -sp - 0.5f; dec[e] = __expf(-__expf(wl)); av[e] = sigmoidf_(a0[c0 + e] + z2[e]); gv[e] = z3[e];
                kkv[e] = k8[e] * k_k[c0 + e]; ss += kkv[e] * kkv[e]; km[e] = k8[e] * (1.f + (av[e] - 1.f) * k_a[c0 + e]); bs += r8[e] * km[e] * r_k[c0 + e]; }
            ss = sum8(ss); bs = sum8(bs); const float rn = 1.f / sqrtf(fmaxf(ss, 1e-24f));
            float na[8], nb[8];
#pragma unroll
            for (int e = 0; e < 8; ++e) { const float kk = kkv[e] * rn; na[e] = -kk; nb[e] = kk * av[e]; bo[e] = bs * v8[e]; }
            const size_t o = m * RW_W + c0;
            store8(oR + o, r8); store8(oW + o, dec); store8(oK + o, km); store8(oV + o, v8); store8(oA + o, na); store8(oB + o, nb); store8(oG + o, gv); store8(oBo + o, bo);
        }
        __syncthreads();
    }
}

__device__ __forceinline__ void p4_rwkv_scan(Frame& F) {
    float* RWb = (float*)(F.ws + WS_RW); constexpr size_t AS = RW_ARR / 4;
    const float *iR = RWb, *iW = RWb + AS, *iK = RWb + 2 * AS, *iV = RWb + 3 * AS, *iA = RWb + 4 * AS, *iB = RWb + 5 * AS; float* oY = RWb + 8 * AS;
    constexpr int TB = 16;
    LAS float* S = (LAS float*)F.lds;
    const int vr = F.tid >> 3, ks = F.tid & 7;
    for (int bh = blockIdx.x; bh < BATCH * 16; bh += F.G) {
        const int b = bh >> 4, h = bh & 15; const size_t base = (size_t)b * SEQ * RW_W + h * 64;
        float st[8];
#pragma unroll
        for (int e = 0; e < 8; ++e) st[e] = 0.f;
        f32x4 stg[3];
        auto gload = [&](int blk) {
#pragma unroll
            for (int i = 0; i < 3; ++i) { const int q = F.tid + i * NTHR, arr = q >> 8, rem = q & 255, t = rem >> 4, c4 = rem & 15;
                const float* src = (arr == 0 ? iR : arr == 1 ? iW : arr == 2 ? iK : arr == 3 ? iV : arr == 4 ? iA : iB) + base + (size_t)(blk * TB + t) * RW_W + c4 * 4;
                stg[i] = *(const f32x4*)src; } };
        auto lstore = [&](int buf) {
#pragma unroll
            for (int i = 0; i < 3; ++i) { const int q = F.tid + i * NTHR; *(LAS f32x4*)(S + buf * (6 * TB * 64) + q * 4) = stg[i]; } };
        gload(0);
        for (int blk = 0; blk < SEQ / TB; ++blk) {
            const int buf = blk & 1;
            lstore(buf);
            if (blk + 1 < SEQ / TB) gload(blk + 1);
            __syncthreads();
            const LAS float* sb = S + buf * (6 * TB * 64);
#pragma unroll 4
            for (int t = 0; t < TB; ++t) {
                const LAS float* p = sb + t * 64 + ks * 8;
                const f32x4 r0 = *(const LAS f32x4*)(p), r1 = *(const LAS f32x4*)(p + 4);
                const f32x4 w0 = *(const LAS f32x4*)(p + TB * 64), w1 = *(const LAS f32x4*)(p + TB * 64 + 4);
                const f32x4 k0 = *(const LAS f32x4*)(p + 2 * TB * 64), k1 = *(const LAS f32x4*)(p + 2 * TB * 64 + 4);
                const float vv = sb[3 * TB * 64 + t * 64 + vr];
                const f32x4 a0 = *(const LAS f32x4*)(p + 4 * TB * 64), a1 = *(const LAS f32x4*)(p + 4 * TB * 64 + 4);
                const f32x4 b0 = *(const LAS f32x4*)(p + 5 * TB * 64), b1 = *(const LAS f32x4*)(p + 5 * TB * 64 + 4);
                float sa = 0.f;
#pragma unroll
                for (int e = 0; e < 4; ++e) { sa += st[e] * a0[e]; sa += st[4 + e] * a1[e]; }
                sa = sum8(sa);
                float y = 0.f;
#pragma unroll
                for (int e = 0; e < 4; ++e) { st[e] = st[e] * w0[e] + sa * b0[e] + vv * k0[e]; st[4 + e] = st[4 + e] * w1[e] + sa * b1[e] + vv * k1[e]; y += st[e] * r0[e]; y += st[4 + e] * r1[e]; }
                y = sum8(y);
                if (ks == 0) oY[base + (size_t)(blk * TB + t) * RW_W + vr] = y;
            }
        }
        __syncthreads();
    }
}


constexpr int RP = 72, SLOTB = 64 * RP * 2;
constexpr int H_AH = 0, H_AHT = 1, H_BH = 2, H_KH = 3, H_RH = 4, H_VT = 5, H_BTT = 6, H_KTT = 7, S_0 = 8, S_1 = 9, S_2 = 10, S_3 = 11, S_4 = 12, S_5 = 13;
constexpr int RC_LW = RW_LDS_END, RC_SEG = RC_LW + 64 * 65 * 4, RC_STAGE0_END = RC_SEG + 8 * 64 * 4;
constexpr int RC_PC = 14 * SLOTB;
static_assert(RC_STAGE0_END <= RING_BYTES && RC_PC + 256 <= RING_BYTES && 8 * SLOTB <= RC_LW, "rwkv chunk LDS map");
constexpr size_t WS_CRT = WS_RW, WS_CMM = WS_RW + 16 * MiB, WS_CY0 = WS_RW + 32 * MiB, WS_CN0 = WS_RW + 64 * MiB;

__device__ __forceinline__ f32x4 tmm(const LAS unsigned char* L, int Xs, int Ys, int tx, int ty, f32x4 acc, int fr, int fq) {
#pragma unroll
    for (int ks = 0; ks < 2; ++ks) { const bf16x8 a = *(const LAS bf16x8*)(L + Xs + ((tx * 16 + fr) * RP + ks * 32 + fq * 8) * 2); const bf16x8 b = *(const LAS bf16x8*)(L + Ys + ((ty * 16 + fr) * RP + ks * 32 + fq * 8) * 2);
        acc = __builtin_amdgcn_mfma_f32_16x16x32_bf16(a, b, acc, 0, 0, 0); }
    return acc;
}
__device__ __forceinline__ void st_rowY(LAS unsigned char* L, int dst, f32x4 v, int tx, int ty, int fr, int fq) {
    v2u w; w.x = pk2(v[0], v[1]); w.y = pk2(v[2], v[3]); *(LAS v2u*)(L + dst + ((ty * 16 + fr) * RP + tx * 16 + fq * 4) * 2) = w; }
__device__ __forceinline__ void st_rowX(LAS unsigned char* L, int dst, f32x4 v, int tx, int ty, int fr, int fq) {
#pragma unroll
    for (int e = 0; e < 4; ++e) *(LAS unsigned short*)(L + dst + ((tx * 16 + fq * 4 + e) * RP + ty * 16 + fr) * 2) = (unsigned short)f2bf(v[e]); }
__device__ __forceinline__ f32x4 ld_rowY(const LAS unsigned char* L, int src, int tx, int ty, int fr, int fq) {
    const v2u w = *(const LAS v2u*)(L + src + ((ty * 16 + fr) * RP + tx * 16 + fq * 4) * 2); return (f32x4){bflo(w.x), bfhi(w.x), bflo(w.y), bfhi(w.y)}; }
__device__ __forceinline__ void inv_iter(LAS unsigned char* L, int wave, int fr, int fq, int PA, int PT, int PnA, int PnT, int Tp, int Tn, bool doP, bool doPA, bool doT) {
#pragma unroll
    for (int i = 0; i < 4; ++i) { const int which = i >> 1, tl = wave + 8 * (i & 1), ty = tl >> 2, tx = tl & 3;
        if (which == 0) { if (!doP) continue;
            f32x4 acc = {0.f, 0.f, 0.f, 0.f}; acc = tmm(L, PT, PA, tx, ty, acc, fr, fq);
            if (doPA) st_rowY(L, PnA, acc, tx, ty, fr, fq); st_rowX(L, PnT, acc, tx, ty, fr, fq);
        } else { if (!doT) continue;
            f32x4 acc = ld_rowY(L, Tp, tx, ty, fr, fq); acc = tmm(L, PT, Tp, tx, ty, acc, fr, fq);
            st_rowY(L, Tn, acc, tx, ty, fr, fq); }
    }
}

__device__ __forceinline__ void p3_rwkv_chunk(Frame& F, const float* const* in) {
    const bf16* PR = (const bf16*)(F.ws + WS_PR);
    const float* mu = in[7]; const float* w0 = in[13]; const float* a0 = in[15]; const float* k_k = in[18]; const float* k_a = in[19]; const float* r_k = in[20];
    const bf16* w2t = (const bf16*)(F.ws + WS_W2T); const bf16* a2t = (const bf16*)(F.ws + WS_A2T); const bf16* g2t = (const bf16*)(F.ws + WS_G2T);
    float* RWb = (float*)(F.ws + WS_RW); constexpr size_t AS = RW_ARR / 4; float *oG = RWb + 6 * AS, *oBo = RWb + 7 * AS;
    LAS unsigned char* L = F.lds;
    int tt = F.tid >> 3, sub = F.tid & 7, fr = F.lane & 15, fq = F.lane >> 4, lane = F.lane;
#define P3_OPAQUE() asm volatile("" : "+v"(tt), "+v"(sub), "+v"(fr), "+v"(fq), "+v"(lane))
    v4u pc[7], pp[7];
#define P3_COLS(h_, g_) ((g_) < 3 ? (g_) * 1024 + (h_) * 64 + sub * 8 : (g_) == 3 ? 3072 + sub * 8 : (g_) == 4 ? 3136 + sub * 8 : 3200 + sub * 16 + ((g_) - 5) * 8)
#define P3_LOADS(u_) do { const int h_ = (u_) & 15, s_ = (((u_) >> 4) & 63) * 64 + tt; const bf16* cur_ = PR + ((size_t)((u_) >> 10) * SEQ + s_) * RW_COLS; \
        _Pragma("unroll") for (int g = 0; g < 7; ++g) { const int co = P3_COLS(h_, g); pc[g] = *(const v4u*)(cur_ + co); const v4u q_ = *(const v4u*)(cur_ - (s_ > 0 ? RW_COLS : 0) + co); pp[g] = s_ > 0 ? q_ : (v4u){0u, 0u, 0u, 0u}; } } while (0)
    if (F.tid == 0) { F.MISC[0] = __hip_atomic_fetch_add((unsigned*)(F.ctl + CW_P3Q), 1u, __ATOMIC_RELAXED, __HIP_MEMORY_SCOPE_AGENT);
                      F.MISC[1] = __hip_atomic_fetch_add((unsigned*)(F.ctl + CW_P3Q), 1u, __ATOMIC_RELAXED, __HIP_MEMORY_SCOPE_AGENT); }
    __syncthreads();
    int u = (int)F.MISC[0], unx = (int)F.MISC[1];
    if (u < 2048) P3_LOADS(u);
    for (int it = 0;; ++it) {
        if (u >= 2048) break;
        if (F.tid == 0) F.MISC[2 + (it & 1)] = __hip_atomic_fetch_add((unsigned*)(F.ctl + CW_P3Q), 1u, __ATOMIC_RELAXED, __HIP_MEMORY_SCOPE_AGENT);
        const int h = u & 15, ch = (u >> 4) & 63, b = u >> 10, s = ch * 64 + tt; const size_t m = (size_t)b * SEQ + s;
        const size_t unit = (size_t)((b * 16 + h) * 64 + ch);
        float r8[8], k8[8], v8[8], t8[8];
#define P3_SHIFT(g_, o_) do { const f32x4 m0_ = ((const f32x4*)(mu + P3_COLS(h, g_)))[0], m1_ = ((const f32x4*)(mu + P3_COLS(h, g_)))[1]; const v4u c_ = pc[g_], p_ = pp[g_]; \
        const float cv_[8] = {bflo(c_.x), bfhi(c_.x), bflo(c_.y), bfhi(c_.y), bflo(c_.z), bfhi(c_.z), bflo(c_.w), bfhi(c_.w)}, pv_[8] = {bflo(p_.x), bfhi(p_.x), bflo(p_.y), bfhi(p_.y), bflo(p_.z), bfhi(p_.z), bflo(p_.w), bfhi(p_.w)}; \
        const float mv_[8] = {m0_[0], m0_[1], m0_[2], m0_[3], m1_[0], m1_[1], m1_[2], m1_[3]}; \
        _Pragma("unroll") for (int e = 0; e < 8; ++e) o_[e] = cv_[e] + (pv_[e] - cv_[e]) * mv_[e]; } while (0)
        P3_SHIFT(0, r8); P3_SHIFT(1, k8); P3_SHIFT(2, v8); P3_SHIFT(3, t8);
#pragma unroll
        for (int e = 0; e < 8; ++e) t8[e] = 1.f - 2.f / (1.f + __expf(2.f * t8[e]));
        *(LAS v4u*)(L + RW_TW + (tt * RWA_PITCH + sub * 8) * 2) = pack8(t8);
        P3_SHIFT(4, t8);
        *(LAS v4u*)(L + RW_AL + (tt * RWA_PITCH + sub * 8) * 2) = pack8(t8);
#pragma unroll
        for (int hlf = 0; hlf < 2; ++hlf) { if (hlf == 0) P3_SHIFT(5, t8); else P3_SHIFT(6, t8);
#pragma unroll
            for (int e = 0; e < 8; ++e) t8[e] = sigmoidf_(t8[e]);
            *(LAS v4u*)(L + RW_GS + (tt * RWG_PITCH + sub * 16 + hlf * 8) * 2) = pack8(t8); }
        __syncthreads();
#pragma unroll
        for (int i = 0; i < 6; ++i) { const int mat = i >> 1, tl = F.wave + 8 * (i & 1), ti = tl >> 2, tj = tl & 3;
            const int aoff = mat == 0 ? RW_TW : mat == 1 ? RW_AL : RW_GS, ap = mat == 2 ? RWG_PITCH : RWA_PITCH, kd = mat == 2 ? 128 : 64;
            const bf16* wt = (mat == 0 ? w2t : mat == 1 ? a2t : g2t) + (size_t)(h * 64 + tj * 16 + fr) * kd + fq * 8;
            f32x4 acc = {0.f, 0.f, 0.f, 0.f};
#pragma unroll
            for (int ks = 0; ks < 4; ++ks) if (ks < kd / 32) { const bf16x8 a = *(const LAS bf16x8*)(L + aoff + ((ti * 16 + fr) * ap + ks * 32 + fq * 8) * 2); const bf16x8 bb = *(const bf16x8*)(wt + ks * 32);
                acc = __builtin_amdgcn_mfma_f32_16x16x32_bf16(a, bb, acc, 0, 0, 0); }
            LAS float* z = (LAS float*)(L + (mat == 0 ? RW_Z1 : mat == 1 ? RW_Z2 : RW_Z3));
#pragma unroll
            for (int e = 0; e < 4; ++e) z[(ti * 16 + fq * 4 + e) * RWZ_PITCH + tj * 16 + fr] = acc[e]; }
        __syncthreads();
        P3_OPAQUE();
        const int c0 = h * 64 + sub * 8;
        float lw[8], na[8], nb[8], km[8];
        {
            const LAS float* z1 = (const LAS float*)(L + RW_Z1) + tt * RWZ_PITCH + sub * 8; const LAS float* z2 = (const LAS float*)(L + RW_Z2) + tt * RWZ_PITCH + sub * 8;
            const LAS float* z3 = (const LAS float*)(L + RW_Z3) + tt * RWZ_PITCH + sub * 8;
            float av[8], gv[8], kkv[8], bo[8], ss = 0.f, bs = 0.f;
#pragma unroll
            for (int e = 0; e < 8; ++e) { const float z = w0[c0 + e] + z1[e]; const float sp = fmaxf(-z, 0.f) + __logf(1.f + __expf(-fabsf(z)));
                lw[e] = -__expf(-sp - 0.5f); av[e] = sigmoidf_(a0[c0 + e] + z2[e]); gv[e] = z3[e];
                kkv[e] = k8[e] * k_k[c0 + e]; ss += kkv[e] * kkv[e]; km[e] = k8[e] * (1.f + (av[e] - 1.f) * k_a[c0 + e]); bs += r8[e] * km[e] * r_k[c0 + e]; }
            ss = sum8(ss); bs = sum8(bs); const float rn = 1.f / sqrtf(fmaxf(ss, 1e-24f));
#pragma unroll
            for (int e = 0; e < 8; ++e) { const float kk = kkv[e] * rn; na[e] = -kk; nb[e] = kk * av[e]; bo[e] = bs * v8[e]; }
            const size_t o = m * RW_W + c0; store8(oG + o, gv); store8(oBo + o, bo);
            LAS float* lwp = (LAS float*)(L + RC_LW) + tt * 65 + sub * 8;
#pragma unroll
            for (int e = 0; e < 8; ++e) lwp[e] = lw[e];
        }
        __syncthreads();
        {
            const int cc = F.tid & 63, sg = F.tid >> 6; LAS float* p = (LAS float*)(L + RC_LW) + (sg * 8) * 65 + cc; float run = 0.f;
#pragma unroll
            for (int i = 0; i < 8; ++i) { run += p[i * 65]; p[i * 65] = run; }
            ((LAS float*)(L + RC_SEG))[sg * 64 + cc] = run;
        }
        __syncthreads();
        {
            const LAS float* lwp = (const LAS float*)(L + RC_LW) + tt * 65 + sub * 8; const LAS float* sgp = (const LAS float*)(L + RC_SEG) + sub * 8; const int sg = tt >> 3;
            float ah[8], rh[8], bh[8], kh[8], bt[8], kt[8];
            float basev[8], totv[8];
#pragma unroll
            for (int e = 0; e < 8; ++e) { basev[e] = 0.f; totv[e] = 0.f; }
#pragma unroll
            for (int q = 0; q < 8; ++q) { const f32x4 s0 = *(const LAS f32x4*)(sgp + q * 64), s1 = *(const LAS f32x4*)(sgp + q * 64 + 4); const float sv[8] = {s0[0], s0[1], s0[2], s0[3], s1[0], s1[1], s1[2], s1[3]};
#pragma unroll
                for (int e = 0; e < 8; ++e) { totv[e] += sv[e]; basev[e] += (q < sg) ? sv[e] : 0.f; } }
#pragma unroll
            for (int e = 0; e < 8; ++e) { const float base = basev[e], tot = totv[e];
                const float cl = lwp[e] + base, clx = cl - lw[e];
                const float ep = __expf(cl), en = __expf(-cl), ee = __expf(tot - cl);
                ah[e] = na[e] * __expf(clx); rh[e] = r8[e] * ep; bh[e] = nb[e] * en; kh[e] = km[e] * en; bt[e] = nb[e] * ee; kt[e] = km[e] * ee;
                if (tt == 63) ((LAS float*)(L + RC_PC))[sub * 8 + e] = __expf(tot); }
            *(LAS v4u*)(L + H_AH * SLOTB + (tt * RP + sub * 8) * 2) = pack8(ah);
            *(LAS v4u*)(L + H_BH * SLOTB + (tt * RP + sub * 8) * 2) = pack8(bh);
            *(LAS v4u*)(L + H_KH * SLOTB + (tt * RP + sub * 8) * 2) = pack8(kh);
            *(LAS v4u*)(L + H_RH * SLOTB + (tt * RP + sub * 8) * 2) = pack8(rh);
#pragma unroll
            for (int e = 0; e < 8; ++e) { const int o = ((sub * 8 + e) * RP + tt) * 2;
                *(LAS unsigned short*)(L + H_AHT * SLOTB + o) = (unsigned short)f2bf(ah[e]); *(LAS unsigned short*)(L + H_VT * SLOTB + o) = (unsigned short)f2bf(v8[e]);
                *(LAS unsigned short*)(L + H_BTT * SLOTB + o) = (unsigned short)f2bf(bt[e]); *(LAS unsigned short*)(L + H_KTT * SLOTB + o) = (unsigned short)f2bf(kt[e]); }
        }
        __syncthreads();
        P3_OPAQUE();
#pragma unroll
        for (int i = 0; i < 8; ++i) { const int mat = i >> 1, tl = F.wave + 8 * (i & 1), ty = tl >> 2, tx = tl & 3;
            const int Xs = ((mat & 1) ? H_KH : H_BH) * SLOTB, Ys = (mat < 2 ? H_AH : H_RH) * SLOTB;
            f32x4 acc = {0.f, 0.f, 0.f, 0.f}; acc = tmm(L, Xs, Ys, tx, ty, acc, fr, fq);
            const int t = ty * 16 + fr, j0 = tx * 16 + fq * 4;
#pragma unroll
            for (int e = 0; e < 4; ++e) { const bool keep = (mat < 2) ? (j0 + e < t) : (j0 + e <= t); acc[e] = keep ? acc[e] : 0.f; }
            const int dst = (mat == 0 ? S_0 : mat == 1 ? S_2 : mat == 2 ? S_3 : S_4) * SLOTB;
            st_rowY(L, dst, acc, tx, ty, fr, fq);
            if (mat == 0) { st_rowX(L, S_1 * SLOTB, acc, tx, ty, fr, fq);
#pragma unroll
                for (int e = 0; e < 4; ++e) acc[e] += (j0 + e == t) ? 1.f : 0.f;
                st_rowY(L, S_5 * SLOTB, acc, tx, ty, fr, fq); }
        }
        __syncthreads();
        P3_OPAQUE();
        if (unx < 2048) P3_LOADS(unx);
        inv_iter(L, F.wave, fr, fq, S_0 * SLOTB, S_1 * SLOTB, H_AH * SLOTB, H_BH * SLOTB, 0, 0, true, true, false);                                  __syncthreads();
        inv_iter(L, F.wave, fr, fq, H_AH * SLOTB, H_BH * SLOTB, S_0 * SLOTB, S_1 * SLOTB, S_5 * SLOTB, H_KH * SLOTB, true, true, true);              __syncthreads();
        inv_iter(L, F.wave, fr, fq, S_0 * SLOTB, S_1 * SLOTB, H_AH * SLOTB, H_BH * SLOTB, H_KH * SLOTB, S_5 * SLOTB, true, true, true);              __syncthreads();
        inv_iter(L, F.wave, fr, fq, H_AH * SLOTB, H_BH * SLOTB, S_0 * SLOTB, S_1 * SLOTB, S_5 * SLOTB, H_KH * SLOTB, true, true, true);              __syncthreads();
        inv_iter(L, F.wave, fr, fq, S_0 * SLOTB, S_1 * SLOTB, 0, H_BH * SLOTB, H_KH * SLOTB, S_5 * SLOTB, true, false, true);                        __syncthreads();
        inv_iter(L, F.wave, fr, fq, 0, H_BH * SLOTB, 0, 0, S_5 * SLOTB, H_KH * SLOTB, false, false, true);                                           __syncthreads();
        P3_OPAQUE();
        constexpr int TS = H_KH * SLOTB;
#pragma unroll
        for (int i = 0; i < 4; ++i) { const int which = i >> 1, tl = F.wave + 8 * (i & 1), ty = tl >> 2, tx = tl & 3;
            f32x4 acc = {0.f, 0.f, 0.f, 0.f};
            if (which == 0) { acc = tmm(L, TS, H_AHT * SLOTB, tx, ty, acc, fr, fq); st_rowY(L, S_0 * SLOTB, acc, tx, ty, fr, fq); }
            else { acc = tmm(L, S_2 * SLOTB, H_VT * SLOTB, tx, ty, acc, fr, fq); st_rowY(L, S_1 * SLOTB, acc, tx, ty, fr, fq); }
        }
        __syncthreads();
        {
            unsigned char* gR = F.ws + WS_CRT + unit * 8192; unsigned char* gM = F.ws + WS_CMM + unit * 8192;
#pragma unroll
            for (int i = 0; i < 6; ++i) { const int which = i >> 1, tl = F.wave + 8 * (i & 1), ty = tl >> 2, tx = tl & 3;
                f32x4 acc = {0.f, 0.f, 0.f, 0.f};
                if (which == 0) { acc = tmm(L, TS, S_1 * SLOTB, tx, ty, acc, fr, fq); st_rowY(L, H_AH * SLOTB, acc, tx, ty, fr, fq); }
                else if (which == 1) {
                    acc = ld_rowY(L, H_RH * SLOTB, tx, ty, fr, fq); acc = tmm(L, S_0 * SLOTB, S_3 * SLOTB, tx, ty, acc, fr, fq);
                    uint2 w; w.x = pk2(acc[0], acc[1]); w.y = pk2(acc[2], acc[3]);
                    *(uint2*)(gR + ((ty * 2 + (tx >> 1)) * 64 + lane) * 16 + (tx & 1) * 8) = w; }
                else {
                    acc = tmm(L, S_0 * SLOTB, H_BTT * SLOTB, tx, ty, acc, fr, fq);
                    const int kr = ty * 16 + fr, kc0 = tx * 16 + fq * 4; const float pc = ((const LAS float*)(L + RC_PC))[kr];
#pragma unroll
                    for (int e = 0; e < 4; ++e) acc[e] += (kc0 + e == kr) ? pc : 0.f;
                    uint2 w; w.x = pk2(acc[0], acc[1]); w.y = pk2(acc[2], acc[3]);
                    *(uint2*)(gM + ((ty * 2 + (tx >> 1)) * 64 + lane) * 16 + (tx & 1) * 8) = w; }
            }
        }
        __syncthreads();
        {
            unsigned char* gY = F.ws + WS_CY0 + unit * 16384; unsigned char* gN = F.ws + WS_CN0 + unit * 16384;
#pragma unroll
            for (int i = 0; i < 4; ++i) { const int which = i >> 1, tl = F.wave + 8 * (i & 1), ty = tl >> 2, tx = tl & 3;
                f32x4 acc = {0.f, 0.f, 0.f, 0.f};
                if (which == 0) { acc = tmm(L, S_3 * SLOTB, H_AH * SLOTB, tx, ty, acc, fr, fq); acc = tmm(L, S_4 * SLOTB, H_VT * SLOTB, tx, ty, acc, fr, fq);
                    *(f32x4*)(gY + ((ty * 4 + tx) * 64 + lane) * 16) = acc; }
                else { acc = tmm(L, H_BTT * SLOTB, H_AH * SLOTB, tx, ty, acc, fr, fq); acc = tmm(L, H_KTT * SLOTB, H_VT * SLOTB, tx, ty, acc, fr, fq);
                    *(f32x4*)(gN + ((ty * 4 + tx) * 64 + lane) * 16) = acc; }
            }
        }
        __syncthreads();
        u = unx; unx = (int)F.MISC[2 + (it & 1)];
    }
#undef P3_COLS
#undef P3_LOADS
#undef P3_SHIFT
#undef P3_OPAQUE
}

constexpr size_t WS_CX = WS_RW + 96 * MiB;
struct ChainOps { bf16x8 mf[4][2]; f32x4 n0[4]; };
__device__ __forceinline__ void chain_load(ChainOps& o, const unsigned char* ws, size_t unit, int vb, int lane) {
    const unsigned char* gM = ws + WS_CMM + unit * 8192; const unsigned char* gN = ws + WS_CN0 + unit * 16384;
#pragma unroll
    for (int ti = 0; ti < 4; ++ti) {
#pragma unroll
        for (int s = 0; s < 2; ++s) o.mf[ti][s] = *(const bf16x8*)(gM + ((ti * 2 + s) * 64 + lane) * 16);
        o.n0[ti] = *(const f32x4*)(gN + ((vb * 4 + ti) * 64 + lane) * 16); }
}
__device__ __forceinline__ void chain_step(const ChainOps& o, f32x4 (&X)[4], unsigned char* gX, int vb, int lane) {
    bf16x8 xb[2];
#pragma unroll
    for (int s = 0; s < 2; ++s) { v4u w; w.x = pk2(X[2 * s][0], X[2 * s][1]); w.y = pk2(X[2 * s][2], X[2 * s][3]); w.z = pk2(X[2 * s + 1][0], X[2 * s + 1][1]); w.w = pk2(X[2 * s + 1][2], X[2 * s + 1][3]);
        xb[s] = __builtin_bit_cast(bf16x8, w); *(v4u*)(gX + ((vb * 2 + s) * 64 + lane) * 16) = w; }
#pragma unroll
    for (int ti = 0; ti < 4; ++ti) { f32x4 xn = __builtin_amdgcn_mfma_f32_16x16x32_bf16(o.mf[ti][0], xb[0], o.n0[ti], 0, 0, 0); X[ti] = __builtin_amdgcn_mfma_f32_16x16x32_bf16(o.mf[ti][1], xb[1], xn, 0, 0, 0); }
}
__device__ __forceinline__ void p4_rwkv_chain(Frame& F) {
    for (int bh = blockIdx.x; bh < BATCH * 16; bh += F.G) {
        if (F.wave < 4) {
            const int vb = F.wave;
            f32x4 X[4];
#pragma unroll
            for (int i = 0; i < 4; ++i) X[i] = (f32x4){0.f, 0.f, 0.f, 0.f};
            unsigned char* gX = F.ws + WS_CX + (size_t)bh * 64 * 8192;
            ChainOps o0, o1;
            chain_load(o0, F.ws, (size_t)bh * 64, vb, F.lane);
#pragma unroll 1
            for (int c = 0; c < 64; c += 2) {
                chain_load(o1, F.ws, (size_t)bh * 64 + c + 1, vb, F.lane);
                chain_step(o0, X, gX + (size_t)c * 8192, vb, F.lane);
                if (c + 2 < 64) chain_load(o0, F.ws, (size_t)bh * 64 + c + 2, vb, F.lane);
                chain_step(o1, X, gX + (size_t)(c + 1) * 8192, vb, F.lane);
            }
        }
    }
}
__device__ __forceinline__ float sum16(float x) { x += dpp_f<0xB1>(x); x += dpp_f<0x4E>(x); x += dpp_f<0x141>(x); x += dpp_f<0x140>(x); return x; }
__device__ __forceinline__ void rwkv_out_job(Frame& F, const float* lnx_g, const float* lnx_b, int job) {
    const int unit = job >> 2, ti = job & 3, bh = unit >> 6, c = unit & 63, b = bh >> 4, h = bh & 15, lane = F.lane, fr = lane & 15, fq = lane >> 4;
    const unsigned char* gR = F.ws + WS_CRT + (size_t)unit * 8192; const unsigned char* gX = F.ws + WS_CX + (size_t)unit * 8192; const unsigned char* gY = F.ws + WS_CY0 + (size_t)unit * 16384;
    float* RWb = (float*)(F.ws + WS_RW); constexpr size_t AS = RW_ARR / 4; const float *iG = RWb + 6 * AS, *iBo = RWb + 7 * AS; bf16* YR = (bf16*)(F.ws + WS_YRW);
    const bf16x8 r0 = *(const bf16x8*)(gR + ((ti * 2 + 0) * 64 + lane) * 16), r1 = *(const bf16x8*)(gR + ((ti * 2 + 1) * 64 + lane) * 16);
    f32x4 y[4];
#pragma unroll
    for (int vb = 0; vb < 4; ++vb) { const bf16x8 x0 = *(const bf16x8*)(gX + ((vb * 2 + 0) * 64 + lane) * 16), x1 = *(const bf16x8*)(gX + ((vb * 2 + 1) * 64 + lane) * 16);
        f32x4 acc = *(const f32x4*)(gY + ((vb * 4 + ti) * 64 + lane) * 16);
        acc = __builtin_amdgcn_mfma_f32_16x16x32_bf16(r0, x0, acc, 0, 0, 0); y[vb] = __builtin_amdgcn_mfma_f32_16x16x32_bf16(r1, x1, acc, 0, 0, 0); }
    float mean[4], rs[4];
#pragma unroll
    for (int e = 0; e < 4; ++e) { mean[e] = sum16((y[0][e] + y[1][e]) + (y[2][e] + y[3][e])) * (1.f / 64.f); float q = 0.f;
#pragma unroll
        for (int vb = 0; vb < 4; ++vb) { const float d = y[vb][e] - mean[e]; q += d * d; }
        rs[e] = 1.f / sqrtf(sum16(q) * (1.f / 64.f) + LNX_EPS); }
#pragma unroll
    for (int vb = 0; vb < 4; ++vb) { const int col = h * 64 + vb * 16 + fr; const float lg = lnx_g[col], lb = lnx_b[col];
#pragma unroll
        for (int e = 0; e < 4; ++e) { const size_t o = ((size_t)b * SEQ + c * 64 + ti * 16 + fq * 4 + e) * RW_W + col;
            YR[o] = (bf16)f2bf(((y[vb][e] - mean[e]) * rs[e] * lg + lb + iBo[o]) * iG[o]); } }
}

__device__ __forceinline__ void p6_combine(Frame& F, const float* const* in) {
    const bf16* O0 = (const bf16*)(F.ws + WS_O0); const bf16* O1 = (const bf16*)(F.ws + WS_O1); bf16* YA = (bf16*)(F.ws + WS_YATT); bf16* YR = (bf16*)(F.ws + WS_YRW);
    const float* subg = in[12]; const float* lnx_g = in[21]; const float* lnx_b = in[22];
    const float d1 = wave_sum(in[8][F.lane] * in[9][F.lane]), d2 = wave_sum(in[10][F.lane] * in[11][F.lane]);
    const float lam = expf(d1) - expf(d2) + LAMBDA_INIT;
    const int gw = F.vcu * NWAVES + F.wave, NGW = F.G * NWAVES, lane = F.lane;
    for (int m = gw; m < M; m += NGW) {
        {
            const size_t o = (size_t)m * ATT_W + lane * 16; float d[16]; float ss = 0.f;
#pragma unroll
            for (int hf = 0; hf < 2; ++hf) { const v4u a = *(const v4u*)(O0 + o + hf * 8), bq = *(const v4u*)(O1 + o + hf * 8);
                const unsigned aw[4] = {a.x, a.y, a.z, a.w}, bw[4] = {bq.x, bq.y, bq.z, bq.w};
#pragma unroll
                for (int e = 0; e < 4; ++e) { d[hf * 8 + 2 * e] = bflo(aw[e]) - lam * bflo(bw[e]); d[hf * 8 + 2 * e + 1] = bfhi(aw[e]) - lam * bfhi(bw[e]); } }
#pragma unroll
            for (int e = 0; e < 16; ++e) ss += d[e] * d[e];
            ss = sum8(ss); const float rs = (1.f - LAMBDA_INIT) / sqrtf(ss * (1.f / 128.f) + SUBLN_EPS);
            const float* sg = subg + (lane & 7) * 16; float y[16];
#pragma unroll
            for (int e = 0; e < 16; ++e) y[e] = d[e] * rs * sg[e];
            v4u w0, w1; w0.x = pk2(y[0], y[1]); w0.y = pk2(y[2], y[3]); w0.z = pk2(y[4], y[5]); w0.w = pk2(y[6], y[7]); w1.x = pk2(y[8], y[9]); w1.y = pk2(y[10], y[11]); w1.z = pk2(y[12], y[13]); w1.w = pk2(y[14], y[15]);
            *(v4u*)(YA + o) = w0; *(v4u*)(YA + o + 8) = w1;
        }
    }
#if RWKV_SEQ
    for (int m = gw; m < M; m += NGW) {
        float* RWb = (float*)(F.ws + WS_RW); constexpr size_t AS = RW_ARR / 4; const float *iG = RWb + 6 * AS, *iBo = RWb + 7 * AS, *iY = RWb + 8 * AS;
        const size_t o = (size_t)m * RW_W + lane * 16; float yv[16]; float s1 = 0.f;
#pragma unroll
        for (int q = 0; q < 4; ++q) { const f32x4 t = *(const f32x4*)(iY + o + q * 4); yv[q * 4] = t[0]; yv[q * 4 + 1] = t[1]; yv[q * 4 + 2] = t[2]; yv[q * 4 + 3] = t[3]; s1 += (t[0] + t[1]) + (t[2] + t[3]); }
        const float mean = sum4(s1) * (1.f / 64.f); float s2 = 0.f;
#pragma unroll
        for (int e = 0; e < 16; ++e) { yv[e] -= mean; s2 += yv[e] * yv[e]; }
        const float rs = 1.f / sqrtf(sum4(s2) * (1.f / 64.f) + LNX_EPS); float y[16];
#pragma unroll
        for (int q = 0; q < 4; ++q) { const f32x4 lg = *(const f32x4*)(lnx_g + lane * 16 + q * 4), lb = *(const f32x4*)(lnx_b + lane * 16 + q * 4), bo = *(const f32x4*)(iBo + o + q * 4), gg = *(const f32x4*)(iG + o + q * 4);
#pragma unroll
            for (int e = 0; e < 4; ++e) y[q * 4 + e] = (yv[q * 4 + e] * rs * lg[e] + lb[e] + bo[e]) * gg[e]; }
        v4u w0, w1; w0.x = pk2(y[0], y[1]); w0.y = pk2(y[2], y[3]); w0.z = pk2(y[4], y[5]); w0.w = pk2(y[6], y[7]); w1.x = pk2(y[8], y[9]); w1.y = pk2(y[10], y[11]); w1.z = pk2(y[12], y[13]); w1.w = pk2(y[14], y[15]);
        *(v4u*)(YR + o) = w0; *(v4u*)(YR + o + 8) = w1;
    }
#else
    for (int job = gw; job < 2048 * 4; job += NGW) rwkv_out_job(F, lnx_g, lnx_b, job);
#endif
}

constexpr int RT_XP = 520;
constexpr int RT_XH = 0, RT_XL = RT_XH + 16 * RT_XP * 2, RT_PART = RT_XL + 16 * RT_XP * 2, RT_LG = RT_PART + 8 * 5 * 1024, RT_END = RT_LG + 16 * 80 * 4;
static_assert(RT_END <= RING_BYTES, "router LDS");
__device__ __forceinline__ void p10_route(Frame& F, const float* const* in) {
    const float* H1 = (const float*)(F.ws + WS_H1); bf16* U2 = (bf16*)(F.ws + WS_U2); const float* ada = (const float*)(F.ws + WS_ADA);
    const float* gffn = in[26]; const float* brg = in[28]; const float* bre = in[30];
    const bf16* WRH = (const bf16*)(F.ws + WS_WRH); const bf16* WRL = (const bf16*)(F.ws + WS_WRL);
    int* tokE = (int*)(F.ws + WS_TOKE); int* tokP = (int*)(F.ws + WS_TOKP); float* tokW = (float*)(F.ws + WS_TOKW); int* list = (int*)(F.ws + WS_LIST);
    unsigned* cnt = (unsigned*)(F.ctl + CW_CNT);
    LAS unsigned char* L = F.lds;
    const int lane = F.lane, w = F.wave, fr = lane & 15, fq = lane >> 4;
    const __amdgpu_buffer_rsrc_t rsH = __builtin_amdgcn_make_buffer_rsrc((void*)WRH, 0, 80 * DM * 2, 0x00020000), rsL = __builtin_amdgcn_make_buffer_rsrc((void*)WRL, 0, 80 * DM * 2, 0x00020000);
    const int voff = (fr * DM + fq * 8) * 2;
#pragma unroll 1
    for (int blk = F.vcu; blk < M / 16; blk += F.G) {
        const int m0 = blk * 16 + w * 2;
        const int b = m0 / SEQ; const float* ad = ada + (size_t)b * 12288;
        bf16x8 wh[2][5], wl[2][5];
#define RT_WLOAD(j_, S_) do { _Pragma("unroll") for (int ct = 0; ct < 5; ++ct) { const int so = __builtin_amdgcn_readfirstlane(((ct * 16) * DM + ((j_) >> 1) * 512 + (w + 8 * ((j_) & 1)) * 32) * 2); \
        wh[S_][ct] = __builtin_bit_cast(bf16x8, __builtin_amdgcn_raw_buffer_load_b128(rsH, voff, so, 0)); wl[S_][ct] = __builtin_bit_cast(bf16x8, __builtin_amdgcn_raw_buffer_load_b128(rsL, voff, so, 0)); } } while (0)
        RT_WLOAD(0, 0);
        f32x4 v0[8], v1[8];
        norm_mod_row2v(H1 + (size_t)m0 * DM, H1 + (size_t)(m0 + 1) * DM, gffn, ad + 8192, ad + 6144, ad + 8192, ad + 6144, U2 + (size_t)m0 * U2P, U2 + (size_t)(m0 + 1) * U2P, lane, v0, v1);
        f32x4 acc[5];
#pragma unroll
        for (int ct = 0; ct < 5; ++ct) acc[ct] = (f32x4){0.f, 0.f, 0.f, 0.f};
#pragma unroll
        for (int kq = 0; kq < 4; ++kq) {
            __syncthreads();
#pragma unroll
            for (int r = 0; r < 2; ++r)
#pragma unroll
                for (int jj = 0; jj < 2; ++jj) { const f32x4 x = r ? v1[2 * kq + jj] : v0[2 * kq + jj]; const int off = ((w * 2 + r) * RT_XP + 4 * lane + 256 * jj) * 2;
                    const unsigned h0 = f2bf(x[0]), h1 = f2bf(x[1]), h2 = f2bf(x[2]), h3 = f2bf(x[3]);
                    v2u hw; hw.x = h0 | (h1 << 16); hw.y = h2 | (h3 << 16); *(LAS v2u*)(L + RT_XH + off) = hw;
                    v2u lw; lw.x = pk2(x[0] - bf2f((unsigned short)h0), x[1] - bf2f((unsigned short)h1)); lw.y = pk2(x[2] - bf2f((unsigned short)h2), x[3] - bf2f((unsigned short)h3)); *(LAS v2u*)(L + RT_XL + off) = lw; }
            __syncthreads();
#pragma unroll
            for (int kk = 0; kk < 2; ++kk) { const int j = 2 * kq + kk, ks = w + 8 * kk;
                if (j < 7) RT_WLOAD(j + 1, (j + 1) & 1);
                const int o = (fr * RT_XP + ks * 32 + fq * 8) * 2; const bf16x8 xh = *(const LAS bf16x8*)(L + RT_XH + o), xl = *(const LAS bf16x8*)(L + RT_XL + o);
#pragma unroll
                for (int ct = 0; ct < 5; ++ct) { f32x4 a = acc[ct];
                    a = __builtin_amdgcn_mfma_f32_16x16x32_bf16(wh[j & 1][ct], xh, a, 0, 0, 0); a = __builtin_amdgcn_mfma_f32_16x16x32_bf16(wh[j & 1][ct], xl, a, 0, 0, 0); a = __builtin_amdgcn_mfma_f32_16x16x32_bf16(wl[j & 1][ct], xh, a, 0, 0, 0);
                    acc[ct] = a; }
                __builtin_amdgcn_sched_barrier(0);
            }
        }
#undef RT_WLOAD
#pragma unroll
        for (int ct = 0; ct < 5; ++ct) *(LAS f32x4*)(L + RT_PART + ((w * 5 + ct) * 64 + lane) * 16) = acc[ct];
        __syncthreads();
        if (F.tid < 320) { const int ct = F.tid >> 6, l = F.tid & 63; f32x4 s = {0.f, 0.f, 0.f, 0.f};
#pragma unroll
            for (int ww = 0; ww < 8; ++ww) s += *(const LAS f32x4*)(L + RT_PART + ((ww * 5 + ct) * 64 + l) * 16);
            const int tok = l & 15, col = ct * 16 + (l >> 4) * 4;
            LAS float* lg = (LAS float*)(L + RT_LG) + tok * 80 + col; lg[0] = s[0]; lg[1] = s[1]; lg[2] = s[2]; lg[3] = s[3]; }
        __syncthreads();
        if (F.tid < 16) {
            const int m = blk * 16 + F.tid; const LAS float* lgp = (const LAS float*)(L + RT_LG) + F.tid * 80;
            float lg[8];
#pragma unroll
            for (int g = 0; g < 8; ++g) lg[g] = lgp[g] + brg[g];
            int gi = 0; float gmax = lg[0];
#pragma unroll
            for (int g = 1; g < 8; ++g) if (lg[g] > gmax) { gmax = lg[g]; gi = g; }
            float gz = 0.f;
#pragma unroll
            for (int g = 0; g < 8; ++g) gz += __expf(lg[g] - gmax);
            const float gp = 1.f / gz;
            float el[8];
#pragma unroll
            for (int i = 0; i < 8; ++i) el[i] = lgp[8 + gi * 8 + i] + bre[gi * 8 + i];
            int i0 = 0; float e0 = el[0];
#pragma unroll
            for (int i = 1; i < 8; ++i) if (el[i] > e0) { e0 = el[i]; i0 = i; }
            int i1 = -1; float e1 = -INFINITY;
#pragma unroll
            for (int i = 0; i < 8; ++i) if (i != i0 && el[i] > e1) { e1 = el[i]; i1 = i; }
            const float x1 = __expf(e1 - e0), w0 = gp / (1.f + x1), w1 = gp * x1 / (1.f + x1);
            const int ea = gi * 8 + i0, eb = gi * 8 + i1;
            const unsigned pa = atomicAdd(cnt + ea, 1u), pb = atomicAdd(cnt + eb, 1u);
            list[(size_t)ea * CAP + pa] = m * 2; list[(size_t)eb * CAP + pb] = m * 2 + 1;
            tokE[m * 2] = ea; tokE[m * 2 + 1] = eb; tokP[m * 2] = (int)pa; tokP[m * 2 + 1] = (int)pb; tokW[m * 2] = w0; tokW[m * 2 + 1] = w1;
        }
    }
}

static_assert(NEXP == 64, "one wave = one lane per expert");
__device__ __forceinline__ int lane_excl_prefix(int v, int lane) {
    int s = 0;
#pragma unroll
    for (int e = 0; e < 64; ++e) { const int c = __builtin_amdgcn_readlane(v, e); s += (e < lane) ? c : 0; }
    return s; }
__device__ __forceinline__ void expert_offsets(const unsigned* cnt, LAS int* offs, LAS int* raw, int tid) {
    asm volatile("" : "+v"(tid));
    if (tid < NEXP) { const int mine = (int)__hip_atomic_load(cnt + tid, __ATOMIC_RELAXED, __HIP_MEMORY_SCOPE_AGENT); const int s = lane_excl_prefix(mine, tid);
        offs[tid] = s; if (tid == NEXP - 1) offs[NEXP] = s + mine; }
    __syncthreads();
}
constexpr int MOE_RCH = 512;
constexpr int MOE_ROWP = 2 * MOE_RCH * 128 + 2 * 64 * 144, MOE_TAB = MOE_ROWP + MOE_RCH * 4, MOE_END = MOE_TAB + 4 * 68 * 4;
static_assert(MOE_END <= RING_BYTES, "moe LDS");
__device__ __forceinline__ const float* uniform_ptr(const float* p) {
    const unsigned long long v = (unsigned long long)p; const unsigned lo = __builtin_amdgcn_readfirstlane((unsigned)v), hi = __builtin_amdgcn_readfirstlane((unsigned)(v >> 32));
    return (const float*)(((unsigned long long)hi << 32) | lo); }
template <int MODE> __device__ __forceinline__ void moe_gemm_pc(Frame& F, const float* const* in, bool tables_ready) {
    constexpr int KD = MODE == 1 ? DM : EFF, NSTEP = KD / 64, ABYTES = 256 * 128, BBYTES = 128 * 128;
    constexpr int bld = MODE == 1 ? EFF : DM, APITCH = (MODE == 1 ? U2P : ACTP) * 2; constexpr size_t out_ld = MODE == 1 ? ACTP : DM;
    static_assert(NSTEP % 2 == 0 && NSTEP >= 8, "steps");
    const bf16* Asrc = (const bf16*)(F.ws + (MODE == 1 ? WS_U2 : WS_ACT));
    const float* Wg = in[31]; const float* Wu = in[32]; const float* Wd = in[33];
    bf16* ACT = (bf16*)(F.ws + WS_ACT); bf16* YS = (bf16*)(F.ws + WS_YS);
    const int* list = (const int*)(F.ws + WS_LIST); const unsigned* cnt = (const unsigned*)(F.ctl + CW_CNT);
    LAS unsigned char* L = F.lds; LAS int* rowp = (LAS int*)(L + MOE_ROWP);
    LAS int* offs = (LAS int*)(L + MOE_TAB); LAS int* srt = offs + 68; LAS int* ust = srt + 68; LAS int* raw = ust + 68;
    int tid_ = F.tid; asm volatile("" : "+v"(tid_));
    const int tid = tid_, w = F.wave;
    if (!tables_ready) {
    if (tid < NEXP) {
        const int mine = (int)__hip_atomic_load(cnt + tid, __ATOMIC_RELAXED, __HIP_MEMORY_SCOPE_AGENT); int s = 0, rank = 0;
#pragma unroll
        for (int e = 0; e < NEXP; ++e) { const int c = __builtin_amdgcn_readlane(mine, e); s += (e < tid) ? c : 0; rank += (c > mine || (c == mine && e < tid)) ? 1 : 0; }
        offs[tid] = s; if (tid == NEXP - 1) offs[NEXP] = s + mine;
        const int pos = rank < NEXP / 2 ? 2 * rank : 2 * (NEXP - 1 - rank) + 1;
        srt[pos] = tid; raw[pos] = 16 * ((mine + 255) >> 8);
        __builtin_amdgcn_s_waitcnt(0xc07f);
        const int u = raw[tid]; const int su = lane_excl_prefix(u, tid);
        ust[tid] = su; if (tid == NEXP - 1) ust[NEXP] = su + u; }
    __syncthreads();
    }
    const int NU = ust[NEXP];
    int un = F.vcu;
    if (un >= NU) return;
#define MOE_DECODE(un_, e_, ct_, r0_, nrows_, slot0_) do { const int pos_ = __popcll(__ballot(F.lane >= 1 && ust[F.lane] <= (un_))); \
        e_ = srt[pos_]; const int ul_ = (un_) - ust[pos_], cnt_ = offs[e_ + 1] - offs[e_]; slot0_ = offs[e_]; const int nch_ = (cnt_ + 255) >> 8; \
        ct_ = ul_ / nch_; r0_ = (ul_ - ct_ * nch_) * 256; nrows_ = (cnt_ - r0_) < 256 ? (cnt_ - r0_) : 256; } while (0)
#define MOE_BBASE(e_, ct_) uniform_ptr(MODE == 1 ? ((w & 2) ? Wu : Wg) + (size_t)(e_) * DM * EFF + (ct_) * 64 : Wd + (size_t)(e_) * EFF * DM + (ct_) * 128)
#define MOE_ROWOF(e_, r0_, nrows_, slot0_, t_) ((MODE == 1) ? (list[(size_t)(e_) * CAP + (r0_) + ((t_) < (nrows_) ? (t_) : 0)] >> 1) : ((slot0_) + (r0_) + ((t_) < (nrows_) ? (t_) : 0)))
    if (w >= 4) {
        const int t8 = tid & 255;
        int kc, gcol, bcol;
        if (MODE == 1) { const int t7 = tid & 127; kc = t7 >> 4; gcol = (t7 & 15) * 4; bcol = ((w >> 1) & 1) * 64 + gcol; }
        else { kc = t8 >> 5; gcol = (t8 & 31) * 4; bcol = gcol; }
        const int bvoff = (kc * 8 * bld + gcol) * 4;
        int e, ct, r0, nrows, slot0; MOE_DECODE(un, e, ct, r0, nrows, slot0);
        rowp[t8] = MOE_ROWOF(e, r0, nrows, slot0, t8);
        __syncthreads();
        const __amdgpu_buffer_rsrc_t rsA = __builtin_amdgcn_make_buffer_rsrc((void*)Asrc, 0, 0x7fffffff, 0x00020000);
        __amdgpu_buffer_rsrc_t rsB = __builtin_amdgcn_make_buffer_rsrc((void*)MOE_BBASE(e, ct), 0, 0x7fffffff, 0x00020000);
        int avoff[8];
#define PC_AVOFF(PB) do { _Pragma("unroll") for (int i = 0; i < 8; ++i) { const int q = t8 + i * 256; avoff[i] = rowp[(PB) * 256 + (q >> 3)] * APITCH + (q & 7) * 16; } } while (0)
        PC_AVOFF(0);
        v4u areg[8]; f32x4 breg[2][8];
#define PC_ALOAD(st) do { _Pragma("unroll") for (int i = 0; i < 8; ++i) areg[i] = __builtin_bit_cast(v4u, __builtin_amdgcn_raw_buffer_load_b128(rsA, avoff[i], (st) * 128, 0)); } while (0)
#define PC_BLOAD(st, S) do { _Pragma("unroll") for (int j = 0; j < 8; ++j) breg[S][j] = __builtin_bit_cast(f32x4, __builtin_amdgcn_raw_buffer_load_b128(rsB, bvoff, ((st) * 64 + j) * bld * 4, 0)); } while (0)
#define PC_WRITE(st, SB) do { \
        const int wb = (st) & 1; LAS unsigned char* Aw = L + wb * ABYTES; LAS unsigned char* Bw = L + 2 * ABYTES + wb * BBYTES; \
        _Pragma("unroll") for (int i = 0; i < 8; ++i) { const int q = t8 + i * 256, r = q >> 3; *(LAS v4u*)(Aw + r * 128 + 16 * ((q & 7) ^ (r & 7))) = areg[i]; } \
        _Pragma("unroll") for (int c = 0; c < 4; ++c) { v4u pw; pw.x = pk2(breg[SB][0][c], breg[SB][1][c]); pw.y = pk2(breg[SB][2][c], breg[SB][3][c]); pw.z = pk2(breg[SB][4][c], breg[SB][5][c]); pw.w = pk2(breg[SB][6][c], breg[SB][7][c]); \
            *(LAS v4u*)(Bw + (bcol + c) * 128 + 16 * (kc ^ (((bcol + c) ^ (bcol >> 2)) & 7))) = pw; } } while (0)
        PC_ALOAD(0); PC_BLOAD(0, 0); PC_BLOAD(1, 1);
        PC_WRITE(0, 0); PC_ALOAD(1); PC_BLOAD(2, 0);
        int pb = 0;
        while (true) {
            const int unn = un + F.G; const bool hasn = unn < NU;
            int e2 = 0, ct2 = 0, r02 = 0, nrows2 = 0, slot02 = 0, rp2 = 0;
            if (hasn) { MOE_DECODE(unn, e2, ct2, r02, nrows2, slot02); rp2 = MOE_ROWOF(e2, r02, nrows2, slot02, t8); }
#pragma unroll 1
            for (int st = 0; st < NSTEP - 4; st += 2) {
                __syncthreads(); PC_WRITE(st + 1, 1); PC_ALOAD(st + 2); PC_BLOAD(st + 3, 1); __builtin_amdgcn_sched_barrier(0);
                __syncthreads(); PC_WRITE(st + 2, 0); PC_ALOAD(st + 3); PC_BLOAD(st + 4, 0); __builtin_amdgcn_sched_barrier(0);
            }
            __syncthreads(); PC_WRITE(NSTEP - 3, 1); PC_ALOAD(NSTEP - 2); PC_BLOAD(NSTEP - 1, 1); rowp[(pb ^ 1) * 256 + t8] = rp2; __builtin_amdgcn_sched_barrier(0);
            __syncthreads(); PC_WRITE(NSTEP - 2, 0); PC_ALOAD(NSTEP - 1);
            if (hasn) { rsB = __builtin_amdgcn_make_buffer_rsrc((void*)MOE_BBASE(e2, ct2), 0, 0x7fffffff, 0x00020000); PC_BLOAD(0, 0); }
            __builtin_amdgcn_sched_barrier(0);
            __syncthreads(); PC_WRITE(NSTEP - 1, 1);
            if (hasn) { PC_AVOFF(pb ^ 1); PC_ALOAD(0); PC_BLOAD(1, 1); }
            __builtin_amdgcn_sched_barrier(0);
            __syncthreads();
            if (!hasn) break;
            PC_WRITE(0, 0); PC_ALOAD(1); PC_BLOAD(2, 0); __builtin_amdgcn_sched_barrier(0);
            un = unn; pb ^= 1;
        }
#undef PC_AVOFF
#undef PC_ALOAD
#undef PC_BLOAD
#undef PC_WRITE
    } else {
        int fr = tid & 15, fq = (tid >> 4) & 3;
        __syncthreads();
        while (true) {
            int e, ct, r0, nrows, slot0; MOE_DECODE(un, e, ct, r0, nrows, slot0);
            bf16* outp = (MODE == 1) ? ACT + (size_t)(slot0 + r0) * ACTP + ct * 64 : YS + (size_t)(slot0 + r0) * DM + ct * 128;
            f32x4 acc[4][8];
#pragma unroll
            for (int a = 0; a < 4; ++a)
#pragma unroll
                for (int n = 0; n < 8; ++n) acc[a][n] = (f32x4){0.f, 0.f, 0.f, 0.f};
            bf16x8 af0[4], af1[4], bfr[8];
#pragma unroll
            for (int a = 0; a < 4; ++a) af1[a] = (bf16x8){0, 0, 0, 0, 0, 0, 0, 0};
#pragma unroll
            for (int n = 4; n < 8; ++n) bfr[n] = (bf16x8){0, 0, 0, 0, 0, 0, 0, 0};
#define PC_SB() __builtin_amdgcn_sched_barrier(0)
#define PC_RDA(ks, a) (*(const LAS bf16x8*)(As + ((w + 4 * (a)) * 16 + fr) * 128 + 16 * (((ks) * 4 + fq) ^ (fr & 7))))
#define PC_RDB(ks, n) (*(const LAS bf16x8*)(Bs + ((n) * 16 + fr) * 128 + 16 * (((ks) * 4 + fq) ^ ((fr ^ (((n) & 1) * 4 + (fr >> 2))) & 7))))
#define PC_MM(AF, N0) do { _Pragma("unroll") for (int n = (N0); n < (N0) + 4; ++n) _Pragma("unroll") for (int a = 0; a < 4; ++a) acc[a][n] = __builtin_amdgcn_mfma_f32_16x16x32_bf16(bfr[n], AF[a], acc[a][n], 0, 0, 0); } while (0)
#define PC_COMPUTE(st) do { \
            const int buf = (st) & 1; const LAS unsigned char* As = L + buf * ABYTES; const LAS unsigned char* Bs = L + 2 * ABYTES + buf * BBYTES; \
            _Pragma("unroll") for (int a = 0; a < 4; ++a) af0[a] = PC_RDA(0, a); \
            _Pragma("unroll") for (int n = 0; n < 4; ++n) bfr[n] = PC_RDB(0, n); \
            PC_SB(); PC_MM(af1, 4); PC_SB();                                     \
            _Pragma("unroll") for (int n = 4; n < 8; ++n) bfr[n] = PC_RDB(0, n); \
            _Pragma("unroll") for (int a = 0; a < 4; ++a) af1[a] = PC_RDA(1, a); \
            PC_SB(); PC_MM(af0, 0); PC_SB();                                     \
            _Pragma("unroll") for (int n = 0; n < 4; ++n) bfr[n] = PC_RDB(1, n); \
            PC_SB(); PC_MM(af0, 4); PC_SB();                                     \
            _Pragma("unroll") for (int n = 4; n < 8; ++n) bfr[n] = PC_RDB(1, n); \
            PC_SB(); PC_MM(af1, 0); PC_SB();                                     \
            } while (0)
#pragma unroll 1
            for (int st = 0; st < NSTEP; st += 2) {
                asm volatile("" : "+v"(fr), "+v"(fq));
                __syncthreads(); PC_COMPUTE(st);
                __syncthreads(); PC_COMPUTE(st + 1);
            }
            PC_MM(af1, 4);
#undef PC_COMPUTE
#undef PC_MM
#undef PC_RDA
#undef PC_RDB
#undef PC_SB
#pragma unroll
            for (int a = 0; a < 4; ++a) { const int r = (w + 4 * a) * 16 + fr;
                if (r < nrows) { bf16* orow = outp + (size_t)r * out_ld;
                    if (MODE == 1) {
#pragma unroll
                        for (int n = 0; n < 4; ++n) { const f32x4 g = acc[a][n], uu = acc[a][n + 4]; float o[4];
#pragma unroll
                            for (int x = 0; x < 4; ++x) o[x] = g[x] / (1.f + __expf(-g[x])) * uu[x];
                            uint2 pw; pw.x = pk2(o[0], o[1]); pw.y = pk2(o[2], o[3]); *(uint2*)(orow + n * 16 + fq * 4) = pw; }
                    } else {
#pragma unroll
                        for (int n = 0; n < 8; ++n) { const f32x4 o = acc[a][n]; uint2 pw; pw.x = pk2(o[0], o[1]); pw.y = pk2(o[2], o[3]); *(uint2*)(orow + n * 16 + fq * 4) = pw; }
                    } } }
            un += F.G; if (un >= NU) break;
        }
    }
#undef MOE_DECODE
#undef MOE_BBASE
#undef MOE_ROWOF
}

__device__ __forceinline__ void p14_final(Frame& F, const float* const* in, float* out) {
    const float* H1 = (const float*)(F.ws + WS_H1); const bf16* YS = (const bf16*)(F.ws + WS_YS); const float* ada = (const float*)(F.ws + WS_ADA); const float* fg = in[34];
    const int* tokE = (const int*)(F.ws + WS_TOKE); const int* tokP = (const int*)(F.ws + WS_TOKP); const float* tokW = (const float*)(F.ws + WS_TOKW);
    const unsigned* cnt = (const unsigned*)(F.ctl + CW_CNT);
    LAS int* offs = (LAS int*)F.lds;
    expert_offsets(cnt, offs, offs + 128, F.tid);
    const int gw = F.vcu * NWAVES + F.wave, NGW = F.G * NWAVES, lane = F.lane;
    for (int m0 = gw; m0 < M; m0 += 2 * NGW) {
        int mm[2], sa[2], sb[2]; float wa[2], wb[2];
#pragma unroll
        for (int r = 0; r < 2; ++r) { const int m = m0 + r * NGW < M ? m0 + r * NGW : m0; mm[r] = m;
            sa[r] = offs[tokE[m * 2]] + tokP[m * 2]; sb[r] = offs[tokE[m * 2 + 1]] + tokP[m * 2 + 1]; wa[r] = tokW[m * 2]; wb[r] = tokW[m * 2 + 1]; }
        f32x4 v[2][8]; float s2[2] = {0.f, 0.f};
#pragma unroll
        for (int r = 0; r < 2; ++r) { const float* gt2 = ada + (size_t)(mm[r] / SEQ) * 12288 + 10240;
            const uint2* y0 = (const uint2*)(YS + (size_t)sa[r] * DM) + lane; const uint2* y1 = (const uint2*)(YS + (size_t)sb[r] * DM) + lane;
            const f32x4* hr = (const f32x4*)(H1 + (size_t)mm[r] * DM) + lane;
#pragma unroll
            for (int j = 0; j < 8; ++j) { const uint2 a = y0[64 * j], c = y1[64 * j]; const f32x4 g = ((const f32x4*)gt2)[lane + 64 * j]; const float w0 = wa[r], w1 = wb[r];
                f32x4 mo; mo[0] = w0 * bflo(a.x) + w1 * bflo(c.x); mo[1] = w0 * bfhi(a.x) + w1 * bfhi(c.x); mo[2] = w0 * bflo(a.y) + w1 * bflo(c.y); mo[3] = w0 * bfhi(a.y) + w1 * bfhi(c.y);
                v[r][j] = hr[64 * j] + g * mo; s2[r] += (v[r][j].x * v[r][j].x + v[r][j].y * v[r][j].y) + (v[r][j].z * v[r][j].z + v[r][j].w * v[r][j].w); } }
#pragma unroll
        for (int r = 0; r < 2; ++r) { if (r == 1 && m0 + NGW >= M) break;
            const float rstd = 1.f / sqrtf(wave_sum(s2[r]) * (1.f / DM) + NORM_EPS);
            f32x4* orow = (f32x4*)(out + (size_t)mm[r] * DM) + lane;
#pragma unroll
            for (int j = 0; j < 8; ++j) orow[64 * j] = v[r][j] * rstd * ((const f32x4*)fg)[lane + 64 * j]; }
    }
}

struct Args { const float* in[35]; float* out; unsigned char* ws; int ph_lo, ph_hi, use_bar, pad; };
__global__ void __launch_bounds__(NTHR, 2) fwd_kernel(Args args) {
    extern __shared__ __attribute__((aligned(16))) unsigned char lds[];
    Frame F;
    F.lds = (LAS unsigned char*)lds; F.MISC = (volatile LAS unsigned*)(F.lds + MISC_OFF);
    F.tid = threadIdx.x; F.lane = F.tid & 63; F.wave = __builtin_amdgcn_readfirstlane(F.tid >> 6);
    F.G = gridDim.x; { const int bx = blockIdx.x; F.vcu = (F.G % 8 == 0) ? (bx % 8) * (F.G / 8) + bx / 8 : bx; }
    F.ws = args.ws; F.ctl = (gu32*)(args.ws + WS_CTL); F.probe = args.pad;
    for (int u = F.tid; u < (LDS_BYTES - LDSCTL_OFF) / 4; u += NTHR) ((LAS unsigned*)(F.lds + LDSCTL_OFF))[u] = 0u;
    __syncthreads();
    XcdBarrier bar; bar.bar = (unsigned*)(F.ctl + CW_BAR); bar.x = 0; bar.st = nullptr;
    if (args.use_bar) bar = xcd_barrier_post((unsigned*)(F.ctl + CW_BAR), F.MISC + 8);
    const int lo = args.ph_lo, hi = args.ph_hi;
    const float* const* in = args.in;
#ifndef PHASE_MASK
#define PHASE_MASK 0xFFFF
#endif
#define IN(k) ((((PHASE_MASK) >> (k)) & 1) && lo <= (k) && (k) < hi)
#define SEAM(k) do { if (IN(k) && IN((k) + 1)) xcd_barrier(bar); } while (0)
#ifndef PROBE_REPEAT_MASK
#define PROBE_REPEAT_MASK 0
#endif
#define REPS(k) for (int rep_ = 0; rep_ < 1 + (((PROBE_REPEAT_MASK) >> (k)) & 1); ++rep_, (rep_ < 1 + (((PROBE_REPEAT_MASK) >> (k)) & 1)) ? xcd_barrier(bar) : (void)0)
    const float* ada = (const float*)(F.ws + WS_ADA);

    if (IN(0)) REPS(0) { p0_prologue(F, in); } SEAM(0);
    if (IN(1)) REPS(1) {
        const int gw = F.vcu * NWAVES + F.wave, NGW = F.G * NWAVES; bf16* U = (bf16*)(F.ws + WS_U);
        for (int m = gw; m < M; m += 2 * NGW) { const int m2 = m + NGW < M ? m + NGW : m; const float* ad = ada + (size_t)(m / SEQ) * 12288; const float* ad2 = ada + (size_t)(m2 / SEQ) * 12288;
            norm_mod_row2(in[0] + (size_t)m * DM, in[0] + (size_t)m2 * DM, in[5], ad + 2048, ad, ad2 + 2048, ad2, U + (size_t)m * DM, U + (size_t)m2 * DM, F.lane); }
    } SEAM(1);
    if (IN(2)) REPS(2) {
        pg8::Gemm g{(const pg8::bf16_t*)(F.ws + WS_U), (const pg8::bf16_t*)(F.ws + WS_WIN_T), M, IN_COLS - 256, DM}; pg8::StaticOrder S; S.init(M, IN_COLS - 256, F.G, (int)blockIdx.x);
        pg8::EpiIn E{F.ws, (const float*)(F.ws + WS_ROPE), 0};
        pg8::gemm_phase<pg8::EpiIn, pg8::StaticOrder, PG8_ALIGN, PG8_SP2>(F.lds + RING_OFF, g, S, E);
    } SEAM(2);
    if (IN(5)) REPS(5) {
        const attn_body::AttnTensors AT{(const attn_body::bf16*)(F.ws + WS_Q), (const attn_body::bf16*)(F.ws + WS_K), (const attn_body::bf16*)(F.ws + WS_V), (attn_body::bf16*)(F.ws + WS_O0), (attn_body::bf16*)(F.ws + WS_O1)};
        const attn_body::StaticOrder S((int)F.G, F.vcu);
        attn_body::attn_phase<attn_body::StaticOrder>((char*)lds + RING_OFF, AT, S);
        __syncthreads();
    }
#if RWKV_SEQ
    if (IN(3)) REPS(3) { p3_rwkv_prep(F, in); } SEAM(3);
    if (IN(4)) REPS(4) { p4_rwkv_scan(F); } SEAM(4);
#else
    if (IN(3)) REPS(3) {
        {
            pg8::Gemm g{(const pg8::bf16_t*)(F.ws + WS_U), (const pg8::bf16_t*)(F.ws + WS_WIN_T) + (size_t)(IN_COLS - 256) * DM, M, 256, DM}; pg8::StaticOrder S; S.init(M, 256, F.G, (int)blockIdx.x);
            pg8::EpiIn E{F.ws, (const float*)(F.ws + WS_ROPE), 40};
            pg8::gemm_phase<pg8::EpiIn, pg8::StaticOrder, PG8_ALIGN, PG8_SP2>(F.lds + RING_OFF, g, S, E);
        }
        p3_rwkv_chunk(F, in); } SEAM(3);
    if (IN(4)) REPS(4) { p4_rwkv_chain(F); } SEAM(4);
#endif
    if (IN(6)) REPS(6) { p6_combine(F, in); } SEAM(6);
    if (IN(7)) REPS(7) {
        pg8::Gemm g{(const pg8::bf16_t*)(F.ws + WS_YATT), (const pg8::bf16_t*)(F.ws + WS_WUPA_T), M, DM, ATT_W}; pg8::StaticOrder S; S.init(M, DM, F.G, (int)blockIdx.x);
        pg8::EpiPair E{(const pg8::bf16_t*)(F.ws + WS_G), (pg8::bf16_t*)(F.ws + WS_MERGED)};
        pg8::gemm_phase_pair<pg8::EpiPair, pg8::StaticOrder, PG8_ALIGN, PG8_SP2>(F.lds + RING_OFF, g, (const pg8::bf16_t*)(F.ws + WS_YRW), (const pg8::bf16_t*)(F.ws + WS_WUPB_T), S, E);
    } SEAM(7);
    if (IN(8)) REPS(8) { }
    if (IN(9)) REPS(9) {
        pg8::Gemm g{(const pg8::bf16_t*)(F.ws + WS_MERGED), (const pg8::bf16_t*)(F.ws + WS_WOUT_T), M, DM, DM}; pg8::StaticOrder S; S.init(M, DM, F.G, (int)blockIdx.x);
        pg8::EpiH1 E{in[0], ada, (float*)(F.ws + WS_H1)};
        pg8::gemm_phase<pg8::EpiH1, pg8::StaticOrder, PG8_ALIGN, PG8_SP2>(F.lds + RING_OFF, g, S, E);
    } SEAM(9);
    if (IN(10)) REPS(10) { p10_route(F, in); } SEAM(10);
    if (IN(11)) REPS(11) { moe_gemm_pc<1>(F, in, false); } SEAM(11);
    if (IN(12)) REPS(12) { moe_gemm_pc<2>(F, in, IN(11)); } SEAM(12);
    if (IN(13)) REPS(13) { p14_final(F, in, args.out); }
#undef IN
#undef SEAM
}

extern "C" void kernel_launch(void* const* d_in, const int* in_sizes, int n_in, void* d_out, int out_size, void* d_ws, size_t ws_size, hipStream_t stream) {
    static int grid = 0;
    if (grid == 0) {
        if (n_in != 35 || out_size != M * DM || ws_size < WS_END) { fprintf(stderr, "kernel_launch: unexpected shapes (n_in %d out %d ws %zu)\n", n_in, out_size, ws_size); grid = -1; return; }
        int dev = 0, cus = 0;
        if (hipGetDevice(&dev) != hipSuccess || hipDeviceGetAttribute(&cus, hipDeviceAttributeMultiprocessorCount, dev) != hipSuccess) { grid = -1; return; }
        if (hipFuncSetAttribute((const void*)fwd_kernel, hipFuncAttributeMaxDynamicSharedMemorySize, LDS_BYTES) != hipSuccess) { fprintf(stderr, "kernel_launch: hipFuncSetAttribute failed\n"); grid = -1; return; }
        int per_cu = 0; (void)hipOccupancyMaxActiveBlocksPerMultiprocessor(&per_cu, (const void*)fwd_kernel, NTHR, LDS_BYTES); (void)hipGetLastError();
        if (per_cu < 1) fprintf(stderr, "kernel_launch: occupancy query says %d\n", per_cu);
        grid = cus;
    }
    if (grid < 0) return;
    (void)hipMemsetAsync((char*)d_ws + WS_CTL, 0, CTL_ZERO_BYTES, stream);
    Args a{};
    for (int i = 0; i < 35; ++i) a.in[i] = (const float*)d_in[i];
    a.out = (float*)d_out; a.ws = (unsigned char*)d_ws; a.pad = 0;
#if MK_ONE_LAUNCH
    a.ph_lo = 0; a.ph_hi = 14; a.use_bar = 1;
    hipLaunchKernelGGL(fwd_kernel, dim3(grid), dim3(NTHR), LDS_BYTES, stream, a);
#ifdef PROBE_PHASE
    a.ph_lo = PROBE_PHASE; a.ph_hi = PROBE_PHASE + 1; a.use_bar = 0; a.pad = 1;
    (void)hipMemsetAsync((char*)d_ws + WS_CTL + CW_P3Q * 4, 0, 16, stream);
    hipLaunchKernelGGL(fwd_kernel, dim3(grid), dim3(NTHR), LDS_BYTES, stream, a);
#endif
#else
    for (int p = 0; p < 14; ++p) { a.ph_lo = p; a.ph_hi = p + 1; a.use_bar = 0;
        hipLaunchKernelGGL(fwd_kernel, dim3(grid), dim3(NTHR), LDS_BYTES, stream, a); }
#endif
}
```

```cpp
#include <hip/hip_runtime.h>
#include <hip/hip_bf16.h>
#include <cstdio>
#include <cstdint>
#include <cmath>
namespace pg8 {
#define PG8_LAS __attribute__((address_space(3)))
typedef unsigned short bf16_t;
typedef short bf16x8 __attribute__((ext_vector_type(8)));
typedef float f32x4 __attribute__((ext_vector_type(4)));
typedef unsigned u32x4 __attribute__((ext_vector_type(4)));
constexpr int BM = 256, BK = 64, HALF = 128, HTB = HALF * BK * 2  , STAGE_BYTES = 8 * HTB, NXCD = 8, WGM = 8;

__host__ __device__ __forceinline__ int lds_byte(int r, int c) { const int st = (r >> 4) * 2 + (c >> 5), rr = r & 15, cc = c & 31, ob = rr * 64 + cc * 2; return st * 1024 + (ob ^ (((ob >> 9) & 1) << 5)); }
__host__ __device__ __forceinline__ void stage_rc(int b, int& R, int& C) { const int st = b / 1024, sb = b % 1024, swz = sb ^ (((sb >> 9) & 1) << 5); R = (st >> 1) * 16 + swz / 64; C = (st & 1) * 32 + (swz % 64) / 2; }
__host__ __device__ __forceinline__ int perm32(int rho) { const int n = rho >> 4, i = rho & 15; return 8 * (i >> 2) + 4 * n + (i & 3); }

struct Unit { int pm, pn; };
struct Gemm { const bf16_t* A; const bf16_t* Bt; int M, N, K; };

struct StaticOrder {
    int nM, nN, nwg, G, c;
    __host__ __device__ void init(int M, int N, int G_, int c_) { nM = M / BM; nN = N / BM; nwg = nM * nN; G = G_; c = c_; }
    __host__ __device__ bool next(int i, Unit& u) const {
        const long L = (long)i * G + c; if (L >= nwg) return false;
        int wgid = (int)L; { const int q = nwg / NXCD, r = nwg % NXCD, xcd = wgid % NXCD, off = wgid / NXCD; wgid = (xcd < r ? xcd * (q + 1) : r * (q + 1) + (xcd - r) * q) + off; }
        const int nig = WGM * nN, gid = wgid / nig, fm = gid * WGM, gsz = (nM - fm) < WGM ? (nM - fm) : WGM;
        u.pm = fm + ((wgid % nig) % gsz); u.pn = (wgid % nig) / gsz; return true;
    }
    __device__ __forceinline__ void a_ready(const Unit&) const {}
    __device__ __forceinline__ void done(const Unit&) const {}
};

__device__ __forceinline__ unsigned cvt_pk_bf16(float lo, float hi) { unsigned r; asm volatile("v_cvt_pk_bf16_f32 %0, %1, %2" : "=v"(r) : "v"(lo), "v"(hi)); return r; }
typedef float f32x2 __attribute__((ext_vector_type(2)));
__device__ __forceinline__ f32x2 gelu_pk(f32x2 v) {
    const f32x2 av = __builtin_elementwise_abs(v), d = av * 0.2316418882f + 1.0f;
    f32x2 t; t.x = __builtin_amdgcn_rcpf(d.x); t.y = __builtin_amdgcn_rcpf(d.y);
    f32x2 q = t * 0.5307027145f + (-0.7265760135f); q = q * t + 0.7107068705f; q = q * t + (-0.142248368f); q = q * t + 0.127414796f; q = q * t;
    const f32x2 s = (v * v) * (-0.72134752044f);
    f32x2 e; e.x = __builtin_amdgcn_exp2f(s.x); e.y = __builtin_amdgcn_exp2f(s.y);
    const f32x2 m = v * (q * e), r = v - m;
    f32x2 o; o.x = v.x < 0.f ? m.x : r.x; o.y = v.y < 0.f ? m.y : r.y; return o;
}


template <class Epi, class Sched, bool ALIGN_EPI = false, bool SP2 = false>
__device__ __forceinline__ void gemm_phase(PG8_LAS unsigned char* lds, const Gemm g, const Sched& S, const Epi& E) {
    int tid_ = threadIdx.x; asm volatile("" : "+v"(tid_));
    const int tid = tid_, wid = __builtin_amdgcn_readfirstlane(tid >> 6), lane = tid & 63, wr = wid >> 2, wc = wid & 3, fr = lane & 15, fq = lane >> 4;
    const int K = g.K, nt = K / BK;
    unsigned voffA[2], voffB[2];
#pragma unroll
    for (int i = 0; i < 2; ++i) { int R, C; stage_rc(tid * 16 + i * 8192, R, C); const int Rb = Epi::PERM ? ((R & ~31) + perm32(R & 31)) : R;
        voffA[i] = (unsigned)(R * K + C) * 2u; voffB[i] = (unsigned)(Rb * K + C) * 2u; }
    const size_t kstep = (size_t)(BK * 2);
    const size_t hstep = (size_t)HALF * K * 2;
    const size_t tstep = 2 * hstep;
    const unsigned ldsw = (unsigned)wid * 1024u;
    const int aoff = lds_byte(wr * 64 + fr, fq * 8), boff = lds_byte(wc * 32 + fr, fq * 8);
#define PG8_SA(b, h) (((b) * 2 + (h)) * HTB)
#define PG8_SB(b, h) ((4 + (b) * 2 + (h)) * HTB)
#define PG8_STAGE(bufoff, gbase, voff) do { _Pragma("unroll") for (int _i = 0; _i < 2; ++_i) \
        __builtin_amdgcn_global_load_lds((const unsigned*)((const char*)(gbase) + (voff)[_i]), (PG8_LAS unsigned*)(lds + (bufoff) + ldsw + _i * 8192), 16, 0, 0); } while (0)
#define PG8_LDA(dst, b, h) do { _Pragma("unroll") for (int m = 0; m < 4; ++m) _Pragma("unroll") for (int k = 0; k < 2; ++k) dst[m][k] = *(const PG8_LAS bf16x8*)(lds + PG8_SA(b, h) + aoff + m * 2048 + k * 1024); } while (0)
#define PG8_LDB(dst, b, h) do { _Pragma("unroll") for (int n = 0; n < 2; ++n) _Pragma("unroll") for (int k = 0; k < 2; ++k) dst[n][k] = *(const PG8_LAS bf16x8*)(lds + PG8_SB(b, h) + boff + n * 2048 + k * 1024); } while (0)
#define PG8_MMA(ai, bj, At, Bt) do { __builtin_amdgcn_s_setprio(1); _Pragma("unroll") for (int m = 0; m < 4; ++m) _Pragma("unroll") for (int n = 0; n < 2; ++n) _Pragma("unroll") for (int k = 0; k < 2; ++k) \
        acc[ai][bj][m][n] = __builtin_amdgcn_mfma_f32_16x16x32_bf16(Bt[n][k], At[m][k], acc[ai][bj][m][n], 0, 0, 0); __builtin_amdgcn_s_setprio(0); } while (0)
#define PG8_WAIT_V(n) asm volatile("s_waitcnt vmcnt(" #n ")" ::: "memory")
#define PG8_WAIT_L(n) asm volatile("s_waitcnt lgkmcnt(" #n ")" ::: "memory")
#define PG8_BAR __builtin_amdgcn_s_barrier()
#define PG8_SCHED __builtin_amdgcn_sched_barrier(0)
    Unit cur, nxt; int ui = 0;
    if (!S.next(0, cur)) return;
    f32x4 acc[2][2][4][2];
#pragma unroll
    for (int a = 0; a < 2; ++a)
#pragma unroll
        for (int b = 0; b < 2; ++b)
#pragma unroll
            for (int m = 0; m < 4; ++m)
#pragma unroll
                for (int n = 0; n < 2; ++n) acc[a][b][m][n] = (f32x4){0.f, 0.f, 0.f, 0.f};
    bf16x8 At[4][2], B0[2][2], B1[2][2];
    const char* cA = (const char*)g.A + (size_t)cur.pm * tstep; const char* cB = (const char*)g.Bt + (size_t)cur.pn * tstep;
    S.a_ready(cur);
    if constexpr (SP2) {
        PG8_STAGE(PG8_SB(0, 0), cB, voffB); PG8_STAGE(PG8_SB(0, 1), cB + hstep, voffB); PG8_STAGE(PG8_SA(0, 0), cA, voffA); PG8_STAGE(PG8_SA(0, 1), cA + hstep, voffA);
        if (wr == 1) PG8_BAR;
        PG8_WAIT_V(2); PG8_BAR;
        PG8_STAGE(PG8_SB(1, 0), cB + kstep, voffB); PG8_STAGE(PG8_SA(1, 0), cA + kstep, voffA); PG8_STAGE(PG8_SB(1, 1), cB + hstep + kstep, voffB);
        PG8_WAIT_V(6); PG8_BAR;
    } else {
        PG8_STAGE(PG8_SB(0, 0), cB, voffB); PG8_STAGE(PG8_SA(0, 0), cA, voffA); PG8_STAGE(PG8_SB(0, 1), cB + hstep, voffB); PG8_STAGE(PG8_SA(0, 1), cA + hstep, voffA);
        if (wr == 1) PG8_BAR;
        PG8_WAIT_V(4); PG8_BAR;
        PG8_STAGE(PG8_SB(1, 0), cB + kstep, voffB); PG8_STAGE(PG8_SA(1, 0), cA + kstep, voffA); PG8_STAGE(PG8_SB(1, 1), cB + hstep + kstep, voffB);
        PG8_WAIT_V(6); PG8_BAR;
    }
    for (;;) {
        const bool has_next = S.next(ui + 1, nxt);
        const char* nA = has_next ? (const char*)g.A + (size_t)nxt.pm * tstep : cA; const char* nB = has_next ? (const char*)g.Bt + (size_t)nxt.pn * tstep : cB;
        for (int t = 0; t < nt; t += 2) {
            const bool last = (t == nt - 2);
            const char* a1 = cA + (size_t)(t + 1) * kstep;
            const char* a2 = last ? nA : cA + (size_t)(t + 2) * kstep; const char* b2 = last ? nB : cB + (size_t)(t + 2) * kstep;
            const char* a3 = a2 + kstep; const char* b3 = b2 + kstep;
            if (last && has_next) S.a_ready(nxt);
            if constexpr (SP2) {
            PG8_LDB(B0, 0, 0); PG8_LDB(B1, 0, 1); PG8_SCHED; PG8_LDA(At, 0, 0); PG8_STAGE(PG8_SA(1, 1), a1 + hstep, voffA);
            PG8_WAIT_V(8); PG8_WAIT_L(0); PG8_BAR; PG8_MMA(0, 0, At, B0); PG8_MMA(0, 1, At, B1); PG8_BAR; PG8_SCHED;
            PG8_LDA(At, 0, 1); PG8_STAGE(PG8_SB(0, 0), b2, voffB); PG8_STAGE(PG8_SB(0, 1), b2 + hstep, voffB); PG8_STAGE(PG8_SA(0, 0), a2, voffA);
            PG8_WAIT_V(8); PG8_WAIT_L(0); PG8_BAR; PG8_MMA(1, 0, At, B0); PG8_MMA(1, 1, At, B1); PG8_BAR; PG8_SCHED;
            PG8_LDB(B0, 1, 0); PG8_LDB(B1, 1, 1); PG8_SCHED; PG8_LDA(At, 1, 0); PG8_STAGE(PG8_SA(0, 1), a2 + hstep, voffA);
            PG8_WAIT_V(8); PG8_WAIT_L(0); PG8_BAR; PG8_MMA(0, 0, At, B0); PG8_MMA(0, 1, At, B1); PG8_BAR; PG8_SCHED;
            PG8_LDA(At, 1, 1); PG8_STAGE(PG8_SB(1, 0), b3, voffB); PG8_STAGE(PG8_SB(1, 1), b3 + hstep, voffB); PG8_STAGE(PG8_SA(1, 0), a3, voffA);
            PG8_WAIT_V(8); PG8_WAIT_L(0); PG8_BAR; PG8_MMA(1, 0, At, B0); PG8_MMA(1, 1, At, B1); PG8_BAR; PG8_SCHED;
            } else {
            PG8_LDB(B0, 0, 0); PG8_SCHED; PG8_LDA(At, 0, 0); PG8_STAGE(PG8_SA(1, 1), a1 + hstep, voffA);
            PG8_WAIT_L(8); PG8_BAR; PG8_WAIT_L(0); PG8_MMA(0, 0, At, B0); PG8_BAR; PG8_SCHED;
            PG8_LDB(B1, 0, 1); PG8_STAGE(PG8_SB(0, 0), b2, voffB);
            PG8_BAR; PG8_WAIT_L(0); PG8_MMA(0, 1, At, B1); PG8_BAR;
            PG8_LDA(At, 0, 1); PG8_STAGE(PG8_SA(0, 0), a2, voffA);
            PG8_BAR; PG8_WAIT_L(0); PG8_MMA(1, 0, At, B0); PG8_BAR; PG8_SCHED;
            PG8_STAGE(PG8_SB(0, 1), b2 + hstep, voffB);
            PG8_WAIT_V(6); PG8_BAR; PG8_MMA(1, 1, At, B1); PG8_BAR;
            PG8_LDB(B0, 1, 0); PG8_SCHED; PG8_LDA(At, 1, 0); PG8_STAGE(PG8_SA(0, 1), a2 + hstep, voffA);
            PG8_WAIT_L(8); PG8_BAR; PG8_WAIT_L(0); PG8_MMA(0, 0, At, B0); PG8_BAR; PG8_SCHED;
            PG8_LDB(B1, 1, 1); PG8_STAGE(PG8_SB(1, 0), b3, voffB);
            PG8_BAR; PG8_WAIT_L(0); PG8_MMA(0, 1, At, B1); PG8_BAR;
            PG8_LDA(At, 1, 1); PG8_STAGE(PG8_SA(1, 0), a3, voffA);
            PG8_BAR; PG8_WAIT_L(0); PG8_MMA(1, 0, At, B0); PG8_BAR; PG8_SCHED;
            PG8_STAGE(PG8_SB(1, 1), b3 + hstep, voffB);
            PG8_WAIT_V(6); PG8_BAR; PG8_MMA(1, 1, At, B1); PG8_BAR;
            }
        }
        if constexpr (ALIGN_EPI) { if (wr == 0) PG8_BAR; }
        if constexpr (!Epi::AFTER_DRAIN) { E(acc, cur, wr, wc, fr, fq); S.done(cur); }
        if (!has_next) break;
#pragma unroll
        for (int a = 0; a < 2; ++a)
#pragma unroll
            for (int b = 0; b < 2; ++b)
#pragma unroll
                for (int m = 0; m < 4; ++m)
#pragma unroll
                    for (int n = 0; n < 2; ++n) acc[a][b][m][n] = (f32x4){0.f, 0.f, 0.f, 0.f};
        cur = nxt; cA = nA; cB = nB; ++ui;
        if constexpr (ALIGN_EPI) { if (wr == 1) PG8_BAR; }
    }
    PG8_WAIT_V(0);
    if constexpr (!ALIGN_EPI) { if (wr == 0) PG8_BAR; }
    PG8_BAR;
    if constexpr (Epi::AFTER_DRAIN) { E.fused(acc, cur, wr, wc, fr, fq, lds, wid, lane); S.done(cur); }
#undef PG8_SA
#undef PG8_SB
#undef PG8_STAGE
#undef PG8_LDA
#undef PG8_LDB
#undef PG8_MMA
#undef PG8_WAIT_V
#undef PG8_WAIT_L
#undef PG8_BAR
#undef PG8_SCHED
}
template <class Epi, class Sched, bool ALIGN_EPI = false, bool SP2 = false>
__device__ __forceinline__ void gemm_phase_pair(PG8_LAS unsigned char* lds, const Gemm g, const bf16_t* A2, const bf16_t* Bt2, const Sched& S, const Epi& E) {
    int tid_ = threadIdx.x; asm volatile("" : "+v"(tid_));
    const int tid = tid_, wid = __builtin_amdgcn_readfirstlane(tid >> 6), lane = tid & 63, wr = wid >> 2, wc = wid & 3, fr = lane & 15, fq = lane >> 4;
    const int K = g.K, nt = K / BK;
    unsigned voffA[2], voffB[2];
#pragma unroll
    for (int i = 0; i < 2; ++i) { int R, C; stage_rc(tid * 16 + i * 8192, R, C); const int Rb = Epi::PERM ? ((R & ~31) + perm32(R & 31)) : R;
        voffA[i] = (unsigned)(R * K + C) * 2u; voffB[i] = (unsigned)(Rb * K + C) * 2u; }
    const size_t kstep = (size_t)(BK * 2);
    const size_t hstep = (size_t)HALF * K * 2;
    const size_t tstep = 2 * hstep;
    const unsigned ldsw = (unsigned)wid * 1024u;
    const int aoff = lds_byte(wr * 64 + fr, fq * 8), boff = lds_byte(wc * 32 + fr, fq * 8);
#define PG8_SA(b, h) (((b) * 2 + (h)) * HTB)
#define PG8_SB(b, h) ((4 + (b) * 2 + (h)) * HTB)
#define PG8_STAGE(bufoff, gbase, voff) do { _Pragma("unroll") for (int _i = 0; _i < 2; ++_i) \
        __builtin_amdgcn_global_load_lds((const unsigned*)((const char*)(gbase) + (voff)[_i]), (PG8_LAS unsigned*)(lds + (bufoff) + ldsw + _i * 8192), 16, 0, 0); } while (0)
#define PG8_LDA(dst, b, h) do { _Pragma("unroll") for (int m = 0; m < 4; ++m) _Pragma("unroll") for (int k = 0; k < 2; ++k) dst[m][k] = *(const PG8_LAS bf16x8*)(lds + PG8_SA(b, h) + aoff + m * 2048 + k * 1024); } while (0)
#define PG8_LDB(dst, b, h) do { _Pragma("unroll") for (int n = 0; n < 2; ++n) _Pragma("unroll") for (int k = 0; k < 2; ++k) dst[n][k] = *(const PG8_LAS bf16x8*)(lds + PG8_SB(b, h) + boff + n * 2048 + k * 1024); } while (0)
#define PG8_MMA(ai, bj, At, Bt) do { __builtin_amdgcn_s_setprio(1); _Pragma("unroll") for (int m = 0; m < 4; ++m) _Pragma("unroll") for (int n = 0; n < 2; ++n) _Pragma("unroll") for (int k = 0; k < 2; ++k) \
        acc[ai][bj][m][n] = __builtin_amdgcn_mfma_f32_16x16x32_bf16(Bt[n][k], At[m][k], acc[ai][bj][m][n], 0, 0, 0); __builtin_amdgcn_s_setprio(0); } while (0)
#define PG8_WAIT_V(n) asm volatile("s_waitcnt vmcnt(" #n ")" ::: "memory")
#define PG8_WAIT_L(n) asm volatile("s_waitcnt lgkmcnt(" #n ")" ::: "memory")
#define PG8_BAR __builtin_amdgcn_s_barrier()
#define PG8_SCHED __builtin_amdgcn_sched_barrier(0)
    Unit cur, nxt; int ui = 0;
    if (!S.next(0, cur)) return;
    f32x4 acc[2][2][4][2];
#pragma unroll
    for (int a = 0; a < 2; ++a)
#pragma unroll
        for (int b = 0; b < 2; ++b)
#pragma unroll
            for (int m = 0; m < 4; ++m)
#pragma unroll
                for (int n = 0; n < 2; ++n) acc[a][b][m][n] = (f32x4){0.f, 0.f, 0.f, 0.f};
    bf16x8 At[4][2], B0[2][2], B1[2][2];
    const char* cA = (const char*)g.A + (size_t)cur.pm * tstep; const char* cB = (const char*)g.Bt + (size_t)cur.pn * tstep;
    S.a_ready(cur);
    if constexpr (SP2) {
        PG8_STAGE(PG8_SB(0, 0), cB, voffB); PG8_STAGE(PG8_SB(0, 1), cB + hstep, voffB); PG8_STAGE(PG8_SA(0, 0), cA, voffA); PG8_STAGE(PG8_SA(0, 1), cA + hstep, voffA);
        if (wr == 1) PG8_BAR;
        PG8_WAIT_V(2); PG8_BAR;
        PG8_STAGE(PG8_SB(1, 0), cB + kstep, voffB); PG8_STAGE(PG8_SA(1, 0), cA + kstep, voffA); PG8_STAGE(PG8_SB(1, 1), cB + hstep + kstep, voffB);
        PG8_WAIT_V(6); PG8_BAR;
    } else {
        PG8_STAGE(PG8_SB(0, 0), cB, voffB); PG8_STAGE(PG8_SA(0, 0), cA, voffA); PG8_STAGE(PG8_SB(0, 1), cB + hstep, voffB); PG8_STAGE(PG8_SA(0, 1), cA + hstep, voffA);
        if (wr == 1) PG8_BAR;
        PG8_WAIT_V(4); PG8_BAR;
        PG8_STAGE(PG8_SB(1, 0), cB + kstep, voffB); PG8_STAGE(PG8_SA(1, 0), cA + kstep, voffA); PG8_STAGE(PG8_SB(1, 1), cB + hstep + kstep, voffB);
        PG8_WAIT_V(6); PG8_BAR;
    }
    for (;;) {
        const int sel = ui & 1; bool has_next = true;
        if (sel == 0) nxt = cur; else has_next = S.next((ui + 1) >> 1, nxt);
        const char* nA = has_next ? (const char*)(sel == 0 ? A2 : g.A) + (size_t)nxt.pm * tstep : cA; const char* nB = has_next ? (const char*)(sel == 0 ? Bt2 : g.Bt) + (size_t)nxt.pn * tstep : cB;
        for (int t = 0; t < nt; t += 2) {
            const bool last = (t == nt - 2);
            const char* a1 = cA + (size_t)(t + 1) * kstep;
            const char* a2 = last ? nA : cA + (size_t)(t + 2) * kstep; const char* b2 = last ? nB : cB + (size_t)(t + 2) * kstep;
            const char* a3 = a2 + kstep; const char* b3 = b2 + kstep;
            if (last && has_next) S.a_ready(nxt);
            if constexpr (SP2) {
            PG8_LDB(B0, 0, 0); PG8_LDB(B1, 0, 1); PG8_SCHED; PG8_LDA(At, 0, 0); PG8_STAGE(PG8_SA(1, 1), a1 + hstep, voffA);
            PG8_WAIT_V(8); PG8_WAIT_L(0); PG8_BAR; PG8_MMA(0, 0, At, B0); PG8_MMA(0, 1, At, B1); PG8_BAR; PG8_SCHED;
            PG8_LDA(At, 0, 1); PG8_STAGE(PG8_SB(0, 0), b2, voffB); PG8_STAGE(PG8_SB(0, 1), b2 + hstep, voffB); PG8_STAGE(PG8_SA(0, 0), a2, voffA);
            PG8_WAIT_V(8); PG8_WAIT_L(0); PG8_BAR; PG8_MMA(1, 0, At, B0); PG8_MMA(1, 1, At, B1); PG8_BAR; PG8_SCHED;
            PG8_LDB(B0, 1, 0); PG8_LDB(B1, 1, 1); PG8_SCHED; PG8_LDA(At, 1, 0); PG8_STAGE(PG8_SA(0, 1), a2 + hstep, voffA);
            PG8_WAIT_V(8); PG8_WAIT_L(0); PG8_BAR; PG8_MMA(0, 0, At, B0); PG8_MMA(0, 1, At, B1); PG8_BAR; PG8_SCHED;
            PG8_LDA(At, 1, 1); PG8_STAGE(PG8_SB(1, 0), b3, voffB); PG8_STAGE(PG8_SB(1, 1), b3 + hstep, voffB); PG8_STAGE(PG8_SA(1, 0), a3, voffA);
            PG8_WAIT_V(8); PG8_WAIT_L(0); PG8_BAR; PG8_MMA(1, 0, At, B0); PG8_MMA(1, 1, At, B1); PG8_BAR; PG8_SCHED;
            } else {
            PG8_LDB(B0, 0, 0); PG8_SCHED; PG8_LDA(At, 0, 0); PG8_STAGE(PG8_SA(1, 1), a1 + hstep, voffA);
            PG8_WAIT_L(8); PG8_BAR; PG8_WAIT_L(0); PG8_MMA(0, 0, At, B0); PG8_BAR; PG8_SCHED;
            PG8_LDB(B1, 0, 1); PG8_STAGE(PG8_SB(0, 0), b2, voffB);
            PG8_BAR; PG8_WAIT_L(0); PG8_MMA(0, 1, At, B1); PG8_BAR;
            PG8_LDA(At, 0, 1); PG8_STAGE(PG8_SA(0, 0), a2, voffA);
            PG8_BAR; PG8_WAIT_L(0); PG8_MMA(1, 0, At, B0); PG8_BAR; PG8_SCHED;
            PG8_STAGE(PG8_SB(0, 1), b2 + hstep, voffB);
            PG8_WAIT_V(6); PG8_BAR; PG8_MMA(1, 1, At, B1); PG8_BAR;
            PG8_LDB(B0, 1, 0); PG8_SCHED; PG8_LDA(At, 1, 0); PG8_STAGE(PG8_SA(0, 1), a2 + hstep, voffA);
            PG8_WAIT_L(8); PG8_BAR; PG8_WAIT_L(0); PG8_MMA(0, 0, At, B0); PG8_BAR; PG8_SCHED;
            PG8_LDB(B1, 1, 1); PG8_STAGE(PG8_SB(1, 0), b3, voffB);
            PG8_BAR; PG8_WAIT_L(0); PG8_MMA(0, 1, At, B1); PG8_BAR;
            PG8_LDA(At, 1, 1); PG8_STAGE(PG8_SA(1, 0), a3, voffA);
            PG8_BAR; PG8_WAIT_L(0); PG8_MMA(1, 0, At, B0); PG8_BAR; PG8_SCHED;
            PG8_STAGE(PG8_SB(1, 1), b3 + hstep, voffB);
            PG8_WAIT_V(6); PG8_BAR; PG8_MMA(1, 1, At, B1); PG8_BAR;
            }
        }
        if constexpr (ALIGN_EPI) { if (wr == 0) PG8_BAR; }
        if (sel == 0) E.mid(acc, cur, wr, wc, fr, fq); else { E(acc, cur, wr, wc, fr, fq); S.done(cur); }
        if (!has_next) break;
        if (sel == 1) {
#pragma unroll
        for (int a = 0; a < 2; ++a)
#pragma unroll
            for (int b = 0; b < 2; ++b)
#pragma unroll
                for (int m = 0; m < 4; ++m)
#pragma unroll
                    for (int n = 0; n < 2; ++n) acc[a][b][m][n] = (f32x4){0.f, 0.f, 0.f, 0.f};
        }
        cur = nxt; cA = nA; cB = nB; ++ui;
        if constexpr (ALIGN_EPI) { if (wr == 1) PG8_BAR; }
    }
    PG8_WAIT_V(0);
    if constexpr (!ALIGN_EPI) { if (wr == 0) PG8_BAR; }
    PG8_BAR;
    if constexpr (Epi::AFTER_DRAIN) { E.fused(acc, cur, wr, wc, fr, fq, lds, wid, lane); S.done(cur); }
#undef PG8_SA
#undef PG8_SB
#undef PG8_STAGE
#undef PG8_LDA
#undef PG8_LDB
#undef PG8_MMA
#undef PG8_WAIT_V
#undef PG8_WAIT_L
#undef PG8_BAR
#undef PG8_SCHED
}
}

#ifndef PG8_SP2
#define PG8_SP2 true
#endif
#ifndef PG8_ALIGN
#define PG8_ALIGN true
#endif

namespace attn_body {
using bf16=__hip_bfloat16;
using bf16x8=__attribute__((ext_vector_type(8)))short;
using s16x4=__attribute__((ext_vector_type(4)))short;
using f32x16=__attribute__((ext_vector_type(16)))float;
using u32x4=__attribute__((ext_vector_type(4)))unsigned;
constexpr int BATCH=2,NHEAD=16,SEQ=4096,D=64,DM=NHEAD*D;
constexpr int NW=8,QBLK=32,QB=QBLK*NW,KVBLK=64,NQB=SEQ/QB;
constexpr int ATTN_PITCH=DM, ATTN_UNIT_ROWS=QB;
__device__ __forceinline__ int crow(int r,int hi){return (r&3)+8*(r>>2)+4*hi;}
#define SBAR() __builtin_amdgcn_sched_barrier(0)
__device__ __forceinline__ void cmask(f32x16&p0,f32x16&p1,int jb,int qrel,int hi){
  const float NEG=-INFINITY; int kb=64*jb+4*hi;
  #pragma unroll
  for(int r=0;r<16;++r){int kv=kb+(r&3)+8*(r>>2); if(kv>qrel)p0[r]=NEG; if(kv+32>qrel)p1[r]=NEG;}
}

constexpr int NSLOT=3, SLOTB=8192;
constexpr int LDS_K=0, LDS_V=NSLOT*SLOTB, LDS_WS=2*NSLOT*SLOTB, LDS_OST=LDS_WS+NW*64*4, LDS_BYTES=LDS_OST+NW*4096;
constexpr float C2=0.125f*1.4426950408889634f;
__device__ __forceinline__ void glds16(const void*gsrc,unsigned lds_dst){unsigned keep;
  asm volatile("s_mov_b32 %0, m0\n\ts_mov_b32 m0, %2\n\ts_nop 0\n\tglobal_load_lds_dwordx4 %1, off\n\ts_mov_b32 m0, %0":"=&s"(keep):"v"(gsrc),"s"(lds_dst):"memory");}
__device__ __forceinline__ float max3f(float a,float b,float c){float r;asm("v_max3_f32 %0, %1, %2, %3":"=v"(r):"v"(a),"v"(b),"v"(c));return r;}
__device__ __forceinline__ float max2f(float a,float b){float r;asm("v_max_f32_e32 %0, %1, %2":"=v"(r):"v"(a),"v"(b));return r;}
__device__ __forceinline__ float fadd_s(float a,float b){float r;asm("v_add_f32_e32 %0, %1, %2":"=v"(r):"v"(a),"v"(b));return r;}
__device__ __forceinline__ float fsub_s(float a,float b){float r;asm("v_sub_f32_e32 %0, %1, %2":"=v"(r):"v"(a),"v"(b));return r;}
typedef float f32x2_t __attribute__((ext_vector_type(2))); typedef __bf16 bf16x2_t __attribute__((ext_vector_type(2)));
__device__ __forceinline__ unsigned cvtpk_s(float lo,float hi){f32x2_t v={lo,hi};bf16x2_t b=__builtin_convertvector(v,bf16x2_t);return __builtin_bit_cast(unsigned,b);}
#define WAIT_BAR(N) asm volatile("s_waitcnt vmcnt(" #N ") lgkmcnt(0)\n\ts_barrier":::"memory")

__device__ __forceinline__ void qkt(f32x16&p0,f32x16&p1,const char*Kslot,const bf16x8*qr,const f32x16&negm,int r32,int hi){
  const char*kb=Kslot+hi*1024+r32*16;
  #pragma unroll
  for(int d0=0;d0<4;++d0){
    const bf16x8 b0=*reinterpret_cast<const bf16x8*>(kb+d0*2048);
    const bf16x8 b1=*reinterpret_cast<const bf16x8*>(kb+d0*2048+512);
    if(d0==0){p0=__builtin_amdgcn_mfma_f32_32x32x16_bf16(b0,qr[0],negm,0,0,0);p1=__builtin_amdgcn_mfma_f32_32x32x16_bf16(b1,qr[0],negm,0,0,0);}
    else{p0=__builtin_amdgcn_mfma_f32_32x32x16_bf16(b0,qr[d0],p0,0,0,0);p1=__builtin_amdgcn_mfma_f32_32x32x16_bf16(b1,qr[d0],p1,0,0,0);}}
}
typedef __attribute__((address_space(3))) const char* lds_cptr;
typedef short v4i16_t __attribute__((ext_vector_type(4)));
__device__ __forceinline__ void kload8(bf16x8*kf,lds_cptr kp){
  kf[0]=*(const __attribute__((address_space(3))) bf16x8*)(kp);      kf[1]=*(const __attribute__((address_space(3))) bf16x8*)(kp+512);
  kf[2]=*(const __attribute__((address_space(3))) bf16x8*)(kp+2048); kf[3]=*(const __attribute__((address_space(3))) bf16x8*)(kp+2560);
  kf[4]=*(const __attribute__((address_space(3))) bf16x8*)(kp+4096); kf[5]=*(const __attribute__((address_space(3))) bf16x8*)(kp+4608);
  kf[6]=*(const __attribute__((address_space(3))) bf16x8*)(kp+6144); kf[7]=*(const __attribute__((address_space(3))) bf16x8*)(kp+6656);
}
__device__ __forceinline__ void kload2(bf16x8*kf,lds_cptr kp,int j){ kf[2*j]=*(const __attribute__((address_space(3))) bf16x8*)(kp+j*2048); kf[2*j+1]=*(const __attribute__((address_space(3))) bf16x8*)(kp+j*2048+512); }
__device__ __forceinline__ s16x4 vtr(lds_cptr p){ return __builtin_bit_cast(s16x4,__builtin_amdgcn_ds_read_tr16_b64_v4i16((__attribute__((address_space(3))) v4i16_t*)p)); }
__device__ __forceinline__ float rowmax(const f32x16&p0,const f32x16&p1){
  float a=max3f(p0[0],p0[1],p1[0]),b=max3f(p0[2],p0[3],p1[1]);a=max3f(a,p1[2],p1[3]);
  #pragma unroll
  for(int r=4;r<16;r+=4){a=max3f(a,p0[r],p0[r+1]);b=max3f(b,p0[r+2],p0[r+3]);a=max3f(a,p1[r],p1[r+1]);b=max3f(b,p1[r+2],p1[r+3]);}
  const float m=max2f(a,b);
  auto rr=__builtin_amdgcn_permlane32_swap(__float_as_uint(m),__float_as_uint(m),false,false);
  return max2f(__uint_as_float(rr[0]),__uint_as_float(rr[1]));
}
__device__ __forceinline__ void pv(f32x16*o,int vb,bf16x8 pa0,bf16x8 pa1,bf16x8 pa2,bf16x8 pa3){
  #pragma unroll
  for(int d0=0;d0<2;++d0){s16x4 lo[4],hi[4];
    #pragma unroll
    for(int ks=0;ks<4;++ks){
      asm volatile("ds_read_b64_tr_b16 %0,%1 offset:%c2":"=&v"(lo[ks]):"v"(vb),"i"(d0*4096+ks*1024):"memory");
      asm volatile("ds_read_b64_tr_b16 %0,%1 offset:%c2":"=&v"(hi[ks]):"v"(vb),"i"(d0*4096+ks*1024+512):"memory");}
    asm volatile("s_waitcnt lgkmcnt(0)":::"memory");SBAR();
    #define PK(k) (bf16x8){lo[k][0],lo[k][1],lo[k][2],lo[k][3],hi[k][0],hi[k][1],hi[k][2],hi[k][3]}
    o[d0]=__builtin_amdgcn_mfma_f32_32x32x16_bf16(pa0,PK(0),o[d0],0,0,0);
    o[d0]=__builtin_amdgcn_mfma_f32_32x32x16_bf16(pa1,PK(1),o[d0],0,0,0);
    o[d0]=__builtin_amdgcn_mfma_f32_32x32x16_bf16(pa2,PK(2),o[d0],0,0,0);
    o[d0]=__builtin_amdgcn_mfma_f32_32x32x16_bf16(pa3,PK(3),o[d0],0,0,0);
    #undef PK
  }
}

#ifndef ATTN_STORE16
#define ATTN_STORE16(p,v) (*(u32x4*)(p)=(v))
#endif
template<int THRL> __device__ __forceinline__ void attn_unit(int b,int qkoff,int voff,int qb,const bf16*Q,const bf16*__restrict__ K,const bf16*__restrict__ V,bf16*O,char*shm){
  const int tid=threadIdx.x,lane=tid&63,r32=lane&31,hi=lane>>5; const int wid=__builtin_amdgcn_readfirstlane(tid>>6);
  const long rowbase=(long)b*SEQ; const int q0=qb*QB;
  const bf16*Qw=Q+(rowbase+q0+wid*QBLK)*DM+qkoff;
  const bf16*Kh=K+rowbase*DM+qkoff,*Vh=V+rowbase*DM+voff;
  const unsigned lds0=(unsigned)(uintptr_t)shm;
  float*wsf=(float*)(shm+LDS_WS)+wid*64;
  const bf16*ksrc=Kh+(long)lane*DM+wid*8;
  const bf16*vsrc=Vh+(long)(16*(wid&3)+(lane>>2))*DM+(wid>>2)*32+(lane&3)*8;
  const unsigned kdst=lds0+LDS_K+wid*1024, vdst=lds0+LDS_V+wid*1024;
  #define DMA_K(t,slot) glds16(ksrc+(long)(t)*KVBLK*DM,(unsigned)__builtin_amdgcn_readfirstlane(kdst+(slot)))
  #define DMA_V(t,slot) glds16(vsrc+(long)(t)*KVBLK*DM,(unsigned)__builtin_amdgcn_readfirstlane(vdst+(slot)))
  const int vb0=(int)(lds0+LDS_V)+((lane>>4)&1)*32+(lane&3)*8+(4*hi+((lane&15)>>2))*64;
  const char*Kbase=shm+LDS_K; bf16x8 kf[8];
  const lds_cptr shm3=(lds_cptr)shm; const lds_cptr kp0=shm3+LDS_K+hi*1024+r32*16; const lds_cptr vp0=shm3+LDS_V+((lane>>4)&1)*32+(lane&3)*8+(4*hi+((lane&15)>>2))*64;
  const int NT=(q0+QB)/KVBLK;
  DMA_K(0,0);DMA_V(0,0);DMA_K(1,SLOTB);
  bf16x8 qr[4];
  #pragma unroll
  for(int d0=0;d0<4;++d0)qr[d0]=*reinterpret_cast<const bf16x8*>(&Qw[(long)r32*DM+d0*16+hi*8]);
  float mhat=0.f,l_reg=0.f;f32x16 o[2];o[0]=f32x16{};o[1]=f32x16{};f32x16 negm=f32x16{};asm volatile("":"+v"(negm));
  const int qrel=wid*QBLK+r32;
  #define CMASK(P0,P1,t) do{int jb_=(t)-(NT-4); if(jb_>=0)cmask(P0,P1,jb_,qrel,hi);}while(0)
  bool resc=false;
  #define START(P0,P1) do{ const float rm=rowmax(P0,P1); resc=false; \
    { const float dl=rm; mhat=fadd_s(mhat,dl); \
      _Pragma("unroll") for(int r=0;r<16;++r){P0[r]=fsub_s(P0[r],dl);P1[r]=fsub_s(P1[r],dl);} \
      _Pragma("unroll") for(int r=0;r<16;++r)negm[r]=-mhat; asm volatile("":"+v"(negm)); } \
    _Pragma("unroll") for(int r=0;r<16;++r)P0[r]=__builtin_amdgcn_exp2f(P0[r]); }while(0)
  #define RESC() do{ if(resc){ asm volatile("s_waitcnt lgkmcnt(0)":::"memory"); \
      _Pragma("unroll") for(int d_=0;d_<2;++d_) _Pragma("unroll") for(int r=0;r<16;++r)o[d_][r]*=wsf[crow(r,hi)]; } }while(0)
  f32x16 pA0,pA1,pB0,pB1;
  int sl_prev=0,sl_cur=0,sl_next=SLOTB;
  #define ROT() do{sl_prev=sl_cur;sl_cur=sl_next;sl_next=(sl_next==(NSLOT-1)*SLOTB)?0:sl_next+SLOTB;}while(0)
  DMA_K(2,2*SLOTB);
  WAIT_BAR(3);
  qkt(pA0,pA1,Kbase,qr,negm,r32,hi);asm volatile("s_nop 15\n\ts_nop 7":"+v"(pA0),"+v"(pA1));CMASK(pA0,pA1,0);
  START(pA0,pA1);
  _Pragma("unroll") for(int r=0;r<16;++r)pA1[r]=__builtin_amdgcn_exp2f(pA1[r]);
  WAIT_BAR(0);
  DMA_K(3,0);DMA_V(1,SLOTB);
  ROT();
  kload8(kf,kp0+sl_cur);
  WAIT_BAR(2);
  s16x4 vlo[8],vhi[8]; u32x4 pw0,pw1,pw2,pw3;
  #define PKW(P,B) cvtpk_s(P[B],P[B+1])
  #define PAF(k) __builtin_bit_cast(bf16x8,pw##k)
  #define VFR(i) (bf16x8){vlo[i][0],vlo[i][1],vlo[i][2],vlo[i][3],vhi[i][0],vhi[i][1],vhi[i][2],vhi[i][3]}
  #define PIN(x) asm volatile("":"+v"(x))
  #define MX3(a,b,c) __builtin_fmaxf(__builtin_fmaxf((a),(b)),(c))
  #define GAPA(MF,A0,A1,A2,A3,W0,W1,PW) do{ MF; sacc+=A0; sacc+=A1; sacc+=A2; sacc+=A3; PIN(sacc); W0; W1; PIN(PW); SBAR(); }while(0)
  #define EX(v) __builtin_amdgcn_exp2f(v)
  #define GAPB(MF,X,B) do{ MF; X[B]=EX(X[B]); X[B+1]=EX(X[B+1]); X[B+2]=EX(X[B+2]); X[B+3]=EX(X[B+3]); PIN(X); SBAR(); }while(0)
  #define VRD(i) do{ vlo[i]=vtr(vp_+(((i)>>2)*4096+((i)&3)*1024)); vhi[i]=vtr(vp_+(((i)>>2)*4096+((i)&3)*1024+512)); }while(0)
  #define KRD(G,j) do{ if(G){ kload2(kf,kp0+sl_next,j); SBAR(); } }while(0)
  #define STEP(C0,C1,P0,P1,t,GK,GV,GL) do{ SBAR(); \
    const lds_cptr vp_=vp0+sl_prev; \
    VRD(0); SBAR(); float sacc=(P0[0]+P0[1]); \
    GAPA(C0=__builtin_amdgcn_mfma_f32_32x32x16_bf16(kf[0],qr[0],negm,0,0,0), P0[2],P0[3],P0[4],P0[5],     pw0[0]=PKW(P0,0), pw0[1]=PKW(P0,2), pw0); \
    VRD(4); SBAR(); GAPA(C1=__builtin_amdgcn_mfma_f32_32x32x16_bf16(kf[1],qr[0],negm,0,0,0), P0[6],P0[7],P0[8],P0[9],     pw0[2]=PKW(P0,4), pw0[3]=PKW(P0,6), pw0); \
    VRD(1); SBAR(); GAPA(C0=__builtin_amdgcn_mfma_f32_32x32x16_bf16(kf[2],qr[1],C0,0,0,0),   P0[10],P0[11],P0[12],P0[13], pw1[0]=PKW(P0,8), pw1[1]=PKW(P0,10), pw1); \
    VRD(5); SBAR(); GAPA(C1=__builtin_amdgcn_mfma_f32_32x32x16_bf16(kf[3],qr[1],C1,0,0,0),   P0[14],P0[15],P1[0],P1[1],   pw1[2]=PKW(P0,12),pw1[3]=PKW(P0,14), pw1); \
    VRD(2); SBAR(); GAPA(C0=__builtin_amdgcn_mfma_f32_32x32x16_bf16(kf[4],qr[2],C0,0,0,0),   P1[2],P1[3],P1[4],P1[5],     pw2[0]=PKW(P1,0), pw2[1]=PKW(P1,2), pw2); \
    VRD(6); SBAR(); GAPA(C1=__builtin_amdgcn_mfma_f32_32x32x16_bf16(kf[5],qr[2],C1,0,0,0),   P1[6],P1[7],P1[8],P1[9],     pw2[2]=PKW(P1,4), pw2[3]=PKW(P1,6), pw2); \
    VRD(3); SBAR(); GAPA(C0=__builtin_amdgcn_mfma_f32_32x32x16_bf16(kf[6],qr[3],C0,0,0,0),   P1[10],P1[11],P1[12],P1[13], pw3[0]=PKW(P1,8), pw3[1]=PKW(P1,10), pw3); \
    VRD(7); SBAR(); GAPA(C1=__builtin_amdgcn_mfma_f32_32x32x16_bf16(kf[7],qr[3],C1,0,0,0),   P1[14],P1[15],0.f,0.f,       pw3[2]=PKW(P1,12),pw3[3]=PKW(P1,14), pw3); \
    l_reg+=sacc; \
    if(GK){DMA_K((t)+3,sl_cur);} if(GV){DMA_V((t)+1,sl_next);} \
    CMASK(C0,C1,t); \
    { float a=MX3(C0[0],C0[1],C1[0]),b=MX3(C0[2],C0[3],C1[1]); a=MX3(a,C1[2],C1[3]); \
      _Pragma("unroll") for(int r=4;r<16;r+=4){a=MX3(a,C0[r],C0[r+1]);b=MX3(b,C0[r+2],C0[r+3]);a=MX3(a,C1[r],C1[r+1]);b=MX3(b,C1[r+2],C1[r+3]);} \
      float rm=__builtin_fmaxf(a,b); { auto rr=__builtin_amdgcn_permlane32_swap(__float_as_uint(rm),__float_as_uint(rm),false,false); rm=__builtin_fmaxf(__uint_as_float(rr[0]),__uint_as_float(rr[1])); } \
      resc=false; \
      if(__builtin_expect(__any(rm>(float)THRL),0)){ const float dl=__builtin_fmaxf(rm,0.f); mhat+=dl; \
        _Pragma("unroll") for(int r=0;r<16;++r){C0[r]-=dl;C1[r]-=dl;} \
        _Pragma("unroll") for(int r=0;r<16;++r)negm[r]=-mhat; asm volatile("":"+v"(negm)); \
        const float f=__builtin_amdgcn_exp2f(-dl); l_reg*=f; if(hi==0)wsf[r32]=f; resc=true; } } \
    SBAR(); \
    GAPB(o[0]=__builtin_amdgcn_mfma_f32_32x32x16_bf16(PAF(0),VFR(0),o[0],0,0,0), C0,0); \
    GAPB(o[1]=__builtin_amdgcn_mfma_f32_32x32x16_bf16(PAF(0),VFR(4),o[1],0,0,0), C0,4); \
    KRD(GL,0); GAPB(o[0]=__builtin_amdgcn_mfma_f32_32x32x16_bf16(PAF(1),VFR(1),o[0],0,0,0), C0,8); \
    KRD(GL,1); GAPB(o[1]=__builtin_amdgcn_mfma_f32_32x32x16_bf16(PAF(1),VFR(5),o[1],0,0,0), C0,12); \
    KRD(GL,2); GAPB(o[0]=__builtin_amdgcn_mfma_f32_32x32x16_bf16(PAF(2),VFR(2),o[0],0,0,0), C1,0); \
    KRD(GL,3); GAPB(o[1]=__builtin_amdgcn_mfma_f32_32x32x16_bf16(PAF(2),VFR(6),o[1],0,0,0), C1,4); \
    GAPB(o[0]=__builtin_amdgcn_mfma_f32_32x32x16_bf16(PAF(3),VFR(3),o[0],0,0,0), C1,8); \
    GAPB(o[1]=__builtin_amdgcn_mfma_f32_32x32x16_bf16(PAF(3),VFR(7),o[1],0,0,0), C1,12); \
    }while(0)
  int t=1;
  #undef CMASK
  #define CMASK(P0,P1,t) do{}while(0)
  for(;t+5<NT;t+=2){
    STEP(pB0,pB1,pA0,pA1,t,true,true,true);     WAIT_BAR(2); RESC(); ROT();
    STEP(pA0,pA1,pB0,pB1,t+1,true,true,true);   WAIT_BAR(2); RESC(); ROT();
  }
  #undef CMASK
  #define CMASK(P0,P1,t) do{int jb_=(t)-(NT-4); if(jb_>=0)cmask(P0,P1,jb_,qrel,hi);}while(0)
  #define ENDW(tt) do{ if((tt)+3<NT){WAIT_BAR(2);} else if((tt)+2<NT){WAIT_BAR(1);} else {WAIT_BAR(0);} }while(0)
  for(;t+1<NT;t+=2){
    STEP(pB0,pB1,pA0,pA1,t,(t+3<NT),(t+1<NT),(t+1<NT));       ENDW(t);   RESC(); ROT();
    STEP(pA0,pA1,pB0,pB1,t+1,(t+4<NT),(t+2<NT),(t+2<NT));     ENDW(t+1); RESC(); ROT();
  }
  STEP(pB0,pB1,pA0,pA1,NT-1,false,false,false); RESC();
  { float sacc=pB0[0]+pB0[1]; _Pragma("unroll") for(int r=2;r<16;++r)sacc+=pB0[r]; _Pragma("unroll") for(int r=0;r<16;++r)sacc+=pB1[r]; l_reg+=sacc;
    pw0=(u32x4){PKW(pB0,0),PKW(pB0,2),PKW(pB0,4),PKW(pB0,6)};pw1=(u32x4){PKW(pB0,8),PKW(pB0,10),PKW(pB0,12),PKW(pB0,14)};pw2=(u32x4){PKW(pB1,0),PKW(pB1,2),PKW(pB1,4),PKW(pB1,6)};pw3=(u32x4){PKW(pB1,8),PKW(pB1,10),PKW(pB1,12),PKW(pB1,14)};
    SBAR(); pv(o,vb0+sl_cur,PAF(0),PAF(1),PAF(2),PAF(3)); }
  #undef PKW
  #undef PAF
  #undef VFR
  #undef PIN
  #undef MX3
  #undef GAPA
  #undef GAPB
  #undef EX
  #undef VRD
  #undef KRD
  #undef STEP
  #undef ENDW
  {auto rr=__builtin_amdgcn_permlane32_swap(__float_as_uint(l_reg),__float_as_uint(l_reg),false,false);l_reg=__uint_as_float(rr[0])+__uint_as_float(rr[1]);}
  if(hi==0)wsf[32+r32]=l_reg;asm volatile("s_waitcnt lgkmcnt(0)":::"memory");
  float rli[16];
  #pragma unroll
  for(int r=0;r<16;++r)rli[r]=__builtin_amdgcn_rcpf(wsf[32+crow(r,hi)]);
  bf16*Ow=O+(rowbase+q0+wid*QBLK)*DM+voff;
  { bf16*stg=(bf16*)(shm+LDS_OST)+wid*2048;
    #pragma unroll
    for(int r=0;r<16;++r){const int orow=crow(r,hi);
      #pragma unroll
      for(int d0=0;d0<2;++d0)stg[orow*64+d0*32+r32]=__float2bfloat16(o[d0][r]*rli[r]);}
    asm volatile("s_waitcnt lgkmcnt(0)":::"memory");
    #pragma unroll
    for(int i=0;i<4;++i){const int row=i*8+(lane>>3),ch=lane&7; const u32x4 v=*(const u32x4*)(stg+row*64+ch*8); ATTN_STORE16(Ow+(long)row*DM+ch*8,v);} }
  asm volatile("s_waitcnt lgkmcnt(0)\n\ts_barrier":::"memory");
  #undef DMA_K
  #undef DMA_V
  #undef CMASK
  #undef START
  #undef RESC
  #undef ROT
}
constexpr int ATTN_LDS_BYTES=LDS_BYTES;
struct AttnTensors { const bf16* Q; const bf16* K; const bf16* V; bf16* O0; bf16* O1; };
struct AttnUnit { int vh; int qb; };
struct StaticOrder {
  int vcu, G;
  __device__ __forceinline__ explicit StaticOrder(int grid,int vcu_):vcu(vcu_),G(grid){}
  __device__ __forceinline__ bool next(int i,AttnUnit&u)const{
    if(G==256){ if(i>=4)return false; const int s=vcu&3; u.vh=vcu>>2; u.qb=(i==0)?s:(i==1)?7-s:(i==2)?8+s:15-s; return true; }
    const int L=i*G+vcu; if(L>=64*NQB)return false; u.vh=L&63; u.qb=NQB-1-(L>>6); return true; }
  __device__ __forceinline__ void a_ready(const AttnUnit&)const{}
  __device__ __forceinline__ void done(const AttnUnit&)const{}
};
template<class Sched,int THRL=8> __device__ __forceinline__ void attn_phase(char*lds,const AttnTensors&T,const Sched&S){
  AttnUnit u;
  for(int i=0;S.next(i,u);++i){ S.a_ready(u);
    const int b=u.vh>>5,h=(u.vh>>2)&7,c=(u.vh>>1)&1,half=u.vh&1;
    attn_unit<THRL>(b,h*128+c*64,h*128+half*64,u.qb,T.Q,T.K,T.V,c?T.O1:T.O0,lds); S.done(u); }
}
#undef SBAR
#undef WAIT_BAR
}

#define GAS __attribute__((address_space(1)))
#define LAS __attribute__((address_space(3)))
typedef unsigned short bf16;
typedef unsigned v4u __attribute__((ext_vector_type(4)));
typedef unsigned v2u __attribute__((ext_vector_type(2)));
typedef float f32x4 __attribute__((ext_vector_type(4)));
typedef short bf16x8 __attribute__((ext_vector_type(8)));
typedef GAS unsigned gu32;
typedef GAS unsigned long long gu64;
#define RLX_AGENT __ATOMIC_RELAXED, __HIP_MEMORY_SCOPE_AGENT
#define LDS_WAIT() asm volatile("s_waitcnt lgkmcnt(0)" ::: "memory")
#define VM_WAIT() asm volatile("s_waitcnt vmcnt(0)" ::: "memory")
__device__ __forceinline__ unsigned long long rt() { return __builtin_amdgcn_s_memrealtime(); }
__device__ __forceinline__ unsigned f2bf(float f) { unsigned u = __builtin_bit_cast(unsigned, f); return (u + 0x7fffu + ((u >> 16) & 1u)) >> 16; }
typedef float f32x2_hw __attribute__((ext_vector_type(2))); typedef __bf16 bf16x2_hw __attribute__((ext_vector_type(2)));
__device__ __forceinline__ unsigned pk2(float lo, float hi) { const f32x2_hw v = {lo, hi}; return __builtin_bit_cast(unsigned, __builtin_convertvector(v, bf16x2_hw)); }

#define XB_TMO      128
#define XB_XCNT(j)  (256  + 64 * (j))
#define XB_XSUB(j)  (1280 + 64 * (j))
#define XB_XGEN(j)  (2304 + 64 * (j))
#define XB_TOP      3328
#define XB_TOPGEN   3392
#define XCD_BAR_WORDS 3456
#define XB_SPIN_CAP (1u << 18)

__device__ __forceinline__ unsigned xb_ld(unsigned* p)              { return __hip_atomic_load(p, __ATOMIC_RELAXED, __HIP_MEMORY_SCOPE_AGENT); }
__device__ __forceinline__ unsigned xb_add(unsigned* p, unsigned v) { return __hip_atomic_fetch_add(p, v, __ATOMIC_RELAXED, __HIP_MEMORY_SCOPE_AGENT); }
__device__ __forceinline__ unsigned xb_xcc_id() { return (unsigned)__builtin_amdgcn_s_getreg((3 << 11) | 20) & 0xFu; }
#define XB_SPIN(cond, bar) do { unsigned _sp = 0; while (cond) { __builtin_amdgcn_s_sleep(1); \
    if ((++_sp & 255u) == 0u) { if (xb_ld(&(bar)[XB_TMO])) break; if (_sp > XB_SPIN_CAP) { atomicAdd(&(bar)[XB_TMO], 1u); break; } } } } while (0)

struct XcdBarrier {
    unsigned* bar; unsigned x;
    volatile LAS unsigned* st;
};

__device__ __forceinline__ XcdBarrier xcd_barrier_post(unsigned* bar, volatile LAS unsigned* st) {
    XcdBarrier b; b.bar = bar; b.x = xb_xcc_id(); b.st = st;
    if (threadIdx.x == 0) (void)xb_add(&bar[XB_XCNT(b.x)], 1u);
    return b;
}
__device__ __forceinline__ void xcd_barrier_complete(unsigned* bar, unsigned x, unsigned& nloc, unsigned& nx) {
    const unsigned G = gridDim.x * gridDim.y * gridDim.z;
    unsigned sum, cnt, mine, sp = 0u;
    for (;;) {
        sum = 0u; cnt = 0u; mine = 0u;
#pragma unroll
        for (unsigned j = 0; j < 16; ++j) { const unsigned c = xb_ld(&bar[XB_XCNT(j)]); sum += c; cnt += (c > 0u) ? 1u : 0u; mine = (j == x) ? c : mine; }
        if (sum == G) break;
        __builtin_amdgcn_s_sleep(1);
        if ((++sp & 255u) == 0u) { if (xb_ld(&bar[XB_TMO])) break; if (sp > XB_SPIN_CAP) { atomicAdd(&bar[XB_TMO], 1u); break; } }
    }
    nloc = mine > 0u ? mine : 1u; nx = cnt > 0u ? cnt : 1u;
}

__device__ __forceinline__ void xcd_barrier(const XcdBarrier& b) {
    asm volatile("s_waitcnt vmcnt(0)" ::: "memory");
    __syncthreads();
    if (threadIdx.x == 0) {
        unsigned* bar = b.bar;
        __builtin_amdgcn_s_waitcnt(0);
        unsigned nloc = b.st[0], nx = b.st[1];
        if (nloc == 0u) { xcd_barrier_complete(bar, b.x, nloc, nx); b.st[0] = nloc; b.st[1] = nx; }
        const unsigned old = xb_add(&bar[XB_XSUB(b.x)], 1u);
        const unsigned gen = old / nloc;
        if (old + 1u == (gen + 1u) * nloc) {
            __builtin_amdgcn_fence(__ATOMIC_RELEASE, "agent");
            asm volatile("s_waitcnt vmcnt(0)" ::: "memory");
            const unsigned og = xb_add(&bar[XB_TOP], 1u);
            const unsigned tg = og / nx;
            if (og + 1u == (tg + 1u) * nx) xb_add(&bar[XB_TOPGEN], 1u);
            else XB_SPIN(xb_ld(&bar[XB_TOPGEN]) == tg, bar);
            __builtin_amdgcn_fence(__ATOMIC_ACQUIRE, "agent");
            xb_add(&bar[XB_XGEN(b.x)], 1u);
            asm volatile("s_waitcnt vmcnt(0)" ::: "memory");
        } else {
            XB_SPIN(xb_ld(&bar[XB_XGEN(b.x)]) == gen, bar);
            __builtin_amdgcn_fence(__ATOMIC_ACQUIRE, "agent");
            asm volatile("s_waitcnt vmcnt(0)" ::: "memory");
        }
    }
    __syncthreads();
}

constexpr int NWAVES = 8, NTHR = 512;
constexpr int BATCH = 2, SEQ = 4096, DM = 2048, M = BATCH * SEQ;
constexpr int ATT_W = 1024, RW_W = 1024, RW_COLS = 3328, GATE_COLS = 4096, IN_COLS = 10496;
constexpr int NEXP = 64, EFF = 1024, CAP = 8192;
constexpr float NORM_EPS = 1e-6f, SUBLN_EPS = 1e-5f, LNX_EPS = 64e-5f;
constexpr float LAMBDA_INIT = 0.2f;
#ifndef RWKV_SEQ
#define RWKV_SEQ 0
#endif
#ifndef MK_ONE_LAUNCH
#define MK_ONE_LAUNCH 1
#endif
constexpr int NPHASE = 14;

constexpr size_t MiB = 1u << 20;
constexpr size_t WS_CTL = 0, CTL_ZERO_BYTES = 1 * MiB;
constexpr size_t WS_ADA = 1 * MiB;
constexpr size_t WS_ROPE = 1 * MiB + 512 * 1024;
constexpr size_t WS_W2T = 2 * MiB;
constexpr size_t WS_A2T = 2 * MiB + 128 * 1024;
constexpr size_t WS_G2T = 2 * MiB + 256 * 1024;
constexpr size_t WS_TOKE = 3 * MiB;
constexpr size_t WS_TOKP = 3 * MiB + 64 * 1024;
constexpr size_t WS_TOKW = 3 * MiB + 128 * 1024;
constexpr size_t WS_LIST = 4 * MiB;
constexpr size_t WS_WRH = 6 * MiB, WS_WRL = 7 * MiB;
constexpr size_t WS_WIN_T = 8 * MiB;
constexpr size_t WS_WUPA_T = 50 * MiB, WS_WUPB_T = 54 * MiB, WS_WOUT_T = 58 * MiB;
constexpr size_t WS_U = 68 * MiB;
constexpr size_t WS_Q = 100 * MiB, WS_K = 116 * MiB, WS_V = 132 * MiB;
constexpr size_t WS_PR = 148 * MiB;
constexpr size_t WS_G = 200 * MiB;
constexpr size_t WS_O0 = 264 * MiB, WS_O1 = 280 * MiB;
constexpr size_t WS_YATT = 296 * MiB, WS_YRW = 312 * MiB;
constexpr size_t WS_MERGED = 392 * MiB;
constexpr size_t WS_H1 = 424 * MiB;
constexpr size_t WS_U2 = 328 * MiB;
constexpr size_t WS_ACT = 520 * MiB;
constexpr int U2P = 2048 + 64, ACTP = 1024 + 64;
constexpr size_t WS_YS = 560 * MiB;
constexpr size_t WS_RW = 632 * MiB;
constexpr size_t RW_ARR = 32 * MiB;
constexpr size_t WS_END = WS_RW + 9 * RW_ARR;
constexpr int CW_TMO = 0, CW_CODE = 1, CW_BAR = 4096, CW_CNT = 8192, CW_P3Q = 8192 + 128;

constexpr int RING_OFF = 0, RING_BYTES = 159744;
constexpr int LDSCTL_OFF = RING_BYTES, MISC_OFF = LDSCTL_OFF + 320;
constexpr int LDS_BYTES = 163840;

__device__ __forceinline__ float bf2f(unsigned short h) { return __builtin_bit_cast(float, (unsigned)h << 16); }
__device__ __forceinline__ float bflo(unsigned w) { return __builtin_bit_cast(float, w << 16); }
__device__ __forceinline__ float bfhi(unsigned w) { return __builtin_bit_cast(float, w & 0xffff0000u); }
__device__ __forceinline__ float wave_sum(float v) {
#pragma unroll
    for (int o = 1; o < 64; o <<= 1) v += __shfl_xor(v, o);
    return v;
}
template <int CTRL> __device__ __forceinline__ float dpp_f(float x) { return __builtin_bit_cast(float, __builtin_amdgcn_update_dpp(0, __builtin_bit_cast(int, x), CTRL, 0xF, 0xF, true)); }
__device__ __forceinline__ float sum8(float x) {
    x += dpp_f<0xB1>(x); x += dpp_f<0x4E>(x); x += dpp_f<0x141>(x); return x; }
__device__ __forceinline__ float sum4(float x) { x += dpp_f<0xB1>(x); x += dpp_f<0x4E>(x); return x; }
__device__ __forceinline__ float sigmoidf_(float x) { return 1.f / (1.f + __expf(-x)); }

struct Frame {
    LAS unsigned char* lds;
    volatile LAS unsigned* MISC;
    gu32* ctl;
    int tid, lane, wave, vcu, G, probe;
    unsigned char* ws;
};

namespace pg8 {
constexpr float QSCALE = 0.125f * 1.4426950408889634f;
struct EpiIn {
    static constexpr bool PERM = true, AFTER_DRAIN = false;
    unsigned char* ws; const float* rope; int pn_off;
    __device__ __forceinline__ void operator()(const f32x4 (&acc)[2][2][4][2], const Unit& u, int wr, int wc, int fr, int fq) const {
        const int row0 = u.pm * BM + wr * 64 + fr, pn = u.pn + pn_off, cw = wc * 32 + 8 * fq;
        if (pn < 8) {
            const int isk = pn >= 4 ? 1 : 0;
            bf16_t* base = (bf16_t*)(ws + WS_Q + (size_t)isk * (WS_K - WS_Q)); const float sc = isk ? 1.f : QSCALE; const int colt = (pn & 3) * 256 + cw;
            const bool ropew = ((wc & 1) == 0);
#pragma unroll
            for (int ai = 0; ai < 2; ++ai)
#pragma unroll
                for (int m = 0; m < 4; ++m) { const int row = row0 + ai * HALF + m * 16; bf16_t* rowp = base + (size_t)row * 1024 + colt;
                    f32x4 c0 = {1.f, 1.f, 1.f, 1.f}, c1 = c0, s0 = {0.f, 0.f, 0.f, 0.f}, s1 = s0;
                    if (ropew) { const f32x4* rp = (const f32x4*)(rope + (size_t)row * 16); c0 = rp[0]; c1 = rp[1]; s0 = rp[2]; s1 = rp[3]; }
#pragma unroll
                    for (int bj = 0; bj < 2; ++bj) { f32x4 v0 = acc[ai][bj][m][0], v1 = acc[ai][bj][m][1];
                        if (ropew) { f32x4 p0, p1;
                            p0[0] = __shfl_xor(v0[0], 16); p0[1] = __shfl_xor(v0[1], 16); p0[2] = __shfl_xor(v0[2], 16); p0[3] = __shfl_xor(v0[3], 16);
                            p1[0] = __shfl_xor(v1[0], 16); p1[1] = __shfl_xor(v1[1], 16); p1[2] = __shfl_xor(v1[2], 16); p1[3] = __shfl_xor(v1[3], 16);
                            if (fq == 0) { v0 = v0 * c0 - p0 * s0; v1 = v1 * c1 - p1 * s1; }
                            else if (fq == 1) { v0 = p0 * s0 + v0 * c0; v1 = p1 * s1 + v1 * c1; } }
                        v0 = v0 * sc; v1 = v1 * sc; u32x4 w; w.x = cvt_pk_bf16(v0[0], v0[1]); w.y = cvt_pk_bf16(v0[2], v0[3]); w.z = cvt_pk_bf16(v1[0], v1[1]); w.w = cvt_pk_bf16(v1[2], v1[3]);
                        *(u32x4*)(rowp + bj * HALF) = w; } }
        } else {
            const int c1 = pn >= 12 ? 1 : 0, c2 = pn >= 25 ? 1 : 0;
            bf16_t* base = (bf16_t*)(ws + WS_V + (size_t)c1 * (WS_PR - WS_V) + (size_t)c2 * (WS_G - WS_PR));
            const int ldc = 1024 + c1 * (RW_COLS - 1024) + c2 * (GATE_COLS - RW_COLS);
            const int colt = (pn - 8 - 4 * c1 - 13 * c2) * 256 + cw;
            const bool sg = pn >= 25;
#pragma unroll
            for (int ai = 0; ai < 2; ++ai)
#pragma unroll
                for (int m = 0; m < 4; ++m) { bf16_t* rowp = base + (size_t)(row0 + ai * HALF + m * 16) * ldc + colt;
#pragma unroll
                    for (int bj = 0; bj < 2; ++bj) { f32x4 v0 = acc[ai][bj][m][0], v1 = acc[ai][bj][m][1];
                        if (sg) { v0[0] = sigmoidf_(v0[0]); v0[1] = sigmoidf_(v0[1]); v0[2] = sigmoidf_(v0[2]); v0[3] = sigmoidf_(v0[3]);
                                  v1[0] = sigmoidf_(v1[0]); v1[1] = sigmoidf_(v1[1]); v1[2] = sigmoidf_(v1[2]); v1[3] = sigmoidf_(v1[3]); }
                        u32x4 w; w.x = cvt_pk_bf16(v0[0], v0[1]); w.y = cvt_pk_bf16(v0[2], v0[3]); w.z = cvt_pk_bf16(v1[0], v1[1]); w.w = cvt_pk_bf16(v1[2], v1[3]);
                        *(u32x4*)(rowp + bj * HALF) = w; } }
        }
    }
};
struct EpiT1 {
    static constexpr bool PERM = false, AFTER_DRAIN = false;
    float* T1; const bf16_t* G;
    __device__ __forceinline__ void operator()(const f32x4 (&acc)[2][2][4][2], const Unit& u, int wr, int wc, int fr, int fq) const {
        const int row0 = u.pm * BM + wr * 64 + fr, col0 = u.pn * BM + wc * 32 + 4 * fq;
#pragma unroll
        for (int ai = 0; ai < 2; ++ai)
#pragma unroll
            for (int m = 0; m < 4; ++m) { const size_t row = (size_t)(row0 + ai * HALF + m * 16);
#pragma unroll
                for (int bj = 0; bj < 2; ++bj)
#pragma unroll
                    for (int n = 0; n < 2; ++n) { const int c = col0 + bj * HALF + n * 16; const uint2 gw = *(const uint2*)(G + row * GATE_COLS + c);
                        f32x4 a = acc[ai][bj][m][n]; a[0] *= bflo(gw.x); a[1] *= bfhi(gw.x); a[2] *= bflo(gw.y); a[3] *= bfhi(gw.y);
                        *(f32x4*)(T1 + row * DM + c) = a; } }
    }
};
struct EpiMerge {
    static constexpr bool PERM = true, AFTER_DRAIN = false;
    const float* T1; const bf16_t* G; bf16_t* O;
    __device__ __forceinline__ void operator()(const f32x4 (&acc)[2][2][4][2], const Unit& u, int wr, int wc, int fr, int fq) const {
        const int row0 = u.pm * BM + wr * 64 + fr, col0 = u.pn * BM + wc * 32 + 8 * fq;
#pragma unroll
        for (int ai = 0; ai < 2; ++ai)
#pragma unroll
            for (int m = 0; m < 4; ++m) { const size_t row = (size_t)(row0 + ai * HALF + m * 16);
#pragma unroll
                for (int bj = 0; bj < 2; ++bj) { const int c = col0 + bj * HALF; const u32x4 gw = *(const u32x4*)(G + row * GATE_COLS + 2048 + c);
                    const f32x4 t0 = *(const f32x4*)(T1 + row * DM + c), t1 = *(const f32x4*)(T1 + row * DM + c + 4);
                    f32x4 v0 = acc[ai][bj][m][0], v1 = acc[ai][bj][m][1];
                    v0[0] = t0[0] + bflo(gw.x) * v0[0]; v0[1] = t0[1] + bfhi(gw.x) * v0[1]; v0[2] = t0[2] + bflo(gw.y) * v0[2]; v0[3] = t0[3] + bfhi(gw.y) * v0[3];
                    v1[0] = t1[0] + bflo(gw.z) * v1[0]; v1[1] = t1[1] + bfhi(gw.z) * v1[1]; v1[2] = t1[2] + bflo(gw.w) * v1[2]; v1[3] = t1[3] + bfhi(gw.w) * v1[3];
                    u32x4 w; w.x = cvt_pk_bf16(v0[0], v0[1]); w.y = cvt_pk_bf16(v0[2], v0[3]); w.z = cvt_pk_bf16(v1[0], v1[1]); w.w = cvt_pk_bf16(v1[2], v1[3]);
                    *(u32x4*)(O + row * DM + c) = w; } }
    }
};
struct EpiPair {
    static constexpr bool PERM = true, AFTER_DRAIN = false;
    const bf16_t* G; bf16_t* O;
    __device__ __forceinline__ void mid(f32x4 (&acc)[2][2][4][2], const Unit& u, int wr, int wc, int fr, int fq) const {
        const int row0 = u.pm * BM + wr * 64 + fr, col0 = u.pn * BM + wc * 32 + 8 * fq;
#pragma unroll
        for (int ai = 0; ai < 2; ++ai)
#pragma unroll
            for (int m = 0; m < 4; ++m) { const size_t row = (size_t)(row0 + ai * HALF + m * 16);
#pragma unroll
                for (int bj = 0; bj < 2; ++bj) { const int c = col0 + bj * HALF; const u32x4 ga = *(const u32x4*)(G + row * GATE_COLS + c), gr = *(const u32x4*)(G + row * GATE_COLS + 2048 + c);
                    f32x4 v0 = acc[ai][bj][m][0], v1 = acc[ai][bj][m][1];
                    v0[0] *= bflo(ga.x) / bflo(gr.x); v0[1] *= bfhi(ga.x) / bfhi(gr.x); v0[2] *= bflo(ga.y) / bflo(gr.y); v0[3] *= bfhi(ga.y) / bfhi(gr.y);
                    v1[0] *= bflo(ga.z) / bflo(gr.z); v1[1] *= bfhi(ga.z) / bfhi(gr.z); v1[2] *= bflo(ga.w) / bflo(gr.w); v1[3] *= bfhi(ga.w) / bfhi(gr.w);
                    acc[ai][bj][m][0] = v0; acc[ai][bj][m][1] = v1; } }
    }
    __device__ __forceinline__ void operator()(const f32x4 (&acc)[2][2][4][2], const Unit& u, int wr, int wc, int fr, int fq) const {
        const int row0 = u.pm * BM + wr * 64 + fr, col0 = u.pn * BM + wc * 32 + 8 * fq;
#pragma unroll
        for (int ai = 0; ai < 2; ++ai)
#pragma unroll
            for (int m = 0; m < 4; ++m) { const size_t row = (size_t)(row0 + ai * HALF + m * 16);
#pragma unroll
                for (int bj = 0; bj < 2; ++bj) { const int c = col0 + bj * HALF; const u32x4 gw = *(const u32x4*)(G + row * GATE_COLS + 2048 + c);
                    f32x4 v0 = acc[ai][bj][m][0], v1 = acc[ai][bj][m][1];
                    v0[0] *= bflo(gw.x); v0[1] *= bfhi(gw.x); v0[2] *= bflo(gw.y); v0[3] *= bfhi(gw.y); v1[0] *= bflo(gw.z); v1[1] *= bfhi(gw.z); v1[2] *= bflo(gw.w); v1[3] *= bfhi(gw.w);
                    u32x4 w; w.x = cvt_pk_bf16(v0[0], v0[1]); w.y = cvt_pk_bf16(v0[2], v0[3]); w.z = cvt_pk_bf16(v1[0], v1[1]); w.w = cvt_pk_bf16(v1[2], v1[3]);
                    *(u32x4*)(O + row * DM + c) = w; } }
    }
};
struct EpiH1 {
    static constexpr bool PERM = false, AFTER_DRAIN = false;
    const float* X; const float* ada; float* H1;
    __device__ __forceinline__ void operator()(const f32x4 (&acc)[2][2][4][2], const Unit& u, int wr, int wc, int fr, int fq) const {
        const int row0 = u.pm * BM + wr * 64 + fr, col0 = u.pn * BM + wc * 32 + 4 * fq;
        const float* gt = ada + (size_t)((u.pm * BM) / SEQ) * 12288 + 4096;
#pragma unroll
        for (int ai = 0; ai < 2; ++ai)
#pragma unroll
            for (int m = 0; m < 4; ++m) { const size_t row = (size_t)(row0 + ai * HALF + m * 16);
#pragma unroll
                for (int bj = 0; bj < 2; ++bj)
#pragma unroll
                    for (int n = 0; n < 2; ++n) { const int c = col0 + bj * HALF + n * 16;
                        const f32x4 xv = *(const f32x4*)(X + row * DM + c), g = *(const f32x4*)(gt + c);
                        *(f32x4*)(H1 + row * DM + c) = xv + g * acc[ai][bj][m][n]; } }
    }
};
}

__device__ __forceinline__ void p0_transpose_item(const float* W, int K, int N, bf16* WT, LAS float* scr, int item, int lane) {
    const int nblk = N / 32, kb = item / nblk, nb = item % nblk, k0 = 64 * kb, n0 = 32 * nb;
#pragma unroll 8
    for (int i = 0; i < 32; ++i) { const int kk = 2 * i + (lane >> 5); scr[kk * 33 + (lane & 31)] = W[(size_t)(k0 + kk) * N + n0 + (lane & 31)]; }
    LDS_WAIT(); asm volatile("" ::: "memory");
    const int c = lane & 7;
#pragma unroll
    for (int j = 0; j < 4; ++j) { const int n = (lane >> 3) + 8 * j; const LAS float* s = scr + (8 * c) * 33 + n;
        v4u o; o.x = pk2(s[0 * 33], s[1 * 33]); o.y = pk2(s[2 * 33], s[3 * 33]); o.z = pk2(s[4 * 33], s[5 * 33]); o.w = pk2(s[6 * 33], s[7 * 33]);
        *(GAS v4u*)(WT + (size_t)(n0 + n) * K + k0 + 8 * c) = o; }
    LDS_WAIT(); asm volatile("" ::: "memory");
}

__device__ __forceinline__ void p0_prologue(Frame& F, const float* const* in) {
    const float* c = in[1]; const int* pos = (const int*)in[2]; const float* ada_w = in[3]; const float* ada_b = in[4];
    float* ada = (float*)(F.ws + WS_ADA); float* rope = (float*)(F.ws + WS_ROPE);
    {
        LAS float* sc = (LAS float*)(F.lds);
        LAS float* red = (LAS float*)(F.lds + 16384);
        for (int i = F.tid; i < 2 * DM; i += NTHR) { const float v = c[i]; sc[i] = v / (1.f + __expf(-v)); }
        __syncthreads();
        const int rg = F.tid / 12, c4 = F.tid % 12;
        for (int cb = F.vcu; cb < 256; cb += F.G) {
            f32x4 a0 = {0.f, 0.f, 0.f, 0.f}, a1 = a0;
            if (rg < 42) {
                const float* wp = ada_w + (size_t)cb * 48 + c4 * 4;
#pragma unroll 7
                for (int k = rg; k < DM; k += 42) { const f32x4 w = *(const f32x4*)(wp + (size_t)k * 12288); a0 += w * sc[k]; a1 += w * sc[DM + k]; }
                LAS float* r = red + rg * 96 + c4 * 4;
                r[0] = a0[0]; r[1] = a0[1]; r[2] = a0[2]; r[3] = a0[3]; r[48] = a1[0]; r[49] = a1[1]; r[50] = a1[2]; r[51] = a1[3];
            }
            __syncthreads();
            if (F.tid < 96) { float s = 0.f; for (int g = 0; g < 42; ++g) s += red[g * 96 + F.tid];
                const int b = F.tid / 48, n = cb * 48 + F.tid % 48; ada[(size_t)b * 12288 + n] = s + ada_b[n]; }
            __syncthreads();
        }
    }
    {
        const int gt = F.vcu * NTHR + F.tid, NGT = F.G * NTHR;
        for (int idx = gt; idx < M * 8; idx += NGT) { const int m = idx >> 3, i = idx & 7;
            const double inv = (i == 0) ? 1.0 : (i == 1) ? 0.19392274474868576 : (i == 2) ? 0.03760603093086393 : (i == 3) ? 0.007292664737217109 : (i == 4) ? 0.001414213562373095
                             : (i == 5) ? 0.0002742481756762073 : (i == 6) ? 5.318295896944988e-05 : 1.031338537721246e-05;
            double a = (double)pos[m] * inv; const double k = __builtin_rint(a * 0.15915494309189535); a -= k * 6.283185307179586;
            const float af = (float)a; rope[(size_t)m * 16 + i] = cosf(af); rope[(size_t)m * 16 + 8 + i] = sinf(af); }
    }
    {
        const int gt = F.vcu * NTHR + F.tid, NGT = F.G * NTHR; bf16* WRH = (bf16*)(F.ws + WS_WRH); bf16* WRL = (bf16*)(F.ws + WS_WRL);
        for (int idx = gt; idx < 80 * DM; idx += NGT) { const int k = idx / 80, col = idx % 80;
            const float wv = col < 8 ? in[27][k * 8 + col] : col < 72 ? in[29][k * 64 + col - 8] : 0.f;
            const unsigned h = f2bf(wv); WRH[(size_t)col * DM + k] = (bf16)h; WRL[(size_t)col * DM + k] = (bf16)f2bf(wv - bf2f((unsigned short)h)); }
    }
    {
        LAS float* scr = (LAS float*)(F.lds + 49152 + F.wave * 8704);
        const int gw = F.vcu * NWAVES + F.wave, NGW = F.G * NWAVES;
        constexpr int I_IN = (DM / 64) * (IN_COLS / 32), I_UP = (1024 / 64) * (DM / 32), I_OUT = (DM / 64) * (DM / 32), I_LR = (64 / 64) * (1024 / 32), I_G2 = (128 / 64) * (1024 / 32);
        constexpr int NITEMS = I_IN + 2 * I_UP + I_OUT + 2 * I_LR + I_G2;
        for (int it = gw; it < NITEMS; it += NGW) {
            int r = it;
            if (r < I_IN) { p0_transpose_item(in[6], DM, IN_COLS, (bf16*)(F.ws + WS_WIN_T), scr, r, F.lane); continue; } r -= I_IN;
            if (r < I_UP) { p0_transpose_item(in[23], 1024, DM, (bf16*)(F.ws + WS_WUPA_T), scr, r, F.lane); continue; } r -= I_UP;
            if (r < I_UP) { p0_transpose_item(in[24], 1024, DM, (bf16*)(F.ws + WS_WUPB_T), scr, r, F.lane); continue; } r -= I_UP;
            if (r < I_OUT) { p0_transpose_item(in[25], DM, DM, (bf16*)(F.ws + WS_WOUT_T), scr, r, F.lane); continue; } r -= I_OUT;
            if (r < I_LR) { p0_transpose_item(in[14], 64, 1024, (bf16*)(F.ws + WS_W2T), scr, r, F.lane); continue; } r -= I_LR;
            if (r < I_LR) { p0_transpose_item(in[16], 64, 1024, (bf16*)(F.ws + WS_A2T), scr, r, F.lane); continue; } r -= I_LR;
            p0_transpose_item(in[17], 128, 1024, (bf16*)(F.ws + WS_G2T), scr, r, F.lane);
        }
    }
}

__device__ __forceinline__ void norm_mod_row(const float* xrow, const float* g, const float* sc, const float* sh, bf16* orow, int lane, f32x4 (&v)[8]) {
    const GAS f32x4* xr = (const GAS f32x4*)xrow + lane; float s2 = 0.f;
#pragma unroll
    for (int j = 0; j < 8; ++j) { v[j] = xr[64 * j]; s2 += (v[j].x * v[j].x + v[j].y * v[j].y) + (v[j].z * v[j].z + v[j].w * v[j].w); }
    const float rstd = 1.f / sqrtf(wave_sum(s2) * (1.f / DM) + NORM_EPS);
    GAS unsigned long long* o8 = (GAS unsigned long long*)orow + lane;
#pragma unroll
    for (int j = 0; j < 8; ++j) { const int i4 = lane + 64 * j; const f32x4 gg = ((const f32x4*)g)[i4], cc = ((const f32x4*)sc)[i4], hh = ((const f32x4*)sh)[i4];
        v[j] = (v[j] * rstd) * gg * (cc + 1.f) + hh;
        o8[64 * j] = (unsigned long long)pk2(v[j].x, v[j].y) | ((unsigned long long)pk2(v[j].z, v[j].w) << 32); }
}

__device__ __forceinline__ void norm_mod_row2v(const float* x0, const float* x1, const float* g, const float* sc0, const float* sh0, const float* sc1, const float* sh1, bf16* o0, bf16* o1, int lane, f32x4 (&va)[8], f32x4 (&vb)[8]) {
    const GAS f32x4* xa = (const GAS f32x4*)x0 + lane; const GAS f32x4* xb = (const GAS f32x4*)x1 + lane; float sa = 0.f, sb = 0.f;
#pragma unroll
    for (int j = 0; j < 8; ++j) { va[j] = xa[64 * j]; vb[j] = xb[64 * j]; }
#pragma unroll
    for (int j = 0; j < 8; ++j) { sa += (va[j].x * va[j].x + va[j].y * va[j].y) + (va[j].z * va[j].z + va[j].w * va[j].w); sb += (vb[j].x * vb[j].x + vb[j].y * vb[j].y) + (vb[j].z * vb[j].z + vb[j].w * vb[j].w); }
    const float ra = 1.f / sqrtf(wave_sum(sa) * (1.f / DM) + NORM_EPS), rb = 1.f / sqrtf(wave_sum(sb) * (1.f / DM) + NORM_EPS);
    GAS unsigned long long* pa = (GAS unsigned long long*)o0 + lane; GAS unsigned long long* pb = (GAS unsigned long long*)o1 + lane;
#pragma unroll
    for (int j = 0; j < 8; ++j) { const int i4 = lane + 64 * j; const f32x4 gg = ((const f32x4*)g)[i4];
        const f32x4 ya = (va[j] * ra) * gg * (((const f32x4*)sc0)[i4] + 1.f) + ((const f32x4*)sh0)[i4], yb = (vb[j] * rb) * gg * (((const f32x4*)sc1)[i4] + 1.f) + ((const f32x4*)sh1)[i4];
        va[j] = ya; vb[j] = yb;
        pa[64 * j] = (unsigned long long)pk2(ya.x, ya.y) | ((unsigned long long)pk2(ya.z, ya.w) << 32); pb[64 * j] = (unsigned long long)pk2(yb.x, yb.y) | ((unsigned long long)pk2(yb.z, yb.w) << 32); }
}
__device__ __forceinline__ void norm_mod_row2(const float* x0, const float* x1, const float* g, const float* sc0, const float* sh0, const float* sc1, const float* sh1, bf16* o0, bf16* o1, int lane) {
    f32x4 va[8], vb[8]; norm_mod_row2v(x0, x1, g, sc0, sh0, sc1, sh1, o0, o1, lane, va, vb); }

constexpr int RWA_PITCH = 72, RWG_PITCH = 136, RWZ_PITCH = 68;
constexpr int RW_TW = 0, RW_AL = RW_TW + 64 * RWA_PITCH * 2, RW_GS = RW_AL + 64 * RWA_PITCH * 2, RW_Z1 = RW_GS + 64 * RWG_PITCH * 2,
              RW_Z2 = RW_Z1 + 64 * RWZ_PITCH * 4, RW_Z3 = RW_Z2 + 64 * RWZ_PITCH * 4, RW_LDS_END = RW_Z3 + 64 * RWZ_PITCH * 4;
static_assert(RW_LDS_END <= RING_BYTES, "rwkv prep LDS");
__device__ __forceinline__ void shift8(const bf16* cur, const bf16* prv, bool hasprev, const float* mu, float (&o)[8]) {
    const v4u c = *(const v4u*)cur; v4u p = {0u, 0u, 0u, 0u}; if (hasprev) p = *(const v4u*)prv;
    const f32x4 m0 = ((const f32x4*)mu)[0], m1 = ((const f32x4*)mu)[1];
    float cv[8] = {bflo(c.x), bfhi(c.x), bflo(c.y), bfhi(c.y), bflo(c.z), bfhi(c.z), bflo(c.w), bfhi(c.w)};
    float pv[8] = {bflo(p.x), bfhi(p.x), bflo(p.y), bfhi(p.y), bflo(p.z), bfhi(p.z), bflo(p.w), bfhi(p.w)};
    float mv[8] = {m0[0], m0[1], m0[2], m0[3], m1[0], m1[1], m1[2], m1[3]};
#pragma unroll
    for (int e = 0; e < 8; ++e) o[e] = cv[e] + (pv[e] - cv[e]) * mv[e];
}
__device__ __forceinline__ v4u pack8(const float (&x)[8]) { v4u o; o.x = pk2(x[0], x[1]); o.y = pk2(x[2], x[3]); o.z = pk2(x[4], x[5]); o.w = pk2(x[6], x[7]); return o; }
__device__ __forceinline__ void store8(float* p, const float (&x)[8]) { ((f32x4*)p)[0] = (f32x4){x[0], x[1], x[2], x[3]}; ((f32x4*)p)[1] = (f32x4){x[4], x[5], x[6], x[7]}; }

__device__ __forceinline__ void p3_rwkv_prep(Frame& F, const float* const* in) {
    const bf16* PR = (const bf16*)(F.ws + WS_PR);
    const float* mu = in[7]; const float* w0 = in[13]; const float* a0 = in[15]; const float* k_k = in[18]; const float* k_a = in[19]; const float* r_k = in[20];
    const bf16* w2t = (const bf16*)(F.ws + WS_W2T); const bf16* a2t = (const bf16*)(F.ws + WS_A2T); const bf16* g2t = (const bf16*)(F.ws + WS_G2T);
    float* RWb = (float*)(F.ws + WS_RW); constexpr size_t AS = RW_ARR / 4;
    float *oR = RWb, *oW = RWb + AS, *oK = RWb + 2 * AS, *oV = RWb + 3 * AS, *oA = RWb + 4 * AS, *oB = RWb + 5 * AS, *oG = RWb + 6 * AS, *oBo = RWb + 7 * AS;
    LAS unsigned char* L = F.lds;
    const int tt = F.tid >> 3, sub = F.tid & 7, fr = F.lane & 15, fq = F.lane >> 4;
    for (int u = F.vcu; u < 2048; u += F.G) {
        const int h = u & 15, ch = (u >> 4) & 63, b = u >> 10, s = ch * 64 + tt; const size_t m = (size_t)b * SEQ + s; const bool hp = s > 0;
        const bf16* cur = PR + m * RW_COLS; const bf16* prv = cur - RW_COLS;
        float r8[8], k8[8], v8[8], t8[8];
        shift8(cur + h * 64 + sub * 8, prv + h * 64 + sub * 8, hp, mu + h * 64 + sub * 8, r8);
        shift8(cur + 1024 + h * 64 + sub * 8, prv + 1024 + h * 64 + sub * 8, hp, mu + 1024 + h * 64 + sub * 8, k8);
        shift8(cur + 2048 + h * 64 + sub * 8, prv + 2048 + h * 64 + sub * 8, hp, mu + 2048 + h * 64 + sub * 8, v8);
        shift8(cur + 3072 + sub * 8, prv + 3072 + sub * 8, hp, mu + 3072 + sub * 8, t8);
#pragma unroll
        for (int e = 0; e < 8; ++e) t8[e] = tanhf(t8[e]);
        *(LAS v4u*)(L + RW_TW + (tt * RWA_PITCH + sub * 8) * 2) = pack8(t8);
        shift8(cur + 3136 + sub * 8, prv + 3136 + sub * 8, hp, mu + 3136 + sub * 8, t8);
        *(LAS v4u*)(L + RW_AL + (tt * RWA_PITCH + sub * 8) * 2) = pack8(t8);
#pragma unroll
        for (int hlf = 0; hlf < 2; ++hlf) { shift8(cur + 3200 + sub * 16 + hlf * 8, prv + 3200 + sub * 16 + hlf * 8, hp, mu + 3200 + sub * 16 + hlf * 8, t8);
#pragma unroll
            for (int e = 0; e < 8; ++e) t8[e] = sigmoidf_(t8[e]);
            *(LAS v4u*)(L + RW_GS + (tt * RWG_PITCH + sub * 16 + hlf * 8) * 2) = pack8(t8); }
        __syncthreads();
#pragma unroll 1
        for (int job = F.wave; job < 48; job += NWAVES) { const int mat = job >> 4, ti = (job >> 2) & 3, tj = job & 3;
            const int aoff = mat == 0 ? RW_TW : mat == 1 ? RW_AL : RW_GS, ap = mat == 2 ? RWG_PITCH : RWA_PITCH, kd = mat == 2 ? 128 : 64;
            const bf16* wt = (mat == 0 ? w2t : mat == 1 ? a2t : g2t) + (size_t)(h * 64 + tj * 16 + fr) * kd + fq * 8;
            f32x4 acc = {0.f, 0.f, 0.f, 0.f};
            for (int ks = 0; ks < kd / 32; ++ks) { const bf16x8 a = *(const LAS bf16x8*)(L + aoff + ((ti * 16 + fr) * ap + ks * 32 + fq * 8) * 2); const bf16x8 bb = *(const bf16x8*)(wt + ks * 32);
                acc = __builtin_amdgcn_mfma_f32_16x16x32_bf16(a, bb, acc, 0, 0, 0); }
            LAS float* z = (LAS float*)(L + (mat == 0 ? RW_Z1 : mat == 1 ? RW_Z2 : RW_Z3));
#pragma unroll
            for (int e = 0; e < 4; ++e) z[(ti * 16 + fq * 4 + e) * RWZ_PITCH + tj * 16 + fr] = acc[e]; }
        __syncthreads();
        {
            const int c0 = h * 64 + sub * 8; const LAS float* z1 = (const LAS float*)(L + RW_Z1) + tt * RWZ_PITCH + sub * 8; const LAS float* z2 = (const LAS float*)(L + RW_Z2) + tt * RWZ_PITCH + sub * 8;
            const LAS float* z3 = (const LAS float*)(L + RW_Z3) + tt * RWZ_PITCH + sub * 8;
            float dec[8], av[8], gv[8], kkv[8], km[8], bo[8], ss = 0.f, bs = 0.f;
#pragma unroll
            for (int e = 0; e < 8; ++e) { const float z = w0[c0 + e] + z1[e]; const float sp = fmaxf(-z, 0.f) + log1pf(__expf(-fabsf(z)));
                const float wl = -sp - 0.5f; dec[e] = __expf(-__expf(wl)); av[e] = sigmoidf_(a0[c0 + e] + z2[e]); gv[e] = z3[e];
                kkv[e] = k8[e] * k_k[c0 + e]; ss += kkv[e] * kkv[e]; km[e] = k8[e] * (1.f + (av[e] - 1.f) * k_a[c0 + e]); bs += r8[e] * km[e] * r_k[c0 + e]; }
            ss = sum8(ss); bs = sum8(bs); const float rn = 1.f / sqrtf(fmaxf(ss, 1e-24f));
            float na[8], nb[8];
#pragma unroll
            for (int e = 0; e < 8; ++e) { const float kk = kkv[e] * rn; na[e] = -kk; nb[e] = kk * av[e]; bo[e] = bs * v8[e]; }
            const size_t o = m * RW_W + c0;
            store8(oR + o, r8); store8(oW + o, dec); store8(oK + o, km); store8(oV + o, v8); store8(oA + o, na); store8(oB + o, nb); store8(oG + o, gv); store8(oBo + o, bo);
        }
        __syncthreads();
    }
}

__device__ __forceinline__ void p4_rwkv_scan(Frame& F) {
    float* RWb = (float*)(F.ws + WS_RW); constexpr size_t AS = RW_ARR / 4;
    const float *iR = RWb, *iW = RWb + AS, *iK = RWb + 2 * AS, *iV = RWb + 3 * AS, *iA = RWb + 4 * AS, *iB = RWb + 5 * AS; float* oY = RWb + 8 * AS;
    constexpr int TB = 16;
    LAS float* S = (LAS float*)F.lds;
    const int vr = F.tid >> 3, ks = F.tid & 7;
    for (int bh = blockIdx.x; bh < BATCH * 16; bh += F.G) {
        const int b = bh >> 4, h = bh & 15; const size_t base = (size_t)b * SEQ * RW_W + h * 64;
        float st[8];
#pragma unroll
        for (int e = 0; e < 8; ++e) st[e] = 0.f;
        f32x4 stg[3];
        auto gload = [&](int blk) {
#pragma unroll
            for (int i = 0; i < 3; ++i) { const int q = F.tid + i * NTHR, arr = q >> 8, rem = q & 255, t = rem >> 4, c4 = rem & 15;
                const float* src = (arr == 0 ? iR : arr == 1 ? iW : arr == 2 ? iK : arr == 3 ? iV : arr == 4 ? iA : iB) + base + (size_t)(blk * TB + t) * RW_W + c4 * 4;
                stg[i] = *(const f32x4*)src; } };
        auto lstore = [&](int buf) {
#pragma unroll
            for (int i = 0; i < 3; ++i) { const int q = F.tid + i * NTHR; *(LAS f32x4*)(S + buf * (6 * TB * 64) + q * 4) = stg[i]; } };
        gload(0);
        for (int blk = 0; blk < SEQ / TB; ++blk) {
            const int buf = blk & 1;
            lstore(buf);
            if (blk + 1 < SEQ / TB) gload(blk + 1);
            __syncthreads();
            const LAS float* sb = S + buf * (6 * TB * 64);
#pragma unroll 4
            for (int t = 0; t < TB; ++t) {
                const LAS float* p = sb + t * 64 + ks * 8;
                const f32x4 r0 = *(const LAS f32x4*)(p), r1 = *(const LAS f32x4*)(p + 4);
                const f32x4 w0 = *(const LAS f32x4*)(p + TB * 64), w1 = *(const LAS f32x4*)(p + TB * 64 + 4);
                const f32x4 k0 = *(const LAS f32x4*)(p + 2 * TB * 64), k1 = *(const LAS f32x4*)(p + 2 * TB * 64 + 4);
                const float vv = sb[3 * TB * 64 + t * 64 + vr];
                const f32x4 a0 = *(const LAS f32x4*)(p + 4 * TB * 64), a1 = *(const LAS f32x4*)(p + 4 * TB * 64 + 4);
                const f32x4 b0 = *(const LAS f32x4*)(p + 5 * TB * 64), b1 = *(const LAS f32x4*)(p + 5 * TB * 64 + 4);
                float sa = 0.f;
#pragma unroll
                for (int e = 0; e < 4; ++e) { sa += st[e] * a0[e]; sa += st[4 + e] * a1[e]; }
                sa = sum8(sa);
                float y = 0.f;
#pragma unroll
                for (int e = 0; e < 4; ++e) { st[e] = st[e] * w0[e] + sa * b0[e] + vv * k0[e]; st[4 + e] = st[4 + e] * w1[e] + sa * b1[e] + vv * k1[e]; y += st[e] * r0[e]; y += st[4 + e] * r1[e]; }
                y = sum8(y);
                if (ks == 0) oY[base + (size_t)(blk * TB + t) * RW_W + vr] = y;
            }
        }
        __syncthreads();
    }
}


constexpr int RP = 72, SLOTB = 64 * RP * 2;
constexpr int H_AH = 0, H_AHT = 1, H_BH = 2, H_KH = 3, H_RH = 4, H_VT = 5, H_BTT = 6, H_KTT = 7, S_0 = 8, S_1 = 9, S_2 = 10, S_3 = 11, S_4 = 12, S_5 = 13;
constexpr int RC_LW = RW_LDS_END, RC_SEG = RC_LW + 64 * 65 * 4, RC_STAGE0_END = RC_SEG + 8 * 64 * 4;
constexpr int RC_PC = 14 * SLOTB;
static_assert(RC_STAGE0_END <= RING_BYTES && RC_PC + 256 <= RING_BYTES && 8 * SLOTB <= RC_LW, "rwkv chunk LDS map");
constexpr size_t WS_CRT = WS_RW, WS_CMM = WS_RW + 16 * MiB, WS_CY0 = WS_RW + 32 * MiB, WS_CN0 = WS_RW + 64 * MiB;

__device__ __forceinline__ f32x4 tmm(const LAS unsigned char* L, int Xs, int Ys, int tx, int ty, f32x4 acc, int fr, int fq) {
#pragma unroll
    for (int ks = 0; ks < 2; ++ks) { const bf16x8 a = *(const LAS bf16x8*)(L + Xs + ((tx * 16 + fr) * RP + ks * 32 + fq * 8) * 2); const bf16x8 b = *(const LAS bf16x8*)(L + Ys + ((ty * 16 + fr) * RP + ks * 32 + fq * 8) * 2);
        acc = __builtin_amdgcn_mfma_f32_16x16x32_bf16(a, b, acc, 0, 0, 0); }
    return acc;
}
__device__ __forceinline__ void st_rowY(LAS unsigned char* L, int dst, f32x4 v, int tx, int ty, int fr, int fq) {
    v2u w; w.x = pk2(v[0], v[1]); w.y = pk2(v[2], v[3]); *(LAS v2u*)(L + dst + ((ty * 16 + fr) * RP + tx * 16 + fq * 4) * 2) = w; }
__device__ __forceinline__ void st_rowX(LAS unsigned char* L, int dst, f32x4 v, int tx, int ty, int fr, int fq) {
#pragma unroll
    for (int e = 0; e < 4; ++e) *(LAS unsigned short*)(L + dst + ((tx * 16 + fq * 4 + e) * RP + ty * 16 + fr) * 2) = (unsigned short)f2bf(v[e]); }
__device__ __forceinline__ f32x4 ld_rowY(const LAS unsigned char* L, int src, int tx, int ty, int fr, int fq) {
    const v2u w = *(const LAS v2u*)(L + src + ((ty * 16 + fr) * RP + tx * 16 + fq * 4) * 2); return (f32x4){bflo(w.x), bfhi(w.x), bflo(w.y), bfhi(w.y)}; }
__device__ __forceinline__ void inv_iter(LAS unsigned char* L, int wave, int fr, int fq, int PA, int PT, int PnA, int PnT, int Tp, int Tn, bool doP, bool doPA, bool doT) {
#pragma unroll
    for (int i = 0; i < 4; ++i) { const int which = i >> 1, tl = wave + 8 * (i & 1), ty = tl >> 2, tx = tl & 3;
        if (which == 0) { if (!doP) continue;
            f32x4 acc = {0.f, 0.f, 0.f, 0.f}; acc = tmm(L, PT, PA, tx, ty, acc, fr, fq);
            if (doPA) st_rowY(L, PnA, acc, tx, ty, fr, fq); st_rowX(L, PnT, acc, tx, ty, fr, fq);
        } else { if (!doT) continue;
            f32x4 acc = ld_rowY(L, Tp, tx, ty, fr, fq); acc = tmm(L, PT, Tp, tx, ty, acc, fr, fq);
            st_rowY(L, Tn, acc, tx, ty, fr, fq); }
    }
}

__device__ __forceinline__ void p3_rwkv_chunk(Frame& F, const float* const* in) {
    const bf16* PR = (const bf16*)(F.ws + WS_PR);
    const float* mu = in[7]; const float* w0 = in[13]; const float* a0 = in[15]; const float* k_k = in[18]; const float* k_a = in[19]; const float* r_k = in[20];
    const bf16* w2t = (const bf16*)(F.ws + WS_W2T); const bf16* a2t = (const bf16*)(F.ws + WS_A2T); const bf16* g2t = (const bf16*)(F.ws + WS_G2T);
    float* RWb = (float*)(F.ws + WS_RW); constexpr size_t AS = RW_ARR / 4; float *oG = RWb + 6 * AS, *oBo = RWb + 7 * AS;
    LAS unsigned char* L = F.lds;
    int tt = F.tid >> 3, sub = F.tid & 7, fr = F.lane & 15, fq = F.lane >> 4, lane = F.lane;
#define P3_OPAQUE() asm volatile("" : "+v"(tt), "+v"(sub), "+v"(fr), "+v"(fq), "+v"(lane))
    v4u pc[7], pp[7];
#define P3_COLS(h_, g_) ((g_) < 3 ? (g_) * 1024 + (h_) * 64 + sub * 8 : (g_) == 3 ? 3072 + sub * 8 : (g_) == 4 ? 3136 + sub * 8 : 3200 + sub * 16 + ((g_) - 5) * 8)
#define P3_LOADS(u_) do { const int h_ = (u_) & 15, s_ = (((u_) >> 4) & 63) * 64 + tt; const bf16* cur_ = PR + ((size_t)((u_) >> 10) * SEQ + s_) * RW_COLS; \
        _Pragma("unroll") for (int g = 0; g < 7; ++g) { const int co = P3_COLS(h_, g); pc[g] = *(const v4u*)(cur_ + co); const v4u q_ = *(const v4u*)(cur_ - (s_ > 0 ? RW_COLS : 0) + co); pp[g] = s_ > 0 ? q_ : (v4u){0u, 0u, 0u, 0u}; } } while (0)
    if (F.tid == 0) { F.MISC[0] = __hip_atomic_fetch_add((unsigned*)(F.ctl + CW_P3Q), 1u, __ATOMIC_RELAXED, __HIP_MEMORY_SCOPE_AGENT);
                      F.MISC[1] = __hip_atomic_fetch_add((unsigned*)(F.ctl + CW_P3Q), 1u, __ATOMIC_RELAXED, __HIP_MEMORY_SCOPE_AGENT); }
    __syncthreads();
    int u = (int)F.MISC[0], unx = (int)F.MISC[1];
    if (u < 2048) P3_LOADS(u);
    for (int it = 0;; ++it) {
        if (u >= 2048) break;
        if (F.tid == 0) F.MISC[2 + (it & 1)] = __hip_atomic_fetch_add((unsigned*)(F.ctl + CW_P3Q), 1u, __ATOMIC_RELAXED, __HIP_MEMORY_SCOPE_AGENT);
        const int h = u & 15, ch = (u >> 4) & 63, b = u >> 10, s = ch * 64 + tt; const size_t m = (size_t)b * SEQ + s;
        const size_t unit = (size_t)((b * 16 + h) * 64 + ch);
        float r8[8], k8[8], v8[8], t8[8];
#define P3_SHIFT(g_, o_) do { const f32x4 m0_ = ((const f32x4*)(mu + P3_COLS(h, g_)))[0], m1_ = ((const f32x4*)(mu + P3_COLS(h, g_)))[1]; const v4u c_ = pc[g_], p_ = pp[g_]; \
        const float cv_[8] = {bflo(c_.x), bfhi(c_.x), bflo(c_.y), bfhi(c_.y), bflo(c_.z), bfhi(c_.z), bflo(c_.w), bfhi(c_.w)}, pv_[8] = {bflo(p_.x), bfhi(p_.x), bflo(p_.y), bfhi(p_.y), bflo(p_.z), bfhi(p_.z), bflo(p_.w), bfhi(p_.w)}; \
        const float mv_[8] = {m0_[0], m0_[1], m0_[2], m0_[3], m1_[0], m1_[1], m1_[2], m1_[3]}; \
        _Pragma("unroll") for (int e = 0; e < 8; ++e) o_[e] = cv_[e] + (pv_[e] - cv_[e]) * mv_[e]; } while (0)
        P3_SHIFT(0, r8); P3_SHIFT(1, k8); P3_SHIFT(2, v8); P3_SHIFT(3, t8);
#pragma unroll
        for (int e = 0; e < 8; ++e) t8[e] = 1.f - 2.f / (1.f + __expf(2.f * t8[e]));
        *(LAS v4u*)(L + RW_TW + (tt * RWA_PITCH + sub * 8) * 2) = pack8(t8);
        P3_SHIFT(4, t8);
        *(LAS v4u*)(L + RW_AL + (tt * RWA_PITCH + sub * 8) * 2) = pack8(t8);
#pragma unroll
        for (int hlf = 0; hlf < 2; ++hlf) { if (hlf == 0) P3_SHIFT(5, t8); else P3_SHIFT(6, t8);
#pragma unroll
            for (int e = 0; e < 8; ++e) t8[e] = sigmoidf_(t8[e]);
            *(LAS v4u*)(L + RW_GS + (tt * RWG_PITCH + sub * 16 + hlf * 8) * 2) = pack8(t8); }
        __syncthreads();
#pragma unroll
        for (int i = 0; i < 6; ++i) { const int mat = i >> 1, tl = F.wave + 8 * (i & 1), ti = tl >> 2, tj = tl & 3;
            const int aoff = mat == 0 ? RW_TW : mat == 1 ? RW_AL : RW_GS, ap = mat == 2 ? RWG_PITCH : RWA_PITCH, kd = mat == 2 ? 128 : 64;
            const bf16* wt = (mat == 0 ? w2t : mat == 1 ? a2t : g2t) + (size_t)(h * 64 + tj * 16 + fr) * kd + fq * 8;
            f32x4 acc = {0.f, 0.f, 0.f, 0.f};
#pragma unroll
            for (int ks = 0; ks < 4; ++ks) if (ks < kd / 32) { const bf16x8 a = *(const LAS bf16x8*)(L + aoff + ((ti * 16 + fr) * ap + ks * 32 + fq * 8) * 2); const bf16x8 bb = *(const bf16x8*)(wt + ks * 32);
                acc = __builtin_amdgcn_mfma_f32_16x16x32_bf16(a, bb, acc, 0, 0, 0); }
            LAS float* z = (LAS float*)(L + (mat == 0 ? RW_Z1 : mat == 1 ? RW_Z2 : RW_Z3));
#pragma unroll
            for (int e = 0; e < 4; ++e) z[(ti * 16 + fq * 4 + e) * RWZ_PITCH + tj * 16 + fr] = acc[e]; }
        __syncthreads();
        P3_OPAQUE();
        const int c0 = h * 64 + sub * 8;
        float lw[8], na[8], nb[8], km[8];
        {
            const LAS float* z1 = (const LAS float*)(L + RW_Z1) + tt * RWZ_PITCH + sub * 8; const LAS float* z2 = (const LAS float*)(L + RW_Z2) + tt * RWZ_PITCH + sub * 8;
            const LAS float* z3 = (const LAS float*)(L + RW_Z3) + tt * RWZ_PITCH + sub * 8;
            float av[8], gv[8], kkv[8], bo[8], ss = 0.f, bs = 0.f;
#pragma unroll
            for (int e = 0; e < 8; ++e) { const float z = w0[c0 + e] + z1[e]; const float sp = fmaxf(-z, 0.f) + __logf(1.f + __expf(-fabsf(z)));
                lw[e] = -__expf(-sp - 0.5f); av[e] = sigmoidf_(a0[c0 + e] + z2[e]); gv[e] = z3[e];
                kkv[e] = k8[e] * k_k[c0 + e]; ss += kkv[e] * kkv[e]; km[e] = k8[e] * (1.f + (av[e] - 1.f) * k_a[c0 + e]); bs += r8[e] * km[e] * r_k[c0 + e]; }
            ss = sum8(ss); bs = sum8(bs); const float rn = 1.f / sqrtf(fmaxf(ss, 1e-24f));
#pragma unroll
            for (int e = 0; e < 8; ++e) { const float kk = kkv[e] * rn; na[e] = -kk; nb[e] = kk * av[e]; bo[e] = bs * v8[e]; }
            const size_t o = m * RW_W + c0; store8(oG + o, gv); store8(oBo + o, bo);
            LAS float* lwp = (LAS float*)(L + RC_LW) + tt * 65 + sub * 8;
#pragma unroll
            for (int e = 0; e < 8; ++e) lwp[e] = lw[e];
        }
        __syncthreads();
        {
            const int cc = F.tid & 63, sg = F.tid >> 6; LAS float* p = (LAS float*)(L + RC_LW) + (sg * 8) * 65 + cc; float run = 0.f;
#pragma unroll
            for (int i = 0; i < 8; ++i) { run += p[i * 65]; p[i * 65] = run; }
            ((LAS float*)(L + RC_SEG))[sg * 64 + cc] = run;
        }
        __syncthreads();
        {
            const LAS float* lwp = (const LAS float*)(L + RC_LW) + tt * 65 + sub * 8; const LAS float* sgp = (const LAS float*)(L + RC_SEG) + sub * 8; const int sg = tt >> 3;
            float ah[8], rh[8], bh[8], kh[8], bt[8], kt[8];
            float basev[8], totv[8];
#pragma unroll
            for (int e = 0; e < 8; ++e) { basev[e] = 0.f; totv[e] = 0.f; }
#pragma unroll
            for (int q = 0; q < 8; ++q) { const f32x4 s0 = *(const LAS f32x4*)(sgp + q * 64), s1 = *(const LAS f32x4*)(sgp + q * 64 + 4); const float sv[8] = {s0[0], s0[1], s0[2], s0[3], s1[0], s1[1], s1[2], s1[3]};
#pragma unroll
                for (int e = 0; e < 8; ++e) { totv[e] += sv[e]; basev[e] += (q < sg) ? sv[e] : 0.f; } }
#pragma unroll
            for (int e = 0; e < 8; ++e) { const float base = basev[e], tot = totv[e];
                const float cl = lwp[e] + base, clx = cl - lw[e];
                const float ep = __expf(cl), en = __expf(-cl), ee = __expf(tot - cl);
                ah[e] = na[e] * __expf(clx); rh[e] = r8[e] * ep; bh[e] = nb[e] * en; kh[e] = km[e] * en; bt[e] = nb[e] * ee; kt[e] = km[e] * ee;
                if (tt == 63) ((LAS float*)(L + RC_PC))[sub * 8 + e] = __expf(tot); }
            *(LAS v4u*)(L + H_AH * SLOTB + (tt * RP + sub * 8) * 2) = pack8(ah);
            *(LAS v4u*)(L + H_BH * SLOTB + (tt * RP + sub * 8) * 2) = pack8(bh);
            *(LAS v4u*)(L + H_KH * SLOTB + (tt * RP + sub * 8) * 2) = pack8(kh);
            *(LAS v4u*)(L + H_RH * SLOTB + (tt * RP + sub * 8) * 2) = pack8(rh);
#pragma unroll
            for (int e = 0; e < 8; ++e) { const int o = ((sub * 8 + e) * RP + tt) * 2;
                *(LAS unsigned short*)(L + H_AHT * SLOTB + o) = (unsigned short)f2bf(ah[e]); *(LAS unsigned short*)(L + H_VT * SLOTB + o) = (unsigned short)f2bf(v8[e]);
                *(LAS unsigned short*)(L + H_BTT * SLOTB + o) = (unsigned short)f2bf(bt[e]); *(LAS unsigned short*)(L + H_KTT * SLOTB + o) = (unsigned short)f2bf(kt[e]); }
        }
        __syncthreads();
        P3_OPAQUE();
#pragma unroll
        for (int i = 0; i < 8; ++i) { const int mat = i >> 1, tl = F.wave + 8 * (i & 1), ty = tl >> 2, tx = tl & 3;
            const int Xs = ((mat & 1) ? H_KH : H_BH) * SLOTB, Ys = (mat < 2 ? H_AH : H_RH) * SLOTB;
            f32x4 acc = {0.f, 0.f, 0.f, 0.f}; acc = tmm(L, Xs, Ys, tx, ty, acc, fr, fq);
            const int t = ty * 16 + fr, j0 = tx * 16 + fq * 4;
#pragma unroll
            for (int e = 0; e < 4; ++e) { const bool keep = (mat < 2) ? (j0 + e < t) : (j0 + e <= t); acc[e] = keep ? acc[e] : 0.f; }
            const int dst = (mat == 0 ? S_0 : mat == 1 ? S_2 : mat == 2 ? S_3 : S_4) * SLOTB;
            st_rowY(L, dst, acc, tx, ty, fr, fq);
            if (mat == 0) { st_rowX(L, S_1 * SLOTB, acc, tx, ty, fr, fq);
#pragma unroll
                for (int e = 0; e < 4; ++e) acc[e] += (j0 + e == t) ? 1.f : 0.f;
                st_rowY(L, S_5 * SLOTB, acc, tx, ty, fr, fq); }
        }
        __syncthreads();
        P3_OPAQUE();
        if (unx < 2048) P3_LOADS(unx);
        inv_iter(L, F.wave, fr, fq, S_0 * SLOTB, S_1 * SLOTB, H_AH * SLOTB, H_BH * SLOTB, 0, 0, true, true, false);                                  __syncthreads();
        inv_iter(L, F.wave, fr, fq, H_AH * SLOTB, H_BH * SLOTB, S_0 * SLOTB, S_1 * SLOTB, S_5 * SLOTB, H_KH * SLOTB, true, true, true);              __syncthreads();
        inv_iter(L, F.wave, fr, fq, S_0 * SLOTB, S_1 * SLOTB, H_AH * SLOTB, H_BH * SLOTB, H_KH * SLOTB, S_5 * SLOTB, true, true, true);              __syncthreads();
        inv_iter(L, F.wave, fr, fq, H_AH * SLOTB, H_BH * SLOTB, S_0 * SLOTB, S_1 * SLOTB, S_5 * SLOTB, H_KH * SLOTB, true, true, true);              __syncthreads();
        inv_iter(L, F.wave, fr, fq, S_0 * SLOTB, S_1 * SLOTB, 0, H_BH * SLOTB, H_KH * SLOTB, S_5 * SLOTB, true, false, true);                        __syncthreads();
        inv_iter(L, F.wave, fr, fq, 0, H_BH * SLOTB, 0, 0, S_5 * SLOTB, H_KH * SLOTB, false, false, true);                                           __syncthreads();
        P3_OPAQUE();
        constexpr int TS = H_KH * SLOTB;
#pragma unroll
        for (int i = 0; i < 4; ++i) { const int which = i >> 1, tl = F.wave + 8 * (i & 1), ty = tl >> 2, tx = tl & 3;
            f32x4 acc = {0.f, 0.f, 0.f, 0.f};
            if (which == 0) { acc = tmm(L, TS, H_AHT * SLOTB, tx, ty, acc, fr, fq); st_rowY(L, S_0 * SLOTB, acc, tx, ty, fr, fq); }
            else { acc = tmm(L, S_2 * SLOTB, H_VT * SLOTB, tx, ty, acc, fr, fq); st_rowY(L, S_1 * SLOTB, acc, tx, ty, fr, fq); }
        }
        __syncthreads();
        {
            unsigned char* gR = F.ws + WS_CRT + unit * 8192; unsigned char* gM = F.ws + WS_CMM + unit * 8192;
#pragma unroll
            for (int i = 0; i < 6; ++i) { const int which = i >> 1, tl = F.wave + 8 * (i & 1), ty = tl >> 2, tx = tl & 3;
                f32x4 acc = {0.f, 0.f, 0.f, 0.f};
                if (which == 0) { acc = tmm(L, TS, S_1 * SLOTB, tx, ty, acc, fr, fq); st_rowY(L, H_AH * SLOTB, acc, tx, ty, fr, fq); }
                else if (which == 1) {
                    acc = ld_rowY(L, H_RH * SLOTB, tx, ty, fr, fq); acc = tmm(L, S_0 * SLOTB, S_3 * SLOTB, tx, ty, acc, fr, fq);
                    uint2 w; w.x = pk2(acc[0], acc[1]); w.y = pk2(acc[2], acc[3]);
                    *(uint2*)(gR + ((ty * 2 + (tx >> 1)) * 64 + lane) * 16 + (tx & 1) * 8) = w; }
                else {
                    acc = tmm(L, S_0 * SLOTB, H_BTT * SLOTB, tx, ty, acc, fr, fq);
                    const int kr = ty * 16 + fr, kc0 = tx * 16 + fq * 4; const float pc = ((const LAS float*)(L + RC_PC))[kr];
#pragma unroll
                    for (int e = 0; e < 4; ++e) acc[e] += (kc0 + e == kr) ? pc : 0.f;
                    uint2 w; w.x = pk2(acc[0], acc[1]); w.y = pk2(acc[2], acc[3]);
                    *(uint2*)(gM + ((ty * 2 + (tx >> 1)) * 64 + lane) * 16 + (tx & 1) * 8) = w; }
            }
        }
        __syncthreads();
        {
            unsigned char* gY = F.ws + WS_CY0 + unit * 16384; unsigned char* gN = F.ws + WS_CN0 + unit * 16384;
#pragma unroll
            for (int i = 0; i < 4; ++i) { const int which = i >> 1, tl = F.wave + 8 * (i & 1), ty = tl >> 2, tx = tl & 3;
                f32x4 acc = {0.f, 0.f, 0.f, 0.f};
                if (which == 0) { acc = tmm(L, S_3 * SLOTB, H_AH * SLOTB, tx, ty, acc, fr, fq); acc = tmm(L, S_4 * SLOTB, H_VT * SLOTB, tx, ty, acc, fr, fq);
                    *(f32x4*)(gY + ((ty * 4 + tx) * 64 + lane) * 16) = acc; }
                else { acc = tmm(L, H_BTT * SLOTB, H_AH * SLOTB, tx, ty, acc, fr, fq); acc = tmm(L, H_KTT * SLOTB, H_VT * SLOTB, tx, ty, acc, fr, fq);
                    *(f32x4*)(gN + ((ty * 4 + tx) * 64 + lane) * 16) = acc; }
            }
        }
        __syncthreads();
        u = unx; unx = (int)F.MISC[2 + (it & 1)];
    }
#undef P3_COLS
#undef P3_LOADS
#undef P3_SHIFT
#undef P3_OPAQUE
}

constexpr size_t WS_CX = WS_RW + 96 * MiB;
struct ChainOps { bf16x8 mf[4][2]; f32x4 n0[4]; };
__device__ __forceinline__ void chain_load(ChainOps& o, const unsigned char* ws, size_t unit, int vb, int lane) {
    const unsigned char* gM = ws + WS_CMM + unit * 8192; const unsigned char* gN = ws + WS_CN0 + unit * 16384;
#pragma unroll
    for (int ti = 0; ti < 4; ++ti) {
#pragma unroll
        for (int s = 0; s < 2; ++s) o.mf[ti][s] = *(const bf16x8*)(gM + ((ti * 2 + s) * 64 + lane) * 16);
        o.n0[ti] = *(const f32x4*)(gN + ((vb * 4 + ti) * 64 + lane) * 16); }
}
__device__ __forceinline__ void chain_step(const ChainOps& o, f32x4 (&X)[4], unsigned char* gX, int vb, int lane) {
    bf16x8 xb[2];
#pragma unroll
    for (int s = 0; s < 2; ++s) { v4u w; w.x = pk2(X[2 * s][0], X[2 * s][1]); w.y = pk2(X[2 * s][2], X[2 * s][3]); w.z = pk2(X[2 * s + 1][0], X[2 * s + 1][1]); w.w = pk2(X[2 * s + 1][2], X[2 * s + 1][3]);
        xb[s] = __builtin_bit_cast(bf16x8, w); *(v4u*)(gX + ((vb * 2 + s) * 64 + lane) * 16) = w; }
#pragma unroll
    for (int ti = 0; ti < 4; ++ti) { f32x4 xn = __builtin_amdgcn_mfma_f32_16x16x32_bf16(o.mf[ti][0], xb[0], o.n0[ti], 0, 0, 0); X[ti] = __builtin_amdgcn_mfma_f32_16x16x32_bf16(o.mf[ti][1], xb[1], xn, 0, 0, 0); }
}
__device__ __forceinline__ void p4_rwkv_chain(Frame& F) {
    for (int bh = blockIdx.x; bh < BATCH * 16; bh += F.G) {
        if (F.wave < 4) {
            const int vb = F.wave;
            f32x4 X[4];
#pragma unroll
            for (int i = 0; i < 4; ++i) X[i] = (f32x4){0.f, 0.f, 0.f, 0.f};
            unsigned char* gX = F.ws + WS_CX + (size_t)bh * 64 * 8192;
            ChainOps o0, o1;
            chain_load(o0, F.ws, (size_t)bh * 64, vb, F.lane);
#pragma unroll 1
            for (int c = 0; c < 64; c += 2) {
                chain_load(o1, F.ws, (size_t)bh * 64 + c + 1, vb, F.lane);
                chain_step(o0, X, gX + (size_t)c * 8192, vb, F.lane);
                if (c + 2 < 64) chain_load(o0, F.ws, (size_t)bh * 64 + c + 2, vb, F.lane);
                chain_step(o1, X, gX + (size_t)(c + 1) * 8192, vb, F.lane);
            }
        }
    }
}
__device__ __forceinline__ float sum16(float x) { x += dpp_f<0xB1>(x); x += dpp_f<0x4E>(x); x += dpp_f<0x141>(x); x += dpp_f<0x140>(x); return x; }
__device__ __forceinline__ void rwkv_out_job(Frame& F, const float* lnx_g, const float* lnx_b, int job) {
    const int unit = job >> 2, ti = job & 3, bh = unit >> 6, c = unit & 63, b = bh >> 4, h = bh & 15, lane = F.lane, fr = lane & 15, fq = lane >> 4;
    const unsigned char* gR = F.ws + WS_CRT + (size_t)unit * 8192; const unsigned char* gX = F.ws + WS_CX + (size_t)unit * 8192; const unsigned char* gY = F.ws + WS_CY0 + (size_t)unit * 16384;
    float* RWb = (float*)(F.ws + WS_RW); constexpr size_t AS = RW_ARR / 4; const float *iG = RWb + 6 * AS, *iBo = RWb + 7 * AS; bf16* YR = (bf16*)(F.ws + WS_YRW);
    const bf16x8 r0 = *(const bf16x8*)(gR + ((ti * 2 + 0) * 64 + lane) * 16), r1 = *(const bf16x8*)(gR + ((ti * 2 + 1) * 64 + lane) * 16);
    f32x4 y[4];
#pragma unroll
    for (int vb = 0; vb < 4; ++vb) { const bf16x8 x0 = *(const bf16x8*)(gX + ((vb * 2 + 0) * 64 + lane) * 16), x1 = *(const bf16x8*)(gX + ((vb * 2 + 1) * 64 + lane) * 16);
        f32x4 acc = *(const f32x4*)(gY + ((vb * 4 + ti) * 64 + lane) * 16);
        acc = __builtin_amdgcn_mfma_f32_16x16x32_bf16(r0, x0, acc, 0, 0, 0); y[vb] = __builtin_amdgcn_mfma_f32_16x16x32_bf16(r1, x1, acc, 0, 0, 0); }
    float mean[4], rs[4];
#pragma unroll
    for (int e = 0; e < 4; ++e) { mean[e] = sum16((y[0][e] + y[1][e]) + (y[2][e] + y[3][e])) * (1.f / 64.f); float q = 0.f;
#pragma unroll
        for (int vb = 0; vb < 4; ++vb) { const float d = y[vb][e] - mean[e]; q += d * d; }
        rs[e] = 1.f / sqrtf(sum16(q) * (1.f / 64.f) + LNX_EPS); }
#pragma unroll
    for (int vb = 0; vb < 4; ++vb) { const int col = h * 64 + vb * 16 + fr; const float lg = lnx_g[col], lb = lnx_b[col];
#pragma unroll
        for (int e = 0; e < 4; ++e) { const size_t o = ((size_t)b * SEQ + c * 64 + ti * 16 + fq * 4 + e) * RW_W + col;
            YR[o] = (bf16)f2bf(((y[vb][e] - mean[e]) * rs[e] * lg + lb + iBo[o]) * iG[o]); } }
}

__device__ __forceinline__ void p6_attn_combine(Frame& F, const float* const* in, int gw, int NGW) {
    const bf16* O0 = (const bf16*)(F.ws + WS_O0); const bf16* O1 = (const bf16*)(F.ws + WS_O1); bf16* YA = (bf16*)(F.ws + WS_YATT);
    const float* subg = in[12];
    const float d1 = wave_sum(in[8][F.lane] * in[9][F.lane]), d2 = wave_sum(in[10][F.lane] * in[11][F.lane]);
    const float lam = expf(d1) - expf(d2) + LAMBDA_INIT;
    const int lane = F.lane;
    for (int m = gw; m < M; m += NGW) {
        {
            const size_t o = (size_t)m * ATT_W + lane * 16; float d[16]; float ss = 0.f;
#pragma unroll
            for (int hf = 0; hf < 2; ++hf) { const v4u a = *(const v4u*)(O0 + o + hf * 8), bq = *(const v4u*)(O1 + o + hf * 8);
                const unsigned aw[4] = {a.x, a.y, a.z, a.w}, bw[4] = {bq.x, bq.y, bq.z, bq.w};
#pragma unroll
                for (int e = 0; e < 4; ++e) { d[hf * 8 + 2 * e] = bflo(aw[e]) - lam * bflo(bw[e]); d[hf * 8 + 2 * e + 1] = bfhi(aw[e]) - lam * bfhi(bw[e]); } }
#pragma unroll
            for (int e = 0; e < 16; ++e) ss += d[e] * d[e];
            ss = sum8(ss); const float rs = (1.f - LAMBDA_INIT) / sqrtf(ss * (1.f / 128.f) + SUBLN_EPS);
            const float* sg = subg + (lane & 7) * 16; float y[16];
#pragma unroll
            for (int e = 0; e < 16; ++e) y[e] = d[e] * rs * sg[e];
            v4u w0, w1; w0.x = pk2(y[0], y[1]); w0.y = pk2(y[2], y[3]); w0.z = pk2(y[4], y[5]); w0.w = pk2(y[6], y[7]); w1.x = pk2(y[8], y[9]); w1.y = pk2(y[10], y[11]); w1.z = pk2(y[12], y[13]); w1.w = pk2(y[14], y[15]);
            *(v4u*)(YA + o) = w0; *(v4u*)(YA + o + 8) = w1;
        }
    }
}
__device__ __forceinline__ void p6_combine(Frame& F, const float* const* in) {
    bf16* YR = (bf16*)(F.ws + WS_YRW); const float* lnx_g = in[21]; const float* lnx_b = in[22];
    const int gw = F.vcu * NWAVES + F.wave, NGW = F.G * NWAVES, lane = F.lane;
    (void)YR; (void)lane;
#if RWKV_SEQ
    p6_attn_combine(F, in, gw, NGW);
    for (int m = gw; m < M; m += NGW) {
        float* RWb = (float*)(F.ws + WS_RW); constexpr size_t AS = RW_ARR / 4; const float *iG = RWb + 6 * AS, *iBo = RWb + 7 * AS, *iY = RWb + 8 * AS;
        const size_t o = (size_t)m * RW_W + lane * 16; float yv[16]; float s1 = 0.f;
#pragma unroll
        for (int q = 0; q < 4; ++q) { const f32x4 t = *(const f32x4*)(iY + o + q * 4); yv[q * 4] = t[0]; yv[q * 4 + 1] = t[1]; yv[q * 4 + 2] = t[2]; yv[q * 4 + 3] = t[3]; s1 += (t[0] + t[1]) + (t[2] + t[3]); }
        const float mean = sum4(s1) * (1.f / 64.f); float s2 = 0.f;
#pragma unroll
        for (int e = 0; e < 16; ++e) { yv[e] -= mean; s2 += yv[e] * yv[e]; }
        const float rs = 1.f / sqrtf(sum4(s2) * (1.f / 64.f) + LNX_EPS); float y[16];
#pragma unroll
        for (int q = 0; q < 4; ++q) { const f32x4 lg = *(const f32x4*)(lnx_g + lane * 16 + q * 4), lb = *(const f32x4*)(lnx_b + lane * 16 + q * 4), bo = *(const f32x4*)(iBo + o + q * 4), gg = *(const f32x4*)(iG + o + q * 4);
#pragma unroll
            for (int e = 0; e < 4; ++e) y[q * 4 + e] = (yv[q * 4 + e] * rs * lg[e] + lb[e] + bo[e]) * gg[e]; }
        v4u w0, w1; w0.x = pk2(y[0], y[1]); w0.y = pk2(y[2], y[3]); w0.z = pk2(y[4], y[5]); w0.w = pk2(y[6], y[7]); w1.x = pk2(y[8], y[9]); w1.y = pk2(y[10], y[11]); w1.z = pk2(y[12], y[13]); w1.w = pk2(y[14], y[15]);
        *(v4u*)(YR + o) = w0; *(v4u*)(YR + o + 8) = w1;
    }
#else
    for (int job = gw; job < 2048 * 4; job += NGW) rwkv_out_job(F, lnx_g, lnx_b, job);
#endif
}

constexpr int RT_XP = 520;
constexpr int RT_XH = 0, RT_XL = RT_XH + 16 * RT_XP * 2, RT_PART = RT_XL + 16 * RT_XP * 2, RT_LG = RT_PART + 8 * 5 * 1024, RT_END = RT_LG + 16 * 80 * 4;
static_assert(RT_END <= RING_BYTES, "router LDS");
__device__ __forceinline__ void p10_route(Frame& F, const float* const* in) {
    const float* H1 = (const float*)(F.ws + WS_H1); bf16* U2 = (bf16*)(F.ws + WS_U2); const float* ada = (const float*)(F.ws + WS_ADA);
    const float* gffn = in[26]; const float* brg = in[28]; const float* bre = in[30];
    const bf16* WRH = (const bf16*)(F.ws + WS_WRH); const bf16* WRL = (const bf16*)(F.ws + WS_WRL);
    int* tokE = (int*)(F.ws + WS_TOKE); int* tokP = (int*)(F.ws + WS_TOKP); float* tokW = (float*)(F.ws + WS_TOKW); int* list = (int*)(F.ws + WS_LIST);
    unsigned* cnt = (unsigned*)(F.ctl + CW_CNT);
    LAS unsigned char* L = F.lds;
    const int lane = F.lane, w = F.wave, fr = lane & 15, fq = lane >> 4;
    const __amdgpu_buffer_rsrc_t rsH = __builtin_amdgcn_make_buffer_rsrc((void*)WRH, 0, 80 * DM * 2, 0x00020000), rsL = __builtin_amdgcn_make_buffer_rsrc((void*)WRL, 0, 80 * DM * 2, 0x00020000);
    const int voff = (fr * DM + fq * 8) * 2;
#pragma unroll 1
    for (int blk = F.vcu; blk < M / 16; blk += F.G) {
        const int m0 = blk * 16 + w * 2;
        const int b = m0 / SEQ; const float* ad = ada + (size_t)b * 12288;
        bf16x8 wh[2][5], wl[2][5];
#define RT_WLOAD(j_, S_) do { _Pragma("unroll") for (int ct = 0; ct < 5; ++ct) { const int so = __builtin_amdgcn_readfirstlane(((ct * 16) * DM + ((j_) >> 1) * 512 + (w + 8 * ((j_) & 1)) * 32) * 2); \
        wh[S_][ct] = __builtin_bit_cast(bf16x8, __builtin_amdgcn_raw_buffer_load_b128(rsH, voff, so, 0)); wl[S_][ct] = __builtin_bit_cast(bf16x8, __builtin_amdgcn_raw_buffer_load_b128(rsL, voff, so, 0)); } } while (0)
        RT_WLOAD(0, 0);
        f32x4 v0[8], v1[8];
        norm_mod_row2v(H1 + (size_t)m0 * DM, H1 + (size_t)(m0 + 1) * DM, gffn, ad + 8192, ad + 6144, ad + 8192, ad + 6144, U2 + (size_t)m0 * U2P, U2 + (size_t)(m0 + 1) * U2P, lane, v0, v1);
        f32x4 acc[5];
#pragma unroll
        for (int ct = 0; ct < 5; ++ct) acc[ct] = (f32x4){0.f, 0.f, 0.f, 0.f};
#pragma unroll
        for (int kq = 0; kq < 4; ++kq) {
            __syncthreads();
#pragma unroll
            for (int r = 0; r < 2; ++r)
#pragma unroll
                for (int jj = 0; jj < 2; ++jj) { const f32x4 x = r ? v1[2 * kq + jj] : v0[2 * kq + jj]; const int off = ((w * 2 + r) * RT_XP + 4 * lane + 256 * jj) * 2;
                    const unsigned h0 = f2bf(x[0]), h1 = f2bf(x[1]), h2 = f2bf(x[2]), h3 = f2bf(x[3]);
                    v2u hw; hw.x = h0 | (h1 << 16); hw.y = h2 | (h3 << 16); *(LAS v2u*)(L + RT_XH + off) = hw;
                    v2u lw; lw.x = pk2(x[0] - bf2f((unsigned short)h0), x[1] - bf2f((unsigned short)h1)); lw.y = pk2(x[2] - bf2f((unsigned short)h2), x[3] - bf2f((unsigned short)h3)); *(LAS v2u*)(L + RT_XL + off) = lw; }
            __syncthreads();
#pragma unroll
            for (int kk = 0; kk < 2; ++kk) { const int j = 2 * kq + kk, ks = w + 8 * kk;
                if (j < 7) RT_WLOAD(j + 1, (j + 1) & 1);
                const int o = (fr * RT_XP + ks * 32 + fq * 8) * 2; const bf16x8 xh = *(const LAS bf16x8*)(L + RT_XH + o), xl = *(const LAS bf16x8*)(L + RT_XL + o);
#pragma unroll
                for (int ct = 0; ct < 5; ++ct) { f32x4 a = acc[ct];
                    a = __builtin_amdgcn_mfma_f32_16x16x32_bf16(wh[j & 1][ct], xh, a, 0, 0, 0); a = __builtin_amdgcn_mfma_f32_16x16x32_bf16(wh[j & 1][ct], xl, a, 0, 0, 0); a = __builtin_amdgcn_mfma_f32_16x16x32_bf16(wl[j & 1][ct], xh, a, 0, 0, 0);
                    acc[ct] = a; }
                __builtin_amdgcn_sched_barrier(0);
            }
        }
#undef RT_WLOAD
#pragma unroll
        for (int ct = 0; ct < 5; ++ct) *(LAS f32x4*)(L + RT_PART + ((w * 5 + ct) * 64 + lane) * 16) = acc[ct];
        __syncthreads();
        if (F.tid < 320) { const int ct = F.tid >> 6, l = F.tid & 63; f32x4 s = {0.f, 0.f, 0.f, 0.f};
#pragma unroll
            for (int ww = 0; ww < 8; ++ww) s += *(const LAS f32x4*)(L + RT_PART + ((ww * 5 + ct) * 64 + l) * 16);
            const int tok = l & 15, col = ct * 16 + (l >> 4) * 4;
            LAS float* lg = (LAS float*)(L + RT_LG) + tok * 80 + col; lg[0] = s[0]; lg[1] = s[1]; lg[2] = s[2]; lg[3] = s[3]; }
        __syncthreads();
        if (F.tid < 16) {
            const int m = blk * 16 + F.tid; const LAS float* lgp = (const LAS float*)(L + RT_LG) + F.tid * 80;
            float lg[8];
#pragma unroll
            for (int g = 0; g < 8; ++g) lg[g] = lgp[g] + brg[g];
            int gi = 0; float gmax = lg[0];
#pragma unroll
            for (int g = 1; g < 8; ++g) if (lg[g] > gmax) { gmax = lg[g]; gi = g; }
            float gz = 0.f;
#pragma unroll
            for (int g = 0; g < 8; ++g) gz += __expf(lg[g] - gmax);
            const float gp = 1.f / gz;
            float el[8];
#pragma unroll
            for (int i = 0; i < 8; ++i) el[i] = lgp[8 + gi * 8 + i] + bre[gi * 8 + i];
            int i0 = 0; float e0 = el[0];
#pragma unroll
            for (int i = 1; i < 8; ++i) if (el[i] > e0) { e0 = el[i]; i0 = i; }
            int i1 = -1; float e1 = -INFINITY;
#pragma unroll
            for (int i = 0; i < 8; ++i) if (i != i0 && el[i] > e1) { e1 = el[i]; i1 = i; }
            const float x1 = __expf(e1 - e0), w0 = gp / (1.f + x1), w1 = gp * x1 / (1.f + x1);
            const int ea = gi * 8 + i0, eb = gi * 8 + i1;
            const unsigned pa = atomicAdd(cnt + ea, 1u), pb = atomicAdd(cnt + eb, 1u);
            list[(size_t)ea * CAP + pa] = m * 2; list[(size_t)eb * CAP + pb] = m * 2 + 1;
            tokE[m * 2] = ea; tokE[m * 2 + 1] = eb; tokP[m * 2] = (int)pa; tokP[m * 2 + 1] = (int)pb; tokW[m * 2] = w0; tokW[m * 2 + 1] = w1;
        }
    }
}

static_assert(NEXP == 64, "one wave = one lane per expert");
__device__ __forceinline__ int lane_excl_prefix(int v, int lane) {
    int s = 0;
#pragma unroll
    for (int e = 0; e < 64; ++e) { const int c = __builtin_amdgcn_readlane(v, e); s += (e < lane) ? c : 0; }
    return s; }
__device__ __forceinline__ void expert_offsets(const unsigned* cnt, LAS int* offs, LAS int* raw, int tid) {
    asm volatile("" : "+v"(tid));
    if (tid < NEXP) { const int mine = (int)__hip_atomic_load(cnt + tid, __ATOMIC_RELAXED, __HIP_MEMORY_SCOPE_AGENT); const int s = lane_excl_prefix(mine, tid);
        offs[tid] = s; if (tid == NEXP - 1) offs[NEXP] = s + mine; }
    __syncthreads();
}
constexpr int MOE_RCH = 512;
constexpr int MOE_ROWP = 2 * MOE_RCH * 128 + 2 * 64 * 144, MOE_TAB = MOE_ROWP + MOE_RCH * 4, MOE_END = MOE_TAB + 4 * 68 * 4;
static_assert(MOE_END <= RING_BYTES, "moe LDS");
__device__ __forceinline__ const float* uniform_ptr(const float* p) {
    const unsigned long long v = (unsigned long long)p; const unsigned lo = __builtin_amdgcn_readfirstlane((unsigned)v), hi = __builtin_amdgcn_readfirstlane((unsigned)(v >> 32));
    return (const float*)(((unsigned long long)hi << 32) | lo); }
template <int MODE> __device__ __forceinline__ void moe_gemm_pc(Frame& F, const float* const* in, bool tables_ready) {
    constexpr int KD = MODE == 1 ? DM : EFF, NSTEP = KD / 64, ABYTES = 256 * 128, BBYTES = 128 * 128;
    constexpr int bld = MODE == 1 ? EFF : DM, APITCH = (MODE == 1 ? U2P : ACTP) * 2; constexpr size_t out_ld = MODE == 1 ? ACTP : DM;
    static_assert(NSTEP % 2 == 0 && NSTEP >= 8, "steps");
    const bf16* Asrc = (const bf16*)(F.ws + (MODE == 1 ? WS_U2 : WS_ACT));
    const float* Wg = in[31]; const float* Wu = in[32]; const float* Wd = in[33];
    bf16* ACT = (bf16*)(F.ws + WS_ACT); bf16* YS = (bf16*)(F.ws + WS_YS);
    const int* list = (const int*)(F.ws + WS_LIST); const unsigned* cnt = (const unsigned*)(F.ctl + CW_CNT);
    LAS unsigned char* L = F.lds; LAS int* rowp = (LAS int*)(L + MOE_ROWP);
    LAS int* offs = (LAS int*)(L + MOE_TAB); LAS int* srt = offs + 68; LAS int* ust = srt + 68; LAS int* raw = ust + 68;
    int tid_ = F.tid; asm volatile("" : "+v"(tid_));
    const int tid = tid_, w = F.wave;
    if (!tables_ready) {
    if (tid < NEXP) {
        const int mine = (int)__hip_atomic_load(cnt + tid, __ATOMIC_RELAXED, __HIP_MEMORY_SCOPE_AGENT); int s = 0, rank = 0;
#pragma unroll
        for (int e = 0; e < NEXP; ++e) { const int c = __builtin_amdgcn_readlane(mine, e); s += (e < tid) ? c : 0; rank += (c > mine || (c == mine && e < tid)) ? 1 : 0; }
        offs[tid] = s; if (tid == NEXP - 1) offs[NEXP] = s + mine;
        const int pos = rank < NEXP / 2 ? 2 * rank : 2 * (NEXP - 1 - rank) + 1;
        srt[pos] = tid; raw[pos] = 16 * ((mine + 255) >> 8);
        __builtin_amdgcn_s_waitcnt(0xc07f);
        const int u = raw[tid]; const int su = lane_excl_prefix(u, tid);
        ust[tid] = su; if (tid == NEXP - 1) ust[NEXP] = su + u; }
    __syncthreads();
    }
    const int NU = ust[NEXP];
    int un = F.vcu;
    if (un >= NU) return;
#define MOE_DECODE(un_, e_, ct_, r0_, nrows_, slot0_) do { const int pos_ = __popcll(__ballot(F.lane >= 1 && ust[F.lane] <= (un_))); \
        e_ = srt[pos_]; const int ul_ = (un_) - ust[pos_], cnt_ = offs[e_ + 1] - offs[e_]; slot0_ = offs[e_]; const int nch_ = (cnt_ + 255) >> 8; \
        ct_ = ul_ / nch_; r0_ = (ul_ - ct_ * nch_) * 256; nrows_ = (cnt_ - r0_) < 256 ? (cnt_ - r0_) : 256; } while (0)
#define MOE_BBASE(e_, ct_) uniform_ptr(MODE == 1 ? ((w & 2) ? Wu : Wg) + (size_t)(e_) * DM * EFF + (ct_) * 64 : Wd + (size_t)(e_) * EFF * DM + (ct_) * 128)
#define MOE_ROWOF(e_, r0_, nrows_, slot0_, t_) ((MODE == 1) ? (list[(size_t)(e_) * CAP + (r0_) + ((t_) < (nrows_) ? (t_) : 0)] >> 1) : ((slot0_) + (r0_) + ((t_) < (nrows_) ? (t_) : 0)))
    if (w >= 4) {
        const int t8 = tid & 255;
        int kc, gcol, bcol;
        if (MODE == 1) { const int t7 = tid & 127; kc = t7 >> 4; gcol = (t7 & 15) * 4; bcol = ((w >> 1) & 1) * 64 + gcol; }
        else { kc = t8 >> 5; gcol = (t8 & 31) * 4; bcol = gcol; }
        const int bvoff = (kc * 8 * bld + gcol) * 4;
        int e, ct, r0, nrows, slot0; MOE_DECODE(un, e, ct, r0, nrows, slot0);
        rowp[t8] = MOE_ROWOF(e, r0, nrows, slot0, t8);
        __syncthreads();
        const __amdgpu_buffer_rsrc_t rsA = __builtin_amdgcn_make_buffer_rsrc((void*)Asrc, 0, 0x7fffffff, 0x00020000);
        __amdgpu_buffer_rsrc_t rsB = __builtin_amdgcn_make_buffer_rsrc((void*)MOE_BBASE(e, ct), 0, 0x7fffffff, 0x00020000);
        int avoff[8];
#define PC_AVOFF(PB) do { _Pragma("unroll") for (int i = 0; i < 8; ++i) { const int q = t8 + i * 256; avoff[i] = rowp[(PB) * 256 + (q >> 3)] * APITCH + (q & 7) * 16; } } while (0)
        PC_AVOFF(0);
        v4u areg[8]; f32x4 breg[2][8];
#define PC_ALOAD(st) do { _Pragma("unroll") for (int i = 0; i < 8; ++i) areg[i] = __builtin_bit_cast(v4u, __builtin_amdgcn_raw_buffer_load_b128(rsA, avoff[i], (st) * 128, 0)); } while (0)
#define PC_BLOAD(st, S) do { _Pragma("unroll") for (int j = 0; j < 8; ++j) breg[S][j] = __builtin_bit_cast(f32x4, __builtin_amdgcn_raw_buffer_load_b128(rsB, bvoff, ((st) * 64 + j) * bld * 4, 0)); } while (0)
#define PC_WRITE(st, SB) do { \
        const int wb = (st) & 1; LAS unsigned char* Aw = L + wb * ABYTES; LAS unsigned char* Bw = L + 2 * ABYTES + wb * BBYTES; \
        _Pragma("unroll") for (int i = 0; i < 8; ++i) { const int q = t8 + i * 256, r = q >> 3; *(LAS v4u*)(Aw + r * 128 + 16 * ((q & 7) ^ (r & 7))) = areg[i]; } \
        _Pragma("unroll") for (int c = 0; c < 4; ++c) { v4u pw; pw.x = pk2(breg[SB][0][c], breg[SB][1][c]); pw.y = pk2(breg[SB][2][c], breg[SB][3][c]); pw.z = pk2(breg[SB][4][c], breg[SB][5][c]); pw.w = pk2(breg[SB][6][c], breg[SB][7][c]); \
            *(LAS v4u*)(Bw + (bcol + c) * 128 + 16 * (kc ^ (((bcol + c) ^ (bcol >> 2)) & 7))) = pw; } } while (0)
        PC_ALOAD(0); PC_BLOAD(0, 0); PC_BLOAD(1, 1);
        PC_WRITE(0, 0); PC_ALOAD(1); PC_BLOAD(2, 0);
        int pb = 0;
        while (true) {
            const int unn = un + F.G; const bool hasn = unn < NU;
            int e2 = 0, ct2 = 0, r02 = 0, nrows2 = 0, slot02 = 0, rp2 = 0;
            if (hasn) { MOE_DECODE(unn, e2, ct2, r02, nrows2, slot02); rp2 = MOE_ROWOF(e2, r02, nrows2, slot02, t8); }
#pragma unroll 1
            for (int st = 0; st < NSTEP - 4; st += 2) {
                __syncthreads(); PC_WRITE(st + 1, 1); PC_ALOAD(st + 2); PC_BLOAD(st + 3, 1); __builtin_amdgcn_sched_barrier(0);
                __syncthreads(); PC_WRITE(st + 2, 0); PC_ALOAD(st + 3); PC_BLOAD(st + 4, 0); __builtin_amdgcn_sched_barrier(0);
            }
            __syncthreads(); PC_WRITE(NSTEP - 3, 1); PC_ALOAD(NSTEP - 2); PC_BLOAD(NSTEP - 1, 1); rowp[(pb ^ 1) * 256 + t8] = rp2; __builtin_amdgcn_sched_barrier(0);
            __syncthreads(); PC_WRITE(NSTEP - 2, 0); PC_ALOAD(NSTEP - 1);
            if (hasn) { rsB = __builtin_amdgcn_make_buffer_rsrc((void*)MOE_BBASE(e2, ct2), 0, 0x7fffffff, 0x00020000); PC_BLOAD(0, 0); }
            __builtin_amdgcn_sched_barrier(0);
            __syncthreads(); PC_WRITE(NSTEP - 1, 1);
            if (hasn) { PC_AVOFF(pb ^ 1); PC_ALOAD(0); PC_BLOAD(1, 1); }
            __builtin_amdgcn_sched_barrier(0);
            __syncthreads();
            if (!hasn) break;
            PC_WRITE(0, 0); PC_ALOAD(1); PC_BLOAD(2, 0); __builtin_amdgcn_sched_barrier(0);
            un = unn; pb ^= 1;
        }
#undef PC_AVOFF
#undef PC_ALOAD
#undef PC_BLOAD
#undef PC_WRITE
    } else {
        int fr = tid & 15, fq = (tid >> 4) & 3;
        __syncthreads();
        while (true) {
            int e, ct, r0, nrows, slot0; MOE_DECODE(un, e, ct, r0, nrows, slot0);
            bf16* outp = (MODE == 1) ? ACT + (size_t)(slot0 + r0) * ACTP + ct * 64 : YS + (size_t)(slot0 + r0) * DM + ct * 128;
            f32x4 acc[4][8];
#pragma unroll
            for (int a = 0; a < 4; ++a)
#pragma unroll
                for (int n = 0; n < 8; ++n) acc[a][n] = (f32x4){0.f, 0.f, 0.f, 0.f};
            bf16x8 af0[4], af1[4], bfr[8];
#pragma unroll
            for (int a = 0; a < 4; ++a) af1[a] = (bf16x8){0, 0, 0, 0, 0, 0, 0, 0};
#pragma unroll
            for (int n = 4; n < 8; ++n) bfr[n] = (bf16x8){0, 0, 0, 0, 0, 0, 0, 0};
#define PC_SB() __builtin_amdgcn_sched_barrier(0)
#define PC_RDA(ks, a) (*(const LAS bf16x8*)(As + ((w + 4 * (a)) * 16 + fr) * 128 + 16 * (((ks) * 4 + fq) ^ (fr & 7))))
#define PC_RDB(ks, n) (*(const LAS bf16x8*)(Bs + ((n) * 16 + fr) * 128 + 16 * (((ks) * 4 + fq) ^ ((fr ^ (((n) & 1) * 4 + (fr >> 2))) & 7))))
#define PC_MM(AF, N0) do { _Pragma("unroll") for (int n = (N0); n < (N0) + 4; ++n) _Pragma("unroll") for (int a = 0; a < 4; ++a) acc[a][n] = __builtin_amdgcn_mfma_f32_16x16x32_bf16(bfr[n], AF[a], acc[a][n], 0, 0, 0); } while (0)
#define PC_COMPUTE(st) do { \
            const int buf = (st) & 1; const LAS unsigned char* As = L + buf * ABYTES; const LAS unsigned char* Bs = L + 2 * ABYTES + buf * BBYTES; \
            _Pragma("unroll") for (int a = 0; a < 4; ++a) af0[a] = PC_RDA(0, a); \
            _Pragma("unroll") for (int n = 0; n < 4; ++n) bfr[n] = PC_RDB(0, n); \
            PC_SB(); PC_MM(af1, 4); PC_SB();                                     \
            _Pragma("unroll") for (int n = 4; n < 8; ++n) bfr[n] = PC_RDB(0, n); \
            _Pragma("unroll") for (int a = 0; a < 4; ++a) af1[a] = PC_RDA(1, a); \
            PC_SB(); PC_MM(af0, 0); PC_SB();                                     \
            _Pragma("unroll") for (int n = 0; n < 4; ++n) bfr[n] = PC_RDB(1, n); \
            PC_SB(); PC_MM(af0, 4); PC_SB();                                     \
            _Pragma("unroll") for (int n = 4; n < 8; ++n) bfr[n] = PC_RDB(1, n); \
            PC_SB(); PC_MM(af1, 0); PC_SB();                                     \
            } while (0)
#pragma unroll 1
            for (int st = 0; st < NSTEP; st += 2) {
                asm volatile("" : "+v"(fr), "+v"(fq));
                __syncthreads(); PC_COMPUTE(st);
                __syncthreads(); PC_COMPUTE(st + 1);
            }
            PC_MM(af1, 4);
#undef PC_COMPUTE
#undef PC_MM
#undef PC_RDA
#undef PC_RDB
#undef PC_SB
#pragma unroll
            for (int a = 0; a < 4; ++a) { const int r = (w + 4 * a) * 16 + fr;
                if (r < nrows) { bf16* orow = outp + (size_t)r * out_ld;
                    if (MODE == 1) {
#pragma unroll
                        for (int n = 0; n < 4; ++n) { const f32x4 g = acc[a][n], uu = acc[a][n + 4]; float o[4];
#pragma unroll
                            for (int x = 0; x < 4; ++x) o[x] = g[x] / (1.f + __expf(-g[x])) * uu[x];
                            uint2 pw; pw.x = pk2(o[0], o[1]); pw.y = pk2(o[2], o[3]); *(uint2*)(orow + n * 16 + fq * 4) = pw; }
                    } else {
#pragma unroll
                        for (int n = 0; n < 8; ++n) { const f32x4 o = acc[a][n]; uint2 pw; pw.x = pk2(o[0], o[1]); pw.y = pk2(o[2], o[3]); *(uint2*)(orow + n * 16 + fq * 4) = pw; }
                    } } }
            un += F.G; if (un >= NU) break;
        }
    }
#undef MOE_DECODE
#undef MOE_BBASE
#undef MOE_ROWOF
}

__device__ __forceinline__ void p14_final(Frame& F, const float* const* in, float* out) {
    const float* H1 = (const float*)(F.ws + WS_H1); const bf16* YS = (const bf16*)(F.ws + WS_YS); const float* ada = (const float*)(F.ws + WS_ADA); const float* fg = in[34];
    const int* tokE = (const int*)(F.ws + WS_TOKE); const int* tokP = (const int*)(F.ws + WS_TOKP); const float* tokW = (const float*)(F.ws + WS_TOKW);
    const unsigned* cnt = (const unsigned*)(F.ctl + CW_CNT);
    LAS int* offs = (LAS int*)F.lds;
    expert_offsets(cnt, offs, offs + 128, F.tid);
    const int gw = F.vcu * NWAVES + F.wave, NGW = F.G * NWAVES, lane = F.lane;
    for (int m0 = gw; m0 < M; m0 += 2 * NGW) {
        int mm[2], sa[2], sb[2]; float wa[2], wb[2];
#pragma unroll
        for (int r = 0; r < 2; ++r) { const int m = m0 + r * NGW < M ? m0 + r * NGW : m0; mm[r] = m;
            sa[r] = offs[tokE[m * 2]] + tokP[m * 2]; sb[r] = offs[tokE[m * 2 + 1]] + tokP[m * 2 + 1]; wa[r] = tokW[m * 2]; wb[r] = tokW[m * 2 + 1]; }
        f32x4 v[2][8]; float s2[2] = {0.f, 0.f};
#pragma unroll
        for (int r = 0; r < 2; ++r) { const float* gt2 = ada + (size_t)(mm[r] / SEQ) * 12288 + 10240;
            const uint2* y0 = (const uint2*)(YS + (size_t)sa[r] * DM) + lane; const uint2* y1 = (const uint2*)(YS + (size_t)sb[r] * DM) + lane;
            const f32x4* hr = (const f32x4*)(H1 + (size_t)mm[r] * DM) + lane;
#pragma unroll
            for (int j = 0; j < 8; ++j) { const uint2 a = y0[64 * j], c = y1[64 * j]; const f32x4 g = ((const f32x4*)gt2)[lane + 64 * j]; const float w0 = wa[r], w1 = wb[r];
                f32x4 mo; mo[0] = w0 * bflo(a.x) + w1 * bflo(c.x); mo[1] = w0 * bfhi(a.x) + w1 * bfhi(c.x); mo[2] = w0 * bflo(a.y) + w1 * bflo(c.y); mo[3] = w0 * bfhi(a.y) + w1 * bfhi(c.y);
                v[r][j] = hr[64 * j] + g * mo; s2[r] += (v[r][j].x * v[r][j].x + v[r][j].y * v[r][j].y) + (v[r][j].z * v[r][j].z + v[r][j].w * v[r][j].w); } }
#pragma unroll
        for (int r = 0; r < 2; ++r) { if (r == 1 && m0 + NGW >= M) break;
            const float rstd = 1.f / sqrtf(wave_sum(s2[r]) * (1.f / DM) + NORM_EPS);
            f32x4* orow = (f32x4*)(out + (size_t)mm[r] * DM) + lane;
#pragma unroll
            for (int j = 0; j < 8; ++j) orow[64 * j] = v[r][j] * rstd * ((const f32x4*)fg)[lane + 64 * j]; }
    }
}

struct Args { const float* in[35]; float* out; unsigned char* ws; int ph_lo, ph_hi, use_bar, pad; };
__global__ void __launch_bounds__(NTHR, 2) fwd_kernel(Args args) {
    extern __shared__ __attribute__((aligned(16))) unsigned char lds[];
    Frame F;
    F.lds = (LAS unsigned char*)lds; F.MISC = (volatile LAS unsigned*)(F.lds + MISC_OFF);
    F.tid = threadIdx.x; F.lane = F.tid & 63; F.wave = __builtin_amdgcn_readfirstlane(F.tid >> 6);
    F.G = gridDim.x; { const int bx = blockIdx.x; F.vcu = (F.G % 8 == 0) ? (bx % 8) * (F.G / 8) + bx / 8 : bx; }
    F.ws = args.ws; F.ctl = (gu32*)(args.ws + WS_CTL); F.probe = args.pad;
    for (int u = F.tid; u < (LDS_BYTES - LDSCTL_OFF) / 4; u += NTHR) ((LAS unsigned*)(F.lds + LDSCTL_OFF))[u] = 0u;
    __syncthreads();
    XcdBarrier bar; bar.bar = (unsigned*)(F.ctl + CW_BAR); bar.x = 0; bar.st = nullptr;
    if (args.use_bar) bar = xcd_barrier_post((unsigned*)(F.ctl + CW_BAR), F.MISC + 8);
    const int lo = args.ph_lo, hi = args.ph_hi;
    const float* const* in = args.in;
#ifndef PHASE_MASK
#define PHASE_MASK 0xFFFF
#endif
#define IN(k) ((((PHASE_MASK) >> (k)) & 1) && lo <= (k) && (k) < hi)
#define SEAM(k) do { if (IN(k) && IN((k) + 1)) xcd_barrier(bar); } while (0)
#ifndef PROBE_REPEAT_MASK
#define PROBE_REPEAT_MASK 0
#endif
#define REPS(k) for (int rep_ = 0; rep_ < 1 + (((PROBE_REPEAT_MASK) >> (k)) & 1); ++rep_, (rep_ < 1 + (((PROBE_REPEAT_MASK) >> (k)) & 1)) ? xcd_barrier(bar) : (void)0)
    const float* ada = (const float*)(F.ws + WS_ADA);

    if (IN(0)) REPS(0) { p0_prologue(F, in); } SEAM(0);
    if (IN(1)) REPS(1) {
        const int gw = F.vcu * NWAVES + F.wave, NGW = F.G * NWAVES; bf16* U = (bf16*)(F.ws + WS_U);
        for (int m = gw; m < M; m += 2 * NGW) { const int m2 = m + NGW < M ? m + NGW : m; const float* ad = ada + (size_t)(m / SEQ) * 12288; const float* ad2 = ada + (size_t)(m2 / SEQ) * 12288;
            norm_mod_row2(in[0] + (size_t)m * DM, in[0] + (size_t)m2 * DM, in[5], ad + 2048, ad, ad2 + 2048, ad2, U + (size_t)m * DM, U + (size_t)m2 * DM, F.lane); }
    } SEAM(1);
    if (IN(2)) REPS(2) {
        pg8::Gemm g{(const pg8::bf16_t*)(F.ws + WS_U), (const pg8::bf16_t*)(F.ws + WS_WIN_T), M, IN_COLS - 256, DM}; pg8::StaticOrder S; S.init(M, IN_COLS - 256, F.G, (int)blockIdx.x);
        pg8::EpiIn E{F.ws, (const float*)(F.ws + WS_ROPE), 0};
        pg8::gemm_phase<pg8::EpiIn, pg8::StaticOrder, PG8_ALIGN, PG8_SP2>(F.lds + RING_OFF, g, S, E);
    } SEAM(2);
    if (IN(5)) REPS(5) {
        const attn_body::AttnTensors AT{(const attn_body::bf16*)(F.ws + WS_Q), (const attn_body::bf16*)(F.ws + WS_K), (const attn_body::bf16*)(F.ws + WS_V), (attn_body::bf16*)(F.ws + WS_O0), (attn_body::bf16*)(F.ws + WS_O1)};
        const attn_body::StaticOrder S((int)F.G, F.vcu);
        attn_body::attn_phase<attn_body::StaticOrder>((char*)lds + RING_OFF, AT, S);
        __syncthreads();
    }
#if RWKV_SEQ
    if (IN(3)) REPS(3) { p3_rwkv_prep(F, in); } SEAM(3);
    if (IN(4)) REPS(4) { p4_rwkv_scan(F); } SEAM(4);
#else
    if (IN(3)) REPS(3) {
        {
            pg8::Gemm g{(const pg8::bf16_t*)(F.ws + WS_U), (const pg8::bf16_t*)(F.ws + WS_WIN_T) + (size_t)(IN_COLS - 256) * DM, M, 256, DM}; pg8::StaticOrder S; S.init(M, 256, F.G, (int)blockIdx.x);
            pg8::EpiIn E{F.ws, (const float*)(F.ws + WS_ROPE), 40};
            pg8::gemm_phase<pg8::EpiIn, pg8::StaticOrder, PG8_ALIGN, PG8_SP2>(F.lds + RING_OFF, g, S, E);
        }
        p3_rwkv_chunk(F, in); } SEAM(3);
    if (IN(4)) REPS(4) {
        p4_rwkv_chain(F);
        const int nch = BATCH * 16 < (int)F.G ? BATCH * 16 : 0;
        if ((int)blockIdx.x >= nch) p6_attn_combine(F, in, ((int)blockIdx.x - nch) * NWAVES + F.wave, ((int)F.G - nch) * NWAVES);
    } SEAM(4);
#endif
    if (IN(6)) REPS(6) { p6_combine(F, in); } SEAM(6);
    if (IN(7)) REPS(7) {
        pg8::Gemm g{(const pg8::bf16_t*)(F.ws + WS_YATT), (const pg8::bf16_t*)(F.ws + WS_WUPA_T), M, DM, ATT_W}; pg8::StaticOrder S; S.init(M, DM, F.G, (int)blockIdx.x);
        pg8::EpiPair E{(const pg8::bf16_t*)(F.ws + WS_G), (pg8::bf16_t*)(F.ws + WS_MERGED)};
        pg8::gemm_phase_pair<pg8::EpiPair, pg8::StaticOrder, PG8_ALIGN, PG8_SP2>(F.lds + RING_OFF, g, (const pg8::bf16_t*)(F.ws + WS_YRW), (const pg8::bf16_t*)(F.ws + WS_WUPB_T), S, E);
    } SEAM(7);
    if (IN(8)) REPS(8) { }
    if (IN(9)) REPS(9) {
        pg8::Gemm g{(const pg8::bf16_t*)(F.ws + WS_MERGED), (const pg8::bf16_t*)(F.ws + WS_WOUT_T), M, DM, DM}; pg8::StaticOrder S; S.init(M, DM, F.G, (int)blockIdx.x);
        pg8::EpiH1 E{in[0], ada, (float*)(F.ws + WS_H1)};
        pg8::gemm_phase<pg8::EpiH1, pg8::StaticOrder, PG8_ALIGN, PG8_SP2>(F.lds + RING_OFF, g, S, E);
    } SEAM(9);
    if (IN(10)) REPS(10) { p10_route(F, in); } SEAM(10);
    if (IN(11)) REPS(11) { moe_gemm_pc<1>(F, in, false); } SEAM(11);
    if (IN(12)) REPS(12) { moe_gemm_pc<2>(F, in, IN(11)); } SEAM(12);
    if (IN(13)) REPS(13) { p14_final(F, in, args.out); }
#undef IN
#undef SEAM
}

extern "C" void kernel_launch(void* const* d_in, const int* in_sizes, int n_in, void* d_out, int out_size, void* d_ws, size_t ws_size, hipStream_t stream) {
    static int grid = 0;
    if (grid == 0) {
        if (n_in != 35 || out_size != M * DM || ws_size < WS_END) { fprintf(stderr, "kernel_launch: unexpected shapes (n_in %d out %d ws %zu)\n", n_in, out_size, ws_size); grid = -1; return; }
        int dev = 0, cus = 0;
        if (hipGetDevice(&dev) != hipSuccess || hipDeviceGetAttribute(&cus, hipDeviceAttributeMultiprocessorCount, dev) != hipSuccess) { grid = -1; return; }
        if (hipFuncSetAttribute((const void*)fwd_kernel, hipFuncAttributeMaxDynamicSharedMemorySize, LDS_BYTES) != hipSuccess) { fprintf(stderr, "kernel_launch: hipFuncSetAttribute failed\n"); grid = -1; return; }
        int per_cu = 0; (void)hipOccupancyMaxActiveBlocksPerMultiprocessor(&per_cu, (const void*)fwd_kernel, NTHR, LDS_BYTES); (void)hipGetLastError();
        if (per_cu < 1) fprintf(stderr, "kernel_launch: occupancy query says %d\n", per_cu);
        grid = cus;
    }
    if (grid < 0) return;
    (void)hipMemsetAsync((char*)d_ws + WS_CTL, 0, CTL_ZERO_BYTES, stream);
    Args a{};
    for (int i = 0; i < 35; ++i) a.in[i] = (const float*)d_in[i];
    a.out = (float*)d_out; a.ws = (unsigned char*)d_ws; a.pad = 0;
#if MK_ONE_LAUNCH
    a.ph_lo = 0; a.ph_hi = 14; a.use_bar = 1;
    hipLaunchKernelGGL(fwd_kernel, dim3(grid), dim3(NTHR), LDS_BYTES, stream, a);
#ifdef PROBE_PHASE
    a.ph_lo = PROBE_PHASE; a.ph_hi = PROBE_PHASE + 1; a.use_bar = 0; a.pad = 1;
    (void)hipMemsetAsync((char*)d_ws + WS_CTL + CW_P3Q * 4, 0, 16, stream);
    hipLaunchKernelGGL(fwd_kernel, dim3(grid), dim3(NTHR), LDS_BYTES, stream, a);
#endif
#else
    for (int p = 0; p < 14; ++p) { a.ph_lo = p; a.ph_hi = p + 1; a.use_bar = 0;
        hipLaunchKernelGGL(fwd_kernel, dim3(grid), dim3(NTHR), LDS_BYTES, stream, a); }
#endif
}
```

```cpp
#include <hip/hip_runtime.h>
#include <hip/hip_bf16.h>
#include <cstdio>
#include <cstdint>
#include <cmath>
namespace pg8 {
#define PG8_LAS __attribute__((address_space(3)))
typedef unsigned short bf16_t;
typedef short bf16x8 __attribute__((ext_vector_type(8)));
typedef float f32x4 __attribute__((ext_vector_type(4)));
typedef unsigned u32x4 __attribute__((ext_vector_type(4)));
constexpr int BM = 256, BK = 64, HALF = 128, HTB = HALF * BK * 2  , STAGE_BYTES = 8 * HTB, NXCD = 8, WGM = 8;

__host__ __device__ __forceinline__ int lds_byte(int r, int c) { const int st = (r >> 4) * 2 + (c >> 5), rr = r & 15, cc = c & 31, ob = rr * 64 + cc * 2; return st * 1024 + (ob ^ (((ob >> 9) & 1) << 5)); }
__host__ __device__ __forceinline__ void stage_rc(int b, int& R, int& C) { const int st = b / 1024, sb = b % 1024, swz = sb ^ (((sb >> 9) & 1) << 5); R = (st >> 1) * 16 + swz / 64; C = (st & 1) * 32 + (swz % 64) / 2; }
__host__ __device__ __forceinline__ int perm32(int rho) { const int n = rho >> 4, i = rho & 15; return 8 * (i >> 2) + 4 * n + (i & 3); }

struct Unit { int pm, pn; };
struct Gemm { const bf16_t* A; const bf16_t* Bt; int M, N, K; };

struct StaticOrder {
    int nM, nN, nwg, G, c;
    __host__ __device__ void init(int M, int N, int G_, int c_) { nM = M / BM; nN = N / BM; nwg = nM * nN; G = G_; c = c_; }
    __host__ __device__ bool next(int i, Unit& u) const {
        const long L = (long)i * G + c; if (L >= nwg) return false;
        int wgid = (int)L; { const int q = nwg / NXCD, r = nwg % NXCD, xcd = wgid % NXCD, off = wgid / NXCD; wgid = (xcd < r ? xcd * (q + 1) : r * (q + 1) + (xcd - r) * q) + off; }
        const int nig = WGM * nN, gid = wgid / nig, fm = gid * WGM, gsz = (nM - fm) < WGM ? (nM - fm) : WGM;
        u.pm = fm + ((wgid % nig) % gsz); u.pn = (wgid % nig) / gsz; return true;
    }
    __device__ __forceinline__ void a_ready(const Unit&) const {}
    __device__ __forceinline__ void done(const Unit&) const {}
};

typedef float f32x2_cv __attribute__((ext_vector_type(2))); typedef __bf16 bf16x2_cv __attribute__((ext_vector_type(2)));
__device__ __forceinline__ unsigned cvt_pk_bf16(float lo, float hi) { const f32x2_cv v = {lo, hi}; return __builtin_bit_cast(unsigned, __builtin_convertvector(v, bf16x2_cv)); }
typedef float f32x2 __attribute__((ext_vector_type(2)));
__device__ __forceinline__ f32x2 gelu_pk(f32x2 v) {
    const f32x2 av = __builtin_elementwise_abs(v), d = av * 0.2316418882f + 1.0f;
    f32x2 t; t.x = __builtin_amdgcn_rcpf(d.x); t.y = __builtin_amdgcn_rcpf(d.y);
    f32x2 q = t * 0.5307027145f + (-0.7265760135f); q = q * t + 0.7107068705f; q = q * t + (-0.142248368f); q = q * t + 0.127414796f; q = q * t;
    const f32x2 s = (v * v) * (-0.72134752044f);
    f32x2 e; e.x = __builtin_amdgcn_exp2f(s.x); e.y = __builtin_amdgcn_exp2f(s.y);
    const f32x2 m = v * (q * e), r = v - m;
    f32x2 o; o.x = v.x < 0.f ? m.x : r.x; o.y = v.y < 0.f ? m.y : r.y; return o;
}


template <class Epi, class Sched, bool ALIGN_EPI = false, bool SP2 = false>
__device__ __forceinline__ void gemm_phase(PG8_LAS unsigned char* lds, const Gemm g, const Sched& S, const Epi& E) {
    int tid_ = threadIdx.x; asm volatile("" : "+v"(tid_));
    const int tid = tid_, wid = __builtin_amdgcn_readfirstlane(tid >> 6), lane = tid & 63, wr = wid >> 2, wc = wid & 3, fr = lane & 15, fq = lane >> 4;
    const int K = g.K, nt = K / BK;
    unsigned voffA[2], voffB[2];
#pragma unroll
    for (int i = 0; i < 2; ++i) { int R, C; stage_rc(tid * 16 + i * 8192, R, C); const int Rb = Epi::PERM ? ((R & ~31) + perm32(R & 31)) : R;
        voffA[i] = (unsigned)(R * K + C) * 2u; voffB[i] = (unsigned)(Rb * K + C) * 2u; }
    const size_t kstep = (size_t)(BK * 2);
    const size_t hstep = (size_t)HALF * K * 2;
    const size_t tstep = 2 * hstep;
    const unsigned ldsw = (unsigned)wid * 1024u;
    const int aoff = lds_byte(wr * 64 + fr, fq * 8), boff = lds_byte(wc * 32 + fr, fq * 8);
#define PG8_SA(b, h) (((b) * 2 + (h)) * HTB)
#define PG8_SB(b, h) ((4 + (b) * 2 + (h)) * HTB)
#define PG8_STAGE(bufoff, gbase, voff) do { _Pragma("unroll") for (int _i = 0; _i < 2; ++_i) \
        __builtin_amdgcn_global_load_lds((const unsigned*)((const char*)(gbase) + (voff)[_i]), (PG8_LAS unsigned*)(lds + (bufoff) + ldsw + _i * 8192), 16, 0, 0); } while (0)
#define PG8_LDA(dst, b, h) do { _Pragma("unroll") for (int m = 0; m < 4; ++m) _Pragma("unroll") for (int k = 0; k < 2; ++k) dst[m][k] = *(const PG8_LAS bf16x8*)(lds + PG8_SA(b, h) + aoff + m * 2048 + k * 1024); } while (0)
#define PG8_LDB(dst, b, h) do { _Pragma("unroll") for (int n = 0; n < 2; ++n) _Pragma("unroll") for (int k = 0; k < 2; ++k) dst[n][k] = *(const PG8_LAS bf16x8*)(lds + PG8_SB(b, h) + boff + n * 2048 + k * 1024); } while (0)
#define PG8_MMA(ai, bj, At, Bt) do { __builtin_amdgcn_s_setprio(1); _Pragma("unroll") for (int m = 0; m < 4; ++m) _Pragma("unroll") for (int n = 0; n < 2; ++n) _Pragma("unroll") for (int k = 0; k < 2; ++k) \
        acc[ai][bj][m][n] = __builtin_amdgcn_mfma_f32_16x16x32_bf16(Bt[n][k], At[m][k], acc[ai][bj][m][n], 0, 0, 0); __builtin_amdgcn_s_setprio(0); } while (0)
#define PG8_WAIT_V(n) asm volatile("s_waitcnt vmcnt(" #n ")" ::: "memory")
#define PG8_WAIT_L(n) asm volatile("s_waitcnt lgkmcnt(" #n ")" ::: "memory")
#define PG8_BAR __builtin_amdgcn_s_barrier()
#define PG8_SCHED __builtin_amdgcn_sched_barrier(0)
    Unit cur, nxt; int ui = 0;
    if (!S.next(0, cur)) return;
    f32x4 acc[2][2][4][2];
#pragma unroll
    for (int a = 0; a < 2; ++a)
#pragma unroll
        for (int b = 0; b < 2; ++b)
#pragma unroll
            for (int m = 0; m < 4; ++m)
#pragma unroll
                for (int n = 0; n < 2; ++n) acc[a][b][m][n] = (f32x4){0.f, 0.f, 0.f, 0.f};
    bf16x8 At[4][2], B0[2][2], B1[2][2];
    const char* cA = (const char*)g.A + (size_t)cur.pm * tstep; const char* cB = (const char*)g.Bt + (size_t)cur.pn * tstep;
    S.a_ready(cur);
    if constexpr (SP2) {
        PG8_STAGE(PG8_SB(0, 0), cB, voffB); PG8_STAGE(PG8_SB(0, 1), cB + hstep, voffB); PG8_STAGE(PG8_SA(0, 0), cA, voffA); PG8_STAGE(PG8_SA(0, 1), cA + hstep, voffA);
        if (wr == 1) PG8_BAR;
        PG8_WAIT_V(2); PG8_BAR;
        PG8_STAGE(PG8_SB(1, 0), cB + kstep, voffB); PG8_STAGE(PG8_SA(1, 0), cA + kstep, voffA); PG8_STAGE(PG8_SB(1, 1), cB + hstep + kstep, voffB);
        PG8_WAIT_V(6); PG8_BAR;
    } else {
        PG8_STAGE(PG8_SB(0, 0), cB, voffB); PG8_STAGE(PG8_SA(0, 0), cA, voffA); PG8_STAGE(PG8_SB(0, 1), cB + hstep, voffB); PG8_STAGE(PG8_SA(0, 1), cA + hstep, voffA);
        if (wr == 1) PG8_BAR;
        PG8_WAIT_V(4); PG8_BAR;
        PG8_STAGE(PG8_SB(1, 0), cB + kstep, voffB); PG8_STAGE(PG8_SA(1, 0), cA + kstep, voffA); PG8_STAGE(PG8_SB(1, 1), cB + hstep + kstep, voffB);
        PG8_WAIT_V(6); PG8_BAR;
    }
    for (;;) {
        const bool has_next = S.next(ui + 1, nxt);
        const char* nA = has_next ? (const char*)g.A + (size_t)nxt.pm * tstep : cA; const char* nB = has_next ? (const char*)g.Bt + (size_t)nxt.pn * tstep : cB;
        for (int t = 0; t < nt; t += 2) {
            const bool last = (t == nt - 2);
            const char* a1 = cA + (size_t)(t + 1) * kstep;
            const char* a2 = last ? nA : cA + (size_t)(t + 2) * kstep; const char* b2 = last ? nB : cB + (size_t)(t + 2) * kstep;
            const char* a3 = a2 + kstep; const char* b3 = b2 + kstep;
            if (last && has_next) S.a_ready(nxt);
            if constexpr (SP2) {
            PG8_LDB(B0, 0, 0); PG8_LDB(B1, 0, 1); PG8_SCHED; PG8_LDA(At, 0, 0); PG8_STAGE(PG8_SA(1, 1), a1 + hstep, voffA);
            PG8_WAIT_V(8); PG8_WAIT_L(0); PG8_BAR; PG8_MMA(0, 0, At, B0); PG8_MMA(0, 1, At, B1); PG8_BAR; PG8_SCHED;
            PG8_LDA(At, 0, 1); PG8_STAGE(PG8_SB(0, 0), b2, voffB); PG8_STAGE(PG8_SB(0, 1), b2 + hstep, voffB); PG8_STAGE(PG8_SA(0, 0), a2, voffA);
            PG8_WAIT_V(8); PG8_WAIT_L(0); PG8_BAR; PG8_MMA(1, 0, At, B0); PG8_MMA(1, 1, At, B1); PG8_BAR; PG8_SCHED;
            PG8_LDB(B0, 1, 0); PG8_LDB(B1, 1, 1); PG8_SCHED; PG8_LDA(At, 1, 0); PG8_STAGE(PG8_SA(0, 1), a2 + hstep, voffA);
            PG8_WAIT_V(8); PG8_WAIT_L(0); PG8_BAR; PG8_MMA(0, 0, At, B0); PG8_MMA(0, 1, At, B1); PG8_BAR; PG8_SCHED;
            PG8_LDA(At, 1, 1); PG8_STAGE(PG8_SB(1, 0), b3, voffB); PG8_STAGE(PG8_SB(1, 1), b3 + hstep, voffB); PG8_STAGE(PG8_SA(1, 0), a3, voffA);
            PG8_WAIT_V(8); PG8_WAIT_L(0); PG8_BAR; PG8_MMA(1, 0, At, B0); PG8_MMA(1, 1, At, B1); PG8_BAR; PG8_SCHED;
            } else {
            PG8_LDB(B0, 0, 0); PG8_SCHED; PG8_LDA(At, 0, 0); PG8_STAGE(PG8_SA(1, 1), a1 + hstep, voffA);
            PG8_WAIT_L(8); PG8_BAR; PG8_WAIT_L(0); PG8_MMA(0, 0, At, B0); PG8_BAR; PG8_SCHED;
            PG8_LDB(B1, 0, 1); PG8_STAGE(PG8_SB(0, 0), b2, voffB);
            PG8_BAR; PG8_WAIT_L(0); PG8_MMA(0, 1, At, B1); PG8_BAR;
            PG8_LDA(At, 0, 1); PG8_STAGE(PG8_SA(0, 0), a2, voffA);
            PG8_BAR; PG8_WAIT_L(0); PG8_MMA(1, 0, At, B0); PG8_BAR; PG8_SCHED;
            PG8_STAGE(PG8_SB(0, 1), b2 + hstep, voffB);
            PG8_WAIT_V(6); PG8_BAR; PG8_MMA(1, 1, At, B1); PG8_BAR;
            PG8_LDB(B0, 1, 0); PG8_SCHED; PG8_LDA(At, 1, 0); PG8_STAGE(PG8_SA(0, 1), a2 + hstep, voffA);
            PG8_WAIT_L(8); PG8_BAR; PG8_WAIT_L(0); PG8_MMA(0, 0, At, B0); PG8_BAR; PG8_SCHED;
            PG8_LDB(B1, 1, 1); PG8_STAGE(PG8_SB(1, 0), b3, voffB);
            PG8_BAR; PG8_WAIT_L(0); PG8_MMA(0, 1, At, B1); PG8_BAR;
            PG8_LDA(At, 1, 1); PG8_STAGE(PG8_SA(1, 0), a3, voffA);
            PG8_BAR; PG8_WAIT_L(0); PG8_MMA(1, 0, At, B0); PG8_BAR; PG8_SCHED;
            PG8_STAGE(PG8_SB(1, 1), b3 + hstep, voffB);
            PG8_WAIT_V(6); PG8_BAR; PG8_MMA(1, 1, At, B1); PG8_BAR;
            }
        }
        if constexpr (ALIGN_EPI) { if (wr == 0) PG8_BAR; }
        if constexpr (!Epi::AFTER_DRAIN) { E(acc, cur, wr, wc, fr, fq); S.done(cur); }
        if (!has_next) break;
#pragma unroll
        for (int a = 0; a < 2; ++a)
#pragma unroll
            for (int b = 0; b < 2; ++b)
#pragma unroll
                for (int m = 0; m < 4; ++m)
#pragma unroll
                    for (int n = 0; n < 2; ++n) acc[a][b][m][n] = (f32x4){0.f, 0.f, 0.f, 0.f};
        cur = nxt; cA = nA; cB = nB; ++ui;
        if constexpr (ALIGN_EPI) { if (wr == 1) PG8_BAR; }
    }
    PG8_WAIT_V(0);
    if constexpr (!ALIGN_EPI) { if (wr == 0) PG8_BAR; }
    PG8_BAR;
    if constexpr (Epi::AFTER_DRAIN) { E.fused(acc, cur, wr, wc, fr, fq, lds, wid, lane); S.done(cur); }
#undef PG8_SA
#undef PG8_SB
#undef PG8_STAGE
#undef PG8_LDA
#undef PG8_LDB
#undef PG8_MMA
#undef PG8_WAIT_V
#undef PG8_WAIT_L
#undef PG8_BAR
#undef PG8_SCHED
}
template <class Epi, class Sched, bool ALIGN_EPI = false, bool SP2 = false>
__device__ __forceinline__ void gemm_phase_pair(PG8_LAS unsigned char* lds, const Gemm g, const bf16_t* A2, const bf16_t* Bt2, const Sched& S, const Epi& E) {
    int tid_ = threadIdx.x; asm volatile("" : "+v"(tid_));
    const int tid = tid_, wid = __builtin_amdgcn_readfirstlane(tid >> 6), lane = tid & 63, wr = wid >> 2, wc = wid & 3, fr = lane & 15, fq = lane >> 4;
    const int K = g.K, nt = K / BK;
    unsigned voffA[2], voffB[2];
#pragma unroll
    for (int i = 0; i < 2; ++i) { int R, C; stage_rc(tid * 16 + i * 8192, R, C); const int Rb = Epi::PERM ? ((R & ~31) + perm32(R & 31)) : R;
        voffA[i] = (unsigned)(R * K + C) * 2u; voffB[i] = (unsigned)(Rb * K + C) * 2u; }
    const size_t kstep = (size_t)(BK * 2);
    const size_t hstep = (size_t)HALF * K * 2;
    const size_t tstep = 2 * hstep;
    const unsigned ldsw = (unsigned)wid * 1024u;
    const int aoff = lds_byte(wr * 64 + fr, fq * 8), boff = lds_byte(wc * 32 + fr, fq * 8);
#define PG8_SA(b, h) (((b) * 2 + (h)) * HTB)
#define PG8_SB(b, h) ((4 + (b) * 2 + (h)) * HTB)
#define PG8_STAGE(bufoff, gbase, voff) do { _Pragma("unroll") for (int _i = 0; _i < 2; ++_i) \
        __builtin_amdgcn_global_load_lds((const unsigned*)((const char*)(gbase) + (voff)[_i]), (PG8_LAS unsigned*)(lds + (bufoff) + ldsw + _i * 8192), 16, 0, 0); } while (0)
#define PG8_LDA(dst, b, h) do { _Pragma("unroll") for (int m = 0; m < 4; ++m) _Pragma("unroll") for (int k = 0; k < 2; ++k) dst[m][k] = *(const PG8_LAS bf16x8*)(lds + PG8_SA(b, h) + aoff + m * 2048 + k * 1024); } while (0)
#define PG8_LDB(dst, b, h) do { _Pragma("unroll") for (int n = 0; n < 2; ++n) _Pragma("unroll") for (int k = 0; k < 2; ++k) dst[n][k] = *(const PG8_LAS bf16x8*)(lds + PG8_SB(b, h) + boff + n * 2048 + k * 1024); } while (0)
#define PG8_MMA(ai, bj, At, Bt) do { __builtin_amdgcn_s_setprio(1); _Pragma("unroll") for (int m = 0; m < 4; ++m) _Pragma("unroll") for (int n = 0; n < 2; ++n) _Pragma("unroll") for (int k = 0; k < 2; ++k) \
        acc[ai][bj][m][n] = __builtin_amdgcn_mfma_f32_16x16x32_bf16(Bt[n][k], At[m][k], acc[ai][bj][m][n], 0, 0, 0); __builtin_amdgcn_s_setprio(0); } while (0)
#define PG8_WAIT_V(n) asm volatile("s_waitcnt vmcnt(" #n ")" ::: "memory")
#define PG8_WAIT_L(n) asm volatile("s_waitcnt lgkmcnt(" #n ")" ::: "memory")
#define PG8_BAR __builtin_amdgcn_s_barrier()
#define PG8_SCHED __builtin_amdgcn_sched_barrier(0)
    Unit cur, nxt; int ui = 0;
    if (!S.next(0, cur)) return;
    f32x4 acc[2][2][4][2];
#pragma unroll
    for (int a = 0; a < 2; ++a)
#pragma unroll
        for (int b = 0; b < 2; ++b)
#pragma unroll
            for (int m = 0; m < 4; ++m)
#pragma unroll
                for (int n = 0; n < 2; ++n) acc[a][b][m][n] = (f32x4){0.f, 0.f, 0.f, 0.f};
    bf16x8 At[4][2], B0[2][2], B1[2][2];
    const char* cA = (const char*)g.A + (size_t)cur.pm * tstep; const char* cB = (const char*)g.Bt + (size_t)cur.pn * tstep;
    S.a_ready(cur);
    if constexpr (SP2) {
        PG8_STAGE(PG8_SB(0, 0), cB, voffB); PG8_STAGE(PG8_SB(0, 1), cB + hstep, voffB); PG8_STAGE(PG8_SA(0, 0), cA, voffA); PG8_STAGE(PG8_SA(0, 1), cA + hstep, voffA);
        if (wr == 1) PG8_BAR;
        PG8_WAIT_V(2); PG8_BAR;
        PG8_STAGE(PG8_SB(1, 0), cB + kstep, voffB); PG8_STAGE(PG8_SA(1, 0), cA + kstep, voffA); PG8_STAGE(PG8_SB(1, 1), cB + hstep + kstep, voffB);
        PG8_WAIT_V(6); PG8_BAR;
    } else {
        PG8_STAGE(PG8_SB(0, 0), cB, voffB); PG8_STAGE(PG8_SA(0, 0), cA, voffA); PG8_STAGE(PG8_SB(0, 1), cB + hstep, voffB); PG8_STAGE(PG8_SA(0, 1), cA + hstep, voffA);
        if (wr == 1) PG8_BAR;
        PG8_WAIT_V(4); PG8_BAR;
        PG8_STAGE(PG8_SB(1, 0), cB + kstep, voffB); PG8_STAGE(PG8_SA(1, 0), cA + kstep, voffA); PG8_STAGE(PG8_SB(1, 1), cB + hstep + kstep, voffB);
        PG8_WAIT_V(6); PG8_BAR;
    }
    for (;;) {
        const int sel = ui & 1; bool has_next = true;
        if (sel == 0) nxt = cur; else has_next = S.next((ui + 1) >> 1, nxt);
        const char* nA = has_next ? (const char*)(sel == 0 ? A2 : g.A) + (size_t)nxt.pm * tstep : cA; const char* nB = has_next ? (const char*)(sel == 0 ? Bt2 : g.Bt) + (size_t)nxt.pn * tstep : cB;
        for (int t = 0; t < nt; t += 2) {
            const bool last = (t == nt - 2);
            const char* a1 = cA + (size_t)(t + 1) * kstep;
            const char* a2 = last ? nA : cA + (size_t)(t + 2) * kstep; const char* b2 = last ? nB : cB + (size_t)(t + 2) * kstep;
            const char* a3 = a2 + kstep; const char* b3 = b2 + kstep;
            if (last && has_next) S.a_ready(nxt);
            if constexpr (SP2) {
            PG8_LDB(B0, 0, 0); PG8_LDB(B1, 0, 1); PG8_SCHED; PG8_LDA(At, 0, 0); PG8_STAGE(PG8_SA(1, 1), a1 + hstep, voffA);
            PG8_WAIT_V(8); PG8_WAIT_L(0); PG8_BAR; PG8_MMA(0, 0, At, B0); PG8_MMA(0, 1, At, B1); PG8_BAR; PG8_SCHED;
            PG8_LDA(At, 0, 1); PG8_STAGE(PG8_SB(0, 0), b2, voffB); PG8_STAGE(PG8_SB(0, 1), b2 + hstep, voffB); PG8_STAGE(PG8_SA(0, 0), a2, voffA);
            PG8_WAIT_V(8); PG8_WAIT_L(0); PG8_BAR; PG8_MMA(1, 0, At, B0); PG8_MMA(1, 1, At, B1); PG8_BAR; PG8_SCHED;
            PG8_LDB(B0, 1, 0); PG8_LDB(B1, 1, 1); PG8_SCHED; PG8_LDA(At, 1, 0); PG8_STAGE(PG8_SA(0, 1), a2 + hstep, voffA);
            PG8_WAIT_V(8); PG8_WAIT_L(0); PG8_BAR; PG8_MMA(0, 0, At, B0); PG8_MMA(0, 1, At, B1); PG8_BAR; PG8_SCHED;
            PG8_LDA(At, 1, 1); PG8_STAGE(PG8_SB(1, 0), b3, voffB); PG8_STAGE(PG8_SB(1, 1), b3 + hstep, voffB); PG8_STAGE(PG8_SA(1, 0), a3, voffA);
            PG8_WAIT_V(8); PG8_WAIT_L(0); PG8_BAR; PG8_MMA(1, 0, At, B0); PG8_MMA(1, 1, At, B1); PG8_BAR; PG8_SCHED;
            } else {
            PG8_LDB(B0, 0, 0); PG8_SCHED; PG8_LDA(At, 0, 0); PG8_STAGE(PG8_SA(1, 1), a1 + hstep, voffA);
            PG8_WAIT_L(8); PG8_BAR; PG8_WAIT_L(0); PG8_MMA(0, 0, At, B0); PG8_BAR; PG8_SCHED;
            PG8_LDB(B1, 0, 1); PG8_STAGE(PG8_SB(0, 0), b2, voffB);
            PG8_BAR; PG8_WAIT_L(0); PG8_MMA(0, 1, At, B1); PG8_BAR;
            PG8_LDA(At, 0, 1); PG8_STAGE(PG8_SA(0, 0), a2, voffA);
            PG8_BAR; PG8_WAIT_L(0); PG8_MMA(1, 0, At, B0); PG8_BAR; PG8_SCHED;
            PG8_STAGE(PG8_SB(0, 1), b2 + hstep, voffB);
            PG8_WAIT_V(6); PG8_BAR; PG8_MMA(1, 1, At, B1); PG8_BAR;
            PG8_LDB(B0, 1, 0); PG8_SCHED; PG8_LDA(At, 1, 0); PG8_STAGE(PG8_SA(0, 1), a2 + hstep, voffA);
            PG8_WAIT_L(8); PG8_BAR; PG8_WAIT_L(0); PG8_MMA(0, 0, At, B0); PG8_BAR; PG8_SCHED;
            PG8_LDB(B1, 1, 1); PG8_STAGE(PG8_SB(1, 0), b3, voffB);
            PG8_BAR; PG8_WAIT_L(0); PG8_MMA(0, 1, At, B1); PG8_BAR;
            PG8_LDA(At, 1, 1); PG8_STAGE(PG8_SA(1, 0), a3, voffA);
            PG8_BAR; PG8_WAIT_L(0); PG8_MMA(1, 0, At, B0); PG8_BAR; PG8_SCHED;
            PG8_STAGE(PG8_SB(1, 1), b3 + hstep, voffB);
            PG8_WAIT_V(6); PG8_BAR; PG8_MMA(1, 1, At, B1); PG8_BAR;
            }
        }
        if constexpr (ALIGN_EPI) { if (wr == 0) PG8_BAR; }
        if (sel == 0) E.mid(acc, cur, wr, wc, fr, fq); else { E(acc, cur, wr, wc, fr, fq); S.done(cur); }
        if (!has_next) break;
        if (sel == 1) {
#pragma unroll
        for (int a = 0; a < 2; ++a)
#pragma unroll
            for (int b = 0; b < 2; ++b)
#pragma unroll
                for (int m = 0; m < 4; ++m)
#pragma unroll
                    for (int n = 0; n < 2; ++n) acc[a][b][m][n] = (f32x4){0.f, 0.f, 0.f, 0.f};
        }
        cur = nxt; cA = nA; cB = nB; ++ui;
        if constexpr (ALIGN_EPI) { if (wr == 1) PG8_BAR; }
    }
    PG8_WAIT_V(0);
    if constexpr (!ALIGN_EPI) { if (wr == 0) PG8_BAR; }
    PG8_BAR;
    if constexpr (Epi::AFTER_DRAIN) { E.fused(acc, cur, wr, wc, fr, fq, lds, wid, lane); S.done(cur); }
#undef PG8_SA
#undef PG8_SB
#undef PG8_STAGE
#undef PG8_LDA
#undef PG8_LDB
#undef PG8_MMA
#undef PG8_WAIT_V
#undef PG8_WAIT_L
#undef PG8_BAR
#undef PG8_SCHED
}
}

#ifndef PG8_SP2
#define PG8_SP2 true
#endif
#ifndef PG8_ALIGN
#define PG8_ALIGN true
#endif

namespace attn_body {
using bf16=__hip_bfloat16;
using bf16x8=__attribute__((ext_vector_type(8)))short;
using s16x4=__attribute__((ext_vector_type(4)))short;
using f32x16=__attribute__((ext_vector_type(16)))float;
using u32x4=__attribute__((ext_vector_type(4)))unsigned;
constexpr int BATCH=2,NHEAD=16,SEQ=4096,D=64,DM=NHEAD*D;
constexpr int NW=8,QBLK=32,QB=QBLK*NW,KVBLK=64,NQB=SEQ/QB;
constexpr int ATTN_PITCH=DM, ATTN_UNIT_ROWS=QB;
__device__ __forceinline__ int crow(int r,int hi){return (r&3)+8*(r>>2)+4*hi;}
#define SBAR() __builtin_amdgcn_sched_barrier(0)
__device__ __forceinline__ void cmask(f32x16&p0,f32x16&p1,int jb,int qrel,int hi){
  const float NEG=-INFINITY; int kb=64*jb+4*hi;
  #pragma unroll
  for(int r=0;r<16;++r){int kv=kb+(r&3)+8*(r>>2); if(kv>qrel)p0[r]=NEG; if(kv+32>qrel)p1[r]=NEG;}
}

constexpr int NSLOT=3, SLOTB=8192;
constexpr int LDS_K=0, LDS_V=NSLOT*SLOTB, LDS_WS=2*NSLOT*SLOTB, LDS_OST=LDS_WS+NW*64*4, LDS_BYTES=LDS_OST+NW*4096;
constexpr float C2=0.125f*1.4426950408889634f;
__device__ __forceinline__ void glds16(const void*gsrc,unsigned lds_dst){unsigned keep;
  asm volatile("s_mov_b32 %0, m0\n\ts_mov_b32 m0, %2\n\ts_nop 0\n\tglobal_load_lds_dwordx4 %1, off\n\ts_mov_b32 m0, %0":"=&s"(keep):"v"(gsrc),"s"(lds_dst):"memory");}
__device__ __forceinline__ float max3f(float a,float b,float c){float r;asm("v_max3_f32 %0, %1, %2, %3":"=v"(r):"v"(a),"v"(b),"v"(c));return r;}
__device__ __forceinline__ float max2f(float a,float b){float r;asm("v_max_f32_e32 %0, %1, %2":"=v"(r):"v"(a),"v"(b));return r;}
__device__ __forceinline__ float fadd_s(float a,float b){float r;asm("v_add_f32_e32 %0, %1, %2":"=v"(r):"v"(a),"v"(b));return r;}
__device__ __forceinline__ float fsub_s(float a,float b){float r;asm("v_sub_f32_e32 %0, %1, %2":"=v"(r):"v"(a),"v"(b));return r;}
typedef float f32x2_t __attribute__((ext_vector_type(2))); typedef __bf16 bf16x2_t __attribute__((ext_vector_type(2)));
__device__ __forceinline__ unsigned cvtpk_s(float lo,float hi){f32x2_t v={lo,hi};bf16x2_t b=__builtin_convertvector(v,bf16x2_t);return __builtin_bit_cast(unsigned,b);}
#define WAIT_BAR(N) asm volatile("s_waitcnt vmcnt(" #N ") lgkmcnt(0)\n\ts_barrier":::"memory")

__device__ __forceinline__ void qkt(f32x16&p0,f32x16&p1,const char*Kslot,const bf16x8*qr,const f32x16&negm,int r32,int hi){
  const char*kb=Kslot+hi*1024+r32*16;
  #pragma unroll
  for(int d0=0;d0<4;++d0){
    const bf16x8 b0=*reinterpret_cast<const bf16x8*>(kb+d0*2048);
    const bf16x8 b1=*reinterpret_cast<const bf16x8*>(kb+d0*2048+512);
    if(d0==0){p0=__builtin_amdgcn_mfma_f32_32x32x16_bf16(b0,qr[0],negm,0,0,0);p1=__builtin_amdgcn_mfma_f32_32x32x16_bf16(b1,qr[0],negm,0,0,0);}
    else{p0=__builtin_amdgcn_mfma_f32_32x32x16_bf16(b0,qr[d0],p0,0,0,0);p1=__builtin_amdgcn_mfma_f32_32x32x16_bf16(b1,qr[d0],p1,0,0,0);}}
}
typedef __attribute__((address_space(3))) const char* lds_cptr;
typedef short v4i16_t __attribute__((ext_vector_type(4)));
__device__ __forceinline__ void kload8(bf16x8*kf,lds_cptr kp){
  kf[0]=*(const __attribute__((address_space(3))) bf16x8*)(kp);      kf[1]=*(const __attribute__((address_space(3))) bf16x8*)(kp+512);
  kf[2]=*(const __attribute__((address_space(3))) bf16x8*)(kp+2048); kf[3]=*(const __attribute__((address_space(3))) bf16x8*)(kp+2560);
  kf[4]=*(const __attribute__((address_space(3))) bf16x8*)(kp+4096); kf[5]=*(const __attribute__((address_space(3))) bf16x8*)(kp+4608);
  kf[6]=*(const __attribute__((address_space(3))) bf16x8*)(kp+6144); kf[7]=*(const __attribute__((address_space(3))) bf16x8*)(kp+6656);
}
__device__ __forceinline__ void kload2(bf16x8*kf,lds_cptr kp,int j){ kf[2*j]=*(const __attribute__((address_space(3))) bf16x8*)(kp+j*2048); kf[2*j+1]=*(const __attribute__((address_space(3))) bf16x8*)(kp+j*2048+512); }
__device__ __forceinline__ s16x4 vtr(lds_cptr p){ return __builtin_bit_cast(s16x4,__builtin_amdgcn_ds_read_tr16_b64_v4i16((__attribute__((address_space(3))) v4i16_t*)p)); }
__device__ __forceinline__ float rowmax(const f32x16&p0,const f32x16&p1){
  float a=max3f(p0[0],p0[1],p1[0]),b=max3f(p0[2],p0[3],p1[1]);a=max3f(a,p1[2],p1[3]);
  #pragma unroll
  for(int r=4;r<16;r+=4){a=max3f(a,p0[r],p0[r+1]);b=max3f(b,p0[r+2],p0[r+3]);a=max3f(a,p1[r],p1[r+1]);b=max3f(b,p1[r+2],p1[r+3]);}
  const float m=max2f(a,b);
  auto rr=__builtin_amdgcn_permlane32_swap(__float_as_uint(m),__float_as_uint(m),false,false);
  return max2f(__uint_as_float(rr[0]),__uint_as_float(rr[1]));
}
__device__ __forceinline__ void pv(f32x16*o,int vb,bf16x8 pa0,bf16x8 pa1,bf16x8 pa2,bf16x8 pa3){
  #pragma unroll
  for(int d0=0;d0<2;++d0){s16x4 lo[4],hi[4];
    #pragma unroll
    for(int ks=0;ks<4;++ks){
      asm volatile("ds_read_b64_tr_b16 %0,%1 offset:%c2":"=&v"(lo[ks]):"v"(vb),"i"(d0*4096+ks*1024):"memory");
      asm volatile("ds_read_b64_tr_b16 %0,%1 offset:%c2":"=&v"(hi[ks]):"v"(vb),"i"(d0*4096+ks*1024+512):"memory");}
    asm volatile("s_waitcnt lgkmcnt(0)":::"memory");SBAR();
    #define PK(k) (bf16x8){lo[k][0],lo[k][1],lo[k][2],lo[k][3],hi[k][0],hi[k][1],hi[k][2],hi[k][3]}
    o[d0]=__builtin_amdgcn_mfma_f32_32x32x16_bf16(pa0,PK(0),o[d0],0,0,0);
    o[d0]=__builtin_amdgcn_mfma_f32_32x32x16_bf16(pa1,PK(1),o[d0],0,0,0);
    o[d0]=__builtin_amdgcn_mfma_f32_32x32x16_bf16(pa2,PK(2),o[d0],0,0,0);
    o[d0]=__builtin_amdgcn_mfma_f32_32x32x16_bf16(pa3,PK(3),o[d0],0,0,0);
    #undef PK
  }
}

#ifndef ATTN_STORE16
#define ATTN_STORE16(p,v) (*(u32x4*)(p)=(v))
#endif
template<int THRL> __device__ __forceinline__ void attn_unit(int b,int qkoff,int voff,int qb,const bf16*Q,const bf16*__restrict__ K,const bf16*__restrict__ V,bf16*O,char*shm){
  const int tid=threadIdx.x,lane=tid&63,r32=lane&31,hi=lane>>5; const int wid=__builtin_amdgcn_readfirstlane(tid>>6);
  const long rowbase=(long)b*SEQ; const int q0=qb*QB;
  const bf16*Qw=Q+(rowbase+q0+wid*QBLK)*DM+qkoff;
  const bf16*Kh=K+rowbase*DM+qkoff,*Vh=V+rowbase*DM+voff;
  const unsigned lds0=(unsigned)(uintptr_t)shm;
  float*wsf=(float*)(shm+LDS_WS)+wid*64;
  const bf16*ksrc=Kh+(long)lane*DM+wid*8;
  const bf16*vsrc=Vh+(long)(16*(wid&3)+(lane>>2))*DM+(wid>>2)*32+(lane&3)*8;
  const unsigned kdst=lds0+LDS_K+wid*1024, vdst=lds0+LDS_V+wid*1024;
  #define DMA_K(t,slot) glds16(ksrc+(long)(t)*KVBLK*DM,(unsigned)__builtin_amdgcn_readfirstlane(kdst+(slot)))
  #define DMA_V(t,slot) glds16(vsrc+(long)(t)*KVBLK*DM,(unsigned)__builtin_amdgcn_readfirstlane(vdst+(slot)))
  const int vb0=(int)(lds0+LDS_V)+((lane>>4)&1)*32+(lane&3)*8+(4*hi+((lane&15)>>2))*64;
  const char*Kbase=shm+LDS_K; bf16x8 kf[8];
  const lds_cptr shm3=(lds_cptr)shm; const lds_cptr kp0=shm3+LDS_K+hi*1024+r32*16; const lds_cptr vp0=shm3+LDS_V+((lane>>4)&1)*32+(lane&3)*8+(4*hi+((lane&15)>>2))*64;
  const int NT=(q0+QB)/KVBLK;
  DMA_K(0,0);DMA_V(0,0);DMA_K(1,SLOTB);
  bf16x8 qr[4];
  #pragma unroll
  for(int d0=0;d0<4;++d0)qr[d0]=*reinterpret_cast<const bf16x8*>(&Qw[(long)r32*DM+d0*16+hi*8]);
  float mhat=0.f,l_reg=0.f;f32x16 o[2];o[0]=f32x16{};o[1]=f32x16{};f32x16 negm=f32x16{};asm volatile("":"+v"(negm));
  const int qrel=wid*QBLK+r32;
  #define CMASK(P0,P1,t) do{int jb_=(t)-(NT-4); if(jb_>=0)cmask(P0,P1,jb_,qrel,hi);}while(0)
  bool resc=false;
  #define START(P0,P1) do{ const float rm=rowmax(P0,P1); resc=false; \
    { const float dl=rm; mhat=fadd_s(mhat,dl); \
      _Pragma("unroll") for(int r=0;r<16;++r){P0[r]=fsub_s(P0[r],dl);P1[r]=fsub_s(P1[r],dl);} \
      _Pragma("unroll") for(int r=0;r<16;++r)negm[r]=-mhat; asm volatile("":"+v"(negm)); } \
    _Pragma("unroll") for(int r=0;r<16;++r)P0[r]=__builtin_amdgcn_exp2f(P0[r]); }while(0)
  #define RESC() do{ if(resc){ asm volatile("s_waitcnt lgkmcnt(0)":::"memory"); \
      _Pragma("unroll") for(int d_=0;d_<2;++d_) _Pragma("unroll") for(int r=0;r<16;++r)o[d_][r]*=wsf[crow(r,hi)]; } }while(0)
  f32x16 pA0,pA1,pB0,pB1;
  int sl_prev=0,sl_cur=0,sl_next=SLOTB;
  #define ROT() do{sl_prev=sl_cur;sl_cur=sl_next;sl_next=(sl_next==(NSLOT-1)*SLOTB)?0:sl_next+SLOTB;}while(0)
  DMA_K(2,2*SLOTB);
  WAIT_BAR(3);
  qkt(pA0,pA1,Kbase,qr,negm,r32,hi);asm volatile("s_nop 15\n\ts_nop 7":"+v"(pA0),"+v"(pA1));CMASK(pA0,pA1,0);
  START(pA0,pA1);
  _Pragma("unroll") for(int r=0;r<16;++r)pA1[r]=__builtin_amdgcn_exp2f(pA1[r]);
  WAIT_BAR(0);
  DMA_K(3,0);DMA_V(1,SLOTB);
  ROT();
  kload8(kf,kp0+sl_cur);
  WAIT_BAR(2);
  s16x4 vlo[8],vhi[8]; u32x4 pw0,pw1,pw2,pw3;
  #define PKW(P,B) cvtpk_s(P[B],P[B+1])
  #define PAF(k) __builtin_bit_cast(bf16x8,pw##k)
  #define VFR(i) (bf16x8){vlo[i][0],vlo[i][1],vlo[i][2],vlo[i][3],vhi[i][0],vhi[i][1],vhi[i][2],vhi[i][3]}
  #define PIN(x) asm volatile("":"+v"(x))
  #define MX3(a,b,c) __builtin_fmaxf(__builtin_fmaxf((a),(b)),(c))
  #define GAPA(MF,A0,A1,A2,A3,W0,W1,PW) do{ MF; sacc+=A0; sacc+=A1; sacc+=A2; sacc+=A3; PIN(sacc); W0; W1; PIN(PW); SBAR(); }while(0)
  #define EX(v) __builtin_amdgcn_exp2f(v)
  #define GAPB(MF,X,B) do{ MF; X[B]=EX(X[B]); X[B+1]=EX(X[B+1]); X[B+2]=EX(X[B+2]); X[B+3]=EX(X[B+3]); PIN(X); SBAR(); }while(0)
  #define VRD(i) do{ vlo[i]=vtr(vp_+(((i)>>2)*4096+((i)&3)*1024)); vhi[i]=vtr(vp_+(((i)>>2)*4096+((i)&3)*1024+512)); }while(0)
  #define KRD(G,j) do{ if(G){ kload2(kf,kp0+sl_next,j); SBAR(); } }while(0)
  #define STEP(C0,C1,P0,P1,t,GK,GV,GL) do{ SBAR(); \
    const lds_cptr vp_=vp0+sl_prev; \
    VRD(0); SBAR(); float sacc=(P0[0]+P0[1]); \
    GAPA(C0=__builtin_amdgcn_mfma_f32_32x32x16_bf16(kf[0],qr[0],negm,0,0,0), P0[2],P0[3],P0[4],P0[5],     pw0[0]=PKW(P0,0), pw0[1]=PKW(P0,2), pw0); \
    VRD(4); SBAR(); GAPA(C1=__builtin_amdgcn_mfma_f32_32x32x16_bf16(kf[1],qr[0],negm,0,0,0), P0[6],P0[7],P0[8],P0[9],     pw0[2]=PKW(P0,4), pw0[3]=PKW(P0,6), pw0); \
    VRD(1); SBAR(); GAPA(C0=__builtin_amdgcn_mfma_f32_32x32x16_bf16(kf[2],qr[1],C0,0,0,0),   P0[10],P0[11],P0[12],P0[13], pw1[0]=PKW(P0,8), pw1[1]=PKW(P0,10), pw1); \
    VRD(5); SBAR(); GAPA(C1=__builtin_amdgcn_mfma_f32_32x32x16_bf16(kf[3],qr[1],C1,0,0,0),   P0[14],P0[15],P1[0],P1[1],   pw1[2]=PKW(P0,12),pw1[3]=PKW(P0,14), pw1); \
    VRD(2); SBAR(); GAPA(C0=__builtin_amdgcn_mfma_f32_32x32x16_bf16(kf[4],qr[2],C0,0,0,0),   P1[2],P1[3],P1[4],P1[5],     pw2[0]=PKW(P1,0), pw2[1]=PKW(P1,2), pw2); \
    VRD(6); SBAR(); GAPA(C1=__builtin_amdgcn_mfma_f32_32x32x16_bf16(kf[5],qr[2],C1,0,0,0),   P1[6],P1[7],P1[8],P1[9],     pw2[2]=PKW(P1,4), pw2[3]=PKW(P1,6), pw2); \
    VRD(3); SBAR(); GAPA(C0=__builtin_amdgcn_mfma_f32_32x32x16_bf16(kf[6],qr[3],C0,0,0,0),   P1[10],P1[11],P1[12],P1[13], pw3[0]=PKW(P1,8), pw3[1]=PKW(P1,10), pw3); \
    VRD(7); SBAR(); GAPA(C1=__builtin_amdgcn_mfma_f32_32x32x16_bf16(kf[7],qr[3],C1,0,0,0),   P1[14],P1[15],0.f,0.f,       pw3[2]=PKW(P1,12),pw3[3]=PKW(P1,14), pw3); \
    l_reg+=sacc; \
    if(GK){DMA_K((t)+3,sl_cur);} if(GV){DMA_V((t)+1,sl_next);} \
    CMASK(C0,C1,t); \
    { float a=MX3(C0[0],C0[1],C1[0]),b=MX3(C0[2],C0[3],C1[1]); a=MX3(a,C1[2],C1[3]); \
      _Pragma("unroll") for(int r=4;r<16;r+=4){a=MX3(a,C0[r],C0[r+1]);b=MX3(b,C0[r+2],C0[r+3]);a=MX3(a,C1[r],C1[r+1]);b=MX3(b,C1[r+2],C1[r+3]);} \
      float rm=__builtin_fmaxf(a,b); { auto rr=__builtin_amdgcn_permlane32_swap(__float_as_uint(rm),__float_as_uint(rm),false,false); rm=__builtin_fmaxf(__uint_as_float(rr[0]),__uint_as_float(rr[1])); } \
      resc=false; \
      if(__builtin_expect(__any(rm>(float)THRL),0)){ const float dl=__builtin_fmaxf(rm,0.f); mhat+=dl; \
        _Pragma("unroll") for(int r=0;r<16;++r){C0[r]-=dl;C1[r]-=dl;} \
        _Pragma("unroll") for(int r=0;r<16;++r)negm[r]=-mhat; asm volatile("":"+v"(negm)); \
        const float f=__builtin_amdgcn_exp2f(-dl); l_reg*=f; if(hi==0)wsf[r32]=f; resc=true; } } \
    SBAR(); \
    GAPB(o[0]=__builtin_amdgcn_mfma_f32_32x32x16_bf16(PAF(0),VFR(0),o[0],0,0,0), C0,0); \
    GAPB(o[1]=__builtin_amdgcn_mfma_f32_32x32x16_bf16(PAF(0),VFR(4),o[1],0,0,0), C0,4); \
    KRD(GL,0); GAPB(o[0]=__builtin_amdgcn_mfma_f32_32x32x16_bf16(PAF(1),VFR(1),o[0],0,0,0), C0,8); \
    KRD(GL,1); GAPB(o[1]=__builtin_amdgcn_mfma_f32_32x32x16_bf16(PAF(1),VFR(5),o[1],0,0,0), C0,12); \
    KRD(GL,2); GAPB(o[0]=__builtin_amdgcn_mfma_f32_32x32x16_bf16(PAF(2),VFR(2),o[0],0,0,0), C1,0); \
    KRD(GL,3); GAPB(o[1]=__builtin_amdgcn_mfma_f32_32x32x16_bf16(PAF(2),VFR(6),o[1],0,0,0), C1,4); \
    GAPB(o[0]=__builtin_amdgcn_mfma_f32_32x32x16_bf16(PAF(3),VFR(3),o[0],0,0,0), C1,8); \
    GAPB(o[1]=__builtin_amdgcn_mfma_f32_32x32x16_bf16(PAF(3),VFR(7),o[1],0,0,0), C1,12); \
    }while(0)
  int t=1;
  #undef CMASK
  #define CMASK(P0,P1,t) do{}while(0)
  for(;t+5<NT;t+=2){
    STEP(pB0,pB1,pA0,pA1,t,true,true,true);     WAIT_BAR(2); RESC(); ROT();
    STEP(pA0,pA1,pB0,pB1,t+1,true,true,true);   WAIT_BAR(2); RESC(); ROT();
  }
  #undef CMASK
  #define CMASK(P0,P1,t) do{int jb_=(t)-(NT-4); if(jb_>=0)cmask(P0,P1,jb_,qrel,hi);}while(0)
  #define ENDW(tt) do{ if((tt)+3<NT){WAIT_BAR(2);} else if((tt)+2<NT){WAIT_BAR(1);} else {WAIT_BAR(0);} }while(0)
  for(;t+1<NT;t+=2){
    STEP(pB0,pB1,pA0,pA1,t,(t+3<NT),(t+1<NT),(t+1<NT));       ENDW(t);   RESC(); ROT();
    STEP(pA0,pA1,pB0,pB1,t+1,(t+4<NT),(t+2<NT),(t+2<NT));     ENDW(t+1); RESC(); ROT();
  }
  STEP(pB0,pB1,pA0,pA1,NT-1,false,false,false); RESC();
  { float sacc=pB0[0]+pB0[1]; _Pragma("unroll") for(int r=2;r<16;++r)sacc+=pB0[r]; _Pragma("unroll") for(int r=0;r<16;++r)sacc+=pB1[r]; l_reg+=sacc;
    pw0=(u32x4){PKW(pB0,0),PKW(pB0,2),PKW(pB0,4),PKW(pB0,6)};pw1=(u32x4){PKW(pB0,8),PKW(pB0,10),PKW(pB0,12),PKW(pB0,14)};pw2=(u32x4){PKW(pB1,0),PKW(pB1,2),PKW(pB1,4),PKW(pB1,6)};pw3=(u32x4){PKW(pB1,8),PKW(pB1,10),PKW(pB1,12),PKW(pB1,14)};
    SBAR(); pv(o,vb0+sl_cur,PAF(0),PAF(1),PAF(2),PAF(3)); }
  #undef PKW
  #undef PAF
  #undef VFR
  #undef PIN
  #undef MX3
  #undef GAPA
  #undef GAPB
  #undef EX
  #undef VRD
  #undef KRD
  #undef STEP
  #undef ENDW
  {auto rr=__builtin_amdgcn_permlane32_swap(__float_as_uint(l_reg),__float_as_uint(l_reg),false,false);l_reg=__uint_as_float(rr[0])+__uint_as_float(rr[1]);}
  if(hi==0)wsf[32+r32]=l_reg;asm volatile("s_waitcnt lgkmcnt(0)":::"memory");
  float rli[16];
  #pragma unroll
  for(int r=0;r<16;++r)rli[r]=__builtin_amdgcn_rcpf(wsf[32+crow(r,hi)]);
  bf16*Ow=O+(rowbase+q0+wid*QBLK)*DM+voff;
  { bf16*stg=(bf16*)(shm+LDS_OST)+wid*2048;
    #pragma unroll
    for(int r=0;r<16;++r){const int orow=crow(r,hi);
      #pragma unroll
      for(int d0=0;d0<2;++d0)stg[orow*64+d0*32+r32]=__float2bfloat16(o[d0][r]*rli[r]);}
    asm volatile("s_waitcnt lgkmcnt(0)":::"memory");
    #pragma unroll
    for(int i=0;i<4;++i){const int row=i*8+(lane>>3),ch=lane&7; const u32x4 v=*(const u32x4*)(stg+row*64+ch*8); ATTN_STORE16(Ow+(long)row*DM+ch*8,v);} }
  asm volatile("s_waitcnt lgkmcnt(0)\n\ts_barrier":::"memory");
  #undef DMA_K
  #undef DMA_V
  #undef CMASK
  #undef START
  #undef RESC
  #undef ROT
}
constexpr int ATTN_LDS_BYTES=LDS_BYTES;
struct AttnTensors { const bf16* Q; const bf16* K; const bf16* V; bf16* O0; bf16* O1; };
struct AttnUnit { int vh; int qb; };
struct StaticOrder {
  int vcu, G;
  __device__ __forceinline__ explicit StaticOrder(int grid,int vcu_):vcu(vcu_),G(grid){}
  __device__ __forceinline__ bool next(int i,AttnUnit&u)const{
    if(G==256){ if(i>=4)return false; const int s=vcu&3; u.vh=vcu>>2; u.qb=(i==0)?s:(i==1)?7-s:(i==2)?8+s:15-s; return true; }
    const int L=i*G+vcu; if(L>=64*NQB)return false; u.vh=L&63; u.qb=NQB-1-(L>>6); return true; }
  __device__ __forceinline__ void a_ready(const AttnUnit&)const{}
  __device__ __forceinline__ void done(const AttnUnit&)const{}
};
template<class Sched,int THRL=8> __device__ __forceinline__ void attn_phase(char*lds,const AttnTensors&T,const Sched&S){
  AttnUnit u;
  for(int i=0;S.next(i,u);++i){ S.a_ready(u);
    const int b=u.vh>>5,h=(u.vh>>2)&7,c=(u.vh>>1)&1,half=u.vh&1;
    attn_unit<THRL>(b,h*128+c*64,h*128+half*64,u.qb,T.Q,T.K,T.V,c?T.O1:T.O0,lds); S.done(u); }
}
#undef SBAR
#undef WAIT_BAR
}

#define GAS __attribute__((address_space(1)))
#define LAS __attribute__((address_space(3)))
typedef unsigned short bf16;
typedef unsigned v4u __attribute__((ext_vector_type(4)));
typedef unsigned v2u __attribute__((ext_vector_type(2)));
typedef float f32x4 __attribute__((ext_vector_type(4)));
typedef short bf16x8 __attribute__((ext_vector_type(8)));
typedef GAS unsigned gu32;
typedef GAS unsigned long long gu64;
#define RLX_AGENT __ATOMIC_RELAXED, __HIP_MEMORY_SCOPE_AGENT
#define LDS_WAIT() asm volatile("s_waitcnt lgkmcnt(0)" ::: "memory")
#define VM_WAIT() asm volatile("s_waitcnt vmcnt(0)" ::: "memory")
__device__ __forceinline__ unsigned long long rt() { return __builtin_amdgcn_s_memrealtime(); }
typedef float f32x2_hw __attribute__((ext_vector_type(2))); typedef __bf16 bf16x2_hw __attribute__((ext_vector_type(2)));
__device__ __forceinline__ unsigned pk2(float lo, float hi) { const f32x2_hw v = {lo, hi}; return __builtin_bit_cast(unsigned, __builtin_convertvector(v, bf16x2_hw)); }
__device__ __forceinline__ unsigned f2bf(float f) { return pk2(f, 0.f) & 0xffffu; }

#define XB_TMO      128
#define XB_XCNT(j)  (256  + 64 * (j))
#define XB_XSUB(j)  (1280 + 64 * (j))
#define XB_XGEN(j)  (2304 + 64 * (j))
#define XB_TOP      3328
#define XB_TOPGEN   3392
#define XCD_BAR_WORDS 3456
#define XB_SPIN_CAP (1u << 18)

__device__ __forceinline__ unsigned xb_ld(unsigned* p)              { return __hip_atomic_load(p, __ATOMIC_RELAXED, __HIP_MEMORY_SCOPE_AGENT); }
__device__ __forceinline__ unsigned xb_add(unsigned* p, unsigned v) { return __hip_atomic_fetch_add(p, v, __ATOMIC_RELAXED, __HIP_MEMORY_SCOPE_AGENT); }
__device__ __forceinline__ unsigned xb_xcc_id() { return (unsigned)__builtin_amdgcn_s_getreg((3 << 11) | 20) & 0xFu; }
#define XB_SPIN(cond, bar) do { unsigned _sp = 0; while (cond) { __builtin_amdgcn_s_sleep(1); \
    if ((++_sp & 255u) == 0u) { if (xb_ld(&(bar)[XB_TMO])) break; if (_sp > XB_SPIN_CAP) { atomicAdd(&(bar)[XB_TMO], 1u); break; } } } } while (0)

struct XcdBarrier {
    unsigned* bar; unsigned x;
    volatile LAS unsigned* st;
};

__device__ __forceinline__ XcdBarrier xcd_barrier_post(unsigned* bar, volatile LAS unsigned* st) {
    XcdBarrier b; b.bar = bar; b.x = xb_xcc_id(); b.st = st;
    if (threadIdx.x == 0) (void)xb_add(&bar[XB_XCNT(b.x)], 1u);
    return b;
}
__device__ __forceinline__ void xcd_barrier_complete(unsigned* bar, unsigned x, unsigned& nloc, unsigned& nx) {
    const unsigned G = gridDim.x * gridDim.y * gridDim.z;
    unsigned sum, cnt, mine, sp = 0u;
    for (;;) {
        sum = 0u; cnt = 0u; mine = 0u;
#pragma unroll
        for (unsigned j = 0; j < 16; ++j) { const unsigned c = xb_ld(&bar[XB_XCNT(j)]); sum += c; cnt += (c > 0u) ? 1u : 0u; mine = (j == x) ? c : mine; }
        if (sum == G) break;
        __builtin_amdgcn_s_sleep(1);
        if ((++sp & 255u) == 0u) { if (xb_ld(&bar[XB_TMO])) break; if (sp > XB_SPIN_CAP) { atomicAdd(&bar[XB_TMO], 1u); break; } }
    }
    nloc = mine > 0u ? mine : 1u; nx = cnt > 0u ? cnt : 1u;
}

__device__ __forceinline__ void xcd_barrier(const XcdBarrier& b) {
    asm volatile("s_waitcnt vmcnt(0)" ::: "memory");
    __syncthreads();
    if (threadIdx.x == 0) {
        unsigned* bar = b.bar;
        __builtin_amdgcn_s_waitcnt(0);
        unsigned nloc = b.st[0], nx = b.st[1];
        if (nloc == 0u) { xcd_barrier_complete(bar, b.x, nloc, nx); b.st[0] = nloc; b.st[1] = nx; }
        const unsigned old = xb_add(&bar[XB_XSUB(b.x)], 1u);
        const unsigned gen = old / nloc;
        if (old + 1u == (gen + 1u) * nloc) {
            __builtin_amdgcn_fence(__ATOMIC_RELEASE, "agent");
            asm volatile("s_waitcnt vmcnt(0)" ::: "memory");
            const unsigned og = xb_add(&bar[XB_TOP], 1u);
            const unsigned tg = og / nx;
            if (og + 1u == (tg + 1u) * nx) xb_add(&bar[XB_TOPGEN], 1u);
            else XB_SPIN(xb_ld(&bar[XB_TOPGEN]) == tg, bar);
            __builtin_amdgcn_fence(__ATOMIC_ACQUIRE, "agent");
            xb_add(&bar[XB_XGEN(b.x)], 1u);
            asm volatile("s_waitcnt vmcnt(0)" ::: "memory");
        } else {
            XB_SPIN(xb_ld(&bar[XB_XGEN(b.x)]) == gen, bar);
            __builtin_amdgcn_fence(__ATOMIC_ACQUIRE, "agent");
            asm volatile("s_waitcnt vmcnt(0)" ::: "memory");
        }
    }
    __syncthreads();
}

constexpr int NWAVES = 8, NTHR = 512;
constexpr int BATCH = 2, SEQ = 4096, DM = 2048, M = BATCH * SEQ;
constexpr int ATT_W = 1024, RW_W = 1024, RW_COLS = 3328, GATE_COLS = 4096, IN_COLS = 10496;
constexpr int NEXP = 64, EFF = 1024, CAP = 8192;
constexpr float NORM_EPS = 1e-6f, SUBLN_EPS = 1e-5f, LNX_EPS = 64e-5f;
constexpr float LAMBDA_INIT = 0.2f;
#ifndef RWKV_SEQ
#define RWKV_SEQ 0
#endif
#ifndef MK_ONE_LAUNCH
#define MK_ONE_LAUNCH 1
#endif
constexpr int NPHASE = 14;

constexpr size_t MiB = 1u << 20;
constexpr size_t WS_CTL = 0, CTL_ZERO_BYTES = 1 * MiB;
constexpr size_t WS_ADA = 1 * MiB;
constexpr size_t WS_ROPE = 1 * MiB + 512 * 1024;
constexpr size_t WS_W2T = 2 * MiB;
constexpr size_t WS_A2T = 2 * MiB + 128 * 1024;
constexpr size_t WS_G2T = 2 * MiB + 256 * 1024;
constexpr size_t WS_TOKE = 3 * MiB;
constexpr size_t WS_TOKP = 3 * MiB + 64 * 1024;
constexpr size_t WS_TOKW = 3 * MiB + 128 * 1024;
constexpr size_t WS_LIST = 4 * MiB;
constexpr size_t WS_WRH = 6 * MiB, WS_WRL = 7 * MiB;
constexpr size_t WS_WIN_T = 8 * MiB;
constexpr size_t WS_WUPA_T = 50 * MiB, WS_WUPB_T = 54 * MiB, WS_WOUT_T = 58 * MiB;
constexpr size_t WS_U = 68 * MiB;
constexpr size_t WS_Q = 100 * MiB, WS_K = 116 * MiB, WS_V = 132 * MiB;
constexpr size_t WS_PR = 148 * MiB;
constexpr size_t WS_G = 200 * MiB;
constexpr size_t WS_O0 = 264 * MiB, WS_O1 = 280 * MiB;
constexpr size_t WS_YATT = 296 * MiB, WS_YRW = 312 * MiB;
constexpr size_t WS_MERGED = 392 * MiB;
constexpr size_t WS_H1 = 424 * MiB;
constexpr size_t WS_U2 = 328 * MiB;
constexpr size_t WS_ACT = 520 * MiB;
constexpr int U2P = 2048 + 64, ACTP = 1024 + 64;
constexpr size_t WS_YS = 560 * MiB;
constexpr size_t WS_RW = 632 * MiB;
constexpr size_t RW_ARR = 32 * MiB;
constexpr size_t WS_END = WS_RW + 9 * RW_ARR;
constexpr int CW_TMO = 0, CW_CODE = 1, CW_BAR = 4096, CW_CNT = 8192, CW_P3Q = 8192 + 128;

constexpr int RING_OFF = 0, RING_BYTES = 159744;
constexpr int LDSCTL_OFF = RING_BYTES, MISC_OFF = LDSCTL_OFF + 320;
constexpr int LDS_BYTES = 163840;

__device__ __forceinline__ float bf2f(unsigned short h) { return __builtin_bit_cast(float, (unsigned)h << 16); }
__device__ __forceinline__ float bflo(unsigned w) { return __builtin_bit_cast(float, w << 16); }
__device__ __forceinline__ float bfhi(unsigned w) { return __builtin_bit_cast(float, w & 0xffff0000u); }
__device__ __forceinline__ float wave_sum(float v) {
#pragma unroll
    for (int o = 1; o < 64; o <<= 1) v += __shfl_xor(v, o);
    return v;
}
template <int CTRL> __device__ __forceinline__ float dpp_f(float x) { return __builtin_bit_cast(float, __builtin_amdgcn_update_dpp(0, __builtin_bit_cast(int, x), CTRL, 0xF, 0xF, true)); }
__device__ __forceinline__ float sum8(float x) {
    x += dpp_f<0xB1>(x); x += dpp_f<0x4E>(x); x += dpp_f<0x141>(x); return x; }
__device__ __forceinline__ float sum4(float x) { x += dpp_f<0xB1>(x); x += dpp_f<0x4E>(x); return x; }
__device__ __forceinline__ float sigmoidf_(float x) { return __builtin_amdgcn_rcpf(1.f + __expf(-x)); }

struct Frame {
    LAS unsigned char* lds;
    volatile LAS unsigned* MISC;
    gu32* ctl;
    int tid, lane, wave, vcu, G, probe;
    unsigned char* ws;
};

namespace pg8 {
constexpr float QSCALE = 0.125f * 1.4426950408889634f;
struct EpiIn {
    static constexpr bool PERM = true, AFTER_DRAIN = false;
    unsigned char* ws; const float* rope; int pn_off;
    __device__ __forceinline__ void operator()(const f32x4 (&acc)[2][2][4][2], const Unit& u, int wr, int wc, int fr, int fq) const {
        const int row0 = u.pm * BM + wr * 64 + fr, pn = u.pn + pn_off, cw = wc * 32 + 8 * fq;
        if (pn < 8) {
            const int isk = pn >= 4 ? 1 : 0;
            bf16_t* base = (bf16_t*)(ws + WS_Q + (size_t)isk * (WS_K - WS_Q)); const float sc = isk ? 1.f : QSCALE; const int colt = (pn & 3) * 256 + cw;
            const bool ropew = ((wc & 1) == 0);
#pragma unroll
            for (int ai = 0; ai < 2; ++ai)
#pragma unroll
                for (int m = 0; m < 4; ++m) { const int row = row0 + ai * HALF + m * 16; bf16_t* rowp = base + (size_t)row * 1024 + colt;
                    f32x4 c0 = {1.f, 1.f, 1.f, 1.f}, c1 = c0, s0 = {0.f, 0.f, 0.f, 0.f}, s1 = s0;
                    if (ropew) { const f32x4* rp = (const f32x4*)(rope + (size_t)row * 16); c0 = rp[0]; c1 = rp[1]; s0 = rp[2]; s1 = rp[3]; }
#pragma unroll
                    for (int bj = 0; bj < 2; ++bj) { f32x4 v0 = acc[ai][bj][m][0], v1 = acc[ai][bj][m][1];
                        if (ropew) { f32x4 p0, p1;
                            p0[0] = __shfl_xor(v0[0], 16); p0[1] = __shfl_xor(v0[1], 16); p0[2] = __shfl_xor(v0[2], 16); p0[3] = __shfl_xor(v0[3], 16);
                            p1[0] = __shfl_xor(v1[0], 16); p1[1] = __shfl_xor(v1[1], 16); p1[2] = __shfl_xor(v1[2], 16); p1[3] = __shfl_xor(v1[3], 16);
                            if (fq == 0) { v0 = v0 * c0 - p0 * s0; v1 = v1 * c1 - p1 * s1; }
                            else if (fq == 1) { v0 = p0 * s0 + v0 * c0; v1 = p1 * s1 + v1 * c1; } }
                        v0 = v0 * sc; v1 = v1 * sc; u32x4 w; w.x = cvt_pk_bf16(v0[0], v0[1]); w.y = cvt_pk_bf16(v0[2], v0[3]); w.z = cvt_pk_bf16(v1[0], v1[1]); w.w = cvt_pk_bf16(v1[2], v1[3]);
                        *(u32x4*)(rowp + bj * HALF) = w; } }
        } else {
            const int c1 = pn >= 12 ? 1 : 0, c2 = pn >= 25 ? 1 : 0;
            bf16_t* base = (bf16_t*)(ws + WS_V + (size_t)c1 * (WS_PR - WS_V) + (size_t)c2 * (WS_G - WS_PR));
            const int ldc = 1024 + c1 * (RW_COLS - 1024) + c2 * (GATE_COLS - RW_COLS);
            const int colt = (pn - 8 - 4 * c1 - 13 * c2) * 256 + cw;
            const bool sg = pn >= 25;
#pragma unroll
            for (int ai = 0; ai < 2; ++ai)
#pragma unroll
                for (int m = 0; m < 4; ++m) { bf16_t* rowp = base + (size_t)(row0 + ai * HALF + m * 16) * ldc + colt;
#pragma unroll
                    for (int bj = 0; bj < 2; ++bj) { f32x4 v0 = acc[ai][bj][m][0], v1 = acc[ai][bj][m][1];
                        if (sg) { v0[0] = sigmoidf_(v0[0]); v0[1] = sigmoidf_(v0[1]); v0[2] = sigmoidf_(v0[2]); v0[3] = sigmoidf_(v0[3]);
                                  v1[0] = sigmoidf_(v1[0]); v1[1] = sigmoidf_(v1[1]); v1[2] = sigmoidf_(v1[2]); v1[3] = sigmoidf_(v1[3]); }
                        u32x4 w; w.x = cvt_pk_bf16(v0[0], v0[1]); w.y = cvt_pk_bf16(v0[2], v0[3]); w.z = cvt_pk_bf16(v1[0], v1[1]); w.w = cvt_pk_bf16(v1[2], v1[3]);
                        *(u32x4*)(rowp + bj * HALF) = w; } }
        }
    }
};
struct EpiT1 {
    static constexpr bool PERM = false, AFTER_DRAIN = false;
    float* T1; const bf16_t* G;
    __device__ __forceinline__ void operator()(const f32x4 (&acc)[2][2][4][2], const Unit& u, int wr, int wc, int fr, int fq) const {
        const int row0 = u.pm * BM + wr * 64 + fr, col0 = u.pn * BM + wc * 32 + 4 * fq;
#pragma unroll
        for (int ai = 0; ai < 2; ++ai)
#pragma unroll
            for (int m = 0; m < 4; ++m) { const size_t row = (size_t)(row0 + ai * HALF + m * 16);
#pragma unroll
                for (int bj = 0; bj < 2; ++bj)
#pragma unroll
                    for (int n = 0; n < 2; ++n) { const int c = col0 + bj * HALF + n * 16; const uint2 gw = *(const uint2*)(G + row * GATE_COLS + c);
                        f32x4 a = acc[ai][bj][m][n]; a[0] *= bflo(gw.x); a[1] *= bfhi(gw.x); a[2] *= bflo(gw.y); a[3] *= bfhi(gw.y);
                        *(f32x4*)(T1 + row * DM + c) = a; } }
    }
};
struct EpiMerge {
    static constexpr bool PERM = true, AFTER_DRAIN = false;
    const float* T1; const bf16_t* G; bf16_t* O;
    __device__ __forceinline__ void operator()(const f32x4 (&acc)[2][2][4][2], const Unit& u, int wr, int wc, int fr, int fq) const {
        const int row0 = u.pm * BM + wr * 64 + fr, col0 = u.pn * BM + wc * 32 + 8 * fq;
#pragma unroll
        for (int ai = 0; ai < 2; ++ai)
#pragma unroll
            for (int m = 0; m < 4; ++m) { const size_t row = (size_t)(row0 + ai * HALF + m * 16);
#pragma unroll
                for (int bj = 0; bj < 2; ++bj) { const int c = col0 + bj * HALF; const u32x4 gw = *(const u32x4*)(G + row * GATE_COLS + 2048 + c);
                    const f32x4 t0 = *(const f32x4*)(T1 + row * DM + c), t1 = *(const f32x4*)(T1 + row * DM + c + 4);
                    f32x4 v0 = acc[ai][bj][m][0], v1 = acc[ai][bj][m][1];
                    v0[0] = t0[0] + bflo(gw.x) * v0[0]; v0[1] = t0[1] + bfhi(gw.x) * v0[1]; v0[2] = t0[2] + bflo(gw.y) * v0[2]; v0[3] = t0[3] + bfhi(gw.y) * v0[3];
                    v1[0] = t1[0] + bflo(gw.z) * v1[0]; v1[1] = t1[1] + bfhi(gw.z) * v1[1]; v1[2] = t1[2] + bflo(gw.w) * v1[2]; v1[3] = t1[3] + bfhi(gw.w) * v1[3];
                    u32x4 w; w.x = cvt_pk_bf16(v0[0], v0[1]); w.y = cvt_pk_bf16(v0[2], v0[3]); w.z = cvt_pk_bf16(v1[0], v1[1]); w.w = cvt_pk_bf16(v1[2], v1[3]);
                    *(u32x4*)(O + row * DM + c) = w; } }
    }
};
struct EpiPair {
    static constexpr bool PERM = true, AFTER_DRAIN = false;
    const bf16_t* G; bf16_t* O;
    __device__ __forceinline__ void mid(f32x4 (&acc)[2][2][4][2], const Unit& u, int wr, int wc, int fr, int fq) const {
        const int row0 = u.pm * BM + wr * 64 + fr, col0 = u.pn * BM + wc * 32 + 8 * fq;
#pragma unroll
        for (int ai = 0; ai < 2; ++ai)
#pragma unroll
            for (int m = 0; m < 4; ++m) { const size_t row = (size_t)(row0 + ai * HALF + m * 16);
#pragma unroll
                for (int bj = 0; bj < 2; ++bj) { const int c = col0 + bj * HALF; const u32x4 ga = *(const u32x4*)(G + row * GATE_COLS + c), gr = *(const u32x4*)(G + row * GATE_COLS + 2048 + c);
                    f32x4 v0 = acc[ai][bj][m][0], v1 = acc[ai][bj][m][1];
                    v0[0] *= bflo(ga.x) / bflo(gr.x); v0[1] *= bfhi(ga.x) / bfhi(gr.x); v0[2] *= bflo(ga.y) / bflo(gr.y); v0[3] *= bfhi(ga.y) / bfhi(gr.y);
                    v1[0] *= bflo(ga.z) / bflo(gr.z); v1[1] *= bfhi(ga.z) / bfhi(gr.z); v1[2] *= bflo(ga.w) / bflo(gr.w); v1[3] *= bfhi(ga.w) / bfhi(gr.w);
                    acc[ai][bj][m][0] = v0; acc[ai][bj][m][1] = v1; } }
    }
    __device__ __forceinline__ void operator()(const f32x4 (&acc)[2][2][4][2], const Unit& u, int wr, int wc, int fr, int fq) const {
        const int row0 = u.pm * BM + wr * 64 + fr, col0 = u.pn * BM + wc * 32 + 8 * fq;
#pragma unroll
        for (int ai = 0; ai < 2; ++ai)
#pragma unroll
            for (int m = 0; m < 4; ++m) { const size_t row = (size_t)(row0 + ai * HALF + m * 16);
#pragma unroll
                for (int bj = 0; bj < 2; ++bj) { const int c = col0 + bj * HALF; const u32x4 gw = *(const u32x4*)(G + row * GATE_COLS + 2048 + c);
                    f32x4 v0 = acc[ai][bj][m][0], v1 = acc[ai][bj][m][1];
                    v0[0] *= bflo(gw.x); v0[1] *= bfhi(gw.x); v0[2] *= bflo(gw.y); v0[3] *= bfhi(gw.y); v1[0] *= bflo(gw.z); v1[1] *= bfhi(gw.z); v1[2] *= bflo(gw.w); v1[3] *= bfhi(gw.w);
                    u32x4 w; w.x = cvt_pk_bf16(v0[0], v0[1]); w.y = cvt_pk_bf16(v0[2], v0[3]); w.z = cvt_pk_bf16(v1[0], v1[1]); w.w = cvt_pk_bf16(v1[2], v1[3]);
                    *(u32x4*)(O + row * DM + c) = w; } }
    }
};
struct EpiH1 {
    static constexpr bool PERM = false, AFTER_DRAIN = false;
    const float* X; const float* ada; float* H1;
    __device__ __forceinline__ void operator()(const f32x4 (&acc)[2][2][4][2], const Unit& u, int wr, int wc, int fr, int fq) const {
        const int row0 = u.pm * BM + wr * 64 + fr, col0 = u.pn * BM + wc * 32 + 4 * fq;
        const float* gt = ada + (size_t)((u.pm * BM) / SEQ) * 12288 + 4096;
#pragma unroll
        for (int ai = 0; ai < 2; ++ai)
#pragma unroll
            for (int m = 0; m < 4; ++m) { const size_t row = (size_t)(row0 + ai * HALF + m * 16);
#pragma unroll
                for (int bj = 0; bj < 2; ++bj)
#pragma unroll
                    for (int n = 0; n < 2; ++n) { const int c = col0 + bj * HALF + n * 16;
                        const f32x4 xv = *(const f32x4*)(X + row * DM + c), g = *(const f32x4*)(gt + c);
                        *(f32x4*)(H1 + row * DM + c) = xv + g * acc[ai][bj][m][n]; } }
    }
};
}

__device__ __forceinline__ void p0_transpose_item(const float* W, int K, int N, bf16* WT, LAS float* scr, int item, int lane) {
    const int nblk = N / 32, kb = item / nblk, nb = item % nblk, k0 = 64 * kb, n0 = 32 * nb;
#pragma unroll 8
    for (int i = 0; i < 32; ++i) { const int kk = 2 * i + (lane >> 5); scr[kk * 33 + (lane & 31)] = W[(size_t)(k0 + kk) * N + n0 + (lane & 31)]; }
    LDS_WAIT(); asm volatile("" ::: "memory");
    const int c = lane & 7;
#pragma unroll
    for (int j = 0; j < 4; ++j) { const int n = (lane >> 3) + 8 * j; const LAS float* s = scr + (8 * c) * 33 + n;
        v4u o; o.x = pk2(s[0 * 33], s[1 * 33]); o.y = pk2(s[2 * 33], s[3 * 33]); o.z = pk2(s[4 * 33], s[5 * 33]); o.w = pk2(s[6 * 33], s[7 * 33]);
        *(GAS v4u*)(WT + (size_t)(n0 + n) * K + k0 + 8 * c) = o; }
    LDS_WAIT(); asm volatile("" ::: "memory");
}

__device__ __forceinline__ void p0_prologue(Frame& F, const float* const* in) {
    const float* c = in[1]; const int* pos = (const int*)in[2]; const float* ada_w = in[3]; const float* ada_b = in[4];
    float* ada = (float*)(F.ws + WS_ADA); float* rope = (float*)(F.ws + WS_ROPE);
    {
        LAS float* sc = (LAS float*)(F.lds);
        LAS float* red = (LAS float*)(F.lds + 16384);
        for (int i = F.tid; i < 2 * DM; i += NTHR) { const float v = c[i]; sc[i] = v / (1.f + __expf(-v)); }
        __syncthreads();
        const int rg = F.tid / 12, c4 = F.tid % 12;
        for (int cb = F.vcu; cb < 256; cb += F.G) {
            f32x4 a0 = {0.f, 0.f, 0.f, 0.f}, a1 = a0;
            if (rg < 42) {
                const float* wp = ada_w + (size_t)cb * 48 + c4 * 4;
#pragma unroll 7
                for (int k = rg; k < DM; k += 42) { const f32x4 w = *(const f32x4*)(wp + (size_t)k * 12288); a0 += w * sc[k]; a1 += w * sc[DM + k]; }
                LAS float* r = red + rg * 96 + c4 * 4;
                r[0] = a0[0]; r[1] = a0[1]; r[2] = a0[2]; r[3] = a0[3]; r[48] = a1[0]; r[49] = a1[1]; r[50] = a1[2]; r[51] = a1[3];
            }
            __syncthreads();
            if (F.tid < 96) { float s = 0.f; for (int g = 0; g < 42; ++g) s += red[g * 96 + F.tid];
                const int b = F.tid / 48, n = cb * 48 + F.tid % 48; ada[(size_t)b * 12288 + n] = s + ada_b[n]; }
            __syncthreads();
        }
    }
    {
        const int gt = F.vcu * NTHR + F.tid, NGT = F.G * NTHR;
        for (int idx = gt; idx < M * 8; idx += NGT) { const int m = idx >> 3, i = idx & 7;
            const double inv = (i == 0) ? 1.0 : (i == 1) ? 0.19392274474868576 : (i == 2) ? 0.03760603093086393 : (i == 3) ? 0.007292664737217109 : (i == 4) ? 0.001414213562373095
                             : (i == 5) ? 0.0002742481756762073 : (i == 6) ? 5.318295896944988e-05 : 1.031338537721246e-05;
            double a = (double)pos[m] * inv; const double k = __builtin_rint(a * 0.15915494309189535); a -= k * 6.283185307179586;
            const float af = (float)a; rope[(size_t)m * 16 + i] = cosf(af); rope[(size_t)m * 16 + 8 + i] = sinf(af); }
    }
    {
        const int gt = F.vcu * NTHR + F.tid, NGT = F.G * NTHR; bf16* WRH = (bf16*)(F.ws + WS_WRH); bf16* WRL = (bf16*)(F.ws + WS_WRL);
        for (int idx = gt; idx < 80 * DM; idx += NGT) { const int k = idx / 80, col = idx % 80;
            const float wv = col < 8 ? in[27][k * 8 + col] : col < 72 ? in[29][k * 64 + col - 8] : 0.f;
            const unsigned h = f2bf(wv); WRH[(size_t)col * DM + k] = (bf16)h; WRL[(size_t)col * DM + k] = (bf16)f2bf(wv - bf2f((unsigned short)h)); }
    }
    {
        LAS float* scr = (LAS float*)(F.lds + 49152 + F.wave * 8704);
        const int gw = F.vcu * NWAVES + F.wave, NGW = F.G * NWAVES;
        constexpr int I_IN = (DM / 64) * (IN_COLS / 32), I_UP = (1024 / 64) * (DM / 32), I_OUT = (DM / 64) * (DM / 32), I_LR = (64 / 64) * (1024 / 32), I_G2 = (128 / 64) * (1024 / 32);
        constexpr int NITEMS = I_IN + 2 * I_UP + I_OUT + 2 * I_LR + I_G2;
        constexpr int NLATE = 2 * I_UP + I_OUT;
        for (int it = gw; it < NITEMS - NLATE; it += NGW) {
            int r = it;
            if (r < I_IN) { p0_transpose_item(in[6], DM, IN_COLS, (bf16*)(F.ws + WS_WIN_T), scr, r, F.lane); continue; } r -= I_IN;
            if (r < I_LR) { p0_transpose_item(in[14], 64, 1024, (bf16*)(F.ws + WS_W2T), scr, r, F.lane); continue; } r -= I_LR;
            if (r < I_LR) { p0_transpose_item(in[16], 64, 1024, (bf16*)(F.ws + WS_A2T), scr, r, F.lane); continue; } r -= I_LR;
            p0_transpose_item(in[17], 128, 1024, (bf16*)(F.ws + WS_G2T), scr, r, F.lane);
        }
    }
}
__device__ __forceinline__ void p4_late_copies(Frame& F, const float* const* in, int gw, int NGW) {
    LAS float* scr = (LAS float*)(F.lds + 49152 + F.wave * 8704);
    constexpr int I_UP = (1024 / 64) * (DM / 32), I_OUT = (DM / 64) * (DM / 32);
    for (int it = gw; it < 2 * I_UP + I_OUT; it += NGW) {
        int r = it;
        if (r < I_UP) { p0_transpose_item(in[23], 1024, DM, (bf16*)(F.ws + WS_WUPA_T), scr, r, F.lane); continue; } r -= I_UP;
        if (r < I_UP) { p0_transpose_item(in[24], 1024, DM, (bf16*)(F.ws + WS_WUPB_T), scr, r, F.lane); continue; } r -= I_UP;
        p0_transpose_item(in[25], DM, DM, (bf16*)(F.ws + WS_WOUT_T), scr, r, F.lane);
    }
}

__device__ __forceinline__ void norm_mod_row(const float* xrow, const float* g, const float* sc, const float* sh, bf16* orow, int lane, f32x4 (&v)[8]) {
    const GAS f32x4* xr = (const GAS f32x4*)xrow + lane; float s2 = 0.f;
#pragma unroll
    for (int j = 0; j < 8; ++j) { v[j] = xr[64 * j]; s2 += (v[j].x * v[j].x + v[j].y * v[j].y) + (v[j].z * v[j].z + v[j].w * v[j].w); }
    const float rstd = 1.f / sqrtf(wave_sum(s2) * (1.f / DM) + NORM_EPS);
    GAS unsigned long long* o8 = (GAS unsigned long long*)orow + lane;
#pragma unroll
    for (int j = 0; j < 8; ++j) { const int i4 = lane + 64 * j; const f32x4 gg = ((const f32x4*)g)[i4], cc = ((const f32x4*)sc)[i4], hh = ((const f32x4*)sh)[i4];
        v[j] = (v[j] * rstd) * gg * (cc + 1.f) + hh;
        o8[64 * j] = (unsigned long long)pk2(v[j].x, v[j].y) | ((unsigned long long)pk2(v[j].z, v[j].w) << 32); }
}

__device__ __forceinline__ void norm_mod_row2v(const float* x0, const float* x1, const float* g, const float* sc0, const float* sh0, const float* sc1, const float* sh1, bf16* o0, bf16* o1, int lane, f32x4 (&va)[8], f32x4 (&vb)[8]) {
    const GAS f32x4* xa = (const GAS f32x4*)x0 + lane; const GAS f32x4* xb = (const GAS f32x4*)x1 + lane; float sa = 0.f, sb = 0.f;
#pragma unroll
    for (int j = 0; j < 8; ++j) { va[j] = xa[64 * j]; vb[j] = xb[64 * j]; }
#pragma unroll
    for (int j = 0; j < 8; ++j) { sa += (va[j].x * va[j].x + va[j].y * va[j].y) + (va[j].z * va[j].z + va[j].w * va[j].w); sb += (vb[j].x * vb[j].x + vb[j].y * vb[j].y) + (vb[j].z * vb[j].z + vb[j].w * vb[j].w); }
    const float ra = 1.f / sqrtf(wave_sum(sa) * (1.f / DM) + NORM_EPS), rb = 1.f / sqrtf(wave_sum(sb) * (1.f / DM) + NORM_EPS);
    GAS unsigned long long* pa = (GAS unsigned long long*)o0 + lane; GAS unsigned long long* pb = (GAS unsigned long long*)o1 + lane;
#pragma unroll
    for (int j = 0; j < 8; ++j) { const int i4 = lane + 64 * j; const f32x4 gg = ((const f32x4*)g)[i4];
        const f32x4 ya = (va[j] * ra) * gg * (((const f32x4*)sc0)[i4] + 1.f) + ((const f32x4*)sh0)[i4], yb = (vb[j] * rb) * gg * (((const f32x4*)sc1)[i4] + 1.f) + ((const f32x4*)sh1)[i4];
        va[j] = ya; vb[j] = yb;
        pa[64 * j] = (unsigned long long)pk2(ya.x, ya.y) | ((unsigned long long)pk2(ya.z, ya.w) << 32); pb[64 * j] = (unsigned long long)pk2(yb.x, yb.y) | ((unsigned long long)pk2(yb.z, yb.w) << 32); }
}
__device__ __forceinline__ void norm_mod_row2(const float* x0, const float* x1, const float* g, const float* sc0, const float* sh0, const float* sc1, const float* sh1, bf16* o0, bf16* o1, int lane) {
    f32x4 va[8], vb[8]; norm_mod_row2v(x0, x1, g, sc0, sh0, sc1, sh1, o0, o1, lane, va, vb); }

constexpr int RWA_PITCH = 72, RWG_PITCH = 136, RWZ_PITCH = 68;
constexpr int RW_TW = 0, RW_AL = RW_TW + 64 * RWA_PITCH * 2, RW_GS = RW_AL + 64 * RWA_PITCH * 2, RW_Z1 = RW_GS + 64 * RWG_PITCH * 2,
              RW_Z2 = RW_Z1 + 64 * RWZ_PITCH * 4, RW_Z3 = RW_Z2 + 64 * RWZ_PITCH * 4, RW_LDS_END = RW_Z3 + 64 * RWZ_PITCH * 4;
static_assert(RW_LDS_END <= RING_BYTES, "rwkv prep LDS");
__device__ __forceinline__ void shift8(const bf16* cur, const bf16* prv, bool hasprev, const float* mu, float (&o)[8]) {
    const v4u c = *(const v4u*)cur; v4u p = {0u, 0u, 0u, 0u}; if (hasprev) p = *(const v4u*)prv;
    const f32x4 m0 = ((const f32x4*)mu)[0], m1 = ((const f32x4*)mu)[1];
    float cv[8] = {bflo(c.x), bfhi(c.x), bflo(c.y), bfhi(c.y), bflo(c.z), bfhi(c.z), bflo(c.w), bfhi(c.w)};
    float pv[8] = {bflo(p.x), bfhi(p.x), bflo(p.y), bfhi(p.y), bflo(p.z), bfhi(p.z), bflo(p.w), bfhi(p.w)};
    float mv[8] = {m0[0], m0[1], m0[2], m0[3], m1[0], m1[1], m1[2], m1[3]};
#pragma unroll
    for (int e = 0; e < 8; ++e) o[e] = cv[e] + (pv[e] - cv[e]) * mv[e];
}
__device__ __forceinline__ v4u pack8(const float (&x)[8]) { v4u o; o.x = pk2(x[0], x[1]); o.y = pk2(x[2], x[3]); o.z = pk2(x[4], x[5]); o.w = pk2(x[6], x[7]); return o; }
__device__ __forceinline__ void store8(float* p, const float (&x)[8]) { ((f32x4*)p)[0] = (f32x4){x[0], x[1], x[2], x[3]}; ((f32x4*)p)[1] = (f32x4){x[4], x[5], x[6], x[7]}; }

__device__ __forceinline__ void p3_rwkv_prep(Frame& F, const float* const* in) {
    const bf16* PR = (const bf16*)(F.ws + WS_PR);
    const float* mu = in[7]; const float* w0 = in[13]; const float* a0 = in[15]; const float* k_k = in[18]; const float* k_a = in[19]; const float* r_k = in[20];
    const bf16* w2t = (const bf16*)(F.ws + WS_W2T); const bf16* a2t = (const bf16*)(F.ws + WS_A2T); const bf16* g2t = (const bf16*)(F.ws + WS_G2T);
    float* RWb = (float*)(F.ws + WS_RW); constexpr size_t AS = RW_ARR / 4;
    float *oR = RWb, *oW = RWb + AS, *oK = RWb + 2 * AS, *oV = RWb + 3 * AS, *oA = RWb + 4 * AS, *oB = RWb + 5 * AS, *oG = RWb + 6 * AS, *oBo = RWb + 7 * AS;
    LAS unsigned char* L = F.lds;
    const int tt = F.tid >> 3, sub = F.tid & 7, fr = F.lane & 15, fq = F.lane >> 4;
    for (int u = F.vcu; u < 2048; u += F.G) {
        const int h = u & 15, ch = (u >> 4) & 63, b = u >> 10, s = ch * 64 + tt; const size_t m = (size_t)b * SEQ + s; const bool hp = s > 0;
        const bf16* cur = PR + m * RW_COLS; const bf16* prv = cur - RW_COLS;
        float r8[8], k8[8], v8[8], t8[8];
        shift8(cur + h * 64 + sub * 8, prv + h * 64 + sub * 8, hp, mu + h * 64 + sub * 8, r8);
        shift8(cur + 1024 + h * 64 + sub * 8, prv + 1024 + h * 64 + sub * 8, hp, mu + 1024 + h * 64 + sub * 8, k8);
        shift8(cur + 2048 + h * 64 + sub * 8, prv + 2048 + h * 64 + sub * 8, hp, mu + 2048 + h * 64 + sub * 8, v8);
        shift8(cur + 3072 + sub * 8, prv + 3072 + sub * 8, hp, mu + 3072 + sub * 8, t8);
#pragma unroll
        for (int e = 0; e < 8; ++e) t8[e] = tanhf(t8[e]);
        *(LAS v4u*)(L + RW_TW + (tt * RWA_PITCH + sub * 8) * 2) = pack8(t8);
        shift8(cur + 3136 + sub * 8, prv + 3136 + sub * 8, hp, mu + 3136 + sub * 8, t8);
        *(LAS v4u*)(L + RW_AL + (tt * RWA_PITCH + sub * 8) * 2) = pack8(t8);
#pragma unroll
        for (int hlf = 0; hlf < 2; ++hlf) { shift8(cur + 3200 + sub * 16 + hlf * 8, prv + 3200 + sub * 16 + hlf * 8, hp, mu + 3200 + sub * 16 + hlf * 8, t8);
#pragma unroll
            for (int e = 0; e < 8; ++e) t8[e] = sigmoidf_(t8[e]);
            *(LAS v4u*)(L + RW_GS + (tt * RWG_PITCH + sub * 16 + hlf * 8) * 2) = pack8(t8); }
        __syncthreads();
#pragma unroll 1
        for (int job = F.wave; job < 48; job += NWAVES) { const int mat = job >> 4, ti = (job >> 2) & 3, tj = job & 3;
            const int aoff = mat == 0 ? RW_TW : mat == 1 ? RW_AL : RW_GS, ap = mat == 2 ? RWG_PITCH : RWA_PITCH, kd = mat == 2 ? 128 : 64;
            const bf16* wt = (mat == 0 ? w2t : mat == 1 ? a2t : g2t) + (size_t)(h * 64 + tj * 16 + fr) * kd + fq * 8;
            f32x4 acc = {0.f, 0.f, 0.f, 0.f};
            for (int ks = 0; ks < kd / 32; ++ks) { const bf16x8 a = *(const LAS bf16x8*)(L + aoff + ((ti * 16 + fr) * ap + ks * 32 + fq * 8) * 2); const bf16x8 bb = *(const bf16x8*)(wt + ks * 32);
                acc = __builtin_amdgcn_mfma_f32_16x16x32_bf16(a, bb, acc, 0, 0, 0); }
            LAS float* z = (LAS float*)(L + (mat == 0 ? RW_Z1 : mat == 1 ? RW_Z2 : RW_Z3));
#pragma unroll
            for (int e = 0; e < 4; ++e) z[(ti * 16 + fq * 4 + e) * RWZ_PITCH + tj * 16 + fr] = acc[e]; }
        __syncthreads();
        {
            const int c0 = h * 64 + sub * 8; const LAS float* z1 = (const LAS float*)(L + RW_Z1) + tt * RWZ_PITCH + sub * 8; const LAS float* z2 = (const LAS float*)(L + RW_Z2) + tt * RWZ_PITCH + sub * 8;
            const LAS float* z3 = (const LAS float*)(L + RW_Z3) + tt * RWZ_PITCH + sub * 8;
            float dec[8], av[8], gv[8], kkv[8], km[8], bo[8], ss = 0.f, bs = 0.f;
#pragma unroll
            for (int e = 0; e < 8; ++e) { const float z = w0[c0 + e] + z1[e]; const float sp = fmaxf(-z, 0.f) + log1pf(__expf(-fabsf(z)));
                const float wl = -sp - 0.5f; dec[e] = __expf(-__expf(wl)); av[e] = sigmoidf_(a0[c0 + e] + z2[e]); gv[e] = z3[e];
                kkv[e] = k8[e] * k_k[c0 + e]; ss += kkv[e] * kkv[e]; km[e] = k8[e] * (1.f + (av[e] - 1.f) * k_a[c0 + e]); bs += r8[e] * km[e] * r_k[c0 + e]; }
            ss = sum8(ss); bs = sum8(bs); const float rn = 1.f / sqrtf(fmaxf(ss, 1e-24f));
            float na[8], nb[8];
#pragma unroll
            for (int e = 0; e < 8; ++e) { const float kk = kkv[e] * rn; na[e] = -kk; nb[e] = kk * av[e]; bo[e] = bs * v8[e]; }
            const size_t o = m * RW_W + c0;
            store8(oR + o, r8); store8(oW + o, dec); store8(oK + o, km); store8(oV + o, v8); store8(oA + o, na); store8(oB + o, nb); store8(oG + o, gv); store8(oBo + o, bo);
        }
        __syncthreads();
    }
}

__device__ __forceinline__ void p4_rwkv_scan(Frame& F) {
    float* RWb = (float*)(F.ws + WS_RW); constexpr size_t AS = RW_ARR / 4;
    const float *iR = RWb, *iW = RWb + AS, *iK = RWb + 2 * AS, *iV = RWb + 3 * AS, *iA = RWb + 4 * AS, *iB = RWb + 5 * AS; float* oY = RWb + 8 * AS;
    constexpr int TB = 16;
    LAS float* S = (LAS float*)F.lds;
    const int vr = F.tid >> 3, ks = F.tid & 7;
    for (int bh = blockIdx.x; bh < BATCH * 16; bh += F.G) {
        const int b = bh >> 4, h = bh & 15; const size_t base = (size_t)b * SEQ * RW_W + h * 64;
        float st[8];
#pragma unroll
        for (int e = 0; e < 8; ++e) st[e] = 0.f;
        f32x4 stg[3];
        auto gload = [&](int blk) {
#pragma unroll
            for (int i = 0; i < 3; ++i) { const int q = F.tid + i * NTHR, arr = q >> 8, rem = q & 255, t = rem >> 4, c4 = rem & 15;
                const float* src = (arr == 0 ? iR : arr == 1 ? iW : arr == 2 ? iK : arr == 3 ? iV : arr == 4 ? iA : iB) + base + (size_t)(blk * TB + t) * RW_W + c4 * 4;
                stg[i] = *(const f32x4*)src; } };
        auto lstore = [&](int buf) {
#pragma unroll
            for (int i = 0; i < 3; ++i) { const int q = F.tid + i * NTHR; *(LAS f32x4*)(S + buf * (6 * TB * 64) + q * 4) = stg[i]; } };
        gload(0);
        for (int blk = 0; blk < SEQ / TB; ++blk) {
            const int buf = blk & 1;
            lstore(buf);
            if (blk + 1 < SEQ / TB) gload(blk + 1);
            __syncthreads();
            const LAS float* sb = S + buf * (6 * TB * 64);
#pragma unroll 4
            for (int t = 0; t < TB; ++t) {
                const LAS float* p = sb + t * 64 + ks * 8;
                const f32x4 r0 = *(const LAS f32x4*)(p), r1 = *(const LAS f32x4*)(p + 4);
                const f32x4 w0 = *(const LAS f32x4*)(p + TB * 64), w1 = *(const LAS f32x4*)(p + TB * 64 + 4);
                const f32x4 k0 = *(const LAS f32x4*)(p + 2 * TB * 64), k1 = *(const LAS f32x4*)(p + 2 * TB * 64 + 4);
                const float vv = sb[3 * TB * 64 + t * 64 + vr];
                const f32x4 a0 = *(const LAS f32x4*)(p + 4 * TB * 64), a1 = *(const LAS f32x4*)(p + 4 * TB * 64 + 4);
                const f32x4 b0 = *(const LAS f32x4*)(p + 5 * TB * 64), b1 = *(const LAS f32x4*)(p + 5 * TB * 64 + 4);
                float sa = 0.f;
#pragma unroll
                for (int e = 0; e < 4; ++e) { sa += st[e] * a0[e]; sa += st[4 + e] * a1[e]; }
                sa = sum8(sa);
                float y = 0.f;
#pragma unroll
                for (int e = 0; e < 4; ++e) { st[e] = st[e] * w0[e] + sa * b0[e] + vv * k0[e]; st[4 + e] = st[4 + e] * w1[e] + sa * b1[e] + vv * k1[e]; y += st[e] * r0[e]; y += st[4 + e] * r1[e]; }
                y = sum8(y);
                if (ks == 0) oY[base + (size_t)(blk * TB + t) * RW_W + vr] = y;
            }
        }
        __syncthreads();
    }
}


constexpr int RP = 72, SLOTB = 64 * RP * 2;
constexpr int H_AH = 0, H_AHT = 1, H_BH = 2, H_KH = 3, H_RH = 4, H_VT = 5, H_BTT = 6, H_KTT = 7, S_0 = 8, S_1 = 9, S_2 = 10, S_3 = 11, S_4 = 12, S_5 = 13;
constexpr int RC_LW = RW_LDS_END, RC_SEG = RC_LW + 64 * 65 * 4, RC_STAGE0_END = RC_SEG + 8 * 64 * 4;
constexpr int RC_PC = 14 * SLOTB;
static_assert(RC_STAGE0_END <= RING_BYTES && RC_PC + 256 <= RING_BYTES && 8 * SLOTB <= RC_LW, "rwkv chunk LDS map");
constexpr size_t WS_CRT = WS_RW, WS_CMM = WS_RW + 16 * MiB, WS_CY0 = WS_RW + 32 * MiB, WS_CN0 = WS_RW + 64 * MiB;

__device__ __forceinline__ f32x4 tmm(const LAS unsigned char* L, int Xs, int Ys, int tx, int ty, f32x4 acc, int fr, int fq) {
#pragma unroll
    for (int ks = 0; ks < 2; ++ks) { const bf16x8 a = *(const LAS bf16x8*)(L + Xs + ((tx * 16 + fr) * RP + ks * 32 + fq * 8) * 2); const bf16x8 b = *(const LAS bf16x8*)(L + Ys + ((ty * 16 + fr) * RP + ks * 32 + fq * 8) * 2);
        acc = __builtin_amdgcn_mfma_f32_16x16x32_bf16(a, b, acc, 0, 0, 0); }
    return acc;
}
__device__ __forceinline__ void st_rowY(LAS unsigned char* L, int dst, f32x4 v, int tx, int ty, int fr, int fq) {
    v2u w; w.x = pk2(v[0], v[1]); w.y = pk2(v[2], v[3]); *(LAS v2u*)(L + dst + ((ty * 16 + fr) * RP + tx * 16 + fq * 4) * 2) = w; }
__device__ __forceinline__ void st_rowX(LAS unsigned char* L, int dst, f32x4 v, int tx, int ty, int fr, int fq) {
#pragma unroll
    for (int e = 0; e < 4; ++e) *(LAS unsigned short*)(L + dst + ((tx * 16 + fq * 4 + e) * RP + ty * 16 + fr) * 2) = (unsigned short)f2bf(v[e]); }
__device__ __forceinline__ f32x4 ld_rowY(const LAS unsigned char* L, int src, int tx, int ty, int fr, int fq) {
    const v2u w = *(const LAS v2u*)(L + src + ((ty * 16 + fr) * RP + tx * 16 + fq * 4) * 2); return (f32x4){bflo(w.x), bfhi(w.x), bflo(w.y), bfhi(w.y)}; }
__device__ __forceinline__ void inv_iter(LAS unsigned char* L, int wave, int fr, int fq, int PA, int PT, int PnA, int PnT, int Tp, int Tn, bool doP, bool doPA, bool doT) {
#pragma unroll
    for (int i = 0; i < 4; ++i) { const int which = i >> 1, tl = wave + 8 * (i & 1), ty = tl >> 2, tx = tl & 3;
        if (which == 0) { if (!doP) continue;
            f32x4 acc = {0.f, 0.f, 0.f, 0.f}; acc = tmm(L, PT, PA, tx, ty, acc, fr, fq);
            if (doPA) st_rowY(L, PnA, acc, tx, ty, fr, fq); st_rowX(L, PnT, acc, tx, ty, fr, fq);
        } else { if (!doT) continue;
            f32x4 acc = ld_rowY(L, Tp, tx, ty, fr, fq); acc = tmm(L, PT, Tp, tx, ty, acc, fr, fq);
            st_rowY(L, Tn, acc, tx, ty, fr, fq); }
    }
}

__device__ __forceinline__ void p3_rwkv_chunk(Frame& F, const float* const* in) {
    const bf16* PR = (const bf16*)(F.ws + WS_PR);
    const float* mu = in[7]; const float* w0 = in[13]; const float* a0 = in[15]; const float* k_k = in[18]; const float* k_a = in[19]; const float* r_k = in[20];
    const bf16* w2t = (const bf16*)(F.ws + WS_W2T); const bf16* a2t = (const bf16*)(F.ws + WS_A2T); const bf16* g2t = (const bf16*)(F.ws + WS_G2T);
    float* RWb = (float*)(F.ws + WS_RW); constexpr size_t AS = RW_ARR / 4; float *oG = RWb + 6 * AS, *oBo = RWb + 7 * AS;
    LAS unsigned char* L = F.lds;
    int tt = F.tid >> 3, sub = F.tid & 7, fr = F.lane & 15, fq = F.lane >> 4, lane = F.lane;
#define P3_OPAQUE() asm volatile("" : "+v"(tt), "+v"(sub), "+v"(fr), "+v"(fq), "+v"(lane))
    v4u pc[7], pp[7];
#define P3_COLS(h_, g_) ((g_) < 3 ? (g_) * 1024 + (h_) * 64 + sub * 8 : (g_) == 3 ? 3072 + sub * 8 : (g_) == 4 ? 3136 + sub * 8 : 3200 + sub * 16 + ((g_) - 5) * 8)
#define P3_LOADS(u_) do { const int h_ = (u_) & 15, s_ = (((u_) >> 4) & 63) * 64 + tt; const bf16* cur_ = PR + ((size_t)((u_) >> 10) * SEQ + s_) * RW_COLS; \
        _Pragma("unroll") for (int g = 0; g < 7; ++g) { const int co = P3_COLS(h_, g); pc[g] = *(const v4u*)(cur_ + co); const v4u q_ = *(const v4u*)(cur_ - (s_ > 0 ? RW_COLS : 0) + co); pp[g] = s_ > 0 ? q_ : (v4u){0u, 0u, 0u, 0u}; } } while (0)
    if (F.tid == 0) { F.MISC[0] = __hip_atomic_fetch_add((unsigned*)(F.ctl + CW_P3Q), 1u, __ATOMIC_RELAXED, __HIP_MEMORY_SCOPE_AGENT);
                      F.MISC[1] = __hip_atomic_fetch_add((unsigned*)(F.ctl + CW_P3Q), 1u, __ATOMIC_RELAXED, __HIP_MEMORY_SCOPE_AGENT); }
    __syncthreads();
    int u = (int)F.MISC[0], unx = (int)F.MISC[1];
    if (u < 2048) P3_LOADS(u);
    for (int it = 0;; ++it) {
        if (u >= 2048) break;
        if (F.tid == 0) F.MISC[2 + (it & 1)] = __hip_atomic_fetch_add((unsigned*)(F.ctl + CW_P3Q), 1u, __ATOMIC_RELAXED, __HIP_MEMORY_SCOPE_AGENT);
        const int h = u & 15, ch = (u >> 4) & 63, b = u >> 10, s = ch * 64 + tt; const size_t m = (size_t)b * SEQ + s;
        const size_t unit = (size_t)((b * 16 + h) * 64 + ch);
        float r8[8], k8[8], v8[8], t8[8];
#define P3_SHIFT(g_, o_) do { const f32x4 m0_ = ((const f32x4*)(mu + P3_COLS(h, g_)))[0], m1_ = ((const f32x4*)(mu + P3_COLS(h, g_)))[1]; const v4u c_ = pc[g_], p_ = pp[g_]; \
        const float cv_[8] = {bflo(c_.x), bfhi(c_.x), bflo(c_.y), bfhi(c_.y), bflo(c_.z), bfhi(c_.z), bflo(c_.w), bfhi(c_.w)}, pv_[8] = {bflo(p_.x), bfhi(p_.x), bflo(p_.y), bfhi(p_.y), bflo(p_.z), bfhi(p_.z), bflo(p_.w), bfhi(p_.w)}; \
        const float mv_[8] = {m0_[0], m0_[1], m0_[2], m0_[3], m1_[0], m1_[1], m1_[2], m1_[3]}; \
        _Pragma("unroll") for (int e = 0; e < 8; ++e) o_[e] = cv_[e] + (pv_[e] - cv_[e]) * mv_[e]; } while (0)
        P3_SHIFT(0, r8); P3_SHIFT(1, k8); P3_SHIFT(2, v8); P3_SHIFT(3, t8);
#pragma unroll
        for (int e = 0; e < 8; ++e) t8[e] = 1.f - 2.f * __builtin_amdgcn_rcpf(1.f + __expf(2.f * t8[e]));
        *(LAS v4u*)(L + RW_TW + (tt * RWA_PITCH + sub * 8) * 2) = pack8(t8);
        P3_SHIFT(4, t8);
        *(LAS v4u*)(L + RW_AL + (tt * RWA_PITCH + sub * 8) * 2) = pack8(t8);
#pragma unroll
        for (int hlf = 0; hlf < 2; ++hlf) { if (hlf == 0) P3_SHIFT(5, t8); else P3_SHIFT(6, t8);
#pragma unroll
            for (int e = 0; e < 8; ++e) t8[e] = sigmoidf_(t8[e]);
            *(LAS v4u*)(L + RW_GS + (tt * RWG_PITCH + sub * 16 + hlf * 8) * 2) = pack8(t8); }
        __syncthreads();
#pragma unroll
        for (int i = 0; i < 6; ++i) { const int mat = i >> 1, tl = F.wave + 8 * (i & 1), ti = tl >> 2, tj = tl & 3;
            const int aoff = mat == 0 ? RW_TW : mat == 1 ? RW_AL : RW_GS, ap = mat == 2 ? RWG_PITCH : RWA_PITCH, kd = mat == 2 ? 128 : 64;
            const bf16* wt = (mat == 0 ? w2t : mat == 1 ? a2t : g2t) + (size_t)(h * 64 + tj * 16 + fr) * kd + fq * 8;
            f32x4 acc = {0.f, 0.f, 0.f, 0.f};
#pragma unroll
            for (int ks = 0; ks < 4; ++ks) if (ks < kd / 32) { const bf16x8 a = *(const LAS bf16x8*)(L + aoff + ((ti * 16 + fr) * ap + ks * 32 + fq * 8) * 2); const bf16x8 bb = *(const bf16x8*)(wt + ks * 32);
                acc = __builtin_amdgcn_mfma_f32_16x16x32_bf16(a, bb, acc, 0, 0, 0); }
            LAS float* z = (LAS float*)(L + (mat == 0 ? RW_Z1 : mat == 1 ? RW_Z2 : RW_Z3));
#pragma unroll
            for (int e = 0; e < 4; ++e) z[(ti * 16 + fq * 4 + e) * RWZ_PITCH + tj * 16 + fr] = acc[e]; }
        __syncthreads();
        P3_OPAQUE();
        const int c0 = h * 64 + sub * 8;
        float lw[8], na[8], nb[8], km[8];
        {
            const LAS float* z1 = (const LAS float*)(L + RW_Z1) + tt * RWZ_PITCH + sub * 8; const LAS float* z2 = (const LAS float*)(L + RW_Z2) + tt * RWZ_PITCH + sub * 8;
            const LAS float* z3 = (const LAS float*)(L + RW_Z3) + tt * RWZ_PITCH + sub * 8;
            float av[8], gv[8], kkv[8], bo[8], ss = 0.f, bs = 0.f;
#pragma unroll
            for (int e = 0; e < 8; ++e) { const float z = w0[c0 + e] + z1[e]; const float sp = fmaxf(-z, 0.f) + __logf(1.f + __expf(-fabsf(z)));
                lw[e] = -__expf(-sp - 0.5f); av[e] = sigmoidf_(a0[c0 + e] + z2[e]); gv[e] = z3[e];
                kkv[e] = k8[e] * k_k[c0 + e]; ss += kkv[e] * kkv[e]; km[e] = k8[e] * (1.f + (av[e] - 1.f) * k_a[c0 + e]); bs += r8[e] * km[e] * r_k[c0 + e]; }
            ss = sum8(ss); bs = sum8(bs); const float rn = 1.f / sqrtf(fmaxf(ss, 1e-24f));
#pragma unroll
            for (int e = 0; e < 8; ++e) { const float kk = kkv[e] * rn; na[e] = -kk; nb[e] = kk * av[e]; bo[e] = bs * v8[e]; }
            const size_t o = m * RW_W + c0; *(v4u*)((bf16*)oG + o) = pack8(gv); *(v4u*)((bf16*)oBo + o) = pack8(bo);
            LAS float* lwp = (LAS float*)(L + RC_LW) + tt * 65 + sub * 8;
#pragma unroll
            for (int e = 0; e < 8; ++e) lwp[e] = lw[e];
        }
        __syncthreads();
        {
            const int cc = F.tid & 63, sg = F.tid >> 6; LAS float* p = (LAS float*)(L + RC_LW) + (sg * 8) * 65 + cc; float run = 0.f;
#pragma unroll
            for (int i = 0; i < 8; ++i) { run += p[i * 65]; p[i * 65] = run; }
            ((LAS float*)(L + RC_SEG))[sg * 64 + cc] = run;
        }
        __syncthreads();
        {
            const LAS float* lwp = (const LAS float*)(L + RC_LW) + tt * 65 + sub * 8; const LAS float* sgp = (const LAS float*)(L + RC_SEG) + sub * 8; const int sg = tt >> 3;
            float ah[8], rh[8], bh[8], kh[8], bt[8], kt[8];
            float basev[8], totv[8];
#pragma unroll
            for (int e = 0; e < 8; ++e) { basev[e] = 0.f; totv[e] = 0.f; }
#pragma unroll
            for (int q = 0; q < 8; ++q) { const f32x4 s0 = *(const LAS f32x4*)(sgp + q * 64), s1 = *(const LAS f32x4*)(sgp + q * 64 + 4); const float sv[8] = {s0[0], s0[1], s0[2], s0[3], s1[0], s1[1], s1[2], s1[3]};
#pragma unroll
                for (int e = 0; e < 8; ++e) { totv[e] += sv[e]; basev[e] += (q < sg) ? sv[e] : 0.f; } }
#pragma unroll
            for (int e = 0; e < 8; ++e) { const float base = basev[e], tot = totv[e];
                const float cl = lwp[e] + base, clx = cl - lw[e];
                const float ep = __expf(cl), en = __expf(-cl), ee = __expf(tot - cl);
                ah[e] = na[e] * __expf(clx); rh[e] = r8[e] * ep; bh[e] = nb[e] * en; kh[e] = km[e] * en; bt[e] = nb[e] * ee; kt[e] = km[e] * ee;
                if (tt == 63) ((LAS float*)(L + RC_PC))[sub * 8 + e] = __expf(tot); }
            *(LAS v4u*)(L + H_AH * SLOTB + (tt * RP + sub * 8) * 2) = pack8(ah);
            *(LAS v4u*)(L + H_BH * SLOTB + (tt * RP + sub * 8) * 2) = pack8(bh);
            *(LAS v4u*)(L + H_KH * SLOTB + (tt * RP + sub * 8) * 2) = pack8(kh);
            *(LAS v4u*)(L + H_RH * SLOTB + (tt * RP + sub * 8) * 2) = pack8(rh);
#pragma unroll
            for (int e = 0; e < 8; ++e) { const int o = ((sub * 8 + e) * RP + tt) * 2;
                *(LAS unsigned short*)(L + H_AHT * SLOTB + o) = (unsigned short)f2bf(ah[e]); *(LAS unsigned short*)(L + H_VT * SLOTB + o) = (unsigned short)f2bf(v8[e]);
                *(LAS unsigned short*)(L + H_BTT * SLOTB + o) = (unsigned short)f2bf(bt[e]); *(LAS unsigned short*)(L + H_KTT * SLOTB + o) = (unsigned short)f2bf(kt[e]); }
        }
        __syncthreads();
        P3_OPAQUE();
#pragma unroll
        for (int i = 0; i < 8; ++i) { const int mat = i >> 1, tl = F.wave + 8 * (i & 1), ty = tl >> 2, tx = tl & 3;
            const int Xs = ((mat & 1) ? H_KH : H_BH) * SLOTB, Ys = (mat < 2 ? H_AH : H_RH) * SLOTB;
            f32x4 acc = {0.f, 0.f, 0.f, 0.f}; acc = tmm(L, Xs, Ys, tx, ty, acc, fr, fq);
            const int t = ty * 16 + fr, j0 = tx * 16 + fq * 4;
#pragma unroll
            for (int e = 0; e < 4; ++e) { const bool keep = (mat < 2) ? (j0 + e < t) : (j0 + e <= t); acc[e] = keep ? acc[e] : 0.f; }
            const int dst = (mat == 0 ? S_0 : mat == 1 ? S_2 : mat == 2 ? S_3 : S_4) * SLOTB;
            st_rowY(L, dst, acc, tx, ty, fr, fq);
            if (mat == 0) { st_rowX(L, S_1 * SLOTB, acc, tx, ty, fr, fq);
#pragma unroll
                for (int e = 0; e < 4; ++e) acc[e] += (j0 + e == t) ? 1.f : 0.f;
                st_rowY(L, S_5 * SLOTB, acc, tx, ty, fr, fq); }
        }
        __syncthreads();
        P3_OPAQUE();
        if (unx < 2048) P3_LOADS(unx);
        inv_iter(L, F.wave, fr, fq, S_0 * SLOTB, S_1 * SLOTB, H_AH * SLOTB, H_BH * SLOTB, 0, 0, true, true, false);                                  __syncthreads();
        inv_iter(L, F.wave, fr, fq, H_AH * SLOTB, H_BH * SLOTB, S_0 * SLOTB, S_1 * SLOTB, S_5 * SLOTB, H_KH * SLOTB, true, true, true);              __syncthreads();
        inv_iter(L, F.wave, fr, fq, S_0 * SLOTB, S_1 * SLOTB, H_AH * SLOTB, H_BH * SLOTB, H_KH * SLOTB, S_5 * SLOTB, true, true, true);              __syncthreads();
        inv_iter(L, F.wave, fr, fq, H_AH * SLOTB, H_BH * SLOTB, S_0 * SLOTB, S_1 * SLOTB, S_5 * SLOTB, H_KH * SLOTB, true, true, true);              __syncthreads();
        inv_iter(L, F.wave, fr, fq, S_0 * SLOTB, S_1 * SLOTB, 0, H_BH * SLOTB, H_KH * SLOTB, S_5 * SLOTB, true, false, true);                        __syncthreads();
        inv_iter(L, F.wave, fr, fq, 0, H_BH * SLOTB, 0, 0, S_5 * SLOTB, H_KH * SLOTB, false, false, true);                                           __syncthreads();
        P3_OPAQUE();
        constexpr int TS = H_KH * SLOTB;
#pragma unroll
        for (int i = 0; i < 4; ++i) { const int which = i >> 1, tl = F.wave + 8 * (i & 1), ty = tl >> 2, tx = tl & 3;
            f32x4 acc = {0.f, 0.f, 0.f, 0.f};
            if (which == 0) { acc = tmm(L, TS, H_AHT * SLOTB, tx, ty, acc, fr, fq); st_rowY(L, S_0 * SLOTB, acc, tx, ty, fr, fq); }
            else { acc = tmm(L, S_2 * SLOTB, H_VT * SLOTB, tx, ty, acc, fr, fq); st_rowY(L, S_1 * SLOTB, acc, tx, ty, fr, fq); }
        }
        __syncthreads();
        {
            unsigned char* gR = F.ws + WS_CRT + unit * 8192; unsigned char* gM = F.ws + WS_CMM + unit * 8192;
#pragma unroll
            for (int i = 0; i < 6; ++i) { const int which = i >> 1, tl = F.wave + 8 * (i & 1), ty = tl >> 2, tx = tl & 3;
                f32x4 acc = {0.f, 0.f, 0.f, 0.f};
                if (which == 0) { acc = tmm(L, TS, S_1 * SLOTB, tx, ty, acc, fr, fq); st_rowY(L, H_AH * SLOTB, acc, tx, ty, fr, fq); }
                else if (which == 1) {
                    acc = ld_rowY(L, H_RH * SLOTB, tx, ty, fr, fq); acc = tmm(L, S_0 * SLOTB, S_3 * SLOTB, tx, ty, acc, fr, fq);
                    uint2 w; w.x = pk2(acc[0], acc[1]); w.y = pk2(acc[2], acc[3]);
                    *(uint2*)(gR + ((ty * 2 + (tx >> 1)) * 64 + lane) * 16 + (tx & 1) * 8) = w; }
                else {
                    acc = tmm(L, S_0 * SLOTB, H_BTT * SLOTB, tx, ty, acc, fr, fq);
                    const int kr = ty * 16 + fr, kc0 = tx * 16 + fq * 4; const float pc = ((const LAS float*)(L + RC_PC))[kr];
#pragma unroll
                    for (int e = 0; e < 4; ++e) acc[e] += (kc0 + e == kr) ? pc : 0.f;
                    uint2 w; w.x = pk2(acc[0], acc[1]); w.y = pk2(acc[2], acc[3]);
                    *(uint2*)(gM + ((ty * 2 + (tx >> 1)) * 64 + lane) * 16 + (tx & 1) * 8) = w; }
            }
        }
        __syncthreads();
        {
            unsigned char* gY = F.ws + WS_CY0 + unit * 16384; unsigned char* gN = F.ws + WS_CN0 + unit * 16384;
#pragma unroll
            for (int i = 0; i < 4; ++i) { const int which = i >> 1, tl = F.wave + 8 * (i & 1), ty = tl >> 2, tx = tl & 3;
                f32x4 acc = {0.f, 0.f, 0.f, 0.f};
                if (which == 0) { acc = tmm(L, H_AH * SLOTB, S_3 * SLOTB, ty, tx, acc, fr, fq); acc = tmm(L, H_VT * SLOTB, S_4 * SLOTB, ty, tx, acc, fr, fq);
                    { v2u w_; w_.x = pk2(acc[0], acc[1]); w_.y = pk2(acc[2], acc[3]); *(v2u*)(gY + ((ty * 4 + tx) * 64 + lane) * 8) = w_; } }
                else { acc = tmm(L, H_BTT * SLOTB, H_AH * SLOTB, tx, ty, acc, fr, fq); acc = tmm(L, H_KTT * SLOTB, H_VT * SLOTB, tx, ty, acc, fr, fq);
                    { v2u w_; w_.x = pk2(acc[0], acc[1]); w_.y = pk2(acc[2], acc[3]); *(v2u*)(gN + ((ty * 4 + tx) * 64 + lane) * 8) = w_; } }
            }
        }
        __syncthreads();
        u = unx; unx = (int)F.MISC[2 + (it & 1)];
    }
#undef P3_COLS
#undef P3_LOADS
#undef P3_SHIFT
#undef P3_OPAQUE
}

constexpr size_t WS_CX = WS_RW + 96 * MiB;
struct ChainOps { bf16x8 mf[4][2]; f32x4 n0[4]; };
__device__ __forceinline__ void chain_load(ChainOps& o, const unsigned char* ws, size_t unit, int vb, int lane) {
    const unsigned char* gM = ws + WS_CMM + unit * 8192; const unsigned char* gN = ws + WS_CN0 + unit * 16384;
#pragma unroll
    for (int ti = 0; ti < 4; ++ti) {
#pragma unroll
        for (int s = 0; s < 2; ++s) o.mf[ti][s] = *(const bf16x8*)(gM + ((ti * 2 + s) * 64 + lane) * 16);
        o.n0[ti] = *(const f32x4*)(gN + ((vb * 4 + ti) * 64 + lane) * 16); }
}
__device__ __forceinline__ void chain_step(const ChainOps& o, f32x4 (&X)[4], unsigned char* gX, int vb, int lane) {
    bf16x8 xb[2];
#pragma unroll
    for (int s = 0; s < 2; ++s) { v4u w; w.x = pk2(X[2 * s][0], X[2 * s][1]); w.y = pk2(X[2 * s][2], X[2 * s][3]); w.z = pk2(X[2 * s + 1][0], X[2 * s + 1][1]); w.w = pk2(X[2 * s + 1][2], X[2 * s + 1][3]);
        xb[s] = __builtin_bit_cast(bf16x8, w); *(v4u*)(gX + ((vb * 2 + s) * 64 + lane) * 16) = w; }
#pragma unroll
    for (int ti = 0; ti < 4; ++ti) { f32x4 xn = __builtin_amdgcn_mfma_f32_16x16x32_bf16(o.mf[ti][0], xb[0], o.n0[ti], 0, 0, 0); X[ti] = __builtin_amdgcn_mfma_f32_16x16x32_bf16(o.mf[ti][1], xb[1], xn, 0, 0, 0); }
}
constexpr int CH_D = 12, CH_SLOT = 12288;
static_assert(CH_D * CH_SLOT <= RING_BYTES, "chain ring");
__device__ __forceinline__ void p4_rwkv_chain(Frame& F) {
    LAS unsigned char* L = F.lds;
    for (int job = blockIdx.x; job < BATCH * 16 * 4; job += F.G) {
        const int bh = job >> 2, vb = job & 3;
        __syncthreads();
        if (F.wave == 4 || F.wave == 5) {
            const int lw = F.wave - 4, lane = F.lane;
#define CH_ISSUE(c_, slot_) do { const unsigned char* gM_ = F.ws + WS_CMM + ((size_t)bh * 64 + (c_)) * 8192; const unsigned char* gN_ = F.ws + WS_CN0 + ((size_t)bh * 64 + (c_)) * 16384 + vb * 2048; \
            _Pragma("unroll") for (int i = 0; i < 5; ++i) { const int p = lw * 5 + i; const unsigned char* src = (p < 8 ? gM_ + p * 1024 : gN_ + (p - 8) * 1024) + lane * 16; \
                __builtin_amdgcn_global_load_lds((const unsigned*)src, (LAS unsigned*)(L + (slot_) * CH_SLOT + p * 1024), 16, 0, 0); } } while (0)
#pragma unroll
            for (int c = 0; c < CH_D - 1; ++c) CH_ISSUE(c, c);
            asm volatile("s_waitcnt vmcnt(50)" ::: "memory");
            int slot = CH_D - 1;
#pragma unroll 1
            for (int c = 0; c < 64; ++c) {
                __syncthreads();
                if (c + CH_D - 1 < 64) { CH_ISSUE(c + CH_D - 1, slot); slot = slot == CH_D - 1 ? 0 : slot + 1; asm volatile("s_waitcnt vmcnt(50)" ::: "memory"); }
                else asm volatile("s_waitcnt vmcnt(0)" ::: "memory");
            }
#undef CH_ISSUE
        } else if (F.wave == 0) {
            const int lane = F.lane;
            f32x4 X[4];
#pragma unroll
            for (int i = 0; i < 4; ++i) X[i] = (f32x4){0.f, 0.f, 0.f, 0.f};
            unsigned char* gX = F.ws + WS_CX + (size_t)bh * 64 * 8192;
            int slot = 0;
#pragma unroll 1
            for (int c = 0; c < 64; ++c) {
                __syncthreads();
                const LAS unsigned char* S = L + slot * CH_SLOT; slot = slot == CH_D - 1 ? 0 : slot + 1;
                ChainOps o;
#pragma unroll
                for (int ti = 0; ti < 4; ++ti) {
#pragma unroll
                    for (int s = 0; s < 2; ++s) o.mf[ti][s] = *(const LAS bf16x8*)(S + ((ti * 2 + s) * 64 + lane) * 16);
                    { const v2u n_ = *(const LAS v2u*)(S + 8192 + (ti * 64 + lane) * 8); o.n0[ti] = (f32x4){bflo(n_.x), bfhi(n_.x), bflo(n_.y), bfhi(n_.y)}; } }
                chain_step(o, X, gX + (size_t)c * 8192, vb, lane);
            }
        } else {
#pragma unroll 1
            for (int c = 0; c < 64; ++c) __syncthreads();
        }
    }
}
__device__ __forceinline__ float sum16(float x) { x += dpp_f<0xB1>(x); x += dpp_f<0x4E>(x); x += dpp_f<0x141>(x); x += dpp_f<0x140>(x); return x; }
__device__ __forceinline__ void rwkv_out_job(Frame& F, const float* lnx_g, const float* lnx_b, int job) {
    const int unit = job >> 2, ti = job & 3, bh = unit >> 6, c = unit & 63, b = bh >> 4, h = bh & 15, lane = F.lane, fr = lane & 15, fq = lane >> 4;
    const unsigned char* gR = F.ws + WS_CRT + (size_t)unit * 8192; const unsigned char* gX = F.ws + WS_CX + (size_t)unit * 8192; const unsigned char* gY = F.ws + WS_CY0 + (size_t)unit * 16384;
    float* RWb = (float*)(F.ws + WS_RW); constexpr size_t AS = RW_ARR / 4; const float *iG = RWb + 6 * AS, *iBo = RWb + 7 * AS; bf16* YR = (bf16*)(F.ws + WS_YRW);
    const bf16x8 r0 = *(const bf16x8*)(gR + ((ti * 2 + 0) * 64 + lane) * 16), r1 = *(const bf16x8*)(gR + ((ti * 2 + 1) * 64 + lane) * 16);
    const size_t o0 = ((size_t)b * SEQ + c * 64 + ti * 16 + fr) * RW_W + h * 64 + fq * 4;
    f32x4 y[4]; v2u gb[4], gg[4];
#pragma unroll
    for (int vb = 0; vb < 4; ++vb) { const bf16x8 x0 = *(const bf16x8*)(gX + ((vb * 2 + 0) * 64 + lane) * 16), x1 = *(const bf16x8*)(gX + ((vb * 2 + 1) * 64 + lane) * 16);
        const v2u ya_ = *(const v2u*)(gY + ((vb * 4 + ti) * 64 + lane) * 8); f32x4 acc = {bflo(ya_.x), bfhi(ya_.x), bflo(ya_.y), bfhi(ya_.y)};
        gb[vb] = *(const v2u*)((const bf16*)iBo + o0 + vb * 16); gg[vb] = *(const v2u*)((const bf16*)iG + o0 + vb * 16);
        acc = __builtin_amdgcn_mfma_f32_16x16x32_bf16(x0, r0, acc, 0, 0, 0); y[vb] = __builtin_amdgcn_mfma_f32_16x16x32_bf16(x1, r1, acc, 0, 0, 0); }
    float s1 = 0.f;
#pragma unroll
    for (int vb = 0; vb < 4; ++vb) s1 += (y[vb][0] + y[vb][1]) + (y[vb][2] + y[vb][3]);
    s1 += __shfl_xor(s1, 16); s1 += __shfl_xor(s1, 32);
    const float mean = s1 * (1.f / 64.f); float q = 0.f;
#pragma unroll
    for (int vb = 0; vb < 4; ++vb)
#pragma unroll
        for (int e = 0; e < 4; ++e) { const float d = y[vb][e] - mean; q += d * d; }
    q += __shfl_xor(q, 16); q += __shfl_xor(q, 32);
    const float rs = 1.f / sqrtf(q * (1.f / 64.f) + LNX_EPS);
    uint2 pw[4];
#pragma unroll
    for (int vb = 0; vb < 4; ++vb) { const int col = h * 64 + vb * 16 + fq * 4; const f32x4 lg = *(const f32x4*)(lnx_g + col), lb = *(const f32x4*)(lnx_b + col); float o[4];
        const float bv[4] = {bflo(gb[vb].x), bfhi(gb[vb].x), bflo(gb[vb].y), bfhi(gb[vb].y)}, gv[4] = {bflo(gg[vb].x), bfhi(gg[vb].x), bflo(gg[vb].y), bfhi(gg[vb].y)};
#pragma unroll
        for (int e = 0; e < 4; ++e) o[e] = ((y[vb][e] - mean) * rs * lg[e] + lb[e] + bv[e]) * gv[e];
        pw[vb].x = pk2(o[0], o[1]); pw[vb].y = pk2(o[2], o[3]); }
    bf16* yb = YR + o0 - fq * 4 + (fq & 1) * 16 + (fq >> 1) * 8;
#pragma unroll
    for (int vb = 0; vb < 4; vb += 2) { const auto sx = __builtin_amdgcn_permlane16_swap(pw[vb].x, pw[vb + 1].x, false, false), sy = __builtin_amdgcn_permlane16_swap(pw[vb].y, pw[vb + 1].y, false, false);
        v4u q4; q4.x = sx[0]; q4.y = sy[0]; q4.z = sx[1]; q4.w = sy[1]; *(v4u*)(yb + vb * 16) = q4; }
}

__device__ __forceinline__ void p6_attn_combine(Frame& F, const float* const* in, int gw, int NGW) {
    const bf16* O0 = (const bf16*)(F.ws + WS_O0); const bf16* O1 = (const bf16*)(F.ws + WS_O1); bf16* YA = (bf16*)(F.ws + WS_YATT);
    const float* subg = in[12];
    const float d1 = wave_sum(in[8][F.lane] * in[9][F.lane]), d2 = wave_sum(in[10][F.lane] * in[11][F.lane]);
    const float lam = expf(d1) - expf(d2) + LAMBDA_INIT;
    int lane = F.lane; asm volatile("" : "+v"(lane));
    for (int m = gw; m < M; m += NGW) {
        {
            const size_t o = (size_t)m * ATT_W + lane * 16; float d[16]; float ss = 0.f;
#pragma unroll
            for (int hf = 0; hf < 2; ++hf) { const v4u a = *(const v4u*)(O0 + o + hf * 8), bq = *(const v4u*)(O1 + o + hf * 8);
                const unsigned aw[4] = {a.x, a.y, a.z, a.w}, bw[4] = {bq.x, bq.y, bq.z, bq.w};
#pragma unroll
                for (int e = 0; e < 4; ++e) { d[hf * 8 + 2 * e] = bflo(aw[e]) - lam * bflo(bw[e]); d[hf * 8 + 2 * e + 1] = bfhi(aw[e]) - lam * bfhi(bw[e]); } }
#pragma unroll
            for (int e = 0; e < 16; ++e) ss += d[e] * d[e];
            ss = sum8(ss); const float rs = (1.f - LAMBDA_INIT) / sqrtf(ss * (1.f / 128.f) + SUBLN_EPS);
            const float* sg = subg + (lane & 7) * 16; float y[16];
#pragma unroll
            for (int e = 0; e < 16; ++e) y[e] = d[e] * rs * sg[e];
            v4u w0, w1; w0.x = pk2(y[0], y[1]); w0.y = pk2(y[2], y[3]); w0.z = pk2(y[4], y[5]); w0.w = pk2(y[6], y[7]); w1.x = pk2(y[8], y[9]); w1.y = pk2(y[10], y[11]); w1.z = pk2(y[12], y[13]); w1.w = pk2(y[14], y[15]);
            *(v4u*)(YA + o) = w0; *(v4u*)(YA + o + 8) = w1;
        }
    }
}
__device__ __forceinline__ void p6_combine(Frame& F, const float* const* in) {
    bf16* YR = (bf16*)(F.ws + WS_YRW); const float* lnx_g = in[21]; const float* lnx_b = in[22];
    const int gw = F.vcu * NWAVES + F.wave, NGW = F.G * NWAVES, lane = F.lane;
    (void)YR; (void)lane;
#if RWKV_SEQ
    p6_attn_combine(F, in, gw, NGW);
    for (int m = gw; m < M; m += NGW) {
        float* RWb = (float*)(F.ws + WS_RW); constexpr size_t AS = RW_ARR / 4; const float *iG = RWb + 6 * AS, *iBo = RWb + 7 * AS, *iY = RWb + 8 * AS;
        const size_t o = (size_t)m * RW_W + lane * 16; float yv[16]; float s1 = 0.f;
#pragma unroll
        for (int q = 0; q < 4; ++q) { const f32x4 t = *(const f32x4*)(iY + o + q * 4); yv[q * 4] = t[0]; yv[q * 4 + 1] = t[1]; yv[q * 4 + 2] = t[2]; yv[q * 4 + 3] = t[3]; s1 += (t[0] + t[1]) + (t[2] + t[3]); }
        const float mean = sum4(s1) * (1.f / 64.f); float s2 = 0.f;
#pragma unroll
        for (int e = 0; e < 16; ++e) { yv[e] -= mean; s2 += yv[e] * yv[e]; }
        const float rs = 1.f / sqrtf(sum4(s2) * (1.f / 64.f) + LNX_EPS); float y[16];
#pragma unroll
        for (int q = 0; q < 4; ++q) { const f32x4 lg = *(const f32x4*)(lnx_g + lane * 16 + q * 4), lb = *(const f32x4*)(lnx_b + lane * 16 + q * 4), bo = *(const f32x4*)(iBo + o + q * 4), gg = *(const f32x4*)(iG + o + q * 4);
#pragma unroll
            for (int e = 0; e < 4; ++e) y[q * 4 + e] = (yv[q * 4 + e] * rs * lg[e] + lb[e] + bo[e]) * gg[e]; }
        v4u w0, w1; w0.x = pk2(y[0], y[1]); w0.y = pk2(y[2], y[3]); w0.z = pk2(y[4], y[5]); w0.w = pk2(y[6], y[7]); w1.x = pk2(y[8], y[9]); w1.y = pk2(y[10], y[11]); w1.z = pk2(y[12], y[13]); w1.w = pk2(y[14], y[15]);
        *(v4u*)(YR + o) = w0; *(v4u*)(YR + o + 8) = w1;
    }
#else
    for (int job = gw; job < 2048 * 4; job += NGW) rwkv_out_job(F, lnx_g, lnx_b, job);
#endif
}

constexpr int RT_XP = 520;
constexpr int RT_XH = 0, RT_XL = RT_XH + 16 * RT_XP * 2, RT_PART = RT_XL + 16 * RT_XP * 2, RT_LG = RT_PART + 8 * 5 * 1024, RT_END = RT_LG + 16 * 80 * 4;
static_assert(RT_END <= RING_BYTES, "router LDS");
__device__ __forceinline__ void p10_route(Frame& F, const float* const* in) {
    const float* H1 = (const float*)(F.ws + WS_H1); bf16* U2 = (bf16*)(F.ws + WS_U2); const float* ada = (const float*)(F.ws + WS_ADA);
    const float* gffn = in[26]; const float* brg = in[28]; const float* bre = in[30];
    const bf16* WRH = (const bf16*)(F.ws + WS_WRH); const bf16* WRL = (const bf16*)(F.ws + WS_WRL);
    int* tokE = (int*)(F.ws + WS_TOKE); int* tokP = (int*)(F.ws + WS_TOKP); float* tokW = (float*)(F.ws + WS_TOKW); int* list = (int*)(F.ws + WS_LIST);
    unsigned* cnt = (unsigned*)(F.ctl + CW_CNT);
    LAS unsigned char* L = F.lds;
    const int lane = F.lane, w = F.wave, fr = lane & 15, fq = lane >> 4;
    const __amdgpu_buffer_rsrc_t rsH = __builtin_amdgcn_make_buffer_rsrc((void*)WRH, 0, 80 * DM * 2, 0x00020000), rsL = __builtin_amdgcn_make_buffer_rsrc((void*)WRL, 0, 80 * DM * 2, 0x00020000);
    const int voff = (fr * DM + fq * 8) * 2;
#pragma unroll 1
    for (int blk = F.vcu; blk < M / 16; blk += F.G) {
        const int m0 = blk * 16 + w * 2;
        const int b = m0 / SEQ; const float* ad = ada + (size_t)b * 12288;
        bf16x8 wh[2][5], wl[2][5];
#define RT_WLOAD(j_, S_) do { _Pragma("unroll") for (int ct = 0; ct < 5; ++ct) { const int so = __builtin_amdgcn_readfirstlane(((ct * 16) * DM + ((j_) >> 1) * 512 + (w + 8 * ((j_) & 1)) * 32) * 2); \
        wh[S_][ct] = __builtin_bit_cast(bf16x8, __builtin_amdgcn_raw_buffer_load_b128(rsH, voff, so, 0)); wl[S_][ct] = __builtin_bit_cast(bf16x8, __builtin_amdgcn_raw_buffer_load_b128(rsL, voff, so, 0)); } } while (0)
        RT_WLOAD(0, 0);
        f32x4 v0[8], v1[8];
        norm_mod_row2v(H1 + (size_t)m0 * DM, H1 + (size_t)(m0 + 1) * DM, gffn, ad + 8192, ad + 6144, ad + 8192, ad + 6144, U2 + (size_t)m0 * U2P, U2 + (size_t)(m0 + 1) * U2P, lane, v0, v1);
        f32x4 acc[5];
#pragma unroll
        for (int ct = 0; ct < 5; ++ct) acc[ct] = (f32x4){0.f, 0.f, 0.f, 0.f};
#pragma unroll
        for (int kq = 0; kq < 4; ++kq) {
            __syncthreads();
#pragma unroll
            for (int r = 0; r < 2; ++r)
#pragma unroll
                for (int jj = 0; jj < 2; ++jj) { const f32x4 x = r ? v1[2 * kq + jj] : v0[2 * kq + jj]; const int off = ((w * 2 + r) * RT_XP + 4 * lane + 256 * jj) * 2;
                    const unsigned h0 = f2bf(x[0]), h1 = f2bf(x[1]), h2 = f2bf(x[2]), h3 = f2bf(x[3]);
                    v2u hw; hw.x = h0 | (h1 << 16); hw.y = h2 | (h3 << 16); *(LAS v2u*)(L + RT_XH + off) = hw;
                    v2u lw; lw.x = pk2(x[0] - bf2f((unsigned short)h0), x[1] - bf2f((unsigned short)h1)); lw.y = pk2(x[2] - bf2f((unsigned short)h2), x[3] - bf2f((unsigned short)h3)); *(LAS v2u*)(L + RT_XL + off) = lw; }
            __syncthreads();
#pragma unroll
            for (int kk = 0; kk < 2; ++kk) { const int j = 2 * kq + kk, ks = w + 8 * kk;
                if (j < 7) RT_WLOAD(j + 1, (j + 1) & 1);
                const int o = (fr * RT_XP + ks * 32 + fq * 8) * 2; const bf16x8 xh = *(const LAS bf16x8*)(L + RT_XH + o), xl = *(const LAS bf16x8*)(L + RT_XL + o);
#pragma unroll
                for (int ct = 0; ct < 5; ++ct) { f32x4 a = acc[ct];
                    a = __builtin_amdgcn_mfma_f32_16x16x32_bf16(wh[j & 1][ct], xh, a, 0, 0, 0); a = __builtin_amdgcn_mfma_f32_16x16x32_bf16(wh[j & 1][ct], xl, a, 0, 0, 0); a = __builtin_amdgcn_mfma_f32_16x16x32_bf16(wl[j & 1][ct], xh, a, 0, 0, 0);
                    acc[ct] = a; }
                __builtin_amdgcn_sched_barrier(0);
            }
        }
#undef RT_WLOAD
#pragma unroll
        for (int ct = 0; ct < 5; ++ct) *(LAS f32x4*)(L + RT_PART + ((w * 5 + ct) * 64 + lane) * 16) = acc[ct];
        __syncthreads();
        if (F.tid < 320) { const int ct = F.tid >> 6, l = F.tid & 63; f32x4 s = {0.f, 0.f, 0.f, 0.f};
#pragma unroll
            for (int ww = 0; ww < 8; ++ww) s += *(const LAS f32x4*)(L + RT_PART + ((ww * 5 + ct) * 64 + l) * 16);
            const int tok = l & 15, col = ct * 16 + (l >> 4) * 4;
            LAS float* lg = (LAS float*)(L + RT_LG) + tok * 80 + col; lg[0] = s[0]; lg[1] = s[1]; lg[2] = s[2]; lg[3] = s[3]; }
        __syncthreads();
        if (F.tid < 16) {
            const int m = blk * 16 + F.tid; const LAS float* lgp = (const LAS float*)(L + RT_LG) + F.tid * 80;
            float lg[8];
#pragma unroll
            for (int g = 0; g < 8; ++g) lg[g] = lgp[g] + brg[g];
            int gi = 0; float gmax = lg[0];
#pragma unroll
            for (int g = 1; g < 8; ++g) if (lg[g] > gmax) { gmax = lg[g]; gi = g; }
            float gz = 0.f;
#pragma unroll
            for (int g = 0; g < 8; ++g) gz += __expf(lg[g] - gmax);
            const float gp = 1.f / gz;
            float el[8];
#pragma unroll
            for (int i = 0; i < 8; ++i) el[i] = lgp[8 + gi * 8 + i] + bre[gi * 8 + i];
            int i0 = 0; float e0 = el[0];
#pragma unroll
            for (int i = 1; i < 8; ++i) if (el[i] > e0) { e0 = el[i]; i0 = i; }
            int i1 = -1; float e1 = -INFINITY;
#pragma unroll
            for (int i = 0; i < 8; ++i) if (i != i0 && el[i] > e1) { e1 = el[i]; i1 = i; }
            const float x1 = __expf(e1 - e0), w0 = gp / (1.f + x1), w1 = gp * x1 / (1.f + x1);
            const int ea = gi * 8 + i0, eb = gi * 8 + i1;
            const unsigned pa = atomicAdd(cnt + ea, 1u), pb = atomicAdd(cnt + eb, 1u);
            list[(size_t)ea * CAP + pa] = m * 2; list[(size_t)eb * CAP + pb] = m * 2 + 1;
            tokE[m * 2] = ea; tokE[m * 2 + 1] = eb; tokP[m * 2] = (int)pa; tokP[m * 2 + 1] = (int)pb; tokW[m * 2] = w0; tokW[m * 2 + 1] = w1;
        }
    }
}

static_assert(NEXP == 64, "one wave = one lane per expert");
__device__ __forceinline__ int lane_excl_prefix(int v, int lane) {
    int s = 0;
#pragma unroll
    for (int e = 0; e < 64; ++e) { const int c = __builtin_amdgcn_readlane(v, e); s += (e < lane) ? c : 0; }
    return s; }
__device__ __forceinline__ void expert_offsets(const unsigned* cnt, LAS int* offs, LAS int* raw, int tid) {
    asm volatile("" : "+v"(tid));
    if (tid < NEXP) { const int mine = (int)__hip_atomic_load(cnt + tid, __ATOMIC_RELAXED, __HIP_MEMORY_SCOPE_AGENT); const int s = lane_excl_prefix(mine, tid);
        offs[tid] = s; if (tid == NEXP - 1) offs[NEXP] = s + mine; }
    __syncthreads();
}
constexpr int MOE_RCH = 512;
constexpr int MOE_ROWP = 2 * MOE_RCH * 128 + 2 * 64 * 144, MOE_TAB = MOE_ROWP + MOE_RCH * 4, MOE_END = MOE_TAB + 4 * 68 * 4;
static_assert(MOE_END <= RING_BYTES, "moe LDS");
__device__ __forceinline__ const float* uniform_ptr(const float* p) {
    const unsigned long long v = (unsigned long long)p; const unsigned lo = __builtin_amdgcn_readfirstlane((unsigned)v), hi = __builtin_amdgcn_readfirstlane((unsigned)(v >> 32));
    return (const float*)(((unsigned long long)hi << 32) | lo); }
template <int MODE> __device__ __forceinline__ void moe_gemm_pc(Frame& F, const float* const* in, bool tables_ready) {
    constexpr int KD = MODE == 1 ? DM : EFF, NSTEP = KD / 64, ABYTES = 256 * 128, BBYTES = 128 * 128;
    constexpr int bld = MODE == 1 ? EFF : DM, APITCH = (MODE == 1 ? U2P : ACTP) * 2; constexpr size_t out_ld = MODE == 1 ? ACTP : DM;
    static_assert(NSTEP % 2 == 0 && NSTEP >= 8, "steps");
    const bf16* Asrc = (const bf16*)(F.ws + (MODE == 1 ? WS_U2 : WS_ACT));
    const float* Wg = in[31]; const float* Wu = in[32]; const float* Wd = in[33];
    bf16* ACT = (bf16*)(F.ws + WS_ACT); bf16* YS = (bf16*)(F.ws + WS_YS);
    const int* list = (const int*)(F.ws + WS_LIST); const unsigned* cnt = (const unsigned*)(F.ctl + CW_CNT);
    LAS unsigned char* L = F.lds; LAS int* rowp = (LAS int*)(L + MOE_ROWP);
    LAS int* offs = (LAS int*)(L + MOE_TAB); LAS int* srt = offs + 68; LAS int* ust = srt + 68; LAS int* raw = ust + 68;
    int tid_ = F.tid; asm volatile("" : "+v"(tid_));
    const int tid = tid_, w = F.wave;
    if (!tables_ready) {
    if (tid < NEXP) {
        const int mine = (int)__hip_atomic_load(cnt + tid, __ATOMIC_RELAXED, __HIP_MEMORY_SCOPE_AGENT); int s = 0, rank = 0;
#pragma unroll
        for (int e = 0; e < NEXP; ++e) { const int c = __builtin_amdgcn_readlane(mine, e); s += (e < tid) ? c : 0; rank += (c > mine || (c == mine && e < tid)) ? 1 : 0; }
        offs[tid] = s; if (tid == NEXP - 1) offs[NEXP] = s + mine;
        const int pos = rank < NEXP / 2 ? 2 * rank : 2 * (NEXP - 1 - rank) + 1;
        srt[pos] = tid; raw[pos] = 16 * ((mine + 255) >> 8);
        __builtin_amdgcn_s_waitcnt(0xc07f);
        const int u = raw[tid]; const int su = lane_excl_prefix(u, tid);
        ust[tid] = su; if (tid == NEXP - 1) ust[NEXP] = su + u; }
    __syncthreads();
    }
    const int NU = ust[NEXP];
    int un = F.vcu;
    if (un >= NU) return;
#define MOE_DECODE(un_, e_, ct_, r0_, nrows_, slot0_) do { const int pos_ = __popcll(__ballot(F.lane >= 1 && ust[F.lane] <= (un_))); \
        e_ = srt[pos_]; const int ul_ = (un_) - ust[pos_], cnt_ = offs[e_ + 1] - offs[e_]; slot0_ = offs[e_]; const int nch_ = (cnt_ + 255) >> 8; \
        ct_ = ul_ / nch_; r0_ = (ul_ - ct_ * nch_) * 256; nrows_ = (cnt_ - r0_) < 256 ? (cnt_ - r0_) : 256; } while (0)
#define MOE_BBASE(e_, ct_) uniform_ptr(MODE == 1 ? ((w & 2) ? Wu : Wg) + (size_t)(e_) * DM * EFF + (ct_) * 64 : Wd + (size_t)(e_) * EFF * DM + (ct_) * 128)
#define MOE_ROWOF(e_, r0_, nrows_, slot0_, t_) ((MODE == 1) ? (list[(size_t)(e_) * CAP + (r0_) + ((t_) < (nrows_) ? (t_) : 0)] >> 1) : ((slot0_) + (r0_) + ((t_) < (nrows_) ? (t_) : 0)))
    if (w >= 4) {
        const int t8 = tid & 255;
        int kc, gcol, bcol;
        if (MODE == 1) { const int t7 = tid & 127; kc = t7 >> 4; gcol = (t7 & 15) * 4; bcol = ((w >> 1) & 1) * 64 + gcol; }
        else { kc = t8 >> 5; gcol = (t8 & 31) * 4; bcol = gcol; }
        const int bvoff = (kc * 8 * bld + gcol) * 4;
        int e, ct, r0, nrows, slot0; MOE_DECODE(un, e, ct, r0, nrows, slot0);
        rowp[t8] = MOE_ROWOF(e, r0, nrows, slot0, t8);
        __syncthreads();
        const __amdgpu_buffer_rsrc_t rsA = __builtin_amdgcn_make_buffer_rsrc((void*)Asrc, 0, 0x7fffffff, 0x00020000);
        __amdgpu_buffer_rsrc_t rsB = __builtin_amdgcn_make_buffer_rsrc((void*)MOE_BBASE(e, ct), 0, 0x7fffffff, 0x00020000);
        int avoff[8];
#define PC_AVOFF(PB) do { _Pragma("unroll") for (int i = 0; i < 8; ++i) { const int q = t8 + i * 256; avoff[i] = rowp[(PB) * 256 + (q >> 3)] * APITCH + (q & 7) * 16; } } while (0)
        PC_AVOFF(0);
        v4u areg[8]; f32x4 breg[2][8];
#define PC_ALOAD(st) do { _Pragma("unroll") for (int i = 0; i < 8; ++i) areg[i] = __builtin_bit_cast(v4u, __builtin_amdgcn_raw_buffer_load_b128(rsA, avoff[i], (st) * 128, 0)); } while (0)
#define PC_BLOAD(st, S) do { _Pragma("unroll") for (int j = 0; j < 8; ++j) breg[S][j] = __builtin_bit_cast(f32x4, __builtin_amdgcn_raw_buffer_load_b128(rsB, bvoff, ((st) * 64 + j) * bld * 4, 0)); } while (0)
#define PC_WRITE(st, SB) do { \
        const int wb = (st) & 1; LAS unsigned char* Aw = L + wb * ABYTES; LAS unsigned char* Bw = L + 2 * ABYTES + wb * BBYTES; \
        _Pragma("unroll") for (int i = 0; i < 8; ++i) { const int q = t8 + i * 256, r = q >> 3; *(LAS v4u*)(Aw + r * 128 + 16 * ((q & 7) ^ (r & 7))) = areg[i]; } \
        _Pragma("unroll") for (int c = 0; c < 4; ++c) { v4u pw; pw.x = pk2(breg[SB][0][c], breg[SB][1][c]); pw.y = pk2(breg[SB][2][c], breg[SB][3][c]); pw.z = pk2(breg[SB][4][c], breg[SB][5][c]); pw.w = pk2(breg[SB][6][c], breg[SB][7][c]); \
            *(LAS v4u*)(Bw + (bcol + c) * 128 + 16 * (kc ^ (((bcol + c) ^ (bcol >> 2)) & 7))) = pw; } } while (0)
        PC_ALOAD(0); PC_BLOAD(0, 0); PC_BLOAD(1, 1);
        PC_WRITE(0, 0); PC_ALOAD(1); PC_BLOAD(2, 0);
        int pb = 0;
        while (true) {
            const int unn = un + F.G; const bool hasn = unn < NU;
            int e2 = 0, ct2 = 0, r02 = 0, nrows2 = 0, slot02 = 0, rp2 = 0;
            if (hasn) { MOE_DECODE(unn, e2, ct2, r02, nrows2, slot02); rp2 = MOE_ROWOF(e2, r02, nrows2, slot02, t8); }
#pragma unroll 1
            for (int st = 0; st < NSTEP - 4; st += 2) {
                __syncthreads(); PC_WRITE(st + 1, 1); PC_ALOAD(st + 2); PC_BLOAD(st + 3, 1); __builtin_amdgcn_sched_barrier(0);
                __syncthreads(); PC_WRITE(st + 2, 0); PC_ALOAD(st + 3); PC_BLOAD(st + 4, 0); __builtin_amdgcn_sched_barrier(0);
            }
            __syncthreads(); PC_WRITE(NSTEP - 3, 1); PC_ALOAD(NSTEP - 2); PC_BLOAD(NSTEP - 1, 1); rowp[(pb ^ 1) * 256 + t8] = rp2; __builtin_amdgcn_sched_barrier(0);
            __syncthreads(); PC_WRITE(NSTEP - 2, 0); PC_ALOAD(NSTEP - 1);
            if (hasn) { rsB = __builtin_amdgcn_make_buffer_rsrc((void*)MOE_BBASE(e2, ct2), 0, 0x7fffffff, 0x00020000); PC_BLOAD(0, 0); }
            __builtin_amdgcn_sched_barrier(0);
            __syncthreads(); PC_WRITE(NSTEP - 1, 1);
            if (hasn) { PC_AVOFF(pb ^ 1); PC_ALOAD(0); PC_BLOAD(1, 1); }
            __builtin_amdgcn_sched_barrier(0);
            __syncthreads();
            if (!hasn) break;
            PC_WRITE(0, 0); PC_ALOAD(1); PC_BLOAD(2, 0); __builtin_amdgcn_sched_barrier(0);
            un = unn; pb ^= 1;
        }
#undef PC_AVOFF
#undef PC_ALOAD
#undef PC_BLOAD
#undef PC_WRITE
    } else {
        int fr = tid & 15, fq = (tid >> 4) & 3;
        __syncthreads();
        while (true) {
            int e, ct, r0, nrows, slot0; MOE_DECODE(un, e, ct, r0, nrows, slot0);
            bf16* outp = (MODE == 1) ? ACT + (size_t)(slot0 + r0) * ACTP + ct * 64 : YS + (size_t)(slot0 + r0) * DM + ct * 128;
            f32x4 acc[4][8];
#pragma unroll
            for (int a = 0; a < 4; ++a)
#pragma unroll
                for (int n = 0; n < 8; ++n) acc[a][n] = (f32x4){0.f, 0.f, 0.f, 0.f};
            bf16x8 af0[4], af1[4], bfr[8];
#pragma unroll
            for (int a = 0; a < 4; ++a) af1[a] = (bf16x8){0, 0, 0, 0, 0, 0, 0, 0};
#pragma unroll
            for (int n = 4; n < 8; ++n) bfr[n] = (bf16x8){0, 0, 0, 0, 0, 0, 0, 0};
#define PC_SB() __builtin_amdgcn_sched_barrier(0)
#define PC_RDA(ks, a) (*(const LAS bf16x8*)(As + ((w + 4 * (a)) * 16 + fr) * 128 + 16 * (((ks) * 4 + fq) ^ (fr & 7))))
#define PC_RDB(ks, n) (*(const LAS bf16x8*)(Bs + ((n) * 16 + fr) * 128 + 16 * (((ks) * 4 + fq) ^ ((fr ^ (((n) & 1) * 4 + (fr >> 2))) & 7))))
#define PC_MM(AF, N0) do { _Pragma("unroll") for (int n = (N0); n < (N0) + 4; ++n) _Pragma("unroll") for (int a = 0; a < 4; ++a) acc[a][n] = __builtin_amdgcn_mfma_f32_16x16x32_bf16(bfr[n], AF[a], acc[a][n], 0, 0, 0); } while (0)
#define PC_COMPUTE(st) do { \
            const int buf = (st) & 1; const LAS unsigned char* As = L + buf * ABYTES; const LAS unsigned char* Bs = L + 2 * ABYTES + buf * BBYTES; \
            _Pragma("unroll") for (int a = 0; a < 4; ++a) af0[a] = PC_RDA(0, a); \
            _Pragma("unroll") for (int n = 0; n < 4; ++n) bfr[n] = PC_RDB(0, n); \
            PC_SB(); PC_MM(af1, 4); PC_SB();                                     \
            _Pragma("unroll") for (int n = 4; n < 8; ++n) bfr[n] = PC_RDB(0, n); \
            _Pragma("unroll") for (int a = 0; a < 4; ++a) af1[a] = PC_RDA(1, a); \
            PC_SB(); PC_MM(af0, 0); PC_SB();                                     \
            _Pragma("unroll") for (int n = 0; n < 4; ++n) bfr[n] = PC_RDB(1, n); \
            PC_SB(); PC_MM(af0, 4); PC_SB();                                     \
            _Pragma("unroll") for (int n = 4; n < 8; ++n) bfr[n] = PC_RDB(1, n); \
            PC_SB(); PC_MM(af1, 0); PC_SB();                                     \
            } while (0)
#pragma unroll 1
            for (int st = 0; st < NSTEP; st += 2) {
                asm volatile("" : "+v"(fr), "+v"(fq));
                __syncthreads(); PC_COMPUTE(st);
                __syncthreads(); PC_COMPUTE(st + 1);
            }
            PC_MM(af1, 4);
#undef PC_COMPUTE
#undef PC_MM
#undef PC_RDA
#undef PC_RDB
#undef PC_SB
#pragma unroll
            for (int a = 0; a < 4; ++a) { const int r = (w + 4 * a) * 16 + fr; bf16* orow = outp + (size_t)r * out_ld + (fq & 1) * 16 + (fq >> 1) * 8;
                constexpr int NP = MODE == 1 ? 4 : 8; uint2 pw[NP];
                if (MODE == 1) {
#pragma unroll
                    for (int n = 0; n < 4; ++n) { const f32x4 g = acc[a][n], uu = acc[a][n + 4]; float o[4];
#pragma unroll
                        for (int x = 0; x < 4; ++x) o[x] = g[x] * __builtin_amdgcn_rcpf(1.f + __expf(-g[x])) * uu[x];
                        pw[n].x = pk2(o[0], o[1]); pw[n].y = pk2(o[2], o[3]); }
                } else {
#pragma unroll
                    for (int n = 0; n < 8; ++n) { const f32x4 o = acc[a][n]; pw[n].x = pk2(o[0], o[1]); pw[n].y = pk2(o[2], o[3]); }
                }
#pragma unroll
                for (int n = 0; n < NP; n += 2) {
                    const auto sx = __builtin_amdgcn_permlane16_swap(pw[n].x, pw[n + 1].x, false, false), sy = __builtin_amdgcn_permlane16_swap(pw[n].y, pw[n + 1].y, false, false);
                    if (r < nrows) { v4u q4; q4.x = sx[0]; q4.y = sy[0]; q4.z = sx[1]; q4.w = sy[1]; *(v4u*)(orow + n * 16) = q4; } }
            }
            un += F.G; if (un >= NU) break;
        }
    }
#undef MOE_DECODE
#undef MOE_BBASE
#undef MOE_ROWOF
}

__device__ __forceinline__ void p14_final(Frame& F, const float* const* in, float* out) {
    const float* H1 = (const float*)(F.ws + WS_H1); const bf16* YS = (const bf16*)(F.ws + WS_YS); const float* ada = (const float*)(F.ws + WS_ADA); const float* fg = in[34];
    const int* tokE = (const int*)(F.ws + WS_TOKE); const int* tokP = (const int*)(F.ws + WS_TOKP); const float* tokW = (const float*)(F.ws + WS_TOKW);
    const unsigned* cnt = (const unsigned*)(F.ctl + CW_CNT);
    LAS int* offs = (LAS int*)F.lds;
    expert_offsets(cnt, offs, offs + 128, F.tid);
    const int gw = F.vcu * NWAVES + F.wave, NGW = F.G * NWAVES, lane = F.lane;
    for (int m0 = gw; m0 < M; m0 += 2 * NGW) {
        int mm[2], sa[2], sb[2]; float wa[2], wb[2];
#pragma unroll
        for (int r = 0; r < 2; ++r) { const int m = m0 + r * NGW < M ? m0 + r * NGW : m0; mm[r] = m;
            sa[r] = offs[tokE[m * 2]] + tokP[m * 2]; sb[r] = offs[tokE[m * 2 + 1]] + tokP[m * 2 + 1]; wa[r] = tokW[m * 2]; wb[r] = tokW[m * 2 + 1]; }
        f32x4 v[2][8]; float s2[2] = {0.f, 0.f};
#pragma unroll
        for (int r = 0; r < 2; ++r) { const float* gt2 = ada + (size_t)(mm[r] / SEQ) * 12288 + 10240;
            const uint2* y0 = (const uint2*)(YS + (size_t)sa[r] * DM) + lane; const uint2* y1 = (const uint2*)(YS + (size_t)sb[r] * DM) + lane;
            const f32x4* hr = (const f32x4*)(H1 + (size_t)mm[r] * DM) + lane;
#pragma unroll
            for (int j = 0; j < 8; ++j) { const uint2 a = y0[64 * j], c = y1[64 * j]; const f32x4 g = ((const f32x4*)gt2)[lane + 64 * j]; const float w0 = wa[r], w1 = wb[r];
                f32x4 mo; mo[0] = w0 * bflo(a.x) + w1 * bflo(c.x); mo[1] = w0 * bfhi(a.x) + w1 * bfhi(c.x); mo[2] = w0 * bflo(a.y) + w1 * bflo(c.y); mo[3] = w0 * bfhi(a.y) + w1 * bfhi(c.y);
                v[r][j] = hr[64 * j] + g * mo; s2[r] += (v[r][j].x * v[r][j].x + v[r][j].y * v[r][j].y) + (v[r][j].z * v[r][j].z + v[r][j].w * v[r][j].w); } }
#pragma unroll
        for (int r = 0; r < 2; ++r) { if (r == 1 && m0 + NGW >= M) break;
            const float rstd = 1.f / sqrtf(wave_sum(s2[r]) * (1.f / DM) + NORM_EPS);
            f32x4* orow = (f32x4*)(out + (size_t)mm[r] * DM) + lane;
#pragma unroll
            for (int j = 0; j < 8; ++j) orow[64 * j] = v[r][j] * rstd * ((const f32x4*)fg)[lane + 64 * j]; }
    }
}

struct Args { const float* in[35]; float* out; unsigned char* ws; int ph_lo, ph_hi, use_bar, pad; };
__global__ void __launch_bounds__(NTHR, 2) fwd_kernel(Args args) {
    extern __shared__ __attribute__((aligned(16))) unsigned char lds[];
    Frame F;
    F.lds = (LAS unsigned char*)lds; F.MISC = (volatile LAS unsigned*)(F.lds + MISC_OFF);
    F.tid = threadIdx.x; F.lane = F.tid & 63; F.wave = __builtin_amdgcn_readfirstlane(F.tid >> 6);
    F.G = gridDim.x; { const int bx = blockIdx.x; F.vcu = (F.G % 8 == 0) ? (bx % 8) * (F.G / 8) + bx / 8 : bx; }
    F.ws = args.ws; F.ctl = (gu32*)(args.ws + WS_CTL); F.probe = args.pad;
    for (int u = F.tid; u < (LDS_BYTES - LDSCTL_OFF) / 4; u += NTHR) ((LAS unsigned*)(F.lds + LDSCTL_OFF))[u] = 0u;
    __syncthreads();
    XcdBarrier bar; bar.bar = (unsigned*)(F.ctl + CW_BAR); bar.x = 0; bar.st = nullptr;
    if (args.use_bar) bar = xcd_barrier_post((unsigned*)(F.ctl + CW_BAR), F.MISC + 8);
    const int lo = args.ph_lo, hi = args.ph_hi;
    const float* const* in = args.in;
#ifndef PHASE_MASK
#define PHASE_MASK 0xFFFF
#endif
#define IN(k) ((((PHASE_MASK) >> (k)) & 1) && lo <= (k) && (k) < hi)
#define SEAM(k) do { if (IN(k) && IN((k) + 1)) xcd_barrier(bar); } while (0)
#ifndef PROBE_REPEAT_MASK
#define PROBE_REPEAT_MASK 0
#endif
#define REPS(k) for (int rep_ = 0; rep_ < 1 + (((PROBE_REPEAT_MASK) >> (k)) & 1); ++rep_, (rep_ < 1 + (((PROBE_REPEAT_MASK) >> (k)) & 1)) ? xcd_barrier(bar) : (void)0)
    const float* ada = (const float*)(F.ws + WS_ADA);

    if (IN(0)) REPS(0) { p0_prologue(F, in); } SEAM(0);
    if (IN(1)) REPS(1) {
        const int gw = F.vcu * NWAVES + F.wave, NGW = F.G * NWAVES; bf16* U = (bf16*)(F.ws + WS_U);
        for (int m = gw; m < M; m += 2 * NGW) { const int m2 = m + NGW < M ? m + NGW : m; const float* ad = ada + (size_t)(m / SEQ) * 12288; const float* ad2 = ada + (size_t)(m2 / SEQ) * 12288;
            norm_mod_row2(in[0] + (size_t)m * DM, in[0] + (size_t)m2 * DM, in[5], ad + 2048, ad, ad2 + 2048, ad2, U + (size_t)m * DM, U + (size_t)m2 * DM, F.lane); }
    } SEAM(1);
    if (IN(2)) REPS(2) {
        pg8::Gemm g{(const pg8::bf16_t*)(F.ws + WS_U), (const pg8::bf16_t*)(F.ws + WS_WIN_T), M, IN_COLS - 256, DM}; pg8::StaticOrder S; S.init(M, IN_COLS - 256, F.G, (int)blockIdx.x);
        pg8::EpiIn E{F.ws, (const float*)(F.ws + WS_ROPE), 0};
        pg8::gemm_phase<pg8::EpiIn, pg8::StaticOrder, PG8_ALIGN, PG8_SP2>(F.lds + RING_OFF, g, S, E);
    } SEAM(2);
    if (IN(5)) REPS(5) {
        const attn_body::AttnTensors AT{(const attn_body::bf16*)(F.ws + WS_Q), (const attn_body::bf16*)(F.ws + WS_K), (const attn_body::bf16*)(F.ws + WS_V), (attn_body::bf16*)(F.ws + WS_O0), (attn_body::bf16*)(F.ws + WS_O1)};
        const attn_body::StaticOrder S((int)F.G, F.vcu);
        attn_body::attn_phase<attn_body::StaticOrder>((char*)lds + RING_OFF, AT, S);
        __syncthreads();
    }
#if RWKV_SEQ
    if (IN(3)) REPS(3) { p3_rwkv_prep(F, in); } SEAM(3);
    if (IN(4)) REPS(4) { p4_rwkv_scan(F); } SEAM(4);
#else
    if (IN(3)) REPS(3) {
        {
            pg8::Gemm g{(const pg8::bf16_t*)(F.ws + WS_U), (const pg8::bf16_t*)(F.ws + WS_WIN_T) + (size_t)(IN_COLS - 256) * DM, M, 256, DM}; pg8::StaticOrder S; S.init(M, 256, F.G, (int)blockIdx.x);
            pg8::EpiIn E{F.ws, (const float*)(F.ws + WS_ROPE), 40};
            pg8::gemm_phase<pg8::EpiIn, pg8::StaticOrder, PG8_ALIGN, PG8_SP2>(F.lds + RING_OFF, g, S, E);
        }
        p3_rwkv_chunk(F, in); } SEAM(3);
    if (IN(4)) REPS(4) {
        p4_rwkv_chain(F);
        constexpr int NJ = BATCH * 16 * 4;
        const int first = (int)F.G > NJ ? NJ : 0;
        if ((int)blockIdx.x >= first) { __syncthreads(); p4_late_copies(F, in, ((int)blockIdx.x - first) * NWAVES + F.wave, ((int)F.G - first) * NWAVES);
            p6_attn_combine(F, in, ((int)blockIdx.x - first) * NWAVES + F.wave, ((int)F.G - first) * NWAVES); }
    } SEAM(4);
#endif
    if (IN(6)) REPS(6) { p6_combine(F, in); } SEAM(6);
    if (IN(7)) REPS(7) {
        pg8::Gemm g{(const pg8::bf16_t*)(F.ws + WS_YATT), (const pg8::bf16_t*)(F.ws + WS_WUPA_T), M, DM, ATT_W}; pg8::StaticOrder S; S.init(M, DM, F.G, (int)blockIdx.x);
        pg8::EpiPair E{(const pg8::bf16_t*)(F.ws + WS_G), (pg8::bf16_t*)(F.ws + WS_MERGED)};
        pg8::gemm_phase_pair<pg8::EpiPair, pg8::StaticOrder, PG8_ALIGN, PG8_SP2>(F.lds + RING_OFF, g, (const pg8::bf16_t*)(F.ws + WS_YRW), (const pg8::bf16_t*)(F.ws + WS_WUPB_T), S, E);
    } SEAM(7);
    if (IN(8)) REPS(8) { }
    if (IN(9)) REPS(9) {
        pg8::Gemm g{(const pg8::bf16_t*)(F.ws + WS_MERGED), (const pg8::bf16_t*)(F.ws + WS_WOUT_T), M, DM, DM}; pg8::StaticOrder S; S.init(M, DM, F.G, (int)blockIdx.x);
        pg8::EpiH1 E{in[0], ada, (float*)(F.ws + WS_H1)};
        pg8::gemm_phase<pg8::EpiH1, pg8::StaticOrder, PG8_ALIGN, PG8_SP2>(F.lds + RING_OFF, g, S, E);
    } SEAM(9);
    if (IN(10)) REPS(10) { p10_route(F, in); } SEAM(10);
    if (IN(11)) REPS(11) { moe_gemm_pc<1>(F, in, false); } SEAM(11);
    if (IN(12)) REPS(12) { moe_gemm_pc<2>(F, in, IN(11)); } SEAM(12);
    if (IN(13)) REPS(13) { p14_final(F, in, args.out); }
#undef IN
#undef SEAM
}

extern "C" void kernel_launch(void* const* d_in, const int* in_sizes, int n_in, void* d_out, int out_size, void* d_ws, size_t ws_size, hipStream_t stream) {
    static int grid = 0;
    if (grid == 0) {
        if (n_in != 35 || out_size != M * DM || ws_size < WS_END) { fprintf(stderr, "kernel_launch: unexpected shapes (n_in %d out %d ws %zu)\n", n_in, out_size, ws_size); grid = -1; return; }
        int dev = 0, cus = 0;
        if (hipGetDevice(&dev) != hipSuccess || hipDeviceGetAttribute(&cus, hipDeviceAttributeMultiprocessorCount, dev) != hipSuccess) { grid = -1; return; }
        if (hipFuncSetAttribute((const void*)fwd_kernel, hipFuncAttributeMaxDynamicSharedMemorySize, LDS_BYTES) != hipSuccess) { fprintf(stderr, "kernel_launch: hipFuncSetAttribute failed\n"); grid = -1; return; }
        int per_cu = 0; (void)hipOccupancyMaxActiveBlocksPerMultiprocessor(&per_cu, (const void*)fwd_kernel, NTHR, LDS_BYTES); (void)hipGetLastError();
        if (per_cu < 1) fprintf(stderr, "kernel_launch: occupancy query says %d\n", per_cu);
        grid = cus;
    }
    if (grid < 0) return;
    (void)hipMemsetAsync((char*)d_ws + WS_CTL, 0, CTL_ZERO_BYTES, stream);
    Args a{};
    for (int i = 0; i < 35; ++i) a.in[i] = (const float*)d_in[i];
    a.out = (float*)d_out; a.ws = (unsigned char*)d_ws; a.pad = 0;
#if MK_ONE_LAUNCH
    a.ph_lo = 0; a.ph_hi = 14; a.use_bar = 1;
    hipLaunchKernelGGL(fwd_kernel, dim3(grid), dim3(NTHR), LDS_BYTES, stream, a);
#ifdef PROBE_PHASE
    a.ph_lo = PROBE_PHASE; a.ph_hi = PROBE_PHASE + 1; a.use_bar = 0; a.pad = 1;
    (void)hipMemsetAsync((char*)d_ws + WS_CTL + CW_P3Q * 4, 0, 16, stream);
    hipLaunchKernelGGL(fwd_kernel, dim3(grid), dim3(NTHR), LDS_BYTES, stream, a);
#endif
#else
    for (int p = 0; p < 14; ++p) { a.ph_lo = p; a.ph_hi = p + 1; a.use_bar = 0;
        hipLaunchKernelGGL(fwd_kernel, dim3(grid), dim3(NTHR), LDS_BYTES, stream, a); }
#endif
}
```
